# Optimizing an MI355X kernel written in HIP

```python
import math
import jax, jax.numpy as jnp
from jax import lax
import numpy as np

D_MODEL = 1024
BATCH = 16
SEQ = 4096
DEPTH = 2
DEC_BATCH = 2
DEC_SEQ = 8192
PAST_LEN = 128

GRID_W = 64
N_Q_HEADS = 16
N_KV_HEADS = 4
HEAD_DIM = 64
Q_BLOCK = 128
ROPE_THETA = 10000.0
AXIS_DIM = HEAD_DIM // 2
Q_WIDTH = N_Q_HEADS * HEAD_DIM
KV_WIDTH = N_KV_HEADS * HEAD_DIM
SSM_WIDTH = 512
SSM_GROUP = 16
N_SSM_GROUPS = SSM_WIDTH // SSM_GROUP
SSM_STATE = 64
N_DIRECTIONS = 2
STEP_MIN = 1e-3
STEP_MAX = 1e-1
D_FF = 4 * D_MODEL
EPS = 1e-6
IN_WIDTH = Q_WIDTH + 2 * KV_WIDTH + SSM_WIDTH + 2 * D_MODEL
SPLIT_POINTS = (
    Q_WIDTH,
    Q_WIDTH + KV_WIDTH,
    Q_WIDTH + 2 * KV_WIDTH,
    Q_WIDTH + 2 * KV_WIDTH + SSM_WIDTH,
    Q_WIDTH + 2 * KV_WIDTH + SSM_WIDTH + D_MODEL,
)

kernel_name = "hybrid_gated_s5_axial_gqa_encoder"


def rms_norm(x, gain):
    xf = x.astype(jnp.float32)
    xf = xf * lax.rsqrt(jnp.mean(xf * xf, axis=-1, keepdims=True) + EPS)
    return (xf * gain.astype(jnp.float32)).astype(x.dtype)


def axial_rope_tables(seq_len):
    rows = seq_len // GRID_W
    row_idx = jnp.broadcast_to(jnp.arange(rows)[:, None], (rows, GRID_W)).reshape(seq_len)
    col_idx = jnp.broadcast_to(jnp.arange(GRID_W)[None, :], (rows, GRID_W)).reshape(seq_len)
    inv_freq = ROPE_THETA ** (-jnp.arange(0, AXIS_DIM, 2, dtype=jnp.float32) / AXIS_DIM)
    ang_r = row_idx.astype(jnp.float32)[:, None] * inv_freq[None, :]
    ang_c = col_idx.astype(jnp.float32)[:, None] * inv_freq[None, :]
    ang = jnp.concatenate([ang_r, ang_c], axis=-1)
    return jnp.cos(ang), jnp.sin(ang)


def apply_axial_rope(x, cos, sin):
    xf = x.astype(jnp.float32).reshape(*x.shape[:-1], HEAD_DIM // 2, 2)
    x1, x2 = xf[..., 0], xf[..., 1]
    c = cos[:, None, :]
    s = sin[:, None, :]
    out = jnp.stack([x1 * c - x2 * s, x1 * s + x2 * c], axis=-1).reshape(x.shape)
    return out.astype(x.dtype)


def gqa_attention(q, k, v):
    b, l = q.shape[0], q.shape[1]
    rep = N_Q_HEADS // N_KV_HEADS
    n_blocks = l // Q_BLOCK
    qb = q.reshape(b, n_blocks, Q_BLOCK, N_KV_HEADS, rep, HEAD_DIM).transpose(1, 0, 2, 3, 4, 5)
    scale = HEAD_DIM ** -0.5

    def block(q_blk):
        s = jnp.einsum("bqgrd,bkgd->bgrqk", q_blk, k,
                       preferred_element_type=jnp.float32) * scale
        p = jax.nn.softmax(s, axis=-1)
        return jnp.einsum("bgrqk,bkgd->bqgrd", p.astype(v.dtype), v)

    o = lax.map(block, qb)
    return o.transpose(1, 0, 2, 3, 4, 5).reshape(b, l, Q_WIDTH)


def _linear_recurrence(e1, e2):
    a1, x1 = e1
    a2, x2 = e2
    return a1 * a2, a2 * x1 + x2


def s5_bidirectional(u, lam_re, lam_im, log_step, b_re, b_im, c_re, c_im, d_skip):
    bsz, l, _ = u.shape
    uf = u.astype(jnp.float32).reshape(bsz, l, N_SSM_GROUPS, SSM_GROUP)
    lam = lax.complex(lam_re.astype(jnp.float32), lam_im.astype(jnp.float32))
    step = jnp.exp(log_step.astype(jnp.float32))
    lam_bar = jnp.exp(lam * step[..., None])
    b = lax.complex(b_re.astype(jnp.float32), b_im.astype(jnp.float32))
    b_bar = ((lam_bar - 1.0) / lam)[..., None] * b
    c = lax.complex(c_re.astype(jnp.float32), c_im.astype(jnp.float32))

    def one_sequence(useq):
        ucx = useq.astype(jnp.complex64)
        outs = []
        for direction, rev in ((0, False), (1, True)):
            bu = jnp.einsum("gpc,lgc->lgp", b_bar[direction], ucx)
            a = jnp.broadcast_to(lam_bar[direction], bu.shape)
            _, h = lax.associative_scan(_linear_recurrence, (a, bu), reverse=rev, axis=0)
            outs.append(jnp.einsum("gcp,lgp->lgc", c[direction], h).real)
        return outs[0] + outs[1]

    y = lax.map(one_sequence, uf)
    y = y + d_skip.astype(jnp.float32).reshape(N_SSM_GROUPS, SSM_GROUP) * uf
    return y.reshape(bsz, l, SSM_WIDTH).astype(u.dtype)


def encoder_layer(x, cos, sin, norm_mix, w_in, q_norm, k_norm, w_attn_proj,
                  lam_re, lam_im, log_step, b_re, b_im, c_re, c_im, d_skip,
                  w_glu_a, w_glu_b, w_out, norm_mlp, w_ff1, w_ff2):
    bsz, l, _ = x.shape
    xn = rms_norm(x, norm_mix)
    proj = xn @ w_in
    q, k, v, u, g_attn, g_ssm = jnp.split(proj, SPLIT_POINTS, axis=-1)

    q = rms_norm(q.reshape(bsz, l, N_Q_HEADS, HEAD_DIM), q_norm)
    k = rms_norm(k.reshape(bsz, l, N_KV_HEADS, HEAD_DIM), k_norm)
    q = apply_axial_rope(q, cos, sin)
    k = apply_axial_rope(k, cos, sin)
    v = v.reshape(bsz, l, N_KV_HEADS, HEAD_DIM)
    attn_out = gqa_attention(q, k, v) @ w_attn_proj

    y = jax.nn.gelu(s5_bidirectional(u, lam_re, lam_im, log_step, b_re, b_im, c_re, c_im, d_skip))
    ssm_out = (y @ w_glu_a) * jax.nn.sigmoid(y @ w_glu_b)

    merged = jax.nn.sigmoid(g_attn) * attn_out + jax.nn.sigmoid(g_ssm) * ssm_out
    x = x + merged @ w_out

    h = rms_norm(x, norm_mlp)
    x = x + jnp.square(jax.nn.relu(h @ w_ff1)) @ w_ff2
    return x


def setup_inputs(seed: int = 0) -> dict:
    key = jax.random.key(seed)
    ks = jax.random.split(key, 24)
    f32 = jnp.float32

    def normal(k, shape, scale):
        return jax.random.normal(k, shape, f32) * scale

    n_idx = jnp.arange(SSM_STATE, dtype=f32)
    lam_shape = (DEPTH, N_DIRECTIONS, N_SSM_GROUPS, SSM_STATE)
    return {
        "x_prompt": jax.random.normal(ks[0], (BATCH, SEQ, D_MODEL), f32),
        "x_sample": jax.random.normal(ks[1], (DEC_BATCH, DEC_SEQ, D_MODEL), f32),
        "norm_mix": 1.0 + normal(ks[2], (DEPTH, D_MODEL), 0.02),
        "w_in": normal(ks[3], (DEPTH, D_MODEL, IN_WIDTH), D_MODEL ** -0.5),
        "q_norm": 1.0 + normal(ks[4], (DEPTH, HEAD_DIM), 0.02),
        "k_norm": 1.0 + normal(ks[5], (DEPTH, HEAD_DIM), 0.02),
        "w_attn_proj": normal(ks[6], (DEPTH, Q_WIDTH, D_MODEL), Q_WIDTH ** -0.5),
        "ssm_lambda_re": -0.5 + normal(ks[7], lam_shape, 0.01),
        "ssm_lambda_im": math.pi * n_idx + normal(ks[8], lam_shape, 0.01),
        "ssm_log_step": jax.random.uniform(ks[9], (DEPTH, N_DIRECTIONS, N_SSM_GROUPS), f32,
                                           math.log(STEP_MIN), math.log(STEP_MAX)),
        "ssm_b_re": normal(ks[10], (DEPTH, N_DIRECTIONS, N_SSM_GROUPS, SSM_STATE, SSM_GROUP), SSM_GROUP ** -0.5),
        "ssm_b_im": normal(ks[11], (DEPTH, N_DIRECTIONS, N_SSM_GROUPS, SSM_STATE, SSM_GROUP), SSM_GROUP ** -0.5),
        "ssm_c_re": normal(ks[12], (DEPTH, N_DIRECTIONS, N_SSM_GROUPS, SSM_GROUP, SSM_STATE), SSM_STATE ** -0.5),
        "ssm_c_im": normal(ks[13], (DEPTH, N_DIRECTIONS, N_SSM_GROUPS, SSM_GROUP, SSM_STATE), SSM_STATE ** -0.5),
        "ssm_d": normal(ks[14], (DEPTH, SSM_WIDTH), 1.0),
        "w_glu_a": normal(ks[15], (DEPTH, SSM_WIDTH, D_MODEL), SSM_WIDTH ** -0.5),
        "w_glu_b": normal(ks[16], (DEPTH, SSM_WIDTH, D_MODEL), SSM_WIDTH ** -0.5),
        "w_out": normal(ks[17], (DEPTH, D_MODEL, D_MODEL), D_MODEL ** -0.5),
        "norm_mlp": 1.0 + normal(ks[18], (DEPTH, D_MODEL), 0.02),
        "w_ff1": normal(ks[19], (DEPTH, D_MODEL, D_FF), D_MODEL ** -0.5),
        "w_ff2": normal(ks[20], (DEPTH, D_FF, D_MODEL), D_FF ** -0.5),
    }


def reference(x_prompt, x_sample, norm_mix, w_in, q_norm, k_norm, w_attn_proj,
              ssm_lambda_re, ssm_lambda_im, ssm_log_step, ssm_b_re, ssm_b_im,
              ssm_c_re, ssm_c_im, ssm_d, w_glu_a, w_glu_b, w_out, norm_mlp, w_ff1, w_ff2):
    def trunk(x):
        cos, sin = axial_rope_tables(x.shape[1])
        for i in range(DEPTH):
            x = encoder_layer(
                x, cos, sin, norm_mix[i], w_in[i], q_norm[i], k_norm[i], w_attn_proj[i],
                ssm_lambda_re[i], ssm_lambda_im[i], ssm_log_step[i], ssm_b_re[i], ssm_b_im[i],
                ssm_c_re[i], ssm_c_im[i], ssm_d[i], w_glu_a[i], w_glu_b[i], w_out[i],
                norm_mlp[i], w_ff1[i], w_ff2[i])
        return x

    y_prompt = trunk(x_prompt)
    y_sample = trunk(x_sample)
    return (y_prompt, y_sample)
```

```cpp
#include <hip/hip_runtime.h>
#include <hip/hip_cooperative_groups.h>
#include <cstdio>
namespace cg = cooperative_groups;

typedef unsigned short u16;
typedef __attribute__((ext_vector_type(8))) short bf16x8;
typedef __attribute__((ext_vector_type(4))) float f32x4;
typedef __attribute__((ext_vector_type(16))) float f32x16;
typedef __attribute__((ext_vector_type(4))) unsigned u32x4;
typedef __attribute__((ext_vector_type(2))) unsigned u32x2;
typedef __attribute__((ext_vector_type(2))) float f32x2;
typedef __attribute__((ext_vector_type(2))) __bf16 bf16v2;

#define DI __device__ __forceinline__
#ifndef N_LAUNCH_MODE
#define N_LAUNCH_MODE 1
#endif

constexpr int NT = 81920;
constexpr int NTP = 65536;
constexpr int NCH = 2560;
constexpr int ASTR = 768;
constexpr int NPHASE = 22;
constexpr int LDS_BYTES = 131072;

constexpr size_t MiB = 1ull << 20;
constexpr size_t WS_WT_IN = 0;
constexpr size_t WS_WT_AP = 16 * MiB;
constexpr size_t WS_WT_GA = 20 * MiB;
constexpr size_t WS_WT_GB = 22 * MiB;
constexpr size_t WS_WT_OUT = 24 * MiB;
constexpr size_t WS_WT_FF1 = 28 * MiB;
constexpr size_t WS_WT_FF2 = 44 * MiB;
constexpr size_t WS_W1T = 60 * MiB;
constexpr size_t WS_WYT = 76 * MiB;
constexpr size_t WS_LPOW = 124 * MiB;
constexpr size_t WS_BBAR = 127 * MiB;
constexpr size_t WS_KTAB = 128 * MiB;
constexpr size_t WS_ROPE = 132 * MiB;
constexpr size_t WS_XN = 133 * MiB;
constexpr size_t WS_BIG = 293 * MiB;
constexpr size_t WS_Q = WS_BIG;
constexpr size_t WS_K = WS_BIG + 160 * MiB;
constexpr size_t WS_VT = WS_BIG + 200 * MiB;
constexpr size_t WS_ASSM = WS_BIG + 240 * MiB;
constexpr size_t WS_S = WS_BIG + 360 * MiB;
constexpr size_t WS_Y = WS_BIG + 440 * MiB;
constexpr size_t WS_ATTO = WS_BIG + 520 * MiB;
constexpr size_t WS_FF = WS_BIG;
constexpr size_t WS_END = WS_BIG + 680 * MiB;

struct P {
  const float* in[21];
  float* out;
  unsigned char* ws;
  int ph_lo, ph_hi;
};

DI u16 f2bf(float f) { unsigned u = __float_as_uint(f); u += 0x7fffu + ((u >> 16) & 1u); return (u16)(u >> 16); }
DI float bf2f(u16 h) { return __uint_as_float(((unsigned)h) << 16); }
DI unsigned pk2(float a, float b) {
  f32x2 v; v[0] = a; v[1] = b;
  bf16v2 r = __builtin_convertvector(v, bf16v2);
  return __builtin_bit_cast(unsigned, r);
}
DI float sigmoidf_(float x) { return 1.0f / (1.0f + __expf(-x)); }
DI float gelu_tanh(float x) {
  float z = 0.7978845608028654f * (x + 0.044715f * x * x * x);
  float e = __expf(2.0f * z);
  return 0.5f * x * (2.0f - 2.0f / (e + 1.0f));
}


DI void sincos_d(double x, double* sn, double* cs) {
  const double TWO_PI_HI = 6.283185307179586232e+00, TWO_PI_LO = 2.449293598294706414e-16;
  double k = rint(x * 0.15915494309189534561);
  double r = (x - k * TWO_PI_HI) - k * TWO_PI_LO;
  r *= 0.25;
  double r2 = r * r;
  double s = 1.0, c = 1.0;
  s = 1.0 - r2 / (18.0 * 19.0);
  s = 1.0 - r2 / (16.0 * 17.0) * s;
  s = 1.0 - r2 / (14.0 * 15.0) * s;
  s = 1.0 - r2 / (12.0 * 13.0) * s;
  s = 1.0 - r2 / (10.0 * 11.0) * s;
  s = 1.0 - r2 / (8.0 * 9.0) * s;
  s = 1.0 - r2 / (6.0 * 7.0) * s;
  s = 1.0 - r2 / (4.0 * 5.0) * s;
  s = 1.0 - r2 / (2.0 * 3.0) * s;
  s *= r;
  c = 1.0 - r2 / (17.0 * 18.0);
  c = 1.0 - r2 / (15.0 * 16.0) * c;
  c = 1.0 - r2 / (13.0 * 14.0) * c;
  c = 1.0 - r2 / (11.0 * 12.0) * c;
  c = 1.0 - r2 / (9.0 * 10.0) * c;
  c = 1.0 - r2 / (7.0 * 8.0) * c;
  c = 1.0 - r2 / (5.0 * 6.0) * c;
  c = 1.0 - r2 / (3.0 * 4.0) * c;
  c = 1.0 - r2 / (1.0 * 2.0) * c;
  double s2 = 2.0 * s * c, c2 = c * c - s * s;
  *sn = 2.0 * s2 * c2; *cs = c2 * c2 - s2 * s2;
}

DI int opaque_tid() { int t = threadIdx.x; asm volatile("" : "+v"(t)); return t; }
DI const char* sgpr_ptr(const char* p) { asm("" : "+s"(p)); return p; }
#define WAIT_V(n) asm volatile("s_waitcnt vmcnt(" #n ")" ::: "memory")
#define WAIT_L(n) asm volatile("s_waitcnt lgkmcnt(" #n ")" ::: "memory")
#define BAR __builtin_amdgcn_s_barrier()
#define SCHED __builtin_amdgcn_sched_barrier(0)
#define GLDS(gp, lp) __builtin_amdgcn_global_load_lds((const unsigned*)(gp), (unsigned*)(lp), 16, 0, 0)

constexpr int GBK = 64, GHALF = 128, GHT = GHALF * GBK;
DI int lds_byte(int r, int c) {
  int st = (r >> 4) * 2 + (c >> 5), rr = r & 15, cc = c & 31, ob = rr * 64 + cc * 2;
  return st * 1024 + (ob ^ (((ob >> 9) & 1) << 5));
}
DI void stage_rc(int b, int& R, int& C) {
  int st = b / 1024, sb = b % 1024, swz = sb ^ (((sb >> 9) & 1) << 5);
  R = (st >> 1) * 16 + swz / 64; C = (st & 1) * 32 + (swz % 64) / 2;
}

typedef f32x4 AccT[2][2][4][2];

template <class Epi>
DI void gemm_tile(const u16* __restrict__ A, const u16* __restrict__ Bt, const int lda, const int ldb, const int K, Epi&& epi) {
  const int TID = opaque_tid();
  extern __shared__ __attribute__((aligned(16))) unsigned char smem[];
  u16* shm = (u16*)smem;
#define SA(b, h) (shm + ((b) * 2 + (h)) * GHT)
#define SB(b, h) (shm + (4 + (b) * 2 + (h)) * GHT)
  int R0, C0, R1, C1;
  stage_rc(TID * 16, R0, C0);
  stage_rc(TID * 16 + 8192, R1, C1);
  const unsigned voA0 = (unsigned)(R0 * lda + C0) * 2u, voA1 = (unsigned)(R1 * lda + C1) * 2u;
  const unsigned voB0 = (unsigned)(R0 * ldb + C0) * 2u, voB1 = (unsigned)(R1 * ldb + C1) * 2u;
  const int hA = GHALF * lda, hB = GHALF * ldb;
  const unsigned wid_u = __builtin_amdgcn_readfirstlane(TID >> 6);
#define STAGE_A(PTR, half, kt) do { const char* _g = sgpr_ptr((const char*)(A + (size_t)(half) * hA + (size_t)(kt) * GBK)); \
    char* _l = (char*)(PTR) + wid_u * 1024u; \
    GLDS(_g + voA0, _l); GLDS(_g + voA1, _l + 8192); } while (0)
#define STAGE_B(PTR, half, kt) do { const char* _g = sgpr_ptr((const char*)(Bt + (size_t)(half) * hB + (size_t)(kt) * GBK)); \
    char* _l = (char*)(PTR) + wid_u * 1024u; \
    GLDS(_g + voB0, _l); GLDS(_g + voB1, _l + 8192); } while (0)
#define LDA(dst, b, h) for (int m = 0; m < 4; ++m) for (int k = 0; k < 2; ++k) \
    dst[m][k] = *reinterpret_cast<const bf16x8*>((char*)SA(b, h) + lds_byte(wr * 64 + m * 16 + fr, k * 32 + fq * 8))
#define LDB(dst, b, h) for (int n = 0; n < 2; ++n) for (int k = 0; k < 2; ++k) \
    dst[n][k] = *reinterpret_cast<const bf16x8*>((char*)SB(b, h) + lds_byte(wc * 32 + n * 16 + fr, k * 32 + fq * 8))
#define MMA(ai, bj, At, Bq) do { __builtin_amdgcn_s_setprio(1); \
    for (int m = 0; m < 4; ++m) for (int n = 0; n < 2; ++n) for (int k = 0; k < 2; ++k) \
      acc[ai][bj][m][n] = __builtin_amdgcn_mfma_f32_16x16x32_bf16(At[m][k], Bq[n][k], acc[ai][bj][m][n], 0, 0, 0); \
    __builtin_amdgcn_s_setprio(0); } while (0)

  const int wid = TID >> 6, lane = TID & 63, wr = wid >> 2, wc = wid & 3, fr = lane & 15, fq = lane >> 4;
  AccT acc;
#pragma unroll
  for (int a = 0; a < 2; ++a)
#pragma unroll
    for (int b = 0; b < 2; ++b)
#pragma unroll
      for (int m = 0; m < 4; ++m)
#pragma unroll
        for (int n = 0; n < 2; ++n) acc[a][b][m][n] = f32x4{0.f, 0.f, 0.f, 0.f};
  bf16x8 At[4][2], B0[2][2], B1[2][2];
  const int nt = K / GBK;
  STAGE_B(SB(0, 0), 0, 0); STAGE_A(SA(0, 0), 0, 0);
  STAGE_B(SB(0, 1), 1, 0); STAGE_A(SA(0, 1), 1, 0);
  if (wr == 1) BAR;
  WAIT_V(4); BAR;
  STAGE_B(SB(1, 0), 0, 1); STAGE_A(SA(1, 0), 0, 1); STAGE_B(SB(1, 1), 1, 1);
  WAIT_V(6); BAR;
  for (int t = 0; t < nt - 2; t += 2) {
    LDB(B0, 0, 0); SCHED; LDA(At, 0, 0); STAGE_A(SA(1, 1), 1, t + 1);
    WAIT_L(8); BAR; WAIT_L(0); MMA(0, 0, At, B0); BAR; SCHED;
    LDB(B1, 0, 1); STAGE_B(SB(0, 0), 0, t + 2);
    BAR; WAIT_L(0); MMA(0, 1, At, B1); BAR;
    LDA(At, 0, 1); STAGE_A(SA(0, 0), 0, t + 2);
    BAR; WAIT_L(0); MMA(1, 0, At, B0); BAR; SCHED;
    STAGE_B(SB(0, 1), 1, t + 2);
    WAIT_V(6); BAR; MMA(1, 1, At, B1); BAR;
    LDB(B0, 1, 0); SCHED; LDA(At, 1, 0); STAGE_A(SA(0, 1), 1, t + 2);
    WAIT_L(8); BAR; WAIT_L(0); MMA(0, 0, At, B0); BAR; SCHED;
    LDB(B1, 1, 1); STAGE_B(SB(1, 0), 0, t + 3);
    BAR; WAIT_L(0); MMA(0, 1, At, B1); BAR;
    LDA(At, 1, 1); STAGE_A(SA(1, 0), 0, t + 3);
    BAR; WAIT_L(0); MMA(1, 0, At, B0); BAR; SCHED;
    STAGE_B(SB(1, 1), 1, t + 3);
    WAIT_V(6); BAR; MMA(1, 1, At, B1); BAR;
  }
  { LDB(B0, 0, 0); LDA(At, 0, 0); STAGE_A(SA(1, 1), 1, nt - 1);
    BAR; WAIT_L(0); MMA(0, 0, At, B0); BAR;
    LDB(B1, 0, 1); BAR; WAIT_L(0); MMA(0, 1, At, B1); BAR;
    LDA(At, 0, 1); WAIT_V(4); BAR; WAIT_L(0); MMA(1, 0, At, B0); MMA(1, 1, At, B1); BAR; }
  { LDB(B0, 1, 0); LDA(At, 1, 0); WAIT_V(2); BAR; WAIT_L(0); MMA(0, 0, At, B0); BAR;
    LDB(B1, 1, 1); WAIT_V(0); BAR; WAIT_L(0); MMA(0, 1, At, B1); BAR;
    LDA(At, 1, 1); BAR; WAIT_L(0); MMA(1, 0, At, B0); MMA(1, 1, At, B1); BAR; }
  if (wr == 0) BAR;
  epi(acc);
#undef SA
#undef SB
}

template <class F>
DI void epi_for(AccT& acc, F&& f) {
  const int TID = opaque_tid();
  const int _wid = TID >> 6, _lane = TID & 63, _wr = _wid >> 2, _wc = _wid & 3, _fr = _lane & 15, _fq = _lane >> 4;
#pragma unroll
  for (int _ai = 0; _ai < 2; ++_ai)
#pragma unroll
    for (int _bj = 0; _bj < 2; ++_bj)
#pragma unroll
      for (int _m = 0; _m < 4; ++_m)
#pragma unroll
        for (int _n = 0; _n < 2; ++_n)
          f(_ai * 128 + _wr * 64 + _m * 16 + _fq * 4, _bj * 128 + _wc * 32 + _n * 16 + _fr, acc[_ai][_bj][_m][_n]);
}

DI void tile_map(int w, int ntn, int& tm, int& tn) {
  int xcd = w & 7, r = w >> 3;
  tn = r % ntn; tm = (r / ntn) * 8 + xcd;
}

DI void transpose_tile(const float* __restrict__ src, int N, u16* __restrict__ dst, int K, int tk, int tn) {
  const int TID = opaque_tid();
  extern __shared__ __attribute__((aligned(16))) unsigned char smem[];
  float* tile = (float*)smem;
  const int t = TID;
  {
    int rk = t >> 3, cs = (t & 7) * 8;
    const float4* s = (const float4*)(src + (size_t)(tk * 64 + rk) * N + tn * 64 + cs);
    float4 a = s[0], b = s[1];
    float* d = tile + rk * 65 + cs;
    d[0] = a.x; d[1] = a.y; d[2] = a.z; d[3] = a.w; d[4] = b.x; d[5] = b.y; d[6] = b.z; d[7] = b.w;
  }
  __syncthreads();
  {
    int n = t >> 3, ks = (t & 7) * 8;
    u32x4 o;
    o[0] = pk2(tile[(ks + 0) * 65 + n], tile[(ks + 1) * 65 + n]);
    o[1] = pk2(tile[(ks + 2) * 65 + n], tile[(ks + 3) * 65 + n]);
    o[2] = pk2(tile[(ks + 4) * 65 + n], tile[(ks + 5) * 65 + n]);
    o[3] = pk2(tile[(ks + 6) * 65 + n], tile[(ks + 7) * 65 + n]);
    *(u32x4*)(dst + (size_t)(tn * 64 + n) * K + tk * 64 + ks) = o;
  }
  __syncthreads();
}

DI void phase_prep_a(const P& p) {
  const int TID = opaque_tid();
  const int bid = blockIdx.x, nb = gridDim.x;
  for (int w = bid; w < 7680; w += nb) {
    int layer = w / 3840, r = w % 3840;
    const float* src; u16* dst; int K, N, tl;
    if (r < 1024) { src = p.in[3] + (size_t)layer * 1024 * 4096; dst = (u16*)(p.ws + WS_WT_IN) + (size_t)layer * 4096 * 1024; K = 1024; N = 4096; tl = r; }
    else if (r < 1280) { src = p.in[6] + (size_t)layer * 1024 * 1024; dst = (u16*)(p.ws + WS_WT_AP) + (size_t)layer * 1024 * 1024; K = 1024; N = 1024; tl = r - 1024; }
    else if (r < 1408) { src = p.in[15] + (size_t)layer * 512 * 1024; dst = (u16*)(p.ws + WS_WT_GA) + (size_t)layer * 1024 * 512; K = 512; N = 1024; tl = r - 1280; }
    else if (r < 1536) { src = p.in[16] + (size_t)layer * 512 * 1024; dst = (u16*)(p.ws + WS_WT_GB) + (size_t)layer * 1024 * 512; K = 512; N = 1024; tl = r - 1408; }
    else if (r < 1792) { src = p.in[17] + (size_t)layer * 1024 * 1024; dst = (u16*)(p.ws + WS_WT_OUT) + (size_t)layer * 1024 * 1024; K = 1024; N = 1024; tl = r - 1536; }
    else if (r < 2816) { src = p.in[19] + (size_t)layer * 1024 * 4096; dst = (u16*)(p.ws + WS_WT_FF1) + (size_t)layer * 4096 * 1024; K = 1024; N = 4096; tl = r - 1792; }
    else { src = p.in[20] + (size_t)layer * 4096 * 1024; dst = (u16*)(p.ws + WS_WT_FF2) + (size_t)layer * 1024 * 4096; K = 4096; N = 1024; tl = r - 2816; }
    int ntn = N / 64;
    transpose_tile(src, N, dst, K, tl / ntn, tl % ntn);
  }
  const int gtid = bid * blockDim.x + TID, nth = nb * blockDim.x;
  float2* LP = (float2*)(p.ws + WS_LPOW);
  float2* BB = (float2*)(p.ws + WS_BBAR);
  for (int i = gtid; i < 8192; i += nth) {
    int lg = i >> 6;
    double step = exp((double)p.in[9][lg]);
    double lr = p.in[7][i], li = p.in[8][i];
    double zr = lr * step, zi = li * step;
    for (int tau = 0; tau <= 32; ++tau) {
      double e = exp(zr * tau), sn, cs;
      sincos_d(zi * tau, &sn, &cs);
      LP[(size_t)i * 33 + tau] = make_float2((float)(e * cs), (float)(e * sn));
    }
    double e = exp(zr), sn, cs;
    sincos_d(zi, &sn, &cs);
    double nr = e * cs - 1.0, ni = e * sn, den = lr * lr + li * li;
    double fr = (nr * lr + ni * li) / den, fi = (ni * lr - nr * li) / den;
    for (int ci = 0; ci < 16; ++ci) {
      double br = p.in[10][(size_t)i * 16 + ci], bi = p.in[11][(size_t)i * 16 + ci];
      BB[(size_t)i * 16 + ci] = make_float2((float)(fr * br - fi * bi), (float)(fr * bi + fi * br));
    }
  }
  float2* RP = (float2*)(p.ws + WS_ROPE);
  for (int i = gtid; i < 128 * 16; i += nth) {
    int pos = i >> 4, f = i & 15;
    double inv = exp(-(double)(2 * f) / 32.0 * 9.210340371976184);
    double sn, cs;
    sincos_d((double)pos * inv, &sn, &cs);
    RP[i] = make_float2((float)cs, (float)sn);
  }
}

DI void phase_prep_b(const P& p) {
  const int TID = opaque_tid();
  const int gtid = blockIdx.x * blockDim.x + TID, nth = gridDim.x * blockDim.x;
  const float2* LP = (const float2*)(p.ws + WS_LPOW);
  const float2* BB = (const float2*)(p.ws + WS_BBAR);
  float* KT = (float*)(p.ws + WS_KTAB);
  const float* cre = p.in[12];
  const float* cim = p.in[13];
  for (int i = gtid; i < (1 << 20); i += nth) {
    int ci = i & 15, co = (i >> 4) & 15, tau = (i >> 8) & 31, lg = i >> 13;
    float s = 0.f;
    for (int pp = 0; pp < 64; ++pp) {
      float cr = cre[(size_t)(lg * 16 + co) * 64 + pp], cI = cim[(size_t)(lg * 16 + co) * 64 + pp];
      float2 l = LP[(size_t)(lg * 64 + pp) * 33 + tau];
      float2 b = BB[(size_t)(lg * 64 + pp) * 16 + ci];
      float xr = l.x * b.x - l.y * b.y, xi = l.x * b.y + l.y * b.x;
      s += cr * xr - cI * xi;
    }
    KT[i] = s;
  }
  u16* W1 = (u16*)(p.ws + WS_W1T);
  for (int i = gtid; i < (1 << 23); i += nth) {
    int k = i & 511, n = (i >> 9) & 255, g = (i >> 17) & 31, layer = i >> 22;
    int dir = n >> 7, pp = (n >> 1) & 63, ri = n & 1, s = k >> 4, ci = k & 15;
    int e = dir ? s : 31 - s;
    int lg = (layer * 2 + dir) * 32 + g;
    float2 l = LP[(size_t)(lg * 64 + pp) * 33 + e];
    float2 b = BB[(size_t)(lg * 64 + pp) * 16 + ci];
    float v = ri ? (l.x * b.y + l.y * b.x) : (l.x * b.x - l.y * b.y);
    W1[i] = f2bf(v);
  }
  u16* WY = (u16*)(p.ws + WS_WYT);
  for (int i = gtid; i < (1 << 23); i += nth) {
    int kk = i & 255, n = (i >> 8) & 511, g = (i >> 17) & 31, layer = i >> 22;
    int t = n >> 4, co = n & 15, dir = kk >> 7, pp = (kk >> 1) & 63, ri = kk & 1;
    int e = dir ? 32 - t : t + 1;
    int lg = (layer * 2 + dir) * 32 + g;
    float cr = cre[(size_t)(lg * 16 + co) * 64 + pp], cI = cim[(size_t)(lg * 16 + co) * 64 + pp];
    float2 l = LP[(size_t)(lg * 64 + pp) * 33 + e];
    float v = ri ? -(cr * l.y + cI * l.x) : (cr * l.x - cI * l.y);
    WY[((size_t)((layer * 32 + g) * 512 + n)) * ASTR + 512 + kk] = f2bf(v);
  }
}

DI void phase_prep_c(const P& p) {
  const int TID = opaque_tid();
  const int gtid = blockIdx.x * blockDim.x + TID, nth = gridDim.x * blockDim.x;
  const float* KT = (const float*)(p.ws + WS_KTAB);
  u16* WY = (u16*)(p.ws + WS_WYT);
  for (int i = gtid; i < (1 << 21); i += nth) {
    int k8 = i & 63, n = (i >> 6) & 511, g = (i >> 15) & 31, layer = i >> 20;
    int t = n >> 4, co = n & 15, s = k8 >> 1, ci0 = (k8 & 1) * 8;
    int tau = t - s;
    float v[8];
    if (tau > 0) {
      const float* q = KT + ((((size_t)(layer * 2 + 0) * 32 + g) * 32 + tau) * 16 + co) * 16 + ci0;
#pragma unroll
      for (int j = 0; j < 8; ++j) v[j] = q[j];
    } else if (tau < 0) {
      const float* q = KT + ((((size_t)(layer * 2 + 1) * 32 + g) * 32 - tau) * 16 + co) * 16 + ci0;
#pragma unroll
      for (int j = 0; j < 8; ++j) v[j] = q[j];
    } else {
      const float* q0 = KT + ((((size_t)(layer * 2 + 0) * 32 + g) * 32) * 16 + co) * 16 + ci0;
      const float* q1 = KT + ((((size_t)(layer * 2 + 1) * 32 + g) * 32) * 16 + co) * 16 + ci0;
#pragma unroll
      for (int j = 0; j < 8; ++j) v[j] = q0[j] + q1[j];
    }
    u32x4 o;
    o[0] = pk2(v[0], v[1]); o[1] = pk2(v[2], v[3]); o[2] = pk2(v[4], v[5]); o[3] = pk2(v[6], v[7]);
    *(u32x4*)(WY + ((size_t)((layer * 32 + g) * 512 + n)) * ASTR + k8 * 8) = o;
  }
}

DI const float* xrow(const P& p, int layer, int tok) {
  if (layer == 0) return tok < NTP ? p.in[0] + (size_t)tok * 1024 : p.in[1] + (size_t)(tok - NTP) * 1024;
  return p.out + (size_t)tok * 1024;
}
DI void phase_norm(const P& p, const float* __restrict__ src0, const float* __restrict__ src1, const float* __restrict__ gain) {
  const int TID = opaque_tid();
  const int lane = TID & 63, wave = TID >> 6;
  u16* XN = (u16*)(p.ws + WS_XN);
  float4 g4[4];
#pragma unroll
  for (int i = 0; i < 4; ++i) g4[i] = *(const float4*)(gain + i * 256 + lane * 4);
  for (int tok = blockIdx.x * 8 + wave; tok < NT; tok += gridDim.x * 8) {
    const float* x = tok < NTP ? src0 + (size_t)tok * 1024 : src1 + (size_t)(tok - NTP) * 1024;
    float4 v[4];
    float ss = 0.f;
#pragma unroll
    for (int i = 0; i < 4; ++i) {
      v[i] = *(const float4*)(x + i * 256 + lane * 4);
      ss += v[i].x * v[i].x + v[i].y * v[i].y + v[i].z * v[i].z + v[i].w * v[i].w;
    }
#pragma unroll
    for (int o = 32; o >= 1; o >>= 1) ss += __shfl_xor(ss, o);
    float rstd = rsqrtf(ss * (1.0f / 1024.0f) + 1e-6f);
#pragma unroll
    for (int i = 0; i < 4; ++i) {
      u32x2 o;
      o[0] = pk2(v[i].x * rstd * g4[i].x, v[i].y * rstd * g4[i].y);
      o[1] = pk2(v[i].z * rstd * g4[i].z, v[i].w * rstd * g4[i].w);
      *(u32x2*)(XN + (size_t)tok * 1024 + i * 256 + lane * 4) = o;
    }
  }
}

DI void phase_scan(const P& p, int layer) {
  const int TID = opaque_tid();
  const int gtid = blockIdx.x * blockDim.x + TID, nth = gridDim.x * blockDim.x;
  const float2* LP = (const float2*)(p.ws + WS_LPOW);
  for (int i = gtid; i < 18 * 4096; i += nth) {
    int pp = i & 63, dir = (i >> 6) & 1, g = (i >> 7) & 31, seq = i >> 12;
    int c0 = seq < 16 ? seq * 128 : 2048 + (seq - 16) * 256;
    int nc = seq < 16 ? 128 : 256;
    float2 a = LP[(size_t)(((layer * 2 + dir) * 32 + g) * 64 + pp) * 33 + 32];
    const float2* S = (const float2*)(p.ws + WS_S) + ((size_t)(g * NCH + c0) * 256 + dir * 128 + pp * 2) / 2;
    unsigned* H = (unsigned*)((u16*)(p.ws + WS_ASSM) + (size_t)(g * NCH + c0) * ASTR + 512 + dir * 128 + pp * 2);
    float hr = 0.f, hi = 0.f;
    if (dir == 0) {
#pragma unroll 8
      for (int c = 0; c < nc; ++c) {
        H[(size_t)c * (ASTR / 2)] = pk2(hr, hi);
        float2 s = S[(size_t)c * 128];
        float nr = a.x * hr - a.y * hi + s.x;
        hi = a.x * hi + a.y * hr + s.y;
        hr = nr;
      }
    } else {
#pragma unroll 8
      for (int c = nc - 1; c >= 0; --c) {
        H[(size_t)c * (ASTR / 2)] = pk2(hr, hi);
        float2 s = S[(size_t)c * 128];
        float nr = a.x * hr - a.y * hi + s.x;
        hi = a.x * hi + a.y * hr + s.y;
        hr = nr;
      }
    }
  }
}

#define MFMA32(a, b, c) __builtin_amdgcn_mfma_f32_32x32x16_bf16((a), (b), (c), 0, 0, 0)
DI void attn_item(const P& p, int seq_start, int L, int head, int qb) {
  const int TID = opaque_tid();
  extern __shared__ __attribute__((aligned(16))) unsigned char smem[];
  const u16* Q = (const u16*)(p.ws + WS_Q);
  const u16* KB = (const u16*)(p.ws + WS_K);
  const u16* VT = (const u16*)(p.ws + WS_VT);
  u16* O = (u16*)(p.ws + WS_ATTO);
  const int tid = TID, wave = tid >> 6, lane = tid & 63, r = lane & 31, h = lane >> 5;
  const int kvh = head >> 2;
  const int q0 = seq_start + qb * 512 + wave * 64;
  bf16x8 qf[2][4];
#pragma unroll
  for (int nt = 0; nt < 2; ++nt)
#pragma unroll
    for (int ds = 0; ds < 4; ++ds)
      qf[nt][ds] = *(const bf16x8*)(Q + (size_t)(q0 + nt * 32 + r) * 1024 + head * 64 + ds * 16 + h * 8);
  const int srow = tid >> 3, spos = tid & 7, scc = spos ^ ((srow >> 1) & 7);
  const u16* kg = KB + ((size_t)kvh * NT + seq_start + srow) * 64 + scc * 8;
  const u16* vg = VT + (size_t)(kvh * 64 + srow) * NT + seq_start + scc * 8;
  unsigned char* ldst = smem + tid * 16;
  const int nkt = L >> 6;
  const int pr = ((r >> 4) * 16) + (((r >> 2) & 1) * 8) + (((r >> 3) & 1) * 4) + (r & 3);
  int koff[4], voff[4];
#pragma unroll
  for (int ds = 0; ds < 4; ++ds) koff[ds] = pr * 128 + (((ds * 2 + h) ^ ((pr >> 1) & 7)) << 4);
#pragma unroll
  for (int c = 0; c < 4; ++c) voff[c] = 8192 + r * 128 + (((c * 2 + h) ^ ((r >> 1) & 7)) << 4);

  f32x16 o[2][2];
#pragma unroll
  for (int a = 0; a < 2; ++a)
#pragma unroll
    for (int b = 0; b < 2; ++b)
#pragma unroll
      for (int j = 0; j < 16; ++j) o[a][b][j] = 0.f;
  float mrun[2] = {-1e30f, -1e30f}, lrun[2] = {0.f, 0.f};

  GLDS(kg, ldst); GLDS(vg, ldst + 8192);
  GLDS(kg + 64 * 64, ldst + 16384); GLDS(vg + 64, ldst + 16384 + 8192);
  int bcur = 0;
  for (int t = 0; t < nkt; ++t) {
    if (t + 1 < nkt) { WAIT_V(2); } else { WAIT_V(0); }
    BAR;
    if (t + 2 < nkt) {
      int bn = bcur + 2; if (bn >= 3) bn -= 3;
      GLDS(kg + (size_t)(t + 2) * 64 * 64, ldst + bn * 16384);
      GLDS(vg + (t + 2) * 64, ldst + bn * 16384 + 8192);
    }
    const unsigned char* kb = smem + bcur * 16384;
    f32x16 s[2][2];
#pragma unroll
    for (int a = 0; a < 2; ++a)
#pragma unroll
      for (int b = 0; b < 2; ++b)
#pragma unroll
        for (int j = 0; j < 16; ++j) s[a][b][j] = 0.f;
#pragma unroll
    for (int ds = 0; ds < 4; ++ds)
#pragma unroll
      for (int kt = 0; kt < 2; ++kt) {
        bf16x8 kf = *(const bf16x8*)(kb + koff[ds] + kt * 4096);
#pragma unroll
        for (int nt = 0; nt < 2; ++nt) s[kt][nt] = MFMA32(kf, qf[nt][ds], s[kt][nt]);
      }
#pragma unroll
    for (int nt = 0; nt < 2; ++nt) {
      float mx = s[0][nt][0];
#pragma unroll
      for (int j = 1; j < 16; ++j) mx = fmaxf(mx, s[0][nt][j]);
#pragma unroll
      for (int j = 0; j < 16; ++j) mx = fmaxf(mx, s[1][nt][j]);
      mx = fmaxf(mx, __shfl_xor(mx, 32));
      float mnew = fmaxf(mrun[nt], mx);
      float alpha = __builtin_amdgcn_exp2f(mrun[nt] - mnew);
      mrun[nt] = mnew;
      float sum = 0.f;
#pragma unroll
      for (int kt = 0; kt < 2; ++kt)
#pragma unroll
        for (int j = 0; j < 16; ++j) { float pv = __builtin_amdgcn_exp2f(s[kt][nt][j] - mnew); s[kt][nt][j] = pv; sum += pv; }
      lrun[nt] = lrun[nt] * alpha + sum;
#pragma unroll
      for (int mt = 0; mt < 2; ++mt)
#pragma unroll
        for (int j = 0; j < 16; ++j) o[mt][nt][j] *= alpha;
    }
#pragma unroll
    for (int kt = 0; kt < 2; ++kt)
#pragma unroll
      for (int s2 = 0; s2 < 2; ++s2) {
        bf16x8 pf[2];
#pragma unroll
        for (int nt = 0; nt < 2; ++nt) {
          u32x4 pk;
#pragma unroll
          for (int i = 0; i < 4; ++i) pk[i] = pk2(s[kt][nt][s2 * 8 + 2 * i], s[kt][nt][s2 * 8 + 2 * i + 1]);
          pf[nt] = __builtin_bit_cast(bf16x8, pk);
        }
#pragma unroll
        for (int mt = 0; mt < 2; ++mt) {
          bf16x8 vf = *(const bf16x8*)(kb + voff[kt * 2 + s2] + mt * 4096);
#pragma unroll
          for (int nt = 0; nt < 2; ++nt) o[mt][nt] = MFMA32(vf, pf[nt], o[mt][nt]);
        }
      }
    bcur = bcur + 1; if (bcur >= 3) bcur = 0;
  }
#pragma unroll
  for (int nt = 0; nt < 2; ++nt) {
    float l = lrun[nt] + __shfl_xor(lrun[nt], 32);
    float inv = 1.0f / l;
    const int tok = q0 + nt * 32 + r;
#pragma unroll
    for (int mt = 0; mt < 2; ++mt)
#pragma unroll
      for (int jg = 0; jg < 4; ++jg) {
        u32x2 ov;
        ov[0] = pk2(o[mt][nt][jg * 4 + 0] * inv, o[mt][nt][jg * 4 + 1] * inv);
        ov[1] = pk2(o[mt][nt][jg * 4 + 2] * inv, o[mt][nt][jg * 4 + 3] * inv);
        *(u32x2*)(O + (size_t)tok * 1024 + head * 64 + mt * 32 + jg * 8 + h * 4) = ov;
      }
  }
  WAIT_L(0);
  BAR;
}


enum { EK_P1 = 0, EK_S, EK_Y, EK_M0, EK_M1, EK_M2, EK_M3, EK_M4, EK_OUT, EK_FF1, EK_FF2 };
struct Job {
  const u16* A; const u16* Bt;
  int lda, ldb, K, kind, tm, tn, layer;
};

DI void epi_p1(const P& p, const Job& jb, AccT& acc) {
  const int TID = opaque_tid();
  const int ft = jb.tm, tt = jb.tn, layer = jb.layer;
  u16* Q = (u16*)(p.ws + WS_Q);
  u16* KB = (u16*)(p.ws + WS_K);
  u16* VT = (u16*)(p.ws + WS_VT);
  u16* AS = (u16*)(p.ws + WS_ASSM);
  const float* qn = p.in[4] + layer * 64;
  const float* kn = p.in[5] + layer * 64;
  const float2* RP = (const float2*)(p.ws + WS_ROPE);
  const int wid = TID >> 6, lane = TID & 63, wr = wid >> 2, wc = wid & 3, fr = lane & 15, fq = lane >> 4;
#pragma unroll
  for (int ai = 0; ai < 2; ++ai) {
    const int fb = ft * 256 + ai * 128 + wr * 64;
#pragma unroll
    for (int bj = 0; bj < 2; ++bj)
#pragma unroll
      for (int n = 0; n < 2; ++n) {
        const int tok = tt * 256 + bj * 128 + wc * 32 + n * 16 + fr;
        if (ft < 5) {
          float ss = 0.f;
#pragma unroll
          for (int m = 0; m < 4; ++m)
#pragma unroll
            for (int j = 0; j < 4; ++j) { float a = acc[ai][bj][m][n][j]; ss += a * a; }
          ss += __shfl_xor(ss, 16);
          ss += __shfl_xor(ss, 32);
          float rstd = rsqrtf(ss * (1.0f / 64.0f) + 1e-6f);
          const float* gn = (ft < 4) ? qn : kn;
          if (ft < 4) rstd *= 0.125f * 1.4426950408889634f;
          const int pos = tok < NTP ? (tok & 4095) : ((tok - NTP) & 8191);
          const int prow = pos >> 6, pcol = pos & 63;
#pragma unroll
          for (int m = 0; m < 4; ++m) {
            const int d0 = m * 16 + fq * 4;
            const float4 g4 = *(const float4*)(gn + d0);
            float v0 = acc[ai][bj][m][n][0] * rstd * g4.x, v1 = acc[ai][bj][m][n][1] * rstd * g4.y;
            float v2 = acc[ai][bj][m][n][2] * rstd * g4.z, v3 = acc[ai][bj][m][n][3] * rstd * g4.w;
            const int i0 = (m & 1) * 8 + fq * 2;
            const float2* rp = RP + ((m < 2) ? prow : pcol) * 16 + i0;
            float2 cs0 = rp[0], cs1 = rp[1];
            u32x2 o;
            o[0] = pk2(v0 * cs0.x - v1 * cs0.y, v0 * cs0.y + v1 * cs0.x);
            o[1] = pk2(v2 * cs1.x - v3 * cs1.y, v2 * cs1.y + v3 * cs1.x);
            if (ft < 4) *(u32x2*)(Q + (size_t)tok * 1024 + fb + d0) = o;
            else *(u32x2*)(KB + ((size_t)((fb - 1024) >> 6) * NT + tok) * 64 + d0) = o;
          }
        } else if (ft == 5) {
          const int kvh = (fb - 1280) >> 6;
#pragma unroll
          for (int m = 0; m < 4; ++m)
#pragma unroll
            for (int j = 0; j < 4; ++j)
              VT[(size_t)(kvh * 64 + m * 16 + fq * 4 + j) * NT + tok] = f2bf(acc[ai][bj][m][n][j]);
        } else {
#pragma unroll
          for (int m = 0; m < 4; ++m) {
            const int g = ((fb - 1536) >> 4) + m;
            u32x2 o;
            o[0] = pk2(acc[ai][bj][m][n][0], acc[ai][bj][m][n][1]);
            o[1] = pk2(acc[ai][bj][m][n][2], acc[ai][bj][m][n][3]);
            *(u32x2*)(AS + ((size_t)g * NCH + (tok >> 5)) * ASTR + (tok & 31) * 16 + fq * 4) = o;
          }
        }
      }
  }
}

DI void run_epilogue(const P& p, const Job& jb, AccT& acc) {
  const int tm = jb.tm, tn = jb.tn, layer = jb.layer;
  switch (jb.kind) {
    case EK_P1: epi_p1(p, jb, acc); break;
    case EK_S: {
      float* Sg = (float*)(p.ws + WS_S) + (size_t)tm * 256 * 256;
      epi_for(acc, [&](const int row0, const int col, const f32x4 v) {
#pragma unroll
        for (int j = 0; j < 4; ++j) Sg[(size_t)(row0 + j) * 256 + col] = v[j];
      });
    } break;
    case EK_Y: {
      const int g = tm / 10, rt = tm % 10;
      const u16* Ag = jb.A;
      u16* Y = (u16*)(p.ws + WS_Y);
      const float* dsk = p.in[14] + layer * 512 + g * 16;
      epi_for(acc, [&](const int row0, const int col, const f32x4 v) {
        const int cc = tn * 256 + col;
        const int t = cc >> 4, co = cc & 15;
        const float dv = dsk[co];
#pragma unroll
        for (int j = 0; j < 4; ++j) {
          const int ch = rt * 256 + row0 + j;
          float u = bf2f(Ag[(size_t)(row0 + j) * ASTR + cc]);
          float yv = gelu_tanh(v[j] + dv * u);
          Y[((size_t)ch * 32 + t) * 512 + g * 16 + co] = f2bf(yv);
        }
      });
    } break;
    case EK_M0: case EK_M1: case EK_M2: case EK_M3: case EK_M4: {
      u16* t1 = (u16*)(p.ws + WS_Q) + (size_t)tm * 256 * 1024 + tn * 256;
      u16* t2 = (u16*)(p.ws + WS_ASSM) + (size_t)tm * 256 * 1024 + tn * 256;
      const int kind = jb.kind;
      epi_for(acc, [&](const int row0, const int col, const f32x4 v) {
#pragma unroll
        for (int j = 0; j < 4; ++j) {
          const size_t o = (size_t)(row0 + j) * 1024 + col;
          float r;
          if (kind == EK_M0) r = sigmoidf_(v[j]);
          else if (kind == EK_M1) r = v[j] * bf2f(t1[o]);
          else if (kind == EK_M2) r = sigmoidf_(v[j]) * bf2f(t1[o]);
          else if (kind == EK_M3) r = sigmoidf_(v[j]);
          else r = bf2f(t2[o]) * v[j] + bf2f(t1[o]);
          if (kind == EK_M3) t2[o] = f2bf(r); else t1[o] = f2bf(r);
        }
      });
    } break;
    case EK_OUT: {
      epi_for(acc, [&](const int row0, const int col, const f32x4 v) {
#pragma unroll
        for (int j = 0; j < 4; ++j) {
          const int tok = tm * 256 + row0 + j, c = tn * 256 + col;
          p.out[(size_t)tok * 1024 + c] = xrow(p, layer, tok)[c] + v[j];
        }
      });
    } break;
    case EK_FF1: {
      u16* f = (u16*)(p.ws + WS_FF) + (size_t)tm * 256 * 4096 + tn * 256;
      epi_for(acc, [&](const int row0, const int col, const f32x4 v) {
#pragma unroll
        for (int j = 0; j < 4; ++j) { float a = fmaxf(v[j], 0.f); f[(size_t)(row0 + j) * 4096 + col] = f2bf(a * a); }
      });
    } break;
    case EK_FF2: {
      float* o = p.out + (size_t)tm * 256 * 1024 + tn * 256;
      epi_for(acc, [&](const int row0, const int col, const f32x4 v) {
#pragma unroll
        for (int j = 0; j < 4; ++j) o[(size_t)(row0 + j) * 1024 + col] += v[j];
      });
    } break;
  }
}

DI void make_job(const P& p, int layer, int s, int w, int step, Job& jb) {
  const u16* XN = (const u16*)(p.ws + WS_XN);
  jb.layer = layer;
  if (s == 0) {
    int tt, ft; tile_map(w, 8, tt, ft);
    jb.A = (const u16*)(p.ws + WS_WT_IN) + (size_t)layer * 4096 * 1024 + (size_t)ft * 256 * 1024;
    jb.Bt = XN + (size_t)tt * 256 * 1024;
    jb.lda = 1024; jb.ldb = 1024; jb.K = 1024; jb.kind = EK_P1; jb.tm = ft; jb.tn = tt;
  } else if (s == 1) {
    int g = w / 10;
    jb.A = (const u16*)(p.ws + WS_ASSM) + (size_t)w * 256 * ASTR;
    jb.Bt = (const u16*)(p.ws + WS_W1T) + ((size_t)layer * 32 + g) * 256 * 512;
    jb.lda = ASTR; jb.ldb = 512; jb.K = 512; jb.kind = EK_S; jb.tm = w; jb.tn = 0;
  } else if (s == 3) {
    int gr = w >> 1, ct = w & 1, g = gr / 10;
    jb.A = (const u16*)(p.ws + WS_ASSM) + (size_t)gr * 256 * ASTR;
    jb.Bt = (const u16*)(p.ws + WS_WYT) + (((size_t)layer * 32 + g) * 512 + ct * 256) * ASTR;
    jb.lda = ASTR; jb.ldb = ASTR; jb.K = ASTR; jb.kind = EK_Y; jb.tm = gr; jb.tn = ct;
  } else if (s == 4) {
    int tm, tn; tile_map(w, 4, tm, tn);
    jb.tm = tm; jb.tn = tn; jb.kind = EK_M0 + step;
    if (step < 2) {
      jb.A = (const u16*)(p.ws + WS_Y) + (size_t)tm * 256 * 512;
      jb.Bt = (const u16*)(p.ws + (step == 0 ? WS_WT_GB : WS_WT_GA)) + (size_t)layer * 1024 * 512 + (size_t)tn * 256 * 512;
      jb.lda = 512; jb.ldb = 512; jb.K = 512;
    } else if (step < 4) {
      jb.A = XN + (size_t)tm * 256 * 1024;
      jb.Bt = (const u16*)(p.ws + WS_WT_IN) + (size_t)layer * 4096 * 1024 + (size_t)((step == 2 ? 3072 : 2048) + tn * 256) * 1024;
      jb.lda = 1024; jb.ldb = 1024; jb.K = 1024;
    } else {
      jb.A = (const u16*)(p.ws + WS_ATTO) + (size_t)tm * 256 * 1024;
      jb.Bt = (const u16*)(p.ws + WS_WT_AP) + (size_t)layer * 1024 * 1024 + (size_t)tn * 256 * 1024;
      jb.lda = 1024; jb.ldb = 1024; jb.K = 1024;
    }
  } else if (s == 5) {
    int tm, tn; tile_map(w, 4, tm, tn);
    jb.A = (const u16*)(p.ws + WS_Q) + (size_t)tm * 256 * 1024;
    jb.Bt = (const u16*)(p.ws + WS_WT_OUT) + (size_t)layer * 1024 * 1024 + (size_t)tn * 256 * 1024;
    jb.lda = 1024; jb.ldb = 1024; jb.K = 1024; jb.kind = EK_OUT; jb.tm = tm; jb.tn = tn;
  } else if (s == 7) {
    int tm, tn; tile_map(w, 16, tm, tn);
    jb.A = XN + (size_t)tm * 256 * 1024;
    jb.Bt = (const u16*)(p.ws + WS_WT_FF1) + (size_t)layer * 4096 * 1024 + (size_t)tn * 256 * 1024;
    jb.lda = 1024; jb.ldb = 1024; jb.K = 1024; jb.kind = EK_FF1; jb.tm = tm; jb.tn = tn;
  } else {
    int tm, tn; tile_map(w, 4, tm, tn);
    jb.A = (const u16*)(p.ws + WS_FF) + (size_t)tm * 256 * 4096;
    jb.Bt = (const u16*)(p.ws + WS_WT_FF2) + (size_t)layer * 1024 * 4096 + (size_t)tn * 256 * 4096;
    jb.lda = 4096; jb.ldb = 4096; jb.K = 4096; jb.kind = EK_FF2; jb.tm = tm; jb.tn = tn;
  }
}

DI void phase_jobs(const P& p, int layer, int s) {
  int nitems, nsteps = 1, nattn = 0;
  switch (s) {
    case 0: nitems = 2560; break;
    case 1: nitems = 320; break;
    case 3: nitems = 3200; nattn = 2560; break;
    case 4: nitems = 1280; nsteps = 5; break;
    case 5: nitems = 1280; break;
    case 7: nitems = 5120; break;
    default: nitems = 1280; break;
  }
  for (int w = blockIdx.x; w < nitems; w += gridDim.x) {
    if (w < nattn) {
      int seq_start, L, head, qb;
      if (w < 512) {
        int xcd = w & 7, r = w >> 3;
        int seq = xcd >> 2, kvh = xcd & 3;
        seq_start = NTP + seq * 8192; L = 8192; head = kvh * 4 + (r >> 4); qb = r & 15;
      } else {
        int w2 = w - 512, xcd = w2 & 7, r = w2 >> 3;
        int grp = (r >> 5) * 8 + xcd, within = r & 31;
        int seq = grp >> 2, kvh = grp & 3;
        seq_start = seq * 4096; L = 4096; head = kvh * 4 + (within >> 3); qb = within & 7;
      }
      attn_item(p, seq_start, L, head, qb);
    } else {
      for (int step = 0; step < nsteps; ++step) {
        Job jb;
        make_job(p, layer, s, w - nattn, step, jb);
        gemm_tile(jb.A, jb.Bt, jb.lda, jb.ldb, jb.K, [&](AccT& acc) { run_epilogue(p, jb, acc); });
      }
    }
  }
}

DI void run_phase(const P& p, int ph) {
  if (ph == 0) { phase_prep_a(p); return; }
  if (ph == 1) { phase_prep_b(p); return; }
  if (ph == 2) { phase_prep_c(p); phase_norm(p, p.in[0], p.in[1], p.in[2]); return; }
  int layer = (ph - 3) / 10, s = (ph - 3) % 10;
  if (s == 2) phase_scan(p, layer);
  else if (s == 6) phase_norm(p, p.out, p.out + (size_t)NTP * 1024, p.in[18] + layer * 1024);
  else if (s == 9) phase_norm(p, p.out, p.out + (size_t)NTP * 1024, p.in[2] + (layer + 1) * 1024);
  else phase_jobs(p, layer, s);
}

__global__ void __launch_bounds__(512, 2) mega_coop(P p) {
  cg::grid_group grid = cg::this_grid();
  for (int ph = p.ph_lo; ph < p.ph_hi; ++ph) {
    run_phase(p, ph);
    if (ph + 1 < p.ph_hi) grid.sync();
  }
}
__global__ void __launch_bounds__(512, 2) mega_one(P p) {
  run_phase(p, p.ph_lo);
}

extern "C" void kernel_launch(void* const* d_in, const int* in_sizes, int n_in, void* d_out, int out_size, void* d_ws, size_t ws_size,
                              hipStream_t stream) {
  static int grid = 0;
  if (grid == 0) {
    if (n_in != 21 || ws_size < WS_END) { fprintf(stderr, "kernel_launch: unexpected n_in %d / ws_size %zu (need %zu)\n", n_in, ws_size, (size_t)WS_END); grid = -1; return; }
    int dev = 0, cus = 0, per_cu = 0;
    hipGetDevice(&dev);
    hipDeviceGetAttribute(&cus, hipDeviceAttributeMultiprocessorCount, dev);
    hipFuncSetAttribute((const void*)mega_coop, hipFuncAttributeMaxDynamicSharedMemorySize, LDS_BYTES);
    hipFuncSetAttribute((const void*)mega_one, hipFuncAttributeMaxDynamicSharedMemorySize, LDS_BYTES);
    hipOccupancyMaxActiveBlocksPerMultiprocessor(&per_cu, (const void*)mega_coop, 512, LDS_BYTES);
    if (per_cu < 1) { fprintf(stderr, "kernel_launch: occupancy query says %d blocks/CU\n", per_cu); per_cu = 1; }
    (void)hipGetLastError();
    grid = cus * 1;
  }
  if (grid < 0) return;
  P p{};
  for (int i = 0; i < 21; ++i) p.in[i] = (const float*)d_in[i];
  p.out = (float*)d_out;
  p.ws = (unsigned char*)d_ws;
#if N_LAUNCH_MODE == 1
  p.ph_lo = 0; p.ph_hi = NPHASE;
  void* args[] = {&p};
  hipError_t e = hipLaunchCooperativeKernel((const void*)mega_coop, dim3(grid), dim3(512), args, LDS_BYTES, stream);
  if (e != hipSuccess) fprintf(stderr, "cooperative launch failed: %s (grid %d)\n", hipGetErrorString(e), grid);
#else
  for (int ph = 0; ph < NPHASE; ++ph) {
    p.ph_lo = ph; p.ph_hi = ph + 1;
    hipLaunchKernelGGL(mega_one, dim3(grid), dim3(512), LDS_BYTES, stream, p);
  }
#endif
}
```

```cpp
#include <hip/hip_runtime.h>
#include <hip/hip_cooperative_groups.h>
#include <cstdio>
namespace cg = cooperative_groups;

typedef unsigned short u16;
typedef __attribute__((ext_vector_type(8))) short bf16x8;
typedef __attribute__((ext_vector_type(4))) float f32x4;
typedef __attribute__((ext_vector_type(16))) float f32x16;
typedef __attribute__((ext_vector_type(4))) unsigned u32x4;
typedef __attribute__((ext_vector_type(2))) unsigned u32x2;
typedef __attribute__((ext_vector_type(2))) float f32x2;
typedef __attribute__((ext_vector_type(2))) __bf16 bf16v2;

#define DI __device__ __forceinline__
#ifndef PROBE_MASK
#define PROBE_MASK 0
#endif
#ifndef N_LAUNCH_MODE
#define N_LAUNCH_MODE 1
#endif

constexpr int NT = 81920;
constexpr int NTP = 65536;
constexpr int NCH = 2560;
constexpr int ASTR = 768;
constexpr int NPHASE = 22;
constexpr int LDS_BYTES = 131072;

constexpr size_t MiB = 1ull << 20;
constexpr size_t WS_WT_IN = 0;
constexpr size_t WS_WT_AP = 16 * MiB;
constexpr size_t WS_WT_GA = 20 * MiB;
constexpr size_t WS_WT_GB = 22 * MiB;
constexpr size_t WS_WT_OUT = 24 * MiB;
constexpr size_t WS_WT_FF1 = 28 * MiB;
constexpr size_t WS_WT_FF2 = 44 * MiB;
constexpr size_t WS_W1T = 60 * MiB;
constexpr size_t WS_WYT = 76 * MiB;
constexpr size_t WS_LPOW = 124 * MiB;
constexpr size_t WS_BBAR = 127 * MiB;
constexpr size_t WS_KTAB = 128 * MiB;
constexpr size_t WS_ROPE = 132 * MiB;
constexpr size_t WS_XN = 133 * MiB;
constexpr size_t WS_BIG = 293 * MiB;
constexpr size_t WS_Q = WS_BIG;
constexpr size_t WS_K = WS_BIG + 160 * MiB;
constexpr size_t WS_VT = WS_BIG + 200 * MiB;
constexpr size_t WS_ASSM = WS_BIG + 240 * MiB;
constexpr size_t WS_S = WS_BIG + 360 * MiB;
constexpr size_t WS_Y = WS_BIG + 440 * MiB;
constexpr size_t WS_ATTO = WS_BIG + 520 * MiB;
constexpr size_t WS_FF = WS_BIG;
constexpr size_t WS_END = WS_BIG + 680 * MiB;

struct P {
  const float* in[21];
  float* out;
  unsigned char* ws;
  int ph_lo, ph_hi;
};

DI u16 f2bf(float f) { unsigned u = __float_as_uint(f); u += 0x7fffu + ((u >> 16) & 1u); return (u16)(u >> 16); }
DI float bf2f(u16 h) { return __uint_as_float(((unsigned)h) << 16); }
DI unsigned pk2(float a, float b) {
  f32x2 v; v[0] = a; v[1] = b;
  bf16v2 r = __builtin_convertvector(v, bf16v2);
  return __builtin_bit_cast(unsigned, r);
}
DI float sigmoidf_(float x) { return 1.0f / (1.0f + __expf(-x)); }
DI float gelu_tanh(float x) {
  float z = 0.7978845608028654f * (x + 0.044715f * x * x * x);
  float e = __expf(2.0f * z);
  return 0.5f * x * (2.0f - 2.0f / (e + 1.0f));
}


DI void sincos_d(double x, double* sn, double* cs) {
  const double TWO_PI_HI = 6.283185307179586232e+00, TWO_PI_LO = 2.449293598294706414e-16;
  double k = rint(x * 0.15915494309189534561);
  double r = (x - k * TWO_PI_HI) - k * TWO_PI_LO;
  r *= 0.25;
  double r2 = r * r;
  double s = 1.0, c = 1.0;
  s = 1.0 - r2 / (18.0 * 19.0);
  s = 1.0 - r2 / (16.0 * 17.0) * s;
  s = 1.0 - r2 / (14.0 * 15.0) * s;
  s = 1.0 - r2 / (12.0 * 13.0) * s;
  s = 1.0 - r2 / (10.0 * 11.0) * s;
  s = 1.0 - r2 / (8.0 * 9.0) * s;
  s = 1.0 - r2 / (6.0 * 7.0) * s;
  s = 1.0 - r2 / (4.0 * 5.0) * s;
  s = 1.0 - r2 / (2.0 * 3.0) * s;
  s *= r;
  c = 1.0 - r2 / (17.0 * 18.0);
  c = 1.0 - r2 / (15.0 * 16.0) * c;
  c = 1.0 - r2 / (13.0 * 14.0) * c;
  c = 1.0 - r2 / (11.0 * 12.0) * c;
  c = 1.0 - r2 / (9.0 * 10.0) * c;
  c = 1.0 - r2 / (7.0 * 8.0) * c;
  c = 1.0 - r2 / (5.0 * 6.0) * c;
  c = 1.0 - r2 / (3.0 * 4.0) * c;
  c = 1.0 - r2 / (1.0 * 2.0) * c;
  double s2 = 2.0 * s * c, c2 = c * c - s * s;
  *sn = 2.0 * s2 * c2; *cs = c2 * c2 - s2 * s2;
}

DI int opaque_tid() { int t = threadIdx.x; asm volatile("" : "+v"(t)); return t; }
DI const char* sgpr_ptr(const char* p) { asm("" : "+s"(p)); return p; }
#define WAIT_V(n) asm volatile("s_waitcnt vmcnt(" #n ")" ::: "memory")
#define WAIT_L(n) asm volatile("s_waitcnt lgkmcnt(" #n ")" ::: "memory")
#define BAR __builtin_amdgcn_s_barrier()
#define SCHED __builtin_amdgcn_sched_barrier(0)
#define GLDS(gp, lp) __builtin_amdgcn_global_load_lds((const unsigned*)(gp), (unsigned*)(lp), 16, 0, 0)

constexpr int GBK = 64, GHALF = 128, GHT = GHALF * GBK;
DI int lds_byte(int r, int c) {
  int st = (r >> 4) * 2 + (c >> 5), rr = r & 15, cc = c & 31, ob = rr * 64 + cc * 2;
  return st * 1024 + (ob ^ (((ob >> 9) & 1) << 5));
}
DI void stage_rc(int b, int& R, int& C) {
  int st = b / 1024, sb = b % 1024, swz = sb ^ (((sb >> 9) & 1) << 5);
  R = (st >> 1) * 16 + swz / 64; C = (st & 1) * 32 + (swz % 64) / 2;
}

typedef f32x4 AccT[2][2][4][2];

template <class Epi>
DI void gemm_tile(const u16* __restrict__ A, const u16* __restrict__ Bt, const int lda, const int ldb, const int K, Epi&& epi) {
  const int TID = opaque_tid();
  extern __shared__ __attribute__((aligned(16))) unsigned char smem[];
  u16* shm = (u16*)smem;
#define SA(b, h) (shm + ((b) * 2 + (h)) * GHT)
#define SB(b, h) (shm + (4 + (b) * 2 + (h)) * GHT)
  int R0, C0, R1, C1;
  stage_rc(TID * 16, R0, C0);
  stage_rc(TID * 16 + 8192, R1, C1);
  const unsigned voA0 = (unsigned)(R0 * lda + C0) * 2u, voA1 = (unsigned)(R1 * lda + C1) * 2u;
  const unsigned voB0 = (unsigned)(R0 * ldb + C0) * 2u, voB1 = (unsigned)(R1 * ldb + C1) * 2u;
  const int hA = GHALF * lda, hB = GHALF * ldb;
  const unsigned wid_u = __builtin_amdgcn_readfirstlane(TID >> 6);
#define STAGE_A(PTR, half, kt) do { const char* _g = sgpr_ptr((const char*)(A + (size_t)(half) * hA + (size_t)(kt) * GBK)); \
    char* _l = (char*)(PTR) + wid_u * 1024u; \
    GLDS(_g + voA0, _l); GLDS(_g + voA1, _l + 8192); } while (0)
#define STAGE_B(PTR, half, kt) do { const char* _g = sgpr_ptr((const char*)(Bt + (size_t)(half) * hB + (size_t)(kt) * GBK)); \
    char* _l = (char*)(PTR) + wid_u * 1024u; \
    GLDS(_g + voB0, _l); GLDS(_g + voB1, _l + 8192); } while (0)
#define LDA(dst, b, h) for (int m = 0; m < 4; ++m) for (int k = 0; k < 2; ++k) \
    dst[m][k] = *reinterpret_cast<const bf16x8*>((char*)SA(b, h) + lds_byte(wr * 64 + m * 16 + fr, k * 32 + fq * 8))
#define LDB(dst, b, h) for (int n = 0; n < 2; ++n) for (int k = 0; k < 2; ++k) \
    dst[n][k] = *reinterpret_cast<const bf16x8*>((char*)SB(b, h) + lds_byte(wc * 32 + n * 16 + fr, k * 32 + fq * 8))
#define MMA(ai, bj, At, Bq) do { __builtin_amdgcn_s_setprio(1); \
    for (int m = 0; m < 4; ++m) for (int n = 0; n < 2; ++n) for (int k = 0; k < 2; ++k) \
      acc[ai][bj][m][n] = __builtin_amdgcn_mfma_f32_16x16x32_bf16(At[m][k], Bq[n][k], acc[ai][bj][m][n], 0, 0, 0); \
    __builtin_amdgcn_s_setprio(0); } while (0)

  const int wid = TID >> 6, lane = TID & 63, wr = wid >> 2, wc = wid & 3, fr = lane & 15, fq = lane >> 4;
  AccT acc;
#pragma unroll
  for (int a = 0; a < 2; ++a)
#pragma unroll
    for (int b = 0; b < 2; ++b)
#pragma unroll
      for (int m = 0; m < 4; ++m)
#pragma unroll
        for (int n = 0; n < 2; ++n) acc[a][b][m][n] = f32x4{0.f, 0.f, 0.f, 0.f};
  bf16x8 At[4][2], B0[2][2], B1[2][2];
  const int nt = K / GBK;
  STAGE_B(SB(0, 0), 0, 0); STAGE_A(SA(0, 0), 0, 0);
  STAGE_B(SB(0, 1), 1, 0); STAGE_A(SA(0, 1), 1, 0);
  if (wr == 1) BAR;
  WAIT_V(4); BAR;
  STAGE_B(SB(1, 0), 0, 1); STAGE_A(SA(1, 0), 0, 1); STAGE_B(SB(1, 1), 1, 1);
  WAIT_V(6); BAR;
  for (int t = 0; t < nt - 2; t += 2) {
    LDB(B0, 0, 0); SCHED; LDA(At, 0, 0); STAGE_A(SA(1, 1), 1, t + 1);
    WAIT_L(8); BAR; WAIT_L(0); MMA(0, 0, At, B0); BAR; SCHED;
    LDB(B1, 0, 1); STAGE_B(SB(0, 0), 0, t + 2);
    BAR; WAIT_L(0); MMA(0, 1, At, B1); BAR;
    LDA(At, 0, 1); STAGE_A(SA(0, 0), 0, t + 2);
    BAR; WAIT_L(0); MMA(1, 0, At, B0); BAR; SCHED;
    STAGE_B(SB(0, 1), 1, t + 2);
    WAIT_V(6); BAR; MMA(1, 1, At, B1); BAR;
    LDB(B0, 1, 0); SCHED; LDA(At, 1, 0); STAGE_A(SA(0, 1), 1, t + 2);
    WAIT_L(8); BAR; WAIT_L(0); MMA(0, 0, At, B0); BAR; SCHED;
    LDB(B1, 1, 1); STAGE_B(SB(1, 0), 0, t + 3);
    BAR; WAIT_L(0); MMA(0, 1, At, B1); BAR;
    LDA(At, 1, 1); STAGE_A(SA(1, 0), 0, t + 3);
    BAR; WAIT_L(0); MMA(1, 0, At, B0); BAR; SCHED;
    STAGE_B(SB(1, 1), 1, t + 3);
    WAIT_V(6); BAR; MMA(1, 1, At, B1); BAR;
  }
  { LDB(B0, 0, 0); LDA(At, 0, 0); STAGE_A(SA(1, 1), 1, nt - 1);
    BAR; WAIT_L(0); MMA(0, 0, At, B0); BAR;
    LDB(B1, 0, 1); BAR; WAIT_L(0); MMA(0, 1, At, B1); BAR;
    LDA(At, 0, 1); WAIT_V(4); BAR; WAIT_L(0); MMA(1, 0, At, B0); MMA(1, 1, At, B1); BAR; }
  { LDB(B0, 1, 0); LDA(At, 1, 0); WAIT_V(2); BAR; WAIT_L(0); MMA(0, 0, At, B0); BAR;
    LDB(B1, 1, 1); WAIT_V(0); BAR; WAIT_L(0); MMA(0, 1, At, B1); BAR;
    LDA(At, 1, 1); BAR; WAIT_L(0); MMA(1, 0, At, B0); MMA(1, 1, At, B1); BAR; }
  if (wr == 0) BAR;
  epi(acc);
#undef SA
#undef SB
}

template <class F>
DI void epi_for(AccT& acc, F&& f) {
  const int TID = opaque_tid();
  const int _wid = TID >> 6, _lane = TID & 63, _wr = _wid >> 2, _wc = _wid & 3, _fr = _lane & 15, _fq = _lane >> 4;
#pragma unroll
  for (int _ai = 0; _ai < 2; ++_ai)
#pragma unroll
    for (int _bj = 0; _bj < 2; ++_bj)
#pragma unroll
      for (int _m = 0; _m < 4; ++_m)
#pragma unroll
        for (int _n = 0; _n < 2; ++_n)
          f(_ai * 128 + _wr * 64 + _m * 16 + _fq * 4, _bj * 128 + _wc * 32 + _n * 16 + _fr, acc[_ai][_bj][_m][_n]);
}

DI void tile_map(int w, int ntn, int& tm, int& tn) {
  int xcd = w & 7, r = w >> 3;
  tn = r % ntn; tm = (r / ntn) * 8 + xcd;
}

DI void transpose_tile(const float* __restrict__ src, int N, u16* __restrict__ dst, int K, int tk, int tn) {
  const int TID = opaque_tid();
  extern __shared__ __attribute__((aligned(16))) unsigned char smem[];
  float* tile = (float*)smem;
  const int t = TID;
  {
    int rk = t >> 3, cs = (t & 7) * 8;
    const float4* s = (const float4*)(src + (size_t)(tk * 64 + rk) * N + tn * 64 + cs);
    float4 a = s[0], b = s[1];
    float* d = tile + rk * 65 + cs;
    d[0] = a.x; d[1] = a.y; d[2] = a.z; d[3] = a.w; d[4] = b.x; d[5] = b.y; d[6] = b.z; d[7] = b.w;
  }
  __syncthreads();
  {
    int n = t >> 3, ks = (t & 7) * 8;
    u32x4 o;
    o[0] = pk2(tile[(ks + 0) * 65 + n], tile[(ks + 1) * 65 + n]);
    o[1] = pk2(tile[(ks + 2) * 65 + n], tile[(ks + 3) * 65 + n]);
    o[2] = pk2(tile[(ks + 4) * 65 + n], tile[(ks + 5) * 65 + n]);
    o[3] = pk2(tile[(ks + 6) * 65 + n], tile[(ks + 7) * 65 + n]);
    *(u32x4*)(dst + (size_t)(tn * 64 + n) * K + tk * 64 + ks) = o;
  }
  __syncthreads();
}

DI void phase_prep_a(const P& p) {
  const int TID = opaque_tid();
  const int bid = blockIdx.x, nb = gridDim.x;
  for (int w = bid; w < 7680; w += nb) {
    int layer = w / 3840, r = w % 3840;
    const float* src; u16* dst; int K, N, tl;
    if (r < 1024) { src = p.in[3] + (size_t)layer * 1024 * 4096; dst = (u16*)(p.ws + WS_WT_IN) + (size_t)layer * 4096 * 1024; K = 1024; N = 4096; tl = r; }
    else if (r < 1280) { src = p.in[6] + (size_t)layer * 1024 * 1024; dst = (u16*)(p.ws + WS_WT_AP) + (size_t)layer * 1024 * 1024; K = 1024; N = 1024; tl = r - 1024; }
    else if (r < 1408) { src = p.in[15] + (size_t)layer * 512 * 1024; dst = (u16*)(p.ws + WS_WT_GA) + (size_t)layer * 1024 * 512; K = 512; N = 1024; tl = r - 1280; }
    else if (r < 1536) { src = p.in[16] + (size_t)layer * 512 * 1024; dst = (u16*)(p.ws + WS_WT_GB) + (size_t)layer * 1024 * 512; K = 512; N = 1024; tl = r - 1408; }
    else if (r < 1792) { src = p.in[17] + (size_t)layer * 1024 * 1024; dst = (u16*)(p.ws + WS_WT_OUT) + (size_t)layer * 1024 * 1024; K = 1024; N = 1024; tl = r - 1536; }
    else if (r < 2816) { src = p.in[19] + (size_t)layer * 1024 * 4096; dst = (u16*)(p.ws + WS_WT_FF1) + (size_t)layer * 4096 * 1024; K = 1024; N = 4096; tl = r - 1792; }
    else { src = p.in[20] + (size_t)layer * 4096 * 1024; dst = (u16*)(p.ws + WS_WT_FF2) + (size_t)layer * 1024 * 4096; K = 4096; N = 1024; tl = r - 2816; }
    int ntn = N / 64;
    transpose_tile(src, N, dst, K, tl / ntn, tl % ntn);
  }
  const int gtid = bid * blockDim.x + TID, nth = nb * blockDim.x;
  float2* LP = (float2*)(p.ws + WS_LPOW);
  float2* BB = (float2*)(p.ws + WS_BBAR);
  for (int i = gtid; i < 8192; i += nth) {
    int lg = i >> 6;
    double step = exp((double)p.in[9][lg]);
    double lr = p.in[7][i], li = p.in[8][i];
    double zr = lr * step, zi = li * step;
    for (int tau = 0; tau <= 32; ++tau) {
      double e = exp(zr * tau), sn, cs;
      sincos_d(zi * tau, &sn, &cs);
      LP[(size_t)i * 33 + tau] = make_float2((float)(e * cs), (float)(e * sn));
    }
    double e = exp(zr), sn, cs;
    sincos_d(zi, &sn, &cs);
    double nr = e * cs - 1.0, ni = e * sn, den = lr * lr + li * li;
    double fr = (nr * lr + ni * li) / den, fi = (ni * lr - nr * li) / den;
    for (int ci = 0; ci < 16; ++ci) {
      double br = p.in[10][(size_t)i * 16 + ci], bi = p.in[11][(size_t)i * 16 + ci];
      BB[(size_t)i * 16 + ci] = make_float2((float)(fr * br - fi * bi), (float)(fr * bi + fi * br));
    }
  }
  float2* RP = (float2*)(p.ws + WS_ROPE);
  for (int i = gtid; i < 128 * 16; i += nth) {
    int pos = i >> 4, f = i & 15;
    double inv = exp(-(double)(2 * f) / 32.0 * 9.210340371976184);
    double sn, cs;
    sincos_d((double)pos * inv, &sn, &cs);
    RP[i] = make_float2((float)cs, (float)sn);
  }
}

DI void phase_prep_b(const P& p) {
  const int TID = opaque_tid();
  const int gtid = blockIdx.x * blockDim.x + TID, nth = gridDim.x * blockDim.x;
  const float2* LP = (const float2*)(p.ws + WS_LPOW);
  const float2* BB = (const float2*)(p.ws + WS_BBAR);
  float* KT = (float*)(p.ws + WS_KTAB);
  const float* cre = p.in[12];
  const float* cim = p.in[13];
  for (int i = gtid; i < (1 << 20); i += nth) {
    int ci = i & 15, co = (i >> 4) & 15, tau = (i >> 8) & 31, lg = i >> 13;
    float s = 0.f;
    for (int pp = 0; pp < 64; ++pp) {
      float cr = cre[(size_t)(lg * 16 + co) * 64 + pp], cI = cim[(size_t)(lg * 16 + co) * 64 + pp];
      float2 l = LP[(size_t)(lg * 64 + pp) * 33 + tau];
      float2 b = BB[(size_t)(lg * 64 + pp) * 16 + ci];
      float xr = l.x * b.x - l.y * b.y, xi = l.x * b.y + l.y * b.x;
      s += cr * xr - cI * xi;
    }
    KT[i] = s;
  }
  u16* W1 = (u16*)(p.ws + WS_W1T);
  for (int i = gtid; i < (1 << 23); i += nth) {
    int k = i & 511, n = (i >> 9) & 255, g = (i >> 17) & 31, layer = i >> 22;
    int dir = n >> 7, pp = (n >> 1) & 63, ri = n & 1, s = k >> 4, ci = k & 15;
    int e = dir ? s : 31 - s;
    int lg = (layer * 2 + dir) * 32 + g;
    float2 l = LP[(size_t)(lg * 64 + pp) * 33 + e];
    float2 b = BB[(size_t)(lg * 64 + pp) * 16 + ci];
    float v = ri ? (l.x * b.y + l.y * b.x) : (l.x * b.x - l.y * b.y);
    W1[i] = f2bf(v);
  }
  u16* WY = (u16*)(p.ws + WS_WYT);
  for (int i = gtid; i < (1 << 23); i += nth) {
    int kk = i & 255, n = (i >> 8) & 511, g = (i >> 17) & 31, layer = i >> 22;
    int t = n >> 4, co = n & 15, dir = kk >> 7, pp = (kk >> 1) & 63, ri = kk & 1;
    int e = dir ? 32 - t : t + 1;
    int lg = (layer * 2 + dir) * 32 + g;
    float cr = cre[(size_t)(lg * 16 + co) * 64 + pp], cI = cim[(size_t)(lg * 16 + co) * 64 + pp];
    float2 l = LP[(size_t)(lg * 64 + pp) * 33 + e];
    float v = ri ? -(cr * l.y + cI * l.x) : (cr * l.x - cI * l.y);
    WY[((size_t)((layer * 32 + g) * 512 + n)) * ASTR + 512 + kk] = f2bf(v);
  }
}

DI void phase_prep_c(const P& p) {
  const int TID = opaque_tid();
  const int gtid = blockIdx.x * blockDim.x + TID, nth = gridDim.x * blockDim.x;
  const float* KT = (const float*)(p.ws + WS_KTAB);
  u16* WY = (u16*)(p.ws + WS_WYT);
  for (int i = gtid; i < (1 << 21); i += nth) {
    int k8 = i & 63, n = (i >> 6) & 511, g = (i >> 15) & 31, layer = i >> 20;
    int t = n >> 4, co = n & 15, s = k8 >> 1, ci0 = (k8 & 1) * 8;
    int tau = t - s;
    float v[8];
    if (tau > 0) {
      const float* q = KT + ((((size_t)(layer * 2 + 0) * 32 + g) * 32 + tau) * 16 + co) * 16 + ci0;
#pragma unroll
      for (int j = 0; j < 8; ++j) v[j] = q[j];
    } else if (tau < 0) {
      const float* q = KT + ((((size_t)(layer * 2 + 1) * 32 + g) * 32 - tau) * 16 + co) * 16 + ci0;
#pragma unroll
      for (int j = 0; j < 8; ++j) v[j] = q[j];
    } else {
      const float* q0 = KT + ((((size_t)(layer * 2 + 0) * 32 + g) * 32) * 16 + co) * 16 + ci0;
      const float* q1 = KT + ((((size_t)(layer * 2 + 1) * 32 + g) * 32) * 16 + co) * 16 + ci0;
#pragma unroll
      for (int j = 0; j < 8; ++j) v[j] = q0[j] + q1[j];
    }
    u32x4 o;
    o[0] = pk2(v[0], v[1]); o[1] = pk2(v[2], v[3]); o[2] = pk2(v[4], v[5]); o[3] = pk2(v[6], v[7]);
    *(u32x4*)(WY + ((size_t)((layer * 32 + g) * 512 + n)) * ASTR + k8 * 8) = o;
  }
}

DI const float* xrow(const P& p, int layer, int tok) {
  if (layer == 0) return tok < NTP ? p.in[0] + (size_t)tok * 1024 : p.in[1] + (size_t)(tok - NTP) * 1024;
  return p.out + (size_t)tok * 1024;
}
DI void phase_norm(const P& p, const float* __restrict__ src0, const float* __restrict__ src1, const float* __restrict__ gain) {
  const int TID = opaque_tid();
  const int lane = TID & 63, wave = TID >> 6;
  u16* XN = (u16*)(p.ws + WS_XN);
  float4 g4[4];
#pragma unroll
  for (int i = 0; i < 4; ++i) g4[i] = *(const float4*)(gain + i * 256 + lane * 4);
  for (int tok = blockIdx.x * 8 + wave; tok < NT; tok += gridDim.x * 8) {
    const float* x = tok < NTP ? src0 + (size_t)tok * 1024 : src1 + (size_t)(tok - NTP) * 1024;
    float4 v[4];
    float ss = 0.f;
#pragma unroll
    for (int i = 0; i < 4; ++i) {
      v[i] = *(const float4*)(x + i * 256 + lane * 4);
      ss += v[i].x * v[i].x + v[i].y * v[i].y + v[i].z * v[i].z + v[i].w * v[i].w;
    }
#pragma unroll
    for (int o = 32; o >= 1; o >>= 1) ss += __shfl_xor(ss, o);
    float rstd = rsqrtf(ss * (1.0f / 1024.0f) + 1e-6f);
#pragma unroll
    for (int i = 0; i < 4; ++i) {
      u32x2 o;
      o[0] = pk2(v[i].x * rstd * g4[i].x, v[i].y * rstd * g4[i].y);
      o[1] = pk2(v[i].z * rstd * g4[i].z, v[i].w * rstd * g4[i].w);
      *(u32x2*)(XN + (size_t)tok * 1024 + i * 256 + lane * 4) = o;
    }
  }
}

DI void phase_scan(const P& p, int layer) {
  const int TID = opaque_tid();
  const int gtid = blockIdx.x * blockDim.x + TID, nth = gridDim.x * blockDim.x;
  const float2* LP = (const float2*)(p.ws + WS_LPOW);
  for (int i = gtid; i < 18 * 4096; i += nth) {
    int pp = i & 63, dir = (i >> 6) & 1, g = (i >> 7) & 31, seq = i >> 12;
    int c0 = seq < 16 ? seq * 128 : 2048 + (seq - 16) * 256;
    int nc = seq < 16 ? 128 : 256;
    float2 a = LP[(size_t)(((layer * 2 + dir) * 32 + g) * 64 + pp) * 33 + 32];
    const float2* S = (const float2*)(p.ws + WS_S) + ((size_t)(g * NCH + c0) * 256 + dir * 128 + pp * 2) / 2;
    unsigned* H = (unsigned*)((u16*)(p.ws + WS_ASSM) + (size_t)(g * NCH + c0) * ASTR + 512 + dir * 128 + pp * 2);
    float hr = 0.f, hi = 0.f;
    if (dir == 0) {
#pragma unroll 8
      for (int c = 0; c < nc; ++c) {
        H[(size_t)c * (ASTR / 2)] = pk2(hr, hi);
        float2 s = S[(size_t)c * 128];
        float nr = a.x * hr - a.y * hi + s.x;
        hi = a.x * hi + a.y * hr + s.y;
        hr = nr;
      }
    } else {
#pragma unroll 8
      for (int c = nc - 1; c >= 0; --c) {
        H[(size_t)c * (ASTR / 2)] = pk2(hr, hi);
        float2 s = S[(size_t)c * 128];
        float nr = a.x * hr - a.y * hi + s.x;
        hi = a.x * hi + a.y * hr + s.y;
        hr = nr;
      }
    }
  }
}

#define MFMA32(a, b, c) __builtin_amdgcn_mfma_f32_32x32x16_bf16((a), (b), (c), 0, 0, 0)
DI void attn_item(const P& p, int seq_start, int L, int head, int qb) {
  const int TID = opaque_tid();
  extern __shared__ __attribute__((aligned(16))) unsigned char smem[];
  const u16* Q = (const u16*)(p.ws + WS_Q);
  const u16* KB = (const u16*)(p.ws + WS_K);
  const u16* VT = (const u16*)(p.ws + WS_VT);
  u16* O = (u16*)(p.ws + WS_ATTO);
  const int tid = TID, wave = tid >> 6, lane = tid & 63, r = lane & 31, h = lane >> 5;
  const int kvh = head >> 2;
  const int q0 = seq_start + qb * 512 + wave * 64;
  bf16x8 qf[2][4];
#pragma unroll
  for (int nt = 0; nt < 2; ++nt)
#pragma unroll
    for (int ds = 0; ds < 4; ++ds)
      qf[nt][ds] = *(const bf16x8*)(Q + (size_t)(q0 + nt * 32 + r) * 1024 + head * 64 + ds * 16 + h * 8);
  const int srow = tid >> 3, spos = tid & 7, scc = spos ^ ((srow >> 1) & 7);
  const u16* kg = KB + ((size_t)kvh * NT + seq_start + srow) * 64 + scc * 8;
  const u16* vg = VT + (size_t)(kvh * 64 + srow) * NT + seq_start + scc * 8;
  unsigned char* ldst = smem + tid * 16;
  const int nkt = L >> 6;
  const int pr = ((r >> 4) * 16) + (((r >> 2) & 1) * 8) + (((r >> 3) & 1) * 4) + (r & 3);
  int koff[4], voff[4];
#pragma unroll
  for (int ds = 0; ds < 4; ++ds) koff[ds] = pr * 128 + (((ds * 2 + h) ^ ((pr >> 1) & 7)) << 4);
#pragma unroll
  for (int c = 0; c < 4; ++c) voff[c] = 8192 + r * 128 + (((c * 2 + h) ^ ((r >> 1) & 7)) << 4);

  f32x16 o[2][2];
#pragma unroll
  for (int a = 0; a < 2; ++a)
#pragma unroll
    for (int b = 0; b < 2; ++b)
#pragma unroll
      for (int j = 0; j < 16; ++j) o[a][b][j] = 0.f;
  float mrun[2] = {-1e30f, -1e30f}, lrun[2] = {0.f, 0.f};

  GLDS(kg, ldst); GLDS(vg, ldst + 8192);
  GLDS(kg + 64 * 64, ldst + 16384); GLDS(vg + 64, ldst + 16384 + 8192);
  int bcur = 0;
  for (int t = 0; t < nkt; ++t) {
    if (t + 1 < nkt) { WAIT_V(2); } else { WAIT_V(0); }
    BAR;
    if (t + 2 < nkt) {
      int bn = bcur + 2; if (bn >= 3) bn -= 3;
      GLDS(kg + (size_t)(t + 2) * 64 * 64, ldst + bn * 16384);
      GLDS(vg + (t + 2) * 64, ldst + bn * 16384 + 8192);
    }
    const unsigned char* kb = smem + bcur * 16384;
    f32x16 s[2][2];
#pragma unroll
    for (int a = 0; a < 2; ++a)
#pragma unroll
      for (int b = 0; b < 2; ++b)
#pragma unroll
        for (int j = 0; j < 16; ++j) s[a][b][j] = 0.f;
#pragma unroll
    for (int ds = 0; ds < 4; ++ds)
#pragma unroll
      for (int kt = 0; kt < 2; ++kt) {
        bf16x8 kf = *(const bf16x8*)(kb + koff[ds] + kt * 4096);
#pragma unroll
        for (int nt = 0; nt < 2; ++nt) s[kt][nt] = MFMA32(kf, qf[nt][ds], s[kt][nt]);
      }
#pragma unroll
    for (int nt = 0; nt < 2; ++nt) {
      float mx = s[0][nt][0];
#pragma unroll
      for (int j = 1; j < 16; ++j) mx = fmaxf(mx, s[0][nt][j]);
#pragma unroll
      for (int j = 0; j < 16; ++j) mx = fmaxf(mx, s[1][nt][j]);
      mx = fmaxf(mx, __shfl_xor(mx, 32));
      float mnew = fmaxf(mrun[nt], mx);
      float alpha = __builtin_amdgcn_exp2f(mrun[nt] - mnew);
      mrun[nt] = mnew;
      float sum = 0.f;
#pragma unroll
      for (int kt = 0; kt < 2; ++kt)
#pragma unroll
        for (int j = 0; j < 16; ++j) { float pv = __builtin_amdgcn_exp2f(s[kt][nt][j] - mnew); s[kt][nt][j] = pv; sum += pv; }
      lrun[nt] = lrun[nt] * alpha + sum;
#pragma unroll
      for (int mt = 0; mt < 2; ++mt)
#pragma unroll
        for (int j = 0; j < 16; ++j) o[mt][nt][j] *= alpha;
    }
#pragma unroll
    for (int kt = 0; kt < 2; ++kt)
#pragma unroll
      for (int s2 = 0; s2 < 2; ++s2) {
        bf16x8 pf[2];
#pragma unroll
        for (int nt = 0; nt < 2; ++nt) {
          u32x4 pk;
#pragma unroll
          for (int i = 0; i < 4; ++i) pk[i] = pk2(s[kt][nt][s2 * 8 + 2 * i], s[kt][nt][s2 * 8 + 2 * i + 1]);
          pf[nt] = __builtin_bit_cast(bf16x8, pk);
        }
#pragma unroll
        for (int mt = 0; mt < 2; ++mt) {
          bf16x8 vf = *(const bf16x8*)(kb + voff[kt * 2 + s2] + mt * 4096);
#pragma unroll
          for (int nt = 0; nt < 2; ++nt) o[mt][nt] = MFMA32(vf, pf[nt], o[mt][nt]);
        }
      }
    bcur = bcur + 1; if (bcur >= 3) bcur = 0;
  }
#pragma unroll
  for (int nt = 0; nt < 2; ++nt) {
    float l = lrun[nt] + __shfl_xor(lrun[nt], 32);
    float inv = 1.0f / l;
    const int tok = q0 + nt * 32 + r;
#pragma unroll
    for (int mt = 0; mt < 2; ++mt)
#pragma unroll
      for (int jg = 0; jg < 4; ++jg) {
        u32x2 ov;
        ov[0] = pk2(o[mt][nt][jg * 4 + 0] * inv, o[mt][nt][jg * 4 + 1] * inv);
        ov[1] = pk2(o[mt][nt][jg * 4 + 2] * inv, o[mt][nt][jg * 4 + 3] * inv);
        *(u32x2*)(O + (size_t)tok * 1024 + head * 64 + mt * 32 + jg * 8 + h * 4) = ov;
      }
  }
  WAIT_L(0);
  BAR;
}


enum { EK_P1 = 0, EK_S, EK_Y, EK_M0, EK_M1, EK_M2, EK_M3, EK_M4, EK_OUT, EK_FF1, EK_FF2 };
struct Job {
  const u16* A; const u16* Bt;
  int lda, ldb, K, kind, tm, tn, layer;
};

DI void epi_p1(const P& p, const Job& jb, AccT& acc) {
  const int TID = opaque_tid();
  const int ft = jb.tm, tt = jb.tn, layer = jb.layer;
  u16* Q = (u16*)(p.ws + WS_Q);
  u16* KB = (u16*)(p.ws + WS_K);
  u16* VT = (u16*)(p.ws + WS_VT);
  u16* AS = (u16*)(p.ws + WS_ASSM);
  const float* qn = p.in[4] + layer * 64;
  const float* kn = p.in[5] + layer * 64;
  const float2* RP = (const float2*)(p.ws + WS_ROPE);
  const int wid = TID >> 6, lane = TID & 63, wr = wid >> 2, wc = wid & 3, fr = lane & 15, fq = lane >> 4;
#pragma unroll
  for (int ai = 0; ai < 2; ++ai) {
    const int fb = ft * 256 + ai * 128 + wr * 64;
#pragma unroll
    for (int bj = 0; bj < 2; ++bj)
#pragma unroll
      for (int n = 0; n < 2; ++n) {
        const int tok = tt * 256 + bj * 128 + wc * 32 + n * 16 + fr;
        if (ft < 5) {
          float ss = 0.f;
#pragma unroll
          for (int m = 0; m < 4; ++m)
#pragma unroll
            for (int j = 0; j < 4; ++j) { float a = acc[ai][bj][m][n][j]; ss += a * a; }
          ss += __shfl_xor(ss, 16);
          ss += __shfl_xor(ss, 32);
          float rstd = rsqrtf(ss * (1.0f / 64.0f) + 1e-6f);
          const float* gn = (ft < 4) ? qn : kn;
          if (ft < 4) rstd *= 0.125f * 1.4426950408889634f;
          const int pos = tok < NTP ? (tok & 4095) : ((tok - NTP) & 8191);
          const int prow = pos >> 6, pcol = pos & 63;
#pragma unroll
          for (int m = 0; m < 4; ++m) {
            const int d0 = m * 16 + fq * 4;
            const float4 g4 = *(const float4*)(gn + d0);
            float v0 = acc[ai][bj][m][n][0] * rstd * g4.x, v1 = acc[ai][bj][m][n][1] * rstd * g4.y;
            float v2 = acc[ai][bj][m][n][2] * rstd * g4.z, v3 = acc[ai][bj][m][n][3] * rstd * g4.w;
            const int i0 = (m & 1) * 8 + fq * 2;
            const float2* rp = RP + ((m < 2) ? prow : pcol) * 16 + i0;
            float2 cs0 = rp[0], cs1 = rp[1];
            u32x2 o;
            o[0] = pk2(v0 * cs0.x - v1 * cs0.y, v0 * cs0.y + v1 * cs0.x);
            o[1] = pk2(v2 * cs1.x - v3 * cs1.y, v2 * cs1.y + v3 * cs1.x);
            if (ft < 4) *(u32x2*)(Q + (size_t)tok * 1024 + fb + d0) = o;
            else *(u32x2*)(KB + ((size_t)((fb - 1024) >> 6) * NT + tok) * 64 + d0) = o;
          }
        } else if (ft == 5) {
          const int kvh = (fb - 1280) >> 6;
#pragma unroll
          for (int m = 0; m < 4; ++m)
#pragma unroll
            for (int j = 0; j < 4; ++j)
              VT[(size_t)(kvh * 64 + m * 16 + fq * 4 + j) * NT + tok] = f2bf(acc[ai][bj][m][n][j]);
        } else {
#pragma unroll
          for (int m = 0; m < 4; ++m) {
            const int g = ((fb - 1536) >> 4) + m;
            u32x2 o;
            o[0] = pk2(acc[ai][bj][m][n][0], acc[ai][bj][m][n][1]);
            o[1] = pk2(acc[ai][bj][m][n][2], acc[ai][bj][m][n][3]);
            *(u32x2*)(AS + ((size_t)g * NCH + (tok >> 5)) * ASTR + (tok & 31) * 16 + fq * 4) = o;
          }
        }
      }
  }
}

DI u32x2 ld8(const u16* q) { return *(const u32x2*)q; }
DI float bflo(unsigned u) { return __uint_as_float(u << 16); }
DI float bfhi(unsigned u) { return __uint_as_float(u & 0xffff0000u); }

DI void run_epilogue(const P& p, const Job& jb, AccT& acc) {
  const int tm = jb.tm, tn = jb.tn, layer = jb.layer;
  switch (jb.kind) {
    case EK_P1: epi_p1(p, jb, acc); break;
    case EK_S: {
      float* Sg = (float*)(p.ws + WS_S) + (size_t)tn * 256 * 256;
      epi_for(acc, [&](const int row0, const int col, const f32x4 v) {
        *(f32x4*)(Sg + (size_t)col * 256 + row0) = v;
      });
    } break;
    case EK_Y: {
      const int g = tn / 10;
      const u16* Ug = jb.Bt;
      u16* Y = (u16*)(p.ws + WS_Y);
      const float* dsk = p.in[14] + layer * 512 + g * 16;
      const int ch0 = (tn % 10) * 256;
      epi_for(acc, [&](const int row0, const int col, const f32x4 v) {
        const int r = tm * 256 + row0;
        const int t = r >> 4, co = r & 15;
        const f32x4 dv = *(const f32x4*)(dsk + co);
        const u32x2 u = ld8(Ug + (size_t)col * ASTR + r);
        u32x2 o;
        o[0] = pk2(gelu_tanh(v[0] + dv[0] * bflo(u[0])), gelu_tanh(v[1] + dv[1] * bfhi(u[0])));
        o[1] = pk2(gelu_tanh(v[2] + dv[2] * bflo(u[1])), gelu_tanh(v[3] + dv[3] * bfhi(u[1])));
        *(u32x2*)(Y + ((size_t)(ch0 + col) * 32 + t) * 512 + g * 16 + co) = o;
      });
    } break;
    case EK_M0: case EK_M1: case EK_M2: case EK_M3: case EK_M4: {
      u16* t1 = (u16*)(p.ws + WS_Q) + (size_t)tn * 256 * 1024 + tm * 256;
      u16* t2 = (u16*)(p.ws + WS_ASSM) + (size_t)tn * 256 * 1024 + tm * 256;
      const int kind = jb.kind;
      epi_for(acc, [&](const int row0, const int col, const f32x4 v) {
        const size_t o = (size_t)col * 1024 + row0;
        f32x4 r;
        if (kind == EK_M0 || kind == EK_M3) {
#pragma unroll
          for (int j = 0; j < 4; ++j) r[j] = sigmoidf_(v[j]);
        } else {
          const u32x2 a = ld8(t1 + o);
          const float a0 = bflo(a[0]), a1 = bfhi(a[0]), a2 = bflo(a[1]), a3 = bfhi(a[1]);
          if (kind == EK_M1) { r[0] = v[0] * a0; r[1] = v[1] * a1; r[2] = v[2] * a2; r[3] = v[3] * a3; }
          else if (kind == EK_M2) { r[0] = sigmoidf_(v[0]) * a0; r[1] = sigmoidf_(v[1]) * a1; r[2] = sigmoidf_(v[2]) * a2; r[3] = sigmoidf_(v[3]) * a3; }
          else {
            const u32x2 b = ld8(t2 + o);
            r[0] = bflo(b[0]) * v[0] + a0; r[1] = bfhi(b[0]) * v[1] + a1; r[2] = bflo(b[1]) * v[2] + a2; r[3] = bfhi(b[1]) * v[3] + a3;
          }
        }
        u32x2 w; w[0] = pk2(r[0], r[1]); w[1] = pk2(r[2], r[3]);
        if (kind == EK_M3) *(u32x2*)(t2 + o) = w; else *(u32x2*)(t1 + o) = w;
      });
    } break;
    case EK_OUT: {
      epi_for(acc, [&](const int row0, const int col, const f32x4 v) {
        const int tok = tn * 256 + col, c = tm * 256 + row0;
        const f32x4 x = *(const f32x4*)(xrow(p, layer, tok) + c);
        *(f32x4*)(p.out + (size_t)tok * 1024 + c) = x + v;
      });
    } break;
    case EK_FF1: {
      u16* f = (u16*)(p.ws + WS_FF) + (size_t)tn * 256 * 4096 + tm * 256;
      epi_for(acc, [&](const int row0, const int col, const f32x4 v) {
        const float a0 = fmaxf(v[0], 0.f), a1 = fmaxf(v[1], 0.f), a2 = fmaxf(v[2], 0.f), a3 = fmaxf(v[3], 0.f);
        u32x2 w; w[0] = pk2(a0 * a0, a1 * a1); w[1] = pk2(a2 * a2, a3 * a3);
        *(u32x2*)(f + (size_t)col * 4096 + row0) = w;
      });
    } break;
    case EK_FF2: {
      float* o = p.out + (size_t)tn * 256 * 1024 + tm * 256;
      epi_for(acc, [&](const int row0, const int col, const f32x4 v) {
        f32x4* q = (f32x4*)(o + (size_t)col * 1024 + row0);
        *q = *q + v;
      });
    } break;
  }
}

DI void make_job(const P& p, int layer, int s, int w, int step, Job& jb) {
  const u16* XN = (const u16*)(p.ws + WS_XN);
  jb.layer = layer;
  if (s == 1) {
    int g = w / 10;
    jb.A = (const u16*)(p.ws + WS_W1T) + ((size_t)layer * 32 + g) * 256 * 512;
    jb.Bt = (const u16*)(p.ws + WS_ASSM) + (size_t)w * 256 * ASTR;
    jb.lda = 512; jb.ldb = ASTR; jb.K = 512; jb.kind = EK_S; jb.tm = 0; jb.tn = w;
    return;
  }
  if (s == 3) {
    int gc = w >> 1, rt = w & 1, g = gc / 10;
    jb.A = (const u16*)(p.ws + WS_WYT) + (((size_t)layer * 32 + g) * 512 + rt * 256) * ASTR;
    jb.Bt = (const u16*)(p.ws + WS_ASSM) + (size_t)gc * 256 * ASTR;
    jb.lda = ASTR; jb.ldb = ASTR; jb.K = ASTR; jb.kind = EK_Y; jb.tm = rt; jb.tn = gc;
    return;
  }
  const int nft = (s == 0) ? 8 : (s == 7) ? 16 : 4;
  int tt, ft; tile_map(w, nft, tt, ft);
  jb.tm = ft; jb.tn = tt;
  jb.lda = 1024; jb.ldb = 1024; jb.K = 1024;
  if (s == 0) {
    jb.A = (const u16*)(p.ws + WS_WT_IN) + (size_t)layer * 4096 * 1024 + (size_t)ft * 256 * 1024;
    jb.Bt = XN + (size_t)tt * 256 * 1024; jb.kind = EK_P1;
  } else if (s == 4) {
    jb.kind = EK_M0 + step;
    if (step < 2) {
      jb.A = (const u16*)(p.ws + (step == 0 ? WS_WT_GB : WS_WT_GA)) + (size_t)layer * 1024 * 512 + (size_t)ft * 256 * 512;
      jb.Bt = (const u16*)(p.ws + WS_Y) + (size_t)tt * 256 * 512;
      jb.lda = 512; jb.ldb = 512; jb.K = 512;
    } else if (step < 4) {
      jb.A = (const u16*)(p.ws + WS_WT_IN) + (size_t)layer * 4096 * 1024 + (size_t)((step == 2 ? 3072 : 2048) + ft * 256) * 1024;
      jb.Bt = XN + (size_t)tt * 256 * 1024;
    } else {
      jb.A = (const u16*)(p.ws + WS_WT_AP) + (size_t)layer * 1024 * 1024 + (size_t)ft * 256 * 1024;
      jb.Bt = (const u16*)(p.ws + WS_ATTO) + (size_t)tt * 256 * 1024;
    }
  } else if (s == 5) {
    jb.A = (const u16*)(p.ws + WS_WT_OUT) + (size_t)layer * 1024 * 1024 + (size_t)ft * 256 * 1024;
    jb.Bt = (const u16*)(p.ws + WS_Q) + (size_t)tt * 256 * 1024; jb.kind = EK_OUT;
  } else if (s == 7) {
    jb.A = (const u16*)(p.ws + WS_WT_FF1) + (size_t)layer * 4096 * 1024 + (size_t)ft * 256 * 1024;
    jb.Bt = XN + (size_t)tt * 256 * 1024; jb.kind = EK_FF1;
  } else {
    jb.A = (const u16*)(p.ws + WS_WT_FF2) + (size_t)layer * 1024 * 4096 + (size_t)ft * 256 * 4096;
    jb.Bt = (const u16*)(p.ws + WS_FF) + (size_t)tt * 256 * 4096;
    jb.lda = 4096; jb.ldb = 4096; jb.K = 4096; jb.kind = EK_FF2;
  }
}

DI void phase_jobs(const P& p, int layer, int s) {
  int nitems, nsteps = 1, nattn = 0;
  switch (s) {
    case 0: nitems = 2560; break;
    case 1: nitems = 320; break;
    case 3: nitems = 3200; nattn = 2560; break;
    case 4: nitems = 1280; nsteps = 5; break;
    case 5: nitems = 1280; break;
    case 7: nitems = 5120; break;
    default: nitems = 1280; break;
  }
  for (int w = blockIdx.x; w < nitems; w += gridDim.x) {
    if (w < nattn) {
      int seq_start, L, head, qb;
      if (w < 512) {
        int xcd = w & 7, r = w >> 3;
        int seq = xcd >> 2, kvh = xcd & 3;
        seq_start = NTP + seq * 8192; L = 8192; head = kvh * 4 + (r >> 4); qb = r & 15;
      } else {
        int w2 = w - 512, xcd = w2 & 7, r = w2 >> 3;
        int grp = (r >> 5) * 8 + xcd, within = r & 31;
        int seq = grp >> 2, kvh = grp & 3;
        seq_start = seq * 4096; L = 4096; head = kvh * 4 + (within >> 3); qb = within & 7;
      }
      attn_item(p, seq_start, L, head, qb);
    } else {
      for (int step = 0; step < nsteps; ++step) {
        Job jb;
        make_job(p, layer, s, w - nattn, step, jb);
        gemm_tile(jb.A, jb.Bt, jb.lda, jb.ldb, jb.K, [&](AccT& acc) { run_epilogue(p, jb, acc); });
      }
    }
  }
}

DI void run_phase(const P& p, int ph) {
  if (ph == 0) { phase_prep_a(p); return; }
  if (ph == 1) { phase_prep_b(p); return; }
  if (ph == 2) { phase_prep_c(p); phase_norm(p, p.in[0], p.in[1], p.in[2]); return; }
  int layer = (ph - 3) / 10, s = (ph - 3) % 10;
  if (s == 2) phase_scan(p, layer);
  else if (s == 6) phase_norm(p, p.out, p.out + (size_t)NTP * 1024, p.in[18] + layer * 1024);
  else if (s == 9) phase_norm(p, p.out, p.out + (size_t)NTP * 1024, p.in[2] + (layer + 1) * 1024);
  else phase_jobs(p, layer, s);
}

__global__ void __launch_bounds__(512, 2) mega_coop(P p) {
  cg::grid_group grid = cg::this_grid();
  for (int ph = p.ph_lo; ph < p.ph_hi; ++ph) {
    run_phase(p, ph);
#if PROBE_MASK
    {
      const int s_ = ph < 3 ? -1 : (ph - 3) % 10;
      bool rep = false;
      if ((PROBE_MASK & 1) && s_ == 3) rep = true;
      if ((PROBE_MASK & 2) && (s_ == 0 || s_ == 4 || s_ == 7)) rep = true;
      if ((PROBE_MASK & 4) && (ph < 3 || s_ == 1 || s_ == 2 || s_ == 6 || s_ == 9)) rep = true;
      if (rep) run_phase(p, ph);
    }
#endif
    if (ph + 1 < p.ph_hi) grid.sync();
  }
}
#if N_LAUNCH_MODE == 0
__global__ void __launch_bounds__(512, 2) mega_one(P p) {
  run_phase(p, p.ph_lo);
}
#endif

extern "C" void kernel_launch(void* const* d_in, const int* in_sizes, int n_in, void* d_out, int out_size, void* d_ws, size_t ws_size,
                              hipStream_t stream) {
  static int grid = 0;
  if (grid == 0) {
    if (n_in != 21 || ws_size < WS_END) { fprintf(stderr, "kernel_launch: unexpected n_in %d / ws_size %zu (need %zu)\n", n_in, ws_size, (size_t)WS_END); grid = -1; return; }
    int dev = 0, cus = 0, per_cu = 0;
    hipGetDevice(&dev);
    hipDeviceGetAttribute(&cus, hipDeviceAttributeMultiprocessorCount, dev);
    hipFuncSetAttribute((const void*)mega_coop, hipFuncAttributeMaxDynamicSharedMemorySize, LDS_BYTES);
#if N_LAUNCH_MODE == 0
    hipFuncSetAttribute((const void*)mega_one, hipFuncAttributeMaxDynamicSharedMemorySize, LDS_BYTES);
#endif
    hipOccupancyMaxActiveBlocksPerMultiprocessor(&per_cu, (const void*)mega_coop, 512, LDS_BYTES);
    if (per_cu < 1) { fprintf(stderr, "kernel_launch: occupancy query says %d blocks/CU\n", per_cu); per_cu = 1; }
    (void)hipGetLastError();
    grid = cus * 1;
  }
  if (grid < 0) return;
  P p{};
  for (int i = 0; i < 21; ++i) p.in[i] = (const float*)d_in[i];
  p.out = (float*)d_out;
  p.ws = (unsigned char*)d_ws;
#if N_LAUNCH_MODE == 1
  p.ph_lo = 0; p.ph_hi = NPHASE;
  void* args[] = {&p};
  hipError_t e = hipLaunchCooperativeKernel((const void*)mega_coop, dim3(grid), dim3(512), args, LDS_BYTES, stream);
  if (e != hipSuccess) fprintf(stderr, "cooperative launch failed: %s (grid %d)\n", hipGetErrorString(e), grid);
#else
  for (int ph = 0; ph < NPHASE; ++ph) {
    p.ph_lo = ph; p.ph_hi = ph + 1;
    hipLaunchKernelGGL(mega_one, dim3(grid), dim3(512), LDS_BYTES, stream, p);
  }
#endif
}
```

```cpp
#include <hip/hip_runtime.h>
#include <hip/hip_cooperative_groups.h>
#include <cstdio>
namespace cg = cooperative_groups;

typedef unsigned short u16;
typedef __attribute__((ext_vector_type(8))) short bf16x8;
typedef __attribute__((ext_vector_type(4))) float f32x4;
typedef __attribute__((ext_vector_type(16))) float f32x16;
typedef __attribute__((ext_vector_type(4))) unsigned u32x4;
typedef __attribute__((ext_vector_type(2))) unsigned u32x2;
typedef __attribute__((ext_vector_type(2))) float f32x2;
typedef __attribute__((ext_vector_type(2))) __bf16 bf16v2;

#define DI __device__ __forceinline__
#ifndef PROBE_MASK
#define PROBE_MASK 0
#endif
#ifndef N_LAUNCH_MODE
#define N_LAUNCH_MODE 1
#endif

constexpr int NT = 81920;
constexpr int NTP = 65536;
constexpr int NCH = 2560;
constexpr int ASTR = 768;
constexpr int NPHASE = 22;
constexpr int LDS_BYTES = 131072;

constexpr size_t MiB = 1ull << 20;
constexpr size_t WS_WT_IN = 0;
constexpr size_t WS_WT_AP = 16 * MiB;
constexpr size_t WS_WT_GA = 20 * MiB;
constexpr size_t WS_WT_GB = 22 * MiB;
constexpr size_t WS_WT_OUT = 24 * MiB;
constexpr size_t WS_WT_FF1 = 28 * MiB;
constexpr size_t WS_WT_FF2 = 44 * MiB;
constexpr size_t WS_W1T = 60 * MiB;
constexpr size_t WS_WYT = 76 * MiB;
constexpr size_t WS_LPOW = 124 * MiB;
constexpr size_t WS_BBAR = 127 * MiB;
constexpr size_t WS_KTAB = 128 * MiB;
constexpr size_t WS_ROPE = 132 * MiB;
constexpr size_t WS_XN = 133 * MiB;
constexpr size_t WS_BIG = 293 * MiB;
constexpr size_t WS_Q = WS_BIG;
constexpr size_t WS_K = WS_BIG + 160 * MiB;
constexpr size_t WS_VT = WS_BIG + 200 * MiB;
constexpr size_t WS_ASSM = WS_BIG + 240 * MiB;
constexpr size_t WS_S = WS_BIG + 360 * MiB;
constexpr size_t WS_Y = WS_BIG + 440 * MiB;
constexpr size_t WS_ATTO = WS_BIG + 520 * MiB;
constexpr size_t WS_FF = WS_BIG;
constexpr size_t WS_END = WS_BIG + 680 * MiB;

struct P {
  const float* in[21];
  float* out;
  unsigned char* ws;
  int ph_lo, ph_hi;
};

DI u16 f2bf(float f) { unsigned u = __float_as_uint(f); u += 0x7fffu + ((u >> 16) & 1u); return (u16)(u >> 16); }
DI float bf2f(u16 h) { return __uint_as_float(((unsigned)h) << 16); }
DI unsigned pk2(float a, float b) {
  f32x2 v; v[0] = a; v[1] = b;
  bf16v2 r = __builtin_convertvector(v, bf16v2);
  return __builtin_bit_cast(unsigned, r);
}
DI float sigmoidf_(float x) { return 1.0f / (1.0f + __expf(-x)); }
DI float gelu_tanh(float x) {
  float z = 0.7978845608028654f * (x + 0.044715f * x * x * x);
  float e = __expf(2.0f * z);
  return 0.5f * x * (2.0f - 2.0f / (e + 1.0f));
}


DI void sincos_d(double x, double* sn, double* cs) {
  const double TWO_PI_HI = 6.283185307179586232e+00, TWO_PI_LO = 2.449293598294706414e-16;
  double k = rint(x * 0.15915494309189534561);
  double r = (x - k * TWO_PI_HI) - k * TWO_PI_LO;
  r *= 0.25;
  double r2 = r * r;
  double s = 1.0, c = 1.0;
  s = 1.0 - r2 / (18.0 * 19.0);
  s = 1.0 - r2 / (16.0 * 17.0) * s;
  s = 1.0 - r2 / (14.0 * 15.0) * s;
  s = 1.0 - r2 / (12.0 * 13.0) * s;
  s = 1.0 - r2 / (10.0 * 11.0) * s;
  s = 1.0 - r2 / (8.0 * 9.0) * s;
  s = 1.0 - r2 / (6.0 * 7.0) * s;
  s = 1.0 - r2 / (4.0 * 5.0) * s;
  s = 1.0 - r2 / (2.0 * 3.0) * s;
  s *= r;
  c = 1.0 - r2 / (17.0 * 18.0);
  c = 1.0 - r2 / (15.0 * 16.0) * c;
  c = 1.0 - r2 / (13.0 * 14.0) * c;
  c = 1.0 - r2 / (11.0 * 12.0) * c;
  c = 1.0 - r2 / (9.0 * 10.0) * c;
  c = 1.0 - r2 / (7.0 * 8.0) * c;
  c = 1.0 - r2 / (5.0 * 6.0) * c;
  c = 1.0 - r2 / (3.0 * 4.0) * c;
  c = 1.0 - r2 / (1.0 * 2.0) * c;
  double s2 = 2.0 * s * c, c2 = c * c - s * s;
  *sn = 2.0 * s2 * c2; *cs = c2 * c2 - s2 * s2;
}

DI int opaque_tid() { int t = threadIdx.x; asm volatile("" : "+v"(t)); return t; }
DI const char* sgpr_ptr(const char* p) { asm("" : "+s"(p)); return p; }
#define WAIT_V(n) asm volatile("s_waitcnt vmcnt(" #n ")" ::: "memory")
#define WAIT_L(n) asm volatile("s_waitcnt lgkmcnt(" #n ")" ::: "memory")
#define BAR __builtin_amdgcn_s_barrier()
#define SCHED __builtin_amdgcn_sched_barrier(0)
#define GLDS(gp, lp) __builtin_amdgcn_global_load_lds((const unsigned*)(gp), (unsigned*)(lp), 16, 0, 0)

constexpr int GBK = 64, GHALF = 128, GHT = GHALF * GBK;
DI int lds_byte(int r, int c) {
  int st = (r >> 4) * 2 + (c >> 5), rr = r & 15, cc = c & 31, ob = rr * 64 + cc * 2;
  return st * 1024 + (ob ^ (((ob >> 9) & 1) << 5));
}
DI void stage_rc(int b, int& R, int& C) {
  int st = b / 1024, sb = b % 1024, swz = sb ^ (((sb >> 9) & 1) << 5);
  R = (st >> 1) * 16 + swz / 64; C = (st & 1) * 32 + (swz % 64) / 2;
}

typedef f32x4 AccT[2][2][4][2];

template <class Epi>
DI void gemm_tile(const u16* __restrict__ A, const u16* __restrict__ Bt, const int lda, const int ldb, const int K, Epi&& epi) {
  const int TID = opaque_tid();
  extern __shared__ __attribute__((aligned(16))) unsigned char smem[];
  u16* shm = (u16*)smem;
#define SA(b, h) (shm + ((b) * 2 + (h)) * GHT)
#define SB(b, h) (shm + (4 + (b) * 2 + (h)) * GHT)
  int R0, C0, R1, C1;
  stage_rc(TID * 16, R0, C0);
  stage_rc(TID * 16 + 8192, R1, C1);
  const unsigned voA0 = (unsigned)(R0 * lda + C0) * 2u, voA1 = (unsigned)(R1 * lda + C1) * 2u;
  const unsigned voB0 = (unsigned)(R0 * ldb + C0) * 2u, voB1 = (unsigned)(R1 * ldb + C1) * 2u;
  const int hA = GHALF * lda, hB = GHALF * ldb;
  const unsigned wid_u = __builtin_amdgcn_readfirstlane(TID >> 6);
#define STAGE_A(PTR, half, kt) do { const char* _g = sgpr_ptr((const char*)(A + (size_t)(half) * hA + (size_t)(kt) * GBK)); \
    char* _l = (char*)(PTR) + wid_u * 1024u; \
    GLDS(_g + voA0, _l); GLDS(_g + voA1, _l + 8192); } while (0)
#define STAGE_B(PTR, half, kt) do { const char* _g = sgpr_ptr((const char*)(Bt + (size_t)(half) * hB + (size_t)(kt) * GBK)); \
    char* _l = (char*)(PTR) + wid_u * 1024u; \
    GLDS(_g + voB0, _l); GLDS(_g + voB1, _l + 8192); } while (0)
#define LDA(dst, b, h) for (int m = 0; m < 4; ++m) for (int k = 0; k < 2; ++k) \
    dst[m][k] = *reinterpret_cast<const bf16x8*>((char*)SA(b, h) + lds_byte(wr * 64 + m * 16 + fr, k * 32 + fq * 8))
#define LDB(dst, b, h) for (int n = 0; n < 2; ++n) for (int k = 0; k < 2; ++k) \
    dst[n][k] = *reinterpret_cast<const bf16x8*>((char*)SB(b, h) + lds_byte(wc * 32 + n * 16 + fr, k * 32 + fq * 8))
#define MMA(ai, bj, At, Bq) do { __builtin_amdgcn_s_setprio(1); \
    for (int m = 0; m < 4; ++m) for (int n = 0; n < 2; ++n) for (int k = 0; k < 2; ++k) \
      acc[ai][bj][m][n] = __builtin_amdgcn_mfma_f32_16x16x32_bf16(At[m][k], Bq[n][k], acc[ai][bj][m][n], 0, 0, 0); \
    __builtin_amdgcn_s_setprio(0); } while (0)

  const int wid = TID >> 6, lane = TID & 63, wr = wid >> 2, wc = wid & 3, fr = lane & 15, fq = lane >> 4;
  AccT acc;
#pragma unroll
  for (int a = 0; a < 2; ++a)
#pragma unroll
    for (int b = 0; b < 2; ++b)
#pragma unroll
      for (int m = 0; m < 4; ++m)
#pragma unroll
        for (int n = 0; n < 2; ++n) acc[a][b][m][n] = f32x4{0.f, 0.f, 0.f, 0.f};
  bf16x8 At[4][2], B0[2][2], B1[2][2];
  const int nt = K / GBK;
  STAGE_B(SB(0, 0), 0, 0); STAGE_A(SA(0, 0), 0, 0);
  STAGE_B(SB(0, 1), 1, 0); STAGE_A(SA(0, 1), 1, 0);
  if (wr == 1) BAR;
  WAIT_V(4); BAR;
  STAGE_B(SB(1, 0), 0, 1); STAGE_A(SA(1, 0), 0, 1); STAGE_B(SB(1, 1), 1, 1);
  WAIT_V(6); BAR;
  for (int t = 0; t < nt - 2; t += 2) {
    LDB(B0, 0, 0); SCHED; LDA(At, 0, 0); STAGE_A(SA(1, 1), 1, t + 1);
    WAIT_L(8); BAR; WAIT_L(0); MMA(0, 0, At, B0); BAR; SCHED;
    LDB(B1, 0, 1); STAGE_B(SB(0, 0), 0, t + 2);
    BAR; WAIT_L(0); MMA(0, 1, At, B1); BAR;
    LDA(At, 0, 1); STAGE_A(SA(0, 0), 0, t + 2);
    BAR; WAIT_L(0); MMA(1, 0, At, B0); BAR; SCHED;
    STAGE_B(SB(0, 1), 1, t + 2);
    WAIT_V(6); BAR; MMA(1, 1, At, B1); BAR;
    LDB(B0, 1, 0); SCHED; LDA(At, 1, 0); STAGE_A(SA(0, 1), 1, t + 2);
    WAIT_L(8); BAR; WAIT_L(0); MMA(0, 0, At, B0); BAR; SCHED;
    LDB(B1, 1, 1); STAGE_B(SB(1, 0), 0, t + 3);
    BAR; WAIT_L(0); MMA(0, 1, At, B1); BAR;
    LDA(At, 1, 1); STAGE_A(SA(1, 0), 0, t + 3);
    BAR; WAIT_L(0); MMA(1, 0, At, B0); BAR; SCHED;
    STAGE_B(SB(1, 1), 1, t + 3);
    WAIT_V(6); BAR; MMA(1, 1, At, B1); BAR;
  }
  { LDB(B0, 0, 0); LDA(At, 0, 0); STAGE_A(SA(1, 1), 1, nt - 1);
    BAR; WAIT_L(0); MMA(0, 0, At, B0); BAR;
    LDB(B1, 0, 1); BAR; WAIT_L(0); MMA(0, 1, At, B1); BAR;
    LDA(At, 0, 1); WAIT_V(4); BAR; WAIT_L(0); MMA(1, 0, At, B0); MMA(1, 1, At, B1); BAR; }
  { LDB(B0, 1, 0); LDA(At, 1, 0); WAIT_V(2); BAR; WAIT_L(0); MMA(0, 0, At, B0); BAR;
    LDB(B1, 1, 1); WAIT_V(0); BAR; WAIT_L(0); MMA(0, 1, At, B1); BAR;
    LDA(At, 1, 1); BAR; WAIT_L(0); MMA(1, 0, At, B0); MMA(1, 1, At, B1); BAR; }
  if (wr == 0) BAR;
  epi(acc);
#undef SA
#undef SB
}

template <class F>
DI void epi_for(AccT& acc, F&& f) {
  const int TID = opaque_tid();
  const int _wid = TID >> 6, _lane = TID & 63, _wr = _wid >> 2, _wc = _wid & 3, _fr = _lane & 15, _fq = _lane >> 4;
#pragma unroll
  for (int _ai = 0; _ai < 2; ++_ai)
#pragma unroll
    for (int _bj = 0; _bj < 2; ++_bj)
#pragma unroll
      for (int _m = 0; _m < 4; ++_m)
#pragma unroll
        for (int _n = 0; _n < 2; ++_n)
          f(_ai * 128 + _wr * 64 + _m * 16 + _fq * 4, _bj * 128 + _wc * 32 + _n * 16 + _fr, acc[_ai][_bj][_m][_n]);
}

DI void tile_map(int w, int ntn, int& tm, int& tn) {
  int xcd = w & 7, r = w >> 3;
  tn = r % ntn; tm = (r / ntn) * 8 + xcd;
}

DI void transpose_tile(const float* __restrict__ src, int N, u16* __restrict__ dst, int K, int tk, int tn) {
  const int TID = opaque_tid();
  extern __shared__ __attribute__((aligned(16))) unsigned char smem[];
  float* tile = (float*)smem;
  const int t = TID;
  {
    int rk = t >> 3, cs = (t & 7) * 8;
    const float4* s = (const float4*)(src + (size_t)(tk * 64 + rk) * N + tn * 64 + cs);
    float4 a = s[0], b = s[1];
    float* d = tile + rk * 65 + cs;
    d[0] = a.x; d[1] = a.y; d[2] = a.z; d[3] = a.w; d[4] = b.x; d[5] = b.y; d[6] = b.z; d[7] = b.w;
  }
  __syncthreads();
  {
    int n = t >> 3, ks = (t & 7) * 8;
    u32x4 o;
    o[0] = pk2(tile[(ks + 0) * 65 + n], tile[(ks + 1) * 65 + n]);
    o[1] = pk2(tile[(ks + 2) * 65 + n], tile[(ks + 3) * 65 + n]);
    o[2] = pk2(tile[(ks + 4) * 65 + n], tile[(ks + 5) * 65 + n]);
    o[3] = pk2(tile[(ks + 6) * 65 + n], tile[(ks + 7) * 65 + n]);
    *(u32x4*)(dst + (size_t)(tn * 64 + n) * K + tk * 64 + ks) = o;
  }
  __syncthreads();
}

DI void phase_prep_a(const P& p) {
  const int TID = opaque_tid();
  const int bid = blockIdx.x, nb = gridDim.x;
  for (int w = bid; w < 7680; w += nb) {
    int layer = w / 3840, r = w % 3840;
    const float* src; u16* dst; int K, N, tl;
    if (r < 1024) { src = p.in[3] + (size_t)layer * 1024 * 4096; dst = (u16*)(p.ws + WS_WT_IN) + (size_t)layer * 4096 * 1024; K = 1024; N = 4096; tl = r; }
    else if (r < 1280) { src = p.in[6] + (size_t)layer * 1024 * 1024; dst = (u16*)(p.ws + WS_WT_AP) + (size_t)layer * 1024 * 1024; K = 1024; N = 1024; tl = r - 1024; }
    else if (r < 1408) { src = p.in[15] + (size_t)layer * 512 * 1024; dst = (u16*)(p.ws + WS_WT_GA) + (size_t)layer * 1024 * 512; K = 512; N = 1024; tl = r - 1280; }
    else if (r < 1536) { src = p.in[16] + (size_t)layer * 512 * 1024; dst = (u16*)(p.ws + WS_WT_GB) + (size_t)layer * 1024 * 512; K = 512; N = 1024; tl = r - 1408; }
    else if (r < 1792) { src = p.in[17] + (size_t)layer * 1024 * 1024; dst = (u16*)(p.ws + WS_WT_OUT) + (size_t)layer * 1024 * 1024; K = 1024; N = 1024; tl = r - 1536; }
    else if (r < 2816) { src = p.in[19] + (size_t)layer * 1024 * 4096; dst = (u16*)(p.ws + WS_WT_FF1) + (size_t)layer * 4096 * 1024; K = 1024; N = 4096; tl = r - 1792; }
    else { src = p.in[20] + (size_t)layer * 4096 * 1024; dst = (u16*)(p.ws + WS_WT_FF2) + (size_t)layer * 1024 * 4096; K = 4096; N = 1024; tl = r - 2816; }
    int ntn = N / 64;
    transpose_tile(src, N, dst, K, tl / ntn, tl % ntn);
  }
  const int gtid = bid * blockDim.x + TID, nth = nb * blockDim.x;
  float2* LP = (float2*)(p.ws + WS_LPOW);
  float2* BB = (float2*)(p.ws + WS_BBAR);
  for (int i = gtid; i < 8192; i += nth) {
    int lg = i >> 6;
    double step = exp((double)p.in[9][lg]);
    double lr = p.in[7][i], li = p.in[8][i];
    double zr = lr * step, zi = li * step;
    for (int tau = 0; tau <= 32; ++tau) {
      double e = exp(zr * tau), sn, cs;
      sincos_d(zi * tau, &sn, &cs);
      LP[(size_t)i * 33 + tau] = make_float2((float)(e * cs), (float)(e * sn));
    }
    double e = exp(zr), sn, cs;
    sincos_d(zi, &sn, &cs);
    double nr = e * cs - 1.0, ni = e * sn, den = lr * lr + li * li;
    double fr = (nr * lr + ni * li) / den, fi = (ni * lr - nr * li) / den;
    for (int ci = 0; ci < 16; ++ci) {
      double br = p.in[10][(size_t)i * 16 + ci], bi = p.in[11][(size_t)i * 16 + ci];
      BB[(size_t)i * 16 + ci] = make_float2((float)(fr * br - fi * bi), (float)(fr * bi + fi * br));
    }
  }
  float2* RP = (float2*)(p.ws + WS_ROPE);
  for (int i = gtid; i < 128 * 16; i += nth) {
    int pos = i >> 4, f = i & 15;
    double inv = exp(-(double)(2 * f) / 32.0 * 9.210340371976184);
    double sn, cs;
    sincos_d((double)pos * inv, &sn, &cs);
    RP[i] = make_float2((float)cs, (float)sn);
  }
}

DI void phase_prep_b(const P& p) {
  const int TID = opaque_tid();
  const int gtid = blockIdx.x * blockDim.x + TID, nth = gridDim.x * blockDim.x;
  const float2* LP = (const float2*)(p.ws + WS_LPOW);
  const float2* BB = (const float2*)(p.ws + WS_BBAR);
  float* KT = (float*)(p.ws + WS_KTAB);
  const float* cre = p.in[12];
  const float* cim = p.in[13];
  for (int i = gtid; i < (1 << 20); i += nth) {
    int ci = i & 15, co = (i >> 4) & 15, tau = (i >> 8) & 31, lg = i >> 13;
    float s = 0.f;
    for (int pp = 0; pp < 64; ++pp) {
      float cr = cre[(size_t)(lg * 16 + co) * 64 + pp], cI = cim[(size_t)(lg * 16 + co) * 64 + pp];
      float2 l = LP[(size_t)(lg * 64 + pp) * 33 + tau];
      float2 b = BB[(size_t)(lg * 64 + pp) * 16 + ci];
      float xr = l.x * b.x - l.y * b.y, xi = l.x * b.y + l.y * b.x;
      s += cr * xr - cI * xi;
    }
    KT[i] = s;
  }
  u16* W1 = (u16*)(p.ws + WS_W1T);
  for (int i = gtid; i < (1 << 23); i += nth) {
    int k = i & 511, n = (i >> 9) & 255, g = (i >> 17) & 31, layer = i >> 22;
    int dir = n >> 7, pp = (n >> 1) & 63, ri = n & 1, s = k >> 4, ci = k & 15;
    int e = dir ? s : 31 - s;
    int lg = (layer * 2 + dir) * 32 + g;
    float2 l = LP[(size_t)(lg * 64 + pp) * 33 + e];
    float2 b = BB[(size_t)(lg * 64 + pp) * 16 + ci];
    float v = ri ? (l.x * b.y + l.y * b.x) : (l.x * b.x - l.y * b.y);
    W1[i] = f2bf(v);
  }
  u16* WY = (u16*)(p.ws + WS_WYT);
  for (int i = gtid; i < (1 << 23); i += nth) {
    int kk = i & 255, n = (i >> 8) & 511, g = (i >> 17) & 31, layer = i >> 22;
    int t = n >> 4, co = n & 15, dir = kk >> 7, pp = (kk >> 1) & 63, ri = kk & 1;
    int e = dir ? 32 - t : t + 1;
    int lg = (layer * 2 + dir) * 32 + g;
    float cr = cre[(size_t)(lg * 16 + co) * 64 + pp], cI = cim[(size_t)(lg * 16 + co) * 64 + pp];
    float2 l = LP[(size_t)(lg * 64 + pp) * 33 + e];
    float v = ri ? -(cr * l.y + cI * l.x) : (cr * l.x - cI * l.y);
    WY[((size_t)((layer * 32 + g) * 512 + n)) * ASTR + 512 + kk] = f2bf(v);
  }
}

DI void phase_prep_c(const P& p) {
  const int TID = opaque_tid();
  const int gtid = blockIdx.x * blockDim.x + TID, nth = gridDim.x * blockDim.x;
  const float* KT = (const float*)(p.ws + WS_KTAB);
  u16* WY = (u16*)(p.ws + WS_WYT);
  for (int i = gtid; i < (1 << 21); i += nth) {
    int k8 = i & 63, n = (i >> 6) & 511, g = (i >> 15) & 31, layer = i >> 20;
    int t = n >> 4, co = n & 15, s = k8 >> 1, ci0 = (k8 & 1) * 8;
    int tau = t - s;
    float v[8];
    if (tau > 0) {
      const float* q = KT + ((((size_t)(layer * 2 + 0) * 32 + g) * 32 + tau) * 16 + co) * 16 + ci0;
#pragma unroll
      for (int j = 0; j < 8; ++j) v[j] = q[j];
    } else if (tau < 0) {
      const float* q = KT + ((((size_t)(layer * 2 + 1) * 32 + g) * 32 - tau) * 16 + co) * 16 + ci0;
#pragma unroll
      for (int j = 0; j < 8; ++j) v[j] = q[j];
    } else {
      const float* q0 = KT + ((((size_t)(layer * 2 + 0) * 32 + g) * 32) * 16 + co) * 16 + ci0;
      const float* q1 = KT + ((((size_t)(layer * 2 + 1) * 32 + g) * 32) * 16 + co) * 16 + ci0;
#pragma unroll
      for (int j = 0; j < 8; ++j) v[j] = q0[j] + q1[j];
    }
    u32x4 o;
    o[0] = pk2(v[0], v[1]); o[1] = pk2(v[2], v[3]); o[2] = pk2(v[4], v[5]); o[3] = pk2(v[6], v[7]);
    *(u32x4*)(WY + ((size_t)((layer * 32 + g) * 512 + n)) * ASTR + k8 * 8) = o;
  }
}

DI const float* xrow(const P& p, int layer, int tok) {
  if (layer == 0) return tok < NTP ? p.in[0] + (size_t)tok * 1024 : p.in[1] + (size_t)(tok - NTP) * 1024;
  return p.out + (size_t)tok * 1024;
}
DI void phase_norm(const P& p, const float* __restrict__ src0, const float* __restrict__ src1, const float* __restrict__ gain) {
  const int TID = opaque_tid();
  const int lane = TID & 63, wave = TID >> 6;
  u16* XN = (u16*)(p.ws + WS_XN);
  float4 g4[4];
#pragma unroll
  for (int i = 0; i < 4; ++i) g4[i] = *(const float4*)(gain + i * 256 + lane * 4);
  for (int tok = blockIdx.x * 8 + wave; tok < NT; tok += gridDim.x * 8) {
    const float* x = tok < NTP ? src0 + (size_t)tok * 1024 : src1 + (size_t)(tok - NTP) * 1024;
    float4 v[4];
    float ss = 0.f;
#pragma unroll
    for (int i = 0; i < 4; ++i) {
      v[i] = *(const float4*)(x + i * 256 + lane * 4);
      ss += v[i].x * v[i].x + v[i].y * v[i].y + v[i].z * v[i].z + v[i].w * v[i].w;
    }
#pragma unroll
    for (int o = 32; o >= 1; o >>= 1) ss += __shfl_xor(ss, o);
    float rstd = rsqrtf(ss * (1.0f / 1024.0f) + 1e-6f);
#pragma unroll
    for (int i = 0; i < 4; ++i) {
      u32x2 o;
      o[0] = pk2(v[i].x * rstd * g4[i].x, v[i].y * rstd * g4[i].y);
      o[1] = pk2(v[i].z * rstd * g4[i].z, v[i].w * rstd * g4[i].w);
      *(u32x2*)(XN + (size_t)tok * 1024 + i * 256 + lane * 4) = o;
    }
  }
}

DI void phase_scan(const P& p, int layer) {
  const int TID = opaque_tid();
  const int gtid = blockIdx.x * blockDim.x + TID, nth = gridDim.x * blockDim.x;
  const float2* LP = (const float2*)(p.ws + WS_LPOW);
  for (int i = gtid; i < 18 * 4096; i += nth) {
    int pp = i & 63, dir = (i >> 6) & 1, g = (i >> 7) & 31, seq = i >> 12;
    int c0 = seq < 16 ? seq * 128 : 2048 + (seq - 16) * 256;
    int nc = seq < 16 ? 128 : 256;
    float2 a = LP[(size_t)(((layer * 2 + dir) * 32 + g) * 64 + pp) * 33 + 32];
    const float2* S = (const float2*)(p.ws + WS_S) + ((size_t)(g * NCH + c0) * 256 + dir * 128 + pp * 2) / 2;
    unsigned* H = (unsigned*)((u16*)(p.ws + WS_ASSM) + (size_t)(g * NCH + c0) * ASTR + 512 + dir * 128 + pp * 2);
    float hr = 0.f, hi = 0.f;
    if (dir == 0) {
#pragma unroll 8
      for (int c = 0; c < nc; ++c) {
        H[(size_t)c * (ASTR / 2)] = pk2(hr, hi);
        float2 s = S[(size_t)c * 128];
        float nr = a.x * hr - a.y * hi + s.x;
        hi = a.x * hi + a.y * hr + s.y;
        hr = nr;
      }
    } else {
#pragma unroll 8
      for (int c = nc - 1; c >= 0; --c) {
        H[(size_t)c * (ASTR / 2)] = pk2(hr, hi);
        float2 s = S[(size_t)c * 128];
        float nr = a.x * hr - a.y * hi + s.x;
        hi = a.x * hi + a.y * hr + s.y;
        hr = nr;
      }
    }
  }
}

#define MFMA32(a, b, c) __builtin_amdgcn_mfma_f32_32x32x16_bf16((a), (b), (c), 0, 0, 0)
DI void attn_item(const P& p, int seq_start, int L, int head, int qb) {
  const int TID = opaque_tid();
  extern __shared__ __attribute__((aligned(16))) unsigned char smem[];
  const u16* Q = (const u16*)(p.ws + WS_Q);
  const u16* KB = (const u16*)(p.ws + WS_K);
  const u16* VT = (const u16*)(p.ws + WS_VT);
  u16* O = (u16*)(p.ws + WS_ATTO);
  const int tid = TID, wave = tid >> 6, lane = tid & 63, r = lane & 31, h = lane >> 5;
  const int kvh = head >> 2;
  const int q0 = seq_start + qb * 512 + wave * 64;
  bf16x8 qf[2][4];
#pragma unroll
  for (int nt = 0; nt < 2; ++nt)
#pragma unroll
    for (int ds = 0; ds < 4; ++ds)
      qf[nt][ds] = *(const bf16x8*)(Q + (size_t)(q0 + nt * 32 + r) * 1024 + head * 64 + ds * 16 + h * 8);
#pragma unroll
  for (int nt = 0; nt < 2; ++nt)
#pragma unroll
    for (int ds = 0; ds < 4; ++ds) asm volatile("" ::"v"(qf[nt][ds]));
  const int srow = tid >> 3, spos = tid & 7, scc = spos ^ ((srow >> 1) & 7);
  const u16* kg = KB + ((size_t)kvh * NT + seq_start + srow) * 64 + scc * 8;
  const u16* vg = VT + (size_t)(kvh * 64 + srow) * NT + seq_start + scc * 8;
  unsigned char* ldst = smem + tid * 16;
  const int nkt = L >> 6;
  const int pr = ((r >> 4) * 16) + (((r >> 2) & 1) * 8) + (((r >> 3) & 1) * 4) + (r & 3);
  int koff[4];
#pragma unroll
  for (int ds = 0; ds < 4; ++ds) koff[ds] = pr * 128 + (((ds * 2 + h) ^ ((pr >> 1) & 7)) << 4);
  const int vxh = ((r >> 1) & 7) >> 1;
  const int vbase = 8192 + r * 128 + ((h ^ ((r >> 1) & 1)) << 4);

  f32x16 o[2][2];
#pragma unroll
  for (int a = 0; a < 2; ++a)
#pragma unroll
    for (int b = 0; b < 2; ++b)
#pragma unroll
      for (int j = 0; j < 16; ++j) o[a][b][j] = 0.f;
  float mrun[2] = {0.f, 0.f}, lrun[2] = {0.f, 0.f};

  GLDS(kg, ldst); GLDS(vg, ldst + 8192);
  GLDS(kg + 64 * 64, ldst + 16384); GLDS(vg + 64, ldst + 16384 + 8192);
  int bcur = 0;
  for (int t = 0; t < nkt; ++t) {
    if (t + 1 < nkt) { WAIT_V(2); } else { WAIT_V(0); }
    BAR;
    if (t + 2 < nkt) {
      int bn = bcur + 2; if (bn >= 3) bn -= 3;
      GLDS(kg + (size_t)(t + 2) * 64 * 64, ldst + bn * 16384);
      GLDS(vg + (t + 2) * 64, ldst + bn * 16384 + 8192);
    }
    const unsigned char* kb = smem + bcur * 16384;
#pragma unroll 1
    for (int kt = 0; kt < 2; ++kt) {
      bf16x8 kf[4], vf[2][2];
#pragma unroll
      for (int ds = 0; ds < 4; ++ds) kf[ds] = *(const bf16x8*)(kb + koff[ds] + kt * 4096);
#pragma unroll
      for (int s2 = 0; s2 < 2; ++s2)
#pragma unroll
        for (int mt = 0; mt < 2; ++mt) vf[s2][mt] = *(const bf16x8*)(kb + vbase + (((kt * 2 + s2) ^ vxh) << 5) + mt * 4096);
      f32x16 sc[2];
#pragma unroll
      for (int nt = 0; nt < 2; ++nt)
#pragma unroll
        for (int j = 0; j < 16; ++j) sc[nt][j] = -mrun[nt];
#pragma unroll
      for (int ds = 0; ds < 4; ++ds)
#pragma unroll
        for (int nt = 0; nt < 2; ++nt) sc[nt] = MFMA32(kf[ds], qf[nt][ds], sc[nt]);
      float mx[2];
#pragma unroll
      for (int nt = 0; nt < 2; ++nt) {
        float m0 = sc[nt][0];
#pragma unroll
        for (int j = 1; j < 16; ++j) m0 = fmaxf(m0, sc[nt][j]);
        mx[nt] = m0;
      }
      if (__any((fabsf(mx[0]) > 16.0f) | (fabsf(mx[1]) > 16.0f))) {
#pragma unroll
        for (int nt = 0; nt < 2; ++nt) {
          const float mp = fmaxf(mx[nt], __shfl_xor(mx[nt], 32));
          const float dm = (fabsf(mp) > 12.0f) ? mp : 0.0f;
          const float alpha = __builtin_amdgcn_exp2f(-dm);
          mrun[nt] += dm;
          lrun[nt] *= alpha;
#pragma unroll
          for (int j = 0; j < 16; ++j) sc[nt][j] -= dm;
#pragma unroll
          for (int mt = 0; mt < 2; ++mt)
#pragma unroll
            for (int j = 0; j < 16; ++j) o[mt][nt][j] *= alpha;
        }
      }
#pragma unroll
      for (int nt = 0; nt < 2; ++nt) {
        float sum = 0.f;
#pragma unroll
        for (int j = 0; j < 16; ++j) { float pv = __builtin_amdgcn_exp2f(sc[nt][j]); sc[nt][j] = pv; sum += pv; }
        lrun[nt] += sum;
      }
#pragma unroll
      for (int s2 = 0; s2 < 2; ++s2) {
        bf16x8 pf[2];
#pragma unroll
        for (int nt = 0; nt < 2; ++nt) {
          u32x4 pk;
#pragma unroll
          for (int i = 0; i < 4; ++i) pk[i] = pk2(sc[nt][s2 * 8 + 2 * i], sc[nt][s2 * 8 + 2 * i + 1]);
          pf[nt] = __builtin_bit_cast(bf16x8, pk);
        }
#pragma unroll
        for (int mt = 0; mt < 2; ++mt)
#pragma unroll
          for (int nt = 0; nt < 2; ++nt) o[mt][nt] = MFMA32(vf[s2][mt], pf[nt], o[mt][nt]);
      }
    }
    bcur = bcur + 1; if (bcur >= 3) bcur = 0;
  }
#pragma unroll
  for (int nt = 0; nt < 2; ++nt) {
    float l = lrun[nt] + __shfl_xor(lrun[nt], 32);
    float inv = 1.0f / l;
    const int tok = q0 + nt * 32 + r;
#pragma unroll
    for (int mt = 0; mt < 2; ++mt)
#pragma unroll
      for (int jg = 0; jg < 4; ++jg) {
        u32x2 ov;
        ov[0] = pk2(o[mt][nt][jg * 4 + 0] * inv, o[mt][nt][jg * 4 + 1] * inv);
        ov[1] = pk2(o[mt][nt][jg * 4 + 2] * inv, o[mt][nt][jg * 4 + 3] * inv);
        *(u32x2*)(O + (size_t)tok * 1024 + head * 64 + mt * 32 + jg * 8 + h * 4) = ov;
      }
  }
  WAIT_L(0);
  BAR;
}


enum { EK_P1 = 0, EK_S, EK_Y, EK_M0, EK_M1, EK_M2, EK_M3, EK_M4, EK_OUT, EK_FF1, EK_FF2 };
struct Job {
  const u16* A; const u16* Bt;
  int lda, ldb, K, kind, tm, tn, layer;
};

DI void epi_p1(const P& p, const Job& jb, AccT& acc) {
  const int TID = opaque_tid();
  const int ft = jb.tm, tt = jb.tn, layer = jb.layer;
  u16* Q = (u16*)(p.ws + WS_Q);
  u16* KB = (u16*)(p.ws + WS_K);
  u16* VT = (u16*)(p.ws + WS_VT);
  u16* AS = (u16*)(p.ws + WS_ASSM);
  const float* qn = p.in[4] + layer * 64;
  const float* kn = p.in[5] + layer * 64;
  const float2* RP = (const float2*)(p.ws + WS_ROPE);
  const int wid = TID >> 6, lane = TID & 63, wr = wid >> 2, wc = wid & 3, fr = lane & 15, fq = lane >> 4;
#pragma unroll
  for (int ai = 0; ai < 2; ++ai) {
    const int fb = ft * 256 + ai * 128 + wr * 64;
#pragma unroll
    for (int bj = 0; bj < 2; ++bj)
#pragma unroll
      for (int n = 0; n < 2; ++n) {
        const int tok = tt * 256 + bj * 128 + wc * 32 + n * 16 + fr;
        if (ft < 5) {
          float ss = 0.f;
#pragma unroll
          for (int m = 0; m < 4; ++m)
#pragma unroll
            for (int j = 0; j < 4; ++j) { float a = acc[ai][bj][m][n][j]; ss += a * a; }
          ss += __shfl_xor(ss, 16);
          ss += __shfl_xor(ss, 32);
          float rstd = rsqrtf(ss * (1.0f / 64.0f) + 1e-6f);
          const float* gn = (ft < 4) ? qn : kn;
          if (ft < 4) rstd *= 0.125f * 1.4426950408889634f;
          const int pos = tok < NTP ? (tok & 4095) : ((tok - NTP) & 8191);
          const int prow = pos >> 6, pcol = pos & 63;
#pragma unroll
          for (int m = 0; m < 4; ++m) {
            const int d0 = m * 16 + fq * 4;
            const float4 g4 = *(const float4*)(gn + d0);
            float v0 = acc[ai][bj][m][n][0] * rstd * g4.x, v1 = acc[ai][bj][m][n][1] * rstd * g4.y;
            float v2 = acc[ai][bj][m][n][2] * rstd * g4.z, v3 = acc[ai][bj][m][n][3] * rstd * g4.w;
            const int i0 = (m & 1) * 8 + fq * 2;
            const float2* rp = RP + ((m < 2) ? prow : pcol) * 16 + i0;
            float2 cs0 = rp[0], cs1 = rp[1];
            u32x2 o;
            o[0] = pk2(v0 * cs0.x - v1 * cs0.y, v0 * cs0.y + v1 * cs0.x);
            o[1] = pk2(v2 * cs1.x - v3 * cs1.y, v2 * cs1.y + v3 * cs1.x);
            if (ft < 4) *(u32x2*)(Q + (size_t)tok * 1024 + fb + d0) = o;
            else *(u32x2*)(KB + ((size_t)((fb - 1024) >> 6) * NT + tok) * 64 + d0) = o;
          }
        } else if (ft == 5) {
          const int kvh = (fb - 1280) >> 6;
#pragma unroll
          for (int m = 0; m < 4; ++m)
#pragma unroll
            for (int j = 0; j < 4; ++j)
              VT[(size_t)(kvh * 64 + m * 16 + fq * 4 + j) * NT + tok] = f2bf(acc[ai][bj][m][n][j]);
        } else {
#pragma unroll
          for (int m = 0; m < 4; ++m) {
            const int g = ((fb - 1536) >> 4) + m;
            u32x2 o;
            o[0] = pk2(acc[ai][bj][m][n][0], acc[ai][bj][m][n][1]);
            o[1] = pk2(acc[ai][bj][m][n][2], acc[ai][bj][m][n][3]);
            *(u32x2*)(AS + ((size_t)g * NCH + (tok >> 5)) * ASTR + (tok & 31) * 16 + fq * 4) = o;
          }
        }
      }
  }
}

DI u32x2 ld8(const u16* q) { return *(const u32x2*)q; }
DI float bflo(unsigned u) { return __uint_as_float(u << 16); }
DI float bfhi(unsigned u) { return __uint_as_float(u & 0xffff0000u); }

DI void run_epilogue(const P& p, const Job& jb, AccT& acc) {
  const int tm = jb.tm, tn = jb.tn, layer = jb.layer;
  switch (jb.kind) {
    case EK_P1: epi_p1(p, jb, acc); break;
    case EK_S: {
      float* Sg = (float*)(p.ws + WS_S) + (size_t)tn * 256 * 256;
      epi_for(acc, [&](const int row0, const int col, const f32x4 v) {
        *(f32x4*)(Sg + (size_t)col * 256 + row0) = v;
      });
    } break;
    case EK_Y: {
      const int g = tn / 10;
      const u16* Ug = jb.Bt;
      u16* Y = (u16*)(p.ws + WS_Y);
      const float* dsk = p.in[14] + layer * 512 + g * 16;
      const int ch0 = (tn % 10) * 256;
      epi_for(acc, [&](const int row0, const int col, const f32x4 v) {
        const int r = tm * 256 + row0;
        const int t = r >> 4, co = r & 15;
        const f32x4 dv = *(const f32x4*)(dsk + co);
        const u32x2 u = ld8(Ug + (size_t)col * ASTR + r);
        u32x2 o;
        o[0] = pk2(gelu_tanh(v[0] + dv[0] * bflo(u[0])), gelu_tanh(v[1] + dv[1] * bfhi(u[0])));
        o[1] = pk2(gelu_tanh(v[2] + dv[2] * bflo(u[1])), gelu_tanh(v[3] + dv[3] * bfhi(u[1])));
        *(u32x2*)(Y + ((size_t)(ch0 + col) * 32 + t) * 512 + g * 16 + co) = o;
      });
    } break;
    case EK_M0: case EK_M1: case EK_M2: case EK_M3: case EK_M4: {
      u16* t1 = (u16*)(p.ws + WS_Q) + (size_t)tn * 256 * 1024 + tm * 256;
      u16* t2 = (u16*)(p.ws + WS_ASSM) + (size_t)tn * 256 * 1024 + tm * 256;
      const int kind = jb.kind;
      epi_for(acc, [&](const int row0, const int col, const f32x4 v) {
        const size_t o = (size_t)col * 1024 + row0;
        f32x4 r;
        if (kind == EK_M0 || kind == EK_M3) {
#pragma unroll
          for (int j = 0; j < 4; ++j) r[j] = sigmoidf_(v[j]);
        } else {
          const u32x2 a = ld8(t1 + o);
          const float a0 = bflo(a[0]), a1 = bfhi(a[0]), a2 = bflo(a[1]), a3 = bfhi(a[1]);
          if (kind == EK_M1) { r[0] = v[0] * a0; r[1] = v[1] * a1; r[2] = v[2] * a2; r[3] = v[3] * a3; }
          else if (kind == EK_M2) { r[0] = sigmoidf_(v[0]) * a0; r[1] = sigmoidf_(v[1]) * a1; r[2] = sigmoidf_(v[2]) * a2; r[3] = sigmoidf_(v[3]) * a3; }
          else {
            const u32x2 b = ld8(t2 + o);
            r[0] = bflo(b[0]) * v[0] + a0; r[1] = bfhi(b[0]) * v[1] + a1; r[2] = bflo(b[1]) * v[2] + a2; r[3] = bfhi(b[1]) * v[3] + a3;
          }
        }
        u32x2 w; w[0] = pk2(r[0], r[1]); w[1] = pk2(r[2], r[3]);
        if (kind == EK_M3) *(u32x2*)(t2 + o) = w; else *(u32x2*)(t1 + o) = w;
      });
    } break;
    case EK_OUT: {
      epi_for(acc, [&](const int row0, const int col, const f32x4 v) {
        const int tok = tn * 256 + col, c = tm * 256 + row0;
        const f32x4 x = *(const f32x4*)(xrow(p, layer, tok) + c);
        *(f32x4*)(p.out + (size_t)tok * 1024 + c) = x + v;
      });
    } break;
    case EK_FF1: {
      u16* f = (u16*)(p.ws + WS_FF) + (size_t)tn * 256 * 4096 + tm * 256;
      epi_for(acc, [&](const int row0, const int col, const f32x4 v) {
        const float a0 = fmaxf(v[0], 0.f), a1 = fmaxf(v[1], 0.f), a2 = fmaxf(v[2], 0.f), a3 = fmaxf(v[3], 0.f);
        u32x2 w; w[0] = pk2(a0 * a0, a1 * a1); w[1] = pk2(a2 * a2, a3 * a3);
        *(u32x2*)(f + (size_t)col * 4096 + row0) = w;
      });
    } break;
    case EK_FF2: {
      float* o = p.out + (size_t)tn * 256 * 1024 + tm * 256;
      epi_for(acc, [&](const int row0, const int col, const f32x4 v) {
        f32x4* q = (f32x4*)(o + (size_t)col * 1024 + row0);
        *q = *q + v;
      });
    } break;
  }
}

DI void make_job(const P& p, int layer, int s, int w, int step, Job& jb) {
  const u16* XN = (const u16*)(p.ws + WS_XN);
  jb.layer = layer;
  if (s == 1) {
    int g = w / 10;
    jb.A = (const u16*)(p.ws + WS_W1T) + ((size_t)layer * 32 + g) * 256 * 512;
    jb.Bt = (const u16*)(p.ws + WS_ASSM) + (size_t)w * 256 * ASTR;
    jb.lda = 512; jb.ldb = ASTR; jb.K = 512; jb.kind = EK_S; jb.tm = 0; jb.tn = w;
    return;
  }
  if (s == 3) {
    int gc = w >> 1, rt = w & 1, g = gc / 10;
    jb.A = (const u16*)(p.ws + WS_WYT) + (((size_t)layer * 32 + g) * 512 + rt * 256) * ASTR;
    jb.Bt = (const u16*)(p.ws + WS_ASSM) + (size_t)gc * 256 * ASTR;
    jb.lda = ASTR; jb.ldb = ASTR; jb.K = ASTR; jb.kind = EK_Y; jb.tm = rt; jb.tn = gc;
    return;
  }
  const int nft = (s == 0) ? 8 : (s == 7) ? 16 : 4;
  int tt, ft; tile_map(w, nft, tt, ft);
  jb.tm = ft; jb.tn = tt;
  jb.lda = 1024; jb.ldb = 1024; jb.K = 1024;
  if (s == 0) {
    jb.A = (const u16*)(p.ws + WS_WT_IN) + (size_t)layer * 4096 * 1024 + (size_t)ft * 256 * 1024;
    jb.Bt = XN + (size_t)tt * 256 * 1024; jb.kind = EK_P1;
  } else if (s == 4) {
    jb.kind = EK_M0 + step;
    if (step < 2) {
      jb.A = (const u16*)(p.ws + (step == 0 ? WS_WT_GB : WS_WT_GA)) + (size_t)layer * 1024 * 512 + (size_t)ft * 256 * 512;
      jb.Bt = (const u16*)(p.ws + WS_Y) + (size_t)tt * 256 * 512;
      jb.lda = 512; jb.ldb = 512; jb.K = 512;
    } else if (step < 4) {
      jb.A = (const u16*)(p.ws + WS_WT_IN) + (size_t)layer * 4096 * 1024 + (size_t)((step == 2 ? 3072 : 2048) + ft * 256) * 1024;
      jb.Bt = XN + (size_t)tt * 256 * 1024;
    } else {
      jb.A = (const u16*)(p.ws + WS_WT_AP) + (size_t)layer * 1024 * 1024 + (size_t)ft * 256 * 1024;
      jb.Bt = (const u16*)(p.ws + WS_ATTO) + (size_t)tt * 256 * 1024;
    }
  } else if (s == 5) {
    jb.A = (const u16*)(p.ws + WS_WT_OUT) + (size_t)layer * 1024 * 1024 + (size_t)ft * 256 * 1024;
    jb.Bt = (const u16*)(p.ws + WS_Q) + (size_t)tt * 256 * 1024; jb.kind = EK_OUT;
  } else if (s == 7) {
    jb.A = (const u16*)(p.ws + WS_WT_FF1) + (size_t)layer * 4096 * 1024 + (size_t)ft * 256 * 1024;
    jb.Bt = XN + (size_t)tt * 256 * 1024; jb.kind = EK_FF1;
  } else {
    jb.A = (const u16*)(p.ws + WS_WT_FF2) + (size_t)layer * 1024 * 4096 + (size_t)ft * 256 * 4096;
    jb.Bt = (const u16*)(p.ws + WS_FF) + (size_t)tt * 256 * 4096;
    jb.lda = 4096; jb.ldb = 4096; jb.K = 4096; jb.kind = EK_FF2;
  }
}

DI void phase_jobs(const P& p, int layer, int s) {
  int nitems, nsteps = 1, nattn = 0;
  switch (s) {
    case 0: nitems = 2560; break;
    case 1: nitems = 320; break;
    case 3: nitems = 3200; nattn = 2560; break;
    case 4: nitems = 1280; nsteps = 5; break;
    case 5: nitems = 1280; break;
    case 7: nitems = 5120; break;
    default: nitems = 1280; break;
  }
  for (int w = blockIdx.x; w < nitems; w += gridDim.x) {
    if (w < nattn) {
      int seq_start, L, head, qb;
      if (w < 512) {
        int xcd = w & 7, r = w >> 3;
        int seq = xcd >> 2, kvh = xcd & 3;
        seq_start = NTP + seq * 8192; L = 8192; head = kvh * 4 + (r >> 4); qb = r & 15;
      } else {
        int w2 = w - 512, xcd = w2 & 7, r = w2 >> 3;
        int grp = (r >> 5) * 8 + xcd, within = r & 31;
        int seq = grp >> 2, kvh = grp & 3;
        seq_start = seq * 4096; L = 4096; head = kvh * 4 + (within >> 3); qb = within & 7;
      }
      attn_item(p, seq_start, L, head, qb);
    } else {
      for (int step = 0; step < nsteps; ++step) {
        Job jb;
        make_job(p, layer, s, w - nattn, step, jb);
        gemm_tile(jb.A, jb.Bt, jb.lda, jb.ldb, jb.K, [&](AccT& acc) { run_epilogue(p, jb, acc); });
      }
    }
  }
}

DI void run_phase(const P& p, int ph) {
  if (ph == 0) { phase_prep_a(p); return; }
  if (ph == 1) { phase_prep_b(p); return; }
  if (ph == 2) { phase_prep_c(p); phase_norm(p, p.in[0], p.in[1], p.in[2]); return; }
  int layer = (ph - 3) / 10, s = (ph - 3) % 10;
  if (s == 2) phase_scan(p, layer);
  else if (s == 6) phase_norm(p, p.out, p.out + (size_t)NTP * 1024, p.in[18] + layer * 1024);
  else if (s == 9) phase_norm(p, p.out, p.out + (size_t)NTP * 1024, p.in[2] + (layer + 1) * 1024);
  else phase_jobs(p, layer, s);
}

__global__ void __launch_bounds__(512, 2) mega_coop(P p) {
  cg::grid_group grid = cg::this_grid();
  for (int ph = p.ph_lo; ph < p.ph_hi; ++ph) {
    run_phase(p, ph);
#if PROBE_MASK
    {
      const int s_ = ph < 3 ? -1 : (ph - 3) % 10;
      bool rep = false;
      if ((PROBE_MASK & 1) && s_ == 3) rep = true;
      if ((PROBE_MASK & 2) && (s_ == 0 || s_ == 4 || s_ == 7)) rep = true;
      if ((PROBE_MASK & 4) && (ph < 3 || s_ == 1 || s_ == 2 || s_ == 6 || s_ == 9)) rep = true;
      if (rep) run_phase(p, ph);
    }
#endif
    if (ph + 1 < p.ph_hi) grid.sync();
  }
}
#if N_LAUNCH_MODE == 0
__global__ void __launch_bounds__(512, 2) mega_one(P p) {
  run_phase(p, p.ph_lo);
}
#endif

extern "C" void kernel_launch(void* const* d_in, const int* in_sizes, int n_in, void* d_out, int out_size, void* d_ws, size_t ws_size,
                              hipStream_t stream) {
  static int grid = 0;
  if (grid == 0) {
    if (n_in != 21 || ws_size < WS_END) { fprintf(stderr, "kernel_launch: unexpected n_in %d / ws_size %zu (need %zu)\n", n_in, ws_size, (size_t)WS_END); grid = -1; return; }
    int dev = 0, cus = 0, per_cu = 0;
    hipGetDevice(&dev);
    hipDeviceGetAttribute(&cus, hipDeviceAttributeMultiprocessorCount, dev);
    hipFuncSetAttribute((const void*)mega_coop, hipFuncAttributeMaxDynamicSharedMemorySize, LDS_BYTES);
#if N_LAUNCH_MODE == 0
    hipFuncSetAttribute((const void*)mega_one, hipFuncAttributeMaxDynamicSharedMemorySize, LDS_BYTES);
#endif
    hipOccupancyMaxActiveBlocksPerMultiprocessor(&per_cu, (const void*)mega_coop, 512, LDS_BYTES);
    if (per_cu < 1) { fprintf(stderr, "kernel_launch: occupancy query says %d blocks/CU\n", per_cu); per_cu = 1; }
    (void)hipGetLastError();
    grid = cus * 1;
  }
  if (grid < 0) return;
  P p{};
  for (int i = 0; i < 21; ++i) p.in[i] = (const float*)d_in[i];
  p.out = (float*)d_out;
  p.ws = (unsigned char*)d_ws;
#if N_LAUNCH_MODE == 1
  p.ph_lo = 0; p.ph_hi = NPHASE;
  void* args[] = {&p};
  hipError_t e = hipLaunchCooperativeKernel((const void*)mega_coop, dim3(grid), dim3(512), args, LDS_BYTES, stream);
  if (e != hipSuccess) fprintf(stderr, "cooperative launch failed: %s (grid %d)\n", hipGetErrorString(e), grid);
#else
  for (int ph = 0; ph < NPHASE; ++ph) {
    p.ph_lo = ph; p.ph_hi = ph + 1;
    hipLaunchKernelGGL(mega_one, dim3(grid), dim3(512), LDS_BYTES, stream, p);
  }
#endif
}
```

```cpp
#include <hip/hip_runtime.h>
#include <hip/hip_cooperative_groups.h>
#include <cstdio>
namespace cg = cooperative_groups;

typedef unsigned short u16;
typedef __attribute__((ext_vector_type(8))) short bf16x8;
typedef __attribute__((ext_vector_type(4))) float f32x4;
typedef __attribute__((ext_vector_type(16))) float f32x16;
typedef __attribute__((ext_vector_type(4))) unsigned u32x4;
typedef __attribute__((ext_vector_type(2))) unsigned u32x2;
typedef __attribute__((ext_vector_type(2))) float f32x2;
typedef __attribute__((ext_vector_type(2))) __bf16 bf16v2;

#define DI __device__ __forceinline__
#ifndef PROBE_MASK
#define PROBE_MASK 0
#endif
#ifndef STAGGER_SLEEP
#define STAGGER_SLEEP 0
#endif
#ifndef N_LAUNCH_MODE
#define N_LAUNCH_MODE 1
#endif

constexpr int NT = 81920;
constexpr int NTP = 65536;
constexpr int NCH = 2560;
constexpr int ASTR = 768;
constexpr int NPHASE = 19;
constexpr int LDS_BYTES = 131072 + 1024;

constexpr size_t MiB = 1ull << 20;
constexpr size_t WS_WT_IN = 0;
constexpr size_t WS_WT_AP = 16 * MiB;
constexpr size_t WS_WT_GA = 20 * MiB;
constexpr size_t WS_WT_GB = 22 * MiB;
constexpr size_t WS_WT_OUT = 24 * MiB;
constexpr size_t WS_WT_FF1 = 28 * MiB;
constexpr size_t WS_WT_FF2 = 44 * MiB;
constexpr size_t WS_W1T = 60 * MiB;
constexpr size_t WS_WYT = 76 * MiB;
constexpr size_t WS_LPOW = 124 * MiB;
constexpr size_t WS_BBAR = 127 * MiB;
constexpr size_t WS_KTAB = 128 * MiB;
constexpr size_t WS_ROPE = 132 * MiB;
constexpr size_t WS_SSQ = 133 * MiB;
constexpr size_t WS_XN = 135 * MiB;
constexpr size_t WS_BIG = 295 * MiB;
constexpr size_t WS_Q = WS_BIG;
constexpr size_t WS_K = WS_BIG + 160 * MiB;
constexpr size_t WS_VT = WS_BIG + 200 * MiB;
constexpr size_t WS_ASSM = WS_BIG + 240 * MiB;
constexpr size_t WS_S = WS_BIG + 360 * MiB;
constexpr size_t WS_Y = WS_BIG + 440 * MiB;
constexpr size_t WS_ATTO = WS_BIG + 520 * MiB;
constexpr size_t WS_FF = WS_BIG;
constexpr size_t WS_END = WS_BIG + 680 * MiB;

struct P {
  const float* in[21];
  float* out;
  unsigned char* ws;
  int ph_lo, ph_hi;
};

DI u16 f2bf(float f) { unsigned u = __float_as_uint(f); u += 0x7fffu + ((u >> 16) & 1u); return (u16)(u >> 16); }
DI float bf2f(u16 h) { return __uint_as_float(((unsigned)h) << 16); }
DI unsigned pk2(float a, float b) {
  f32x2 v; v[0] = a; v[1] = b;
  bf16v2 r = __builtin_convertvector(v, bf16v2);
  return __builtin_bit_cast(unsigned, r);
}
DI float sigmoidf_(float x) { return 1.0f / (1.0f + __expf(-x)); }
DI float gelu_tanh(float x) {
  float z = 0.7978845608028654f * (x + 0.044715f * x * x * x);
  float e = __expf(2.0f * z);
  return 0.5f * x * (2.0f - 2.0f / (e + 1.0f));
}


DI void sincos_d(double x, double* sn, double* cs) {
  const double TWO_PI_HI = 6.283185307179586232e+00, TWO_PI_LO = 2.449293598294706414e-16;
  double k = rint(x * 0.15915494309189534561);
  double r = (x - k * TWO_PI_HI) - k * TWO_PI_LO;
  r *= 0.25;
  double r2 = r * r;
  double s = 1.0, c = 1.0;
  s = 1.0 - r2 / (18.0 * 19.0);
  s = 1.0 - r2 / (16.0 * 17.0) * s;
  s = 1.0 - r2 / (14.0 * 15.0) * s;
  s = 1.0 - r2 / (12.0 * 13.0) * s;
  s = 1.0 - r2 / (10.0 * 11.0) * s;
  s = 1.0 - r2 / (8.0 * 9.0) * s;
  s = 1.0 - r2 / (6.0 * 7.0) * s;
  s = 1.0 - r2 / (4.0 * 5.0) * s;
  s = 1.0 - r2 / (2.0 * 3.0) * s;
  s *= r;
  c = 1.0 - r2 / (17.0 * 18.0);
  c = 1.0 - r2 / (15.0 * 16.0) * c;
  c = 1.0 - r2 / (13.0 * 14.0) * c;
  c = 1.0 - r2 / (11.0 * 12.0) * c;
  c = 1.0 - r2 / (9.0 * 10.0) * c;
  c = 1.0 - r2 / (7.0 * 8.0) * c;
  c = 1.0 - r2 / (5.0 * 6.0) * c;
  c = 1.0 - r2 / (3.0 * 4.0) * c;
  c = 1.0 - r2 / (1.0 * 2.0) * c;
  double s2 = 2.0 * s * c, c2 = c * c - s * s;
  *sn = 2.0 * s2 * c2; *cs = c2 * c2 - s2 * s2;
}

DI int opaque_tid() { int t = threadIdx.x; asm volatile("" : "+v"(t)); return t; }
DI const char* sgpr_ptr(const char* p) { asm("" : "+s"(p)); return p; }
#define WAIT_V(n) asm volatile("s_waitcnt vmcnt(" #n ")" ::: "memory")
#define WAIT_L(n) asm volatile("s_waitcnt lgkmcnt(" #n ")" ::: "memory")
#define BAR __builtin_amdgcn_s_barrier()
#define SCHED __builtin_amdgcn_sched_barrier(0)
#define GLDS(gp, lp) __builtin_amdgcn_global_load_lds((const unsigned*)(gp), (unsigned*)(lp), 16, 0, 0)

constexpr int GBK = 64, GHALF = 128, GHT = GHALF * GBK;
DI int lds_byte(int r, int c) {
  int st = (r >> 4) * 2 + (c >> 5), rr = r & 15, cc = c & 31, ob = rr * 64 + cc * 2;
  return st * 1024 + (ob ^ (((ob >> 9) & 1) << 5));
}
DI void stage_rc(int b, int& R, int& C) {
  int st = b / 1024, sb = b % 1024, swz = sb ^ (((sb >> 9) & 1) << 5);
  R = (st >> 1) * 16 + swz / 64; C = (st & 1) * 32 + (swz % 64) / 2;
}

typedef f32x4 AccT[2][2][4][2];

template <class Epi>
DI void gemm_tile(const u16* __restrict__ A, const u16* __restrict__ Bt, const int lda, const int ldb, const int gsB, const int tmB, const int K, Epi&& epi) {
  const int TID = opaque_tid();
  extern __shared__ __attribute__((aligned(16))) unsigned char smem[];
  u16* shm = (u16*)smem;
#define SA(b, h) (shm + ((b) * 2 + (h)) * GHT)
#define SB(b, h) (shm + (4 + (b) * 2 + (h)) * GHT)
  int R0, C0, R1, C1;
  stage_rc(TID * 16, R0, C0);
  stage_rc(TID * 16 + 8192, R1, C1);
  const unsigned voA0 = (unsigned)(R0 * lda + C0) * 2u, voA1 = (unsigned)(R1 * lda + C1) * 2u;
  const unsigned voB0 = (unsigned)(R0 * ldb + (C0 & 15) + (C0 >> 4) * gsB) * 2u, voB1 = (unsigned)(R1 * ldb + (C1 & 15) + (C1 >> 4) * gsB) * 2u;
  const int hA = GHALF * lda, hB = GHALF * ldb;
  const unsigned wid_u = __builtin_amdgcn_readfirstlane(TID >> 6);
#define STAGE_A(PTR, half, kt) do { const char* _g = sgpr_ptr((const char*)(A + (size_t)(half) * hA + (size_t)(kt) * GBK)); \
    char* _l = (char*)(PTR) + wid_u * 1024u; \
    GLDS(_g + voA0, _l); GLDS(_g + voA1, _l + 8192); } while (0)
#define STAGE_B(PTR, half, kt) do { const char* _g = sgpr_ptr((const char*)(Bt + (size_t)(half) * hB + (tmB ? (size_t)((((kt) >> 2) << 16) + (((kt) & 3) << 6)) : (size_t)(kt) * (size_t)(4 * gsB)))); \
    char* _l = (char*)(PTR) + wid_u * 1024u; \
    GLDS(_g + voB0, _l); GLDS(_g + voB1, _l + 8192); } while (0)
#define LDA(dst, b, h) for (int m = 0; m < 4; ++m) for (int k = 0; k < 2; ++k) \
    dst[m][k] = *reinterpret_cast<const bf16x8*>((char*)SA(b, h) + lds_byte(wr * 64 + m * 16 + fr, k * 32 + fq * 8))
#define LDB(dst, b, h) for (int n = 0; n < 2; ++n) for (int k = 0; k < 2; ++k) \
    dst[n][k] = *reinterpret_cast<const bf16x8*>((char*)SB(b, h) + lds_byte(wc * 32 + n * 16 + fr, k * 32 + fq * 8))
#define MMA(ai, bj, At, Bq) do { __builtin_amdgcn_s_setprio(1); \
    for (int m = 0; m < 4; ++m) for (int n = 0; n < 2; ++n) for (int k = 0; k < 2; ++k) \
      acc[ai][bj][m][n] = __builtin_amdgcn_mfma_f32_16x16x32_bf16(At[m][k], Bq[n][k], acc[ai][bj][m][n], 0, 0, 0); \
    __builtin_amdgcn_s_setprio(0); } while (0)

  const int wid = TID >> 6, lane = TID & 63, wr = wid >> 2, wc = wid & 3, fr = lane & 15, fq = lane >> 4;
  AccT acc;
#pragma unroll
  for (int a = 0; a < 2; ++a)
#pragma unroll
    for (int b = 0; b < 2; ++b)
#pragma unroll
      for (int m = 0; m < 4; ++m)
#pragma unroll
        for (int n = 0; n < 2; ++n) acc[a][b][m][n] = f32x4{0.f, 0.f, 0.f, 0.f};
  bf16x8 At[4][2], B0[2][2], B1[2][2];
  const int nt = K / GBK;
  STAGE_B(SB(0, 0), 0, 0); STAGE_A(SA(0, 0), 0, 0);
  STAGE_B(SB(0, 1), 1, 0); STAGE_A(SA(0, 1), 1, 0);
  if (wr == 1) BAR;
  WAIT_V(4); BAR;
  STAGE_B(SB(1, 0), 0, 1); STAGE_A(SA(1, 0), 0, 1); STAGE_B(SB(1, 1), 1, 1);
  WAIT_V(6); BAR;
  for (int t = 0; t < nt - 2; t += 2) {
    LDB(B0, 0, 0); SCHED; LDA(At, 0, 0); STAGE_A(SA(1, 1), 1, t + 1);
    WAIT_L(8); BAR; WAIT_L(0); MMA(0, 0, At, B0); BAR; SCHED;
    LDB(B1, 0, 1); STAGE_B(SB(0, 0), 0, t + 2);
    BAR; WAIT_L(0); MMA(0, 1, At, B1); BAR;
    LDA(At, 0, 1); STAGE_A(SA(0, 0), 0, t + 2);
    BAR; WAIT_L(0); MMA(1, 0, At, B0); BAR; SCHED;
    STAGE_B(SB(0, 1), 1, t + 2);
    WAIT_V(6); BAR; MMA(1, 1, At, B1); BAR;
    LDB(B0, 1, 0); SCHED; LDA(At, 1, 0); STAGE_A(SA(0, 1), 1, t + 2);
    WAIT_L(8); BAR; WAIT_L(0); MMA(0, 0, At, B0); BAR; SCHED;
    LDB(B1, 1, 1); STAGE_B(SB(1, 0), 0, t + 3);
    BAR; WAIT_L(0); MMA(0, 1, At, B1); BAR;
    LDA(At, 1, 1); STAGE_A(SA(1, 0), 0, t + 3);
    BAR; WAIT_L(0); MMA(1, 0, At, B0); BAR; SCHED;
    STAGE_B(SB(1, 1), 1, t + 3);
    WAIT_V(6); BAR; MMA(1, 1, At, B1); BAR;
  }
  { LDB(B0, 0, 0); LDA(At, 0, 0); STAGE_A(SA(1, 1), 1, nt - 1);
    BAR; WAIT_L(0); MMA(0, 0, At, B0); BAR;
    LDB(B1, 0, 1); BAR; WAIT_L(0); MMA(0, 1, At, B1); BAR;
    LDA(At, 0, 1); WAIT_V(4); BAR; WAIT_L(0); MMA(1, 0, At, B0); MMA(1, 1, At, B1); BAR; }
  { LDB(B0, 1, 0); LDA(At, 1, 0); WAIT_V(2); BAR; WAIT_L(0); MMA(0, 0, At, B0); BAR;
    LDB(B1, 1, 1); WAIT_V(0); BAR; WAIT_L(0); MMA(0, 1, At, B1); BAR;
    LDA(At, 1, 1); BAR; WAIT_L(0); MMA(1, 0, At, B0); MMA(1, 1, At, B1); BAR; }
  if (wr == 0) BAR;
  epi(acc);
#undef SA
#undef SB
}

template <class F>
DI void epi_for(AccT& acc, F&& f) {
  const int TID = opaque_tid();
  const int _wid = TID >> 6, _lane = TID & 63, _wr = _wid >> 2, _wc = _wid & 3, _fr = _lane & 15, _fq = _lane >> 4;
#pragma unroll
  for (int _ai = 0; _ai < 2; ++_ai)
#pragma unroll
    for (int _bj = 0; _bj < 2; ++_bj)
#pragma unroll
      for (int _m = 0; _m < 4; ++_m)
#pragma unroll
        for (int _n = 0; _n < 2; ++_n)
          f(_ai * 128 + _wr * 64 + _m * 16 + _fq * 4, _bj * 128 + _wc * 32 + _n * 16 + _fr, acc[_ai][_bj][_m][_n]);
}

DI void tile_map(int w, int ntn, int& tm, int& tn) {
  int xcd = w & 7, r = w >> 3;
  tn = r % ntn; tm = (r / ntn) * 8 + xcd;
}

DI void transpose_tile(const float* __restrict__ src, int N, u16* __restrict__ dst, int K, int tk, int tn, const float* __restrict__ gain) {
  const int TID = opaque_tid();
  extern __shared__ __attribute__((aligned(16))) unsigned char smem[];
  float* tile = (float*)smem;
  const int t = TID;
  {
    int rk = t >> 3, cs = (t & 7) * 8;
    const float4* s = (const float4*)(src + (size_t)(tk * 64 + rk) * N + tn * 64 + cs);
    float4 a = s[0], b = s[1];
    if (gain) { const float gk = gain[tk * 64 + rk]; a.x *= gk; a.y *= gk; a.z *= gk; a.w *= gk; b.x *= gk; b.y *= gk; b.z *= gk; b.w *= gk; }
    float* d = tile + rk * 65 + cs;
    d[0] = a.x; d[1] = a.y; d[2] = a.z; d[3] = a.w; d[4] = b.x; d[5] = b.y; d[6] = b.z; d[7] = b.w;
  }
  __syncthreads();
  {
    int n = t >> 3, ks = (t & 7) * 8;
    u32x4 o;
    o[0] = pk2(tile[(ks + 0) * 65 + n], tile[(ks + 1) * 65 + n]);
    o[1] = pk2(tile[(ks + 2) * 65 + n], tile[(ks + 3) * 65 + n]);
    o[2] = pk2(tile[(ks + 4) * 65 + n], tile[(ks + 5) * 65 + n]);
    o[3] = pk2(tile[(ks + 6) * 65 + n], tile[(ks + 7) * 65 + n]);
    *(u32x4*)(dst + (size_t)(tn * 64 + n) * K + tk * 64 + ks) = o;
  }
  __syncthreads();
}

DI void phase_prep_a(const P& p) {
  const int TID = opaque_tid();
  const int bid = blockIdx.x, nb = gridDim.x;
  for (int w = bid; w < 7680; w += nb) {
    int layer = w / 3840, r = w % 3840;
    const float* src; u16* dst; int K, N, tl; const float* gain = nullptr;
    if (r < 1024) { src = p.in[3] + (size_t)layer * 1024 * 4096; dst = (u16*)(p.ws + WS_WT_IN) + (size_t)layer * 4096 * 1024; K = 1024; N = 4096; tl = r; gain = p.in[2] + layer * 1024; }
    else if (r < 1280) { src = p.in[6] + (size_t)layer * 1024 * 1024; dst = (u16*)(p.ws + WS_WT_AP) + (size_t)layer * 1024 * 1024; K = 1024; N = 1024; tl = r - 1024; }
    else if (r < 1408) { src = p.in[15] + (size_t)layer * 512 * 1024; dst = (u16*)(p.ws + WS_WT_GA) + (size_t)layer * 1024 * 512; K = 512; N = 1024; tl = r - 1280; }
    else if (r < 1536) { src = p.in[16] + (size_t)layer * 512 * 1024; dst = (u16*)(p.ws + WS_WT_GB) + (size_t)layer * 1024 * 512; K = 512; N = 1024; tl = r - 1408; }
    else if (r < 1792) { src = p.in[17] + (size_t)layer * 1024 * 1024; dst = (u16*)(p.ws + WS_WT_OUT) + (size_t)layer * 1024 * 1024; K = 1024; N = 1024; tl = r - 1536; }
    else if (r < 2816) { src = p.in[19] + (size_t)layer * 1024 * 4096; dst = (u16*)(p.ws + WS_WT_FF1) + (size_t)layer * 4096 * 1024; K = 1024; N = 4096; tl = r - 1792; gain = p.in[18] + layer * 1024; }
    else { src = p.in[20] + (size_t)layer * 4096 * 1024; dst = (u16*)(p.ws + WS_WT_FF2) + (size_t)layer * 1024 * 4096; K = 4096; N = 1024; tl = r - 2816; }
    int ntn = N / 64;
    transpose_tile(src, N, dst, K, tl / ntn, tl % ntn, gain);
  }
  const int gtid = bid * 512 + TID, nth = nb * 512;
  float2* LP = (float2*)(p.ws + WS_LPOW);
  float2* BB = (float2*)(p.ws + WS_BBAR);
  for (int i = gtid; i < 8192; i += nth) {
    int lg = i >> 6;
    double step = exp((double)p.in[9][lg]);
    double lr = p.in[7][i], li = p.in[8][i];
    double zr = lr * step, zi = li * step;
    for (int tau = 0; tau <= 32; ++tau) {
      double e = exp(zr * tau), sn, cs;
      sincos_d(zi * tau, &sn, &cs);
      LP[(size_t)i * 33 + tau] = make_float2((float)(e * cs), (float)(e * sn));
    }
    double e = exp(zr), sn, cs;
    sincos_d(zi, &sn, &cs);
    double nr = e * cs - 1.0, ni = e * sn, den = lr * lr + li * li;
    double fr = (nr * lr + ni * li) / den, fi = (ni * lr - nr * li) / den;
    for (int ci = 0; ci < 16; ++ci) {
      double br = p.in[10][(size_t)i * 16 + ci], bi = p.in[11][(size_t)i * 16 + ci];
      BB[(size_t)i * 16 + ci] = make_float2((float)(fr * br - fi * bi), (float)(fr * bi + fi * br));
    }
  }
  float2* RP = (float2*)(p.ws + WS_ROPE);
  for (int i = gtid; i < 128 * 16; i += nth) {
    int pos = i >> 4, f = i & 15;
    double inv = exp(-(double)(2 * f) / 32.0 * 9.210340371976184);
    double sn, cs;
    sincos_d((double)pos * inv, &sn, &cs);
    RP[i] = make_float2((float)cs, (float)sn);
  }
}

DI void phase_prep_b(const P& p) {
  const int TID = opaque_tid();
  const int gtid = blockIdx.x * 512 + TID, nth = gridDim.x * 512;
  const float2* LP = (const float2*)(p.ws + WS_LPOW);
  const float2* BB = (const float2*)(p.ws + WS_BBAR);
  float* KT = (float*)(p.ws + WS_KTAB);
  const float* cre = p.in[12];
  const float* cim = p.in[13];
  for (int i = gtid; i < (1 << 20); i += nth) {
    int ci = i & 15, co = (i >> 4) & 15, tau = (i >> 8) & 31, lg = i >> 13;
    float s = 0.f;
    for (int pp = 0; pp < 64; ++pp) {
      float cr = cre[(size_t)(lg * 16 + co) * 64 + pp], cI = cim[(size_t)(lg * 16 + co) * 64 + pp];
      float2 l = LP[(size_t)(lg * 64 + pp) * 33 + tau];
      float2 b = BB[(size_t)(lg * 64 + pp) * 16 + ci];
      float xr = l.x * b.x - l.y * b.y, xi = l.x * b.y + l.y * b.x;
      s += cr * xr - cI * xi;
    }
    KT[i] = s;
  }
  u16* W1 = (u16*)(p.ws + WS_W1T);
  for (int i = gtid; i < (1 << 23); i += nth) {
    int k = i & 511, n = (i >> 9) & 255, g = (i >> 17) & 31, layer = i >> 22;
    int dir = n >> 7, pp = (n >> 1) & 63, ri = n & 1, s = k >> 4, ci = k & 15;
    int e = dir ? s : 31 - s;
    int lg = (layer * 2 + dir) * 32 + g;
    float2 l = LP[(size_t)(lg * 64 + pp) * 33 + e];
    float2 b = BB[(size_t)(lg * 64 + pp) * 16 + ci];
    float v = ri ? (l.x * b.y + l.y * b.x) : (l.x * b.x - l.y * b.y);
    W1[i] = f2bf(v);
  }
  u16* WY = (u16*)(p.ws + WS_WYT);
  for (int i = gtid; i < (1 << 23); i += nth) {
    int kk = i & 255, n = (i >> 8) & 511, g = (i >> 17) & 31, layer = i >> 22;
    int t = n >> 4, co = n & 15, dir = kk >> 7, pp = (kk >> 1) & 63, ri = kk & 1;
    int e = dir ? 32 - t : t + 1;
    int lg = (layer * 2 + dir) * 32 + g;
    float cr = cre[(size_t)(lg * 16 + co) * 64 + pp], cI = cim[(size_t)(lg * 16 + co) * 64 + pp];
    float2 l = LP[(size_t)(lg * 64 + pp) * 33 + e];
    float v = ri ? -(cr * l.y + cI * l.x) : (cr * l.x - cI * l.y);
    WY[((size_t)((layer * 32 + g) * 512 + n)) * ASTR + 512 + kk] = f2bf(v);
  }
}

DI void phase_prep_c(const P& p) {
  const int TID = opaque_tid();
#if PROBE_MASK & 64
  {
    u32x4* dst = (u32x4*)(p.ws + WS_FF);
    u32x4 z; z[0] = 1; z[1] = 2; z[2] = 3; z[3] = 4;
    for (unsigned i = blockIdx.x * 512 + TID; i < 640u * 65536u; i += gridDim.x * 512) { z[0] = i * 2654435761u; z[1] = z[0] ^ (i << 7); z[2] = z[1] * 40503u + i; z[3] = z[2] ^ z[0]; dst[i] = z; }
  }
#endif
  const int gtid = blockIdx.x * 512 + TID, nth = gridDim.x * 512;
  const float* KT = (const float*)(p.ws + WS_KTAB);
  u16* WY = (u16*)(p.ws + WS_WYT);
  for (int i = gtid; i < (1 << 21); i += nth) {
    int k8 = i & 63, n = (i >> 6) & 511, g = (i >> 15) & 31, layer = i >> 20;
    int t = n >> 4, co = n & 15, s = k8 >> 1, ci0 = (k8 & 1) * 8;
    int tau = t - s;
    float v[8];
    if (tau > 0) {
      const float* q = KT + ((((size_t)(layer * 2 + 0) * 32 + g) * 32 + tau) * 16 + co) * 16 + ci0;
#pragma unroll
      for (int j = 0; j < 8; ++j) v[j] = q[j];
    } else if (tau < 0) {
      const float* q = KT + ((((size_t)(layer * 2 + 1) * 32 + g) * 32 - tau) * 16 + co) * 16 + ci0;
#pragma unroll
      for (int j = 0; j < 8; ++j) v[j] = q[j];
    } else {
      const float* q0 = KT + ((((size_t)(layer * 2 + 0) * 32 + g) * 32) * 16 + co) * 16 + ci0;
      const float* q1 = KT + ((((size_t)(layer * 2 + 1) * 32 + g) * 32) * 16 + co) * 16 + ci0;
#pragma unroll
      for (int j = 0; j < 8; ++j) v[j] = q0[j] + q1[j];
    }
    u32x4 o;
    o[0] = pk2(v[0], v[1]); o[1] = pk2(v[2], v[3]); o[2] = pk2(v[4], v[5]); o[3] = pk2(v[6], v[7]);
    *(u32x4*)(WY + ((size_t)((layer * 32 + g) * 512 + n)) * ASTR + k8 * 8) = o;
  }
}

DI const float* xrow(const P& p, int layer, int tok) {
  if (layer == 0) return tok < NTP ? p.in[0] + (size_t)tok * 1024 : p.in[1] + (size_t)(tok - NTP) * 1024;
  return p.out + (size_t)tok * 1024;
}
DI void phase_convert(const P& p, const float* __restrict__ src0, const float* __restrict__ src1) {
  const int TID = opaque_tid();
  const int lane = TID & 63, wave = TID >> 6;
  u16* XN = (u16*)(p.ws + WS_XN);
  float* SSQ = (float*)(p.ws + WS_SSQ);
  for (int tok = blockIdx.x * 8 + wave; tok < NT; tok += gridDim.x * 8) {
    const float* x = tok < NTP ? src0 + (size_t)tok * 1024 : src1 + (size_t)(tok - NTP) * 1024;
    float4 v[4];
    float ss = 0.f;
#pragma unroll
    for (int i = 0; i < 4; ++i) {
      v[i] = *(const float4*)(x + i * 256 + lane * 4);
      ss += v[i].x * v[i].x + v[i].y * v[i].y + v[i].z * v[i].z + v[i].w * v[i].w;
    }
#pragma unroll
    for (int o = 32; o >= 1; o >>= 1) ss += __shfl_xor(ss, o);
    if (lane < 4) SSQ[(size_t)lane * NT + tok] = lane == 0 ? ss : 0.f;
#pragma unroll
    for (int i = 0; i < 4; ++i) {
      u32x2 o;
      o[0] = pk2(v[i].x, v[i].y);
      o[1] = pk2(v[i].z, v[i].w);
      *(u32x2*)(XN + (size_t)tok * 1024 + i * 256 + lane * 4) = o;
    }
  }
}

DI void phase_scan(const P& p, int layer) {
  const int TID = opaque_tid();
  const int gtid = blockIdx.x * 512 + TID, nth = gridDim.x * 512;
  const float2* LP = (const float2*)(p.ws + WS_LPOW);
  for (int i = gtid; i < 18 * 4096; i += nth) {
    int pp = i & 63, dir = (i >> 6) & 1, g = (i >> 7) & 31, seq = i >> 12;
    int c0 = seq < 16 ? seq * 128 : 2048 + (seq - 16) * 256;
    int nc = seq < 16 ? 128 : 256;
    float2 a = LP[(size_t)(((layer * 2 + dir) * 32 + g) * 64 + pp) * 33 + 32];
    const float2* S = (const float2*)(p.ws + WS_S) + ((size_t)(g * NCH + c0) * 256 + dir * 128 + pp * 2) / 2;
    unsigned* H = (unsigned*)((u16*)(p.ws + WS_ASSM) + (size_t)(g * NCH + c0) * ASTR + 512 + dir * 128 + pp * 2);
    float hr = 0.f, hi = 0.f;
    if (dir == 0) {
#pragma unroll 8
      for (int c = 0; c < nc; ++c) {
        H[(size_t)c * (ASTR / 2)] = pk2(hr, hi);
        float2 s = S[(size_t)c * 128];
        float nr = a.x * hr - a.y * hi + s.x;
        hi = a.x * hi + a.y * hr + s.y;
        hr = nr;
      }
    } else {
#pragma unroll 8
      for (int c = nc - 1; c >= 0; --c) {
        H[(size_t)c * (ASTR / 2)] = pk2(hr, hi);
        float2 s = S[(size_t)c * 128];
        float nr = a.x * hr - a.y * hi + s.x;
        hi = a.x * hi + a.y * hr + s.y;
        hr = nr;
      }
    }
  }
}

#define MFMA32(a, b, c) __builtin_amdgcn_mfma_f32_32x32x16_bf16((a), (b), (c), 0, 0, 0)
DI void attn_item(const P& pin, int seq_start, int L, int head, int qb) {
  const int TID = opaque_tid();
  struct { unsigned char* ws; } p;
  p.ws = pin.ws;
  asm volatile("" : "+s"(p.ws));
  extern __shared__ __attribute__((aligned(16))) unsigned char smem[];
  const u16* Q = (const u16*)(p.ws + WS_Q);
  const u16* KB = (const u16*)(p.ws + WS_K);
  const u16* VT = (const u16*)(p.ws + WS_VT);
  u16* O = (u16*)(p.ws + WS_ATTO);
  const int tid = TID, wave = tid >> 6, lane = tid & 63, r = lane & 31, h = lane >> 5;
  const int kvh = head >> 2;
  const int q0 = seq_start + qb * 512 + wave * 64;
  bf16x8 qf[2][4];
#pragma unroll
  for (int nt = 0; nt < 2; ++nt)
#pragma unroll
    for (int ds = 0; ds < 4; ++ds)
      qf[nt][ds] = *(const bf16x8*)(Q + (size_t)(q0 + nt * 32 + r) * 1024 + head * 64 + ds * 16 + h * 8);
#pragma unroll
  for (int nt = 0; nt < 2; ++nt)
#pragma unroll
    for (int ds = 0; ds < 4; ++ds) asm volatile("" ::"v"(qf[nt][ds]));
  const int srow = tid >> 3, spos = tid & 7, scc = spos ^ ((srow >> 1) & 7);
  const u16* kg = KB + ((size_t)kvh * NT + seq_start + srow) * 64 + scc * 8;
  const u16* vg = VT + (size_t)(kvh * 64 + srow) * NT + seq_start + scc * 8;
  unsigned char* ldst = smem + tid * 16;
  const int nkt = L >> 6;
  const int pr = ((r >> 4) * 16) + (((r >> 2) & 1) * 8) + (((r >> 3) & 1) * 4) + (r & 3);
  int koff[4];
#pragma unroll
  for (int ds = 0; ds < 4; ++ds) koff[ds] = pr * 128 + (((ds * 2 + h) ^ ((pr >> 1) & 7)) << 4);
  const int vxh = ((r >> 1) & 7) >> 1;
  const int vbase = 8192 + r * 128 + ((h ^ ((r >> 1) & 1)) << 4);

  f32x16 o[2][2];
#pragma unroll
  for (int a = 0; a < 2; ++a)
#pragma unroll
    for (int b = 0; b < 2; ++b)
#pragma unroll
      for (int j = 0; j < 16; ++j) o[a][b][j] = 0.f;
  float mrun[2] = {0.f, 0.f}, lrun[2] = {0.f, 0.f};

  GLDS(kg, ldst); GLDS(vg, ldst + 8192);
  GLDS(kg + 64 * 64, ldst + 16384); GLDS(vg + 64, ldst + 16384 + 8192);
  int bcur = 0;
  for (int t = 0; t < nkt; ++t) {
    if (t + 1 < nkt) { WAIT_V(2); } else { WAIT_V(0); }
    BAR;
    if (t + 2 < nkt) {
      int bn = bcur + 2; if (bn >= 3) bn -= 3;
      GLDS(kg + (size_t)(t + 2) * 64 * 64, ldst + bn * 16384);
      GLDS(vg + (t + 2) * 64, ldst + bn * 16384 + 8192);
    }
    const unsigned char* kb = smem + bcur * 16384;
#pragma unroll 1
    for (int kt = 0; kt < 2; ++kt) {
      bf16x8 kf[4], vf[2][2];
#pragma unroll
      for (int ds = 0; ds < 4; ++ds) kf[ds] = *(const bf16x8*)(kb + koff[ds] + kt * 4096);
#pragma unroll
      for (int s2 = 0; s2 < 2; ++s2)
#pragma unroll
        for (int mt = 0; mt < 2; ++mt) vf[s2][mt] = *(const bf16x8*)(kb + vbase + (((kt * 2 + s2) ^ vxh) << 5) + mt * 4096);
      f32x16 sc[2];
#pragma unroll
      for (int nt = 0; nt < 2; ++nt)
#pragma unroll
        for (int j = 0; j < 16; ++j) sc[nt][j] = -mrun[nt];
#pragma unroll
      for (int ds = 0; ds < 4; ++ds)
#pragma unroll
        for (int nt = 0; nt < 2; ++nt) sc[nt] = MFMA32(kf[ds], qf[nt][ds], sc[nt]);
      float mx[2];
#pragma unroll
      for (int nt = 0; nt < 2; ++nt) {
        float m0 = sc[nt][0];
#pragma unroll
        for (int j = 1; j < 16; ++j) m0 = fmaxf(m0, sc[nt][j]);
        mx[nt] = m0;
      }
      if (__any((fabsf(mx[0]) > 16.0f) | (fabsf(mx[1]) > 16.0f))) {
#pragma unroll
        for (int nt = 0; nt < 2; ++nt) {
          const float mp = fmaxf(mx[nt], __shfl_xor(mx[nt], 32));
          const float dm = (fabsf(mp) > 12.0f) ? mp : 0.0f;
          const float alpha = __builtin_amdgcn_exp2f(-dm);
          mrun[nt] += dm;
          lrun[nt] *= alpha;
#pragma unroll
          for (int j = 0; j < 16; ++j) sc[nt][j] -= dm;
#pragma unroll
          for (int mt = 0; mt < 2; ++mt)
#pragma unroll
            for (int j = 0; j < 16; ++j) o[mt][nt][j] *= alpha;
        }
      }
#pragma unroll
      for (int nt = 0; nt < 2; ++nt) {
        float sum = 0.f;
#pragma unroll
        for (int j = 0; j < 16; ++j) { float pv = __builtin_amdgcn_exp2f(sc[nt][j]); sc[nt][j] = pv; sum += pv; }
        lrun[nt] += sum;
      }
#pragma unroll
      for (int s2 = 0; s2 < 2; ++s2) {
        bf16x8 pf[2];
#pragma unroll
        for (int nt = 0; nt < 2; ++nt) {
          u32x4 pk;
#pragma unroll
          for (int i = 0; i < 4; ++i) pk[i] = pk2(sc[nt][s2 * 8 + 2 * i], sc[nt][s2 * 8 + 2 * i + 1]);
          pf[nt] = __builtin_bit_cast(bf16x8, pk);
        }
#pragma unroll
        for (int mt = 0; mt < 2; ++mt)
#pragma unroll
          for (int nt = 0; nt < 2; ++nt) o[mt][nt] = MFMA32(vf[s2][mt], pf[nt], o[mt][nt]);
      }
    }
    bcur = bcur + 1; if (bcur >= 3) bcur = 0;
  }
#pragma unroll
  for (int nt = 0; nt < 2; ++nt) {
    float l = lrun[nt] + __shfl_xor(lrun[nt], 32);
    float inv = 1.0f / l;
    const int tok = q0 + nt * 32 + r;
#pragma unroll
    for (int mt = 0; mt < 2; ++mt)
#pragma unroll
      for (int jg = 0; jg < 4; ++jg) {
        u32x2 ov;
        ov[0] = pk2(o[mt][nt][jg * 4 + 0] * inv, o[mt][nt][jg * 4 + 1] * inv);
        ov[1] = pk2(o[mt][nt][jg * 4 + 2] * inv, o[mt][nt][jg * 4 + 3] * inv);
        *(u32x2*)(O + (size_t)tok * 1024 + head * 64 + mt * 32 + jg * 8 + h * 4) = ov;
      }
  }
  WAIT_L(0);
  BAR;
}


enum { EK_Q = 0, EK_K, EK_V, EK_U, EK_S, EK_Y, EK_M0, EK_M1, EK_M2, EK_M3, EK_M4, EK_OUT, EK_FF1, EK_FF2 };
struct Job {
  const u16* A; const u16* Bt;
  int lda, ldb, gsB, tmB, K, kind, tm, tn, layer;
};

DI void stage_acc(AccT& acc, unsigned char* smem, const int tid, const int linear = 0) {
  const int wid = tid >> 6, lane = tid & 63, wr = wid >> 2, wc = wid & 3, fr = lane & 15, fq = lane >> 4;
#if PROBE_MASK
  if (linear) {
    int k = 0;
#pragma unroll
    for (int ai = 0; ai < 2; ++ai)
#pragma unroll
      for (int bj = 0; bj < 2; ++bj)
#pragma unroll
        for (int m = 0; m < 4; ++m)
#pragma unroll
          for (int n = 0; n < 2; ++n) {
            u32x2 w;
            w[0] = pk2(acc[ai][bj][m][n][0], acc[ai][bj][m][n][1]);
            w[1] = pk2(acc[ai][bj][m][n][2], acc[ai][bj][m][n][3]);
            *(u32x2*)(smem + tid * 8 + k * 4096) = w;
            ++k;
          }
    return;
  }
#endif
#pragma unroll
  for (int ai = 0; ai < 2; ++ai)
#pragma unroll
    for (int bj = 0; bj < 2; ++bj)
#pragma unroll
      for (int m = 0; m < 4; ++m)
#pragma unroll
        for (int n = 0; n < 2; ++n) {
          const int col = bj * 128 + wc * 32 + n * 16 + fr;
          const int row0 = ai * 128 + wr * 64 + m * 16 + fq * 4;
          u32x2 w;
          w[0] = pk2(acc[ai][bj][m][n][0], acc[ai][bj][m][n][1]);
          w[1] = pk2(acc[ai][bj][m][n][2], acc[ai][bj][m][n][3]);
          *(u32x2*)(smem + col * 512 + (((row0 >> 3) ^ (col & 31)) << 4) + ((row0 & 4) << 1)) = w;
        }
}
DI void unpack8(const u32x4 u, float* f) {
#pragma unroll
  for (int i = 0; i < 4; ++i) { f[2 * i] = __uint_as_float(u[i] << 16); f[2 * i + 1] = __uint_as_float(u[i] & 0xffff0000u); }
}
DI u32x4 pack8(const float* f) {
  u32x4 o;
#pragma unroll
  for (int i = 0; i < 4; ++i) o[i] = pk2(f[2 * i], f[2 * i + 1]);
  return o;
}

DI float tok_rstd(const unsigned char* ws, int tok) {
  const float* q = (const float*)(ws + WS_SSQ) + tok;
  return rsqrtf((q[0] + q[NT] + q[2 * NT] + q[3 * (size_t)NT]) * (1.0f / 1024.0f) + 1e-6f);
}
DI void run_epilogue(const P& pin, const Job& jb, AccT& acc) {
  extern __shared__ __attribute__((aligned(16))) unsigned char smem[];
  const int TID = opaque_tid();
  P p = pin;
  asm volatile("" : "+s"(p.ws), "+s"(p.out));
  const int tm = jb.tm, tn = jb.tn, layer = jb.layer & 255, kind = jb.kind;
  const int nit = (jb.layer & 256) ? 8 : (jb.layer & 512) ? 1 : (jb.layer & 1024) ? 0 : 16;
#if PROBE_MASK
  if (kind == -1) return;
  if (kind == -3) {
    u32x4 z; z[0] = acc[0][0][0][0][0] > 1e30f ? 1u : 0u; z[1] = 2; z[2] = 3; z[3] = 4;
    for (int it = 0; it < 16; ++it) {
      const int q = it * 512 + TID;
      *(u32x4*)((u16*)(p.ws + WS_FF) + (size_t)(tn * 256 + (q >> 5)) * 4096 + tm * 256 + (q & 31) * 8) = z;
    }
    return;
  }
#endif
  if (kind == EK_S) {
    float* Sg = (float*)(p.ws + WS_S) + (size_t)tn * 256 * 256;
    epi_for(acc, [&](const int row0, const int col, const f32x4 v) { *(f32x4*)(Sg + (size_t)col * 256 + row0) = v; });
    return;
  }
#if PROBE_MASK
  if (jb.layer & 16384) { if (acc[1][1][3][1][3] == 12345.678f) smem[TID] = 1; }
  if (!(jb.layer & 2048))
  for (int rep = (jb.layer & 8192) ? 4 : 1; rep > 0; --rep)
#endif
  stage_acc(acc, smem, TID, (jb.layer & 4096) ? 1 : 0);
  float* lrs = (float*)(smem + 131072);
  if ((kind <= EK_U || kind == EK_M2 || kind == EK_M3 || kind == EK_FF1) && TID < 256) lrs[TID] = tok_rstd(p.ws, tn * 256 + TID);
  __syncthreads();
#pragma unroll 2
  for (int it = 0; it < nit; ++it) {
    const int q = it * 512 + TID;
    int col = q >> 5, c = q & 31;
    if (kind == EK_U) { col = (q >> 1) & 255; c = ((q >> 9) << 1) | (q & 1); }
    const u32x4 sv = *(const u32x4*)(smem + col * 512 + ((c ^ (col & 31)) << 4));
    float f[8], r[8];
    unpack8(sv, f);
#if PROBE_MASK
    if (kind == -2) { if (f[0] > 1e30f) *(u32x4*)(p.ws + WS_FF) = sv; continue; }
#endif
    switch (kind) {
      case EK_Q: case EK_K: {
        const int tok = tn * 256 + col, hl = c >> 3, d0 = (c & 7) * 8;
        const float tr = lrs[col];
        float ss = 0.f;
#pragma unroll
        for (int i = 0; i < 8; ++i) { f[i] *= tr; ss += f[i] * f[i]; }
        ss += __shfl_xor(ss, 1); ss += __shfl_xor(ss, 2); ss += __shfl_xor(ss, 4);
        float rstd = rsqrtf(ss * (1.0f / 64.0f) + 1e-6f);
        if (kind == EK_Q) rstd *= 0.125f * 1.4426950408889634f;
        const float* gn = (kind == EK_Q ? p.in[4] : p.in[5]) + layer * 64 + d0;
        const f32x4 g0 = *(const f32x4*)gn, g1 = *(const f32x4*)(gn + 4);
        const int pos = tok < NTP ? (tok & 4095) : ((tok - NTP) & 8191);
        const int i0 = (c & 7) * 4;
        const float* rp = (const float*)(p.ws + WS_ROPE) + 2 * ((i0 < 16) ? (pos >> 6) * 16 + i0 : (pos & 63) * 16 + i0 - 16);
        const f32x4 cs0 = *(const f32x4*)rp, cs1 = *(const f32x4*)(rp + 4);
        const float x0 = f[0] * rstd * g0[0], x1 = f[1] * rstd * g0[1], x2 = f[2] * rstd * g0[2], x3 = f[3] * rstd * g0[3];
        const float x4 = f[4] * rstd * g1[0], x5 = f[5] * rstd * g1[1], x6 = f[6] * rstd * g1[2], x7 = f[7] * rstd * g1[3];
        r[0] = x0 * cs0[0] - x1 * cs0[1]; r[1] = x0 * cs0[1] + x1 * cs0[0];
        r[2] = x2 * cs0[2] - x3 * cs0[3]; r[3] = x2 * cs0[3] + x3 * cs0[2];
        r[4] = x4 * cs1[0] - x5 * cs1[1]; r[5] = x4 * cs1[1] + x5 * cs1[0];
        r[6] = x6 * cs1[2] - x7 * cs1[3]; r[7] = x6 * cs1[3] + x7 * cs1[2];
        u16* dst = (kind == EK_Q) ? (u16*)(p.ws + WS_Q) + (size_t)tok * 1024 + (tm * 4 + hl) * 64 + d0
                                  : (u16*)(p.ws + WS_K) + ((size_t)hl * NT + tok) * 64 + d0;
        *(u32x4*)dst = pack8(r);
      } break;
      case EK_V: {
        {
          const int tok0 = tn * 256 + c * 8;
#pragma unroll
          for (int i = 0; i < 8; ++i) r[i] = f[i] * lrs[c * 8 + i];
          *(u32x4*)((u16*)(p.ws + WS_VT) + (size_t)col * NT + tok0) = pack8(r);
        }
      } break;
      case EK_U: {
        const int tok = tn * 256 + col, g = (tm - 6) * 16 + (c >> 1);
        const float tr = lrs[col];
#pragma unroll
        for (int i = 0; i < 8; ++i) r[i] = f[i] * tr;
        *(u32x4*)((u16*)(p.ws + WS_ASSM) + ((size_t)g * NCH + (tok >> 5)) * ASTR + (tok & 31) * 16 + (c & 1) * 8) = pack8(r);
      } break;
      case EK_Y: {
        const int g = tn / 10, ch = (tn % 10) * 256 + col, r0 = tm * 256 + c * 8;
        const u32x4 uu = *(const u32x4*)((const u16*)(p.ws + WS_ASSM) + ((size_t)g * NCH + ch) * ASTR + r0);
        float u[8];
        unpack8(uu, u);
        const float* dsk = p.in[14] + layer * 512 + g * 16 + (c & 1) * 8;
        const f32x4 d0 = *(const f32x4*)dsk, d1 = *(const f32x4*)(dsk + 4);
#pragma unroll
        for (int i = 0; i < 4; ++i) { r[i] = gelu_tanh(f[i] + d0[i] * u[i]); r[4 + i] = gelu_tanh(f[4 + i] + d1[i] * u[4 + i]); }
        *(u32x4*)((u16*)(p.ws + WS_Y) + (size_t)g * NT * 16 + (size_t)ch * 512 + r0) = pack8(r);
      } break;
      case EK_M0: case EK_M1: case EK_M2: case EK_M3: case EK_M4: {
        const size_t o = (size_t)(tn * 256 + col) * 1024 + tm * 256 + c * 8;
        u16* t1 = (u16*)(p.ws + WS_Q) + o;
        u16* t2 = (u16*)(p.ws + WS_ASSM) + o;
        if (kind == EK_M2 || kind == EK_M3) {
          const float tr = lrs[col];
#pragma unroll
          for (int i = 0; i < 8; ++i) f[i] *= tr;
        }
        if (kind == EK_M0 || kind == EK_M3) {
#pragma unroll
          for (int i = 0; i < 8; ++i) r[i] = sigmoidf_(f[i]);
        } else {
          float a[8];
          unpack8(*(const u32x4*)t1, a);
          if (kind == EK_M1) {
#pragma unroll
            for (int i = 0; i < 8; ++i) r[i] = f[i] * a[i];
          } else if (kind == EK_M2) {
#pragma unroll
            for (int i = 0; i < 8; ++i) r[i] = sigmoidf_(f[i]) * a[i];
          } else {
            float b[8];
            unpack8(*(const u32x4*)t2, b);
#pragma unroll
            for (int i = 0; i < 8; ++i) r[i] = b[i] * f[i] + a[i];
          }
        }
        *(u32x4*)(kind == EK_M3 ? t2 : t1) = pack8(r);
      } break;
      case EK_OUT: case EK_FF2: {
        const int tok = tn * 256 + col, cc = tm * 256 + c * 8;
        const float* x = (kind == EK_OUT) ? xrow(p, layer, tok) + cc : p.out + (size_t)tok * 1024 + cc;
        float* o = p.out + (size_t)tok * 1024 + cc;
        const f32x4 x0 = *(const f32x4*)x, x1 = *(const f32x4*)(x + 4);
        f32x4 o0, o1;
        float ss = 0.f;
#pragma unroll
        for (int i = 0; i < 4; ++i) { o0[i] = x0[i] + f[i]; o1[i] = x1[i] + f[4 + i]; r[i] = o0[i]; r[4 + i] = o1[i]; ss += o0[i] * o0[i] + o1[i] * o1[i]; }
        *(f32x4*)o = o0; *(f32x4*)(o + 4) = o1;
        *(u32x4*)((u16*)(p.ws + WS_XN) + (size_t)tok * 1024 + cc) = pack8(r);
        ss += __shfl_xor(ss, 1); ss += __shfl_xor(ss, 2); ss += __shfl_xor(ss, 4); ss += __shfl_xor(ss, 8); ss += __shfl_xor(ss, 16);
        if (c == 0) ((float*)(p.ws + WS_SSQ))[(size_t)tm * NT + tok] = ss;
      } break;
      case EK_FF1: {
        const float tr = lrs[col];
#pragma unroll
        for (int i = 0; i < 8; ++i) { const float a = fmaxf(f[i] * tr, 0.f); r[i] = a * a; }
        *(u32x4*)((u16*)(p.ws + WS_FF) + ((size_t)(tn * 16 + tm) << 16) + col * 256 + c * 8) = pack8(r);
      } break;
    }
  }
  __syncthreads();
}

DI void make_job(const P& pin, int layer, int s, int w, int step, Job& jb) {
  struct { unsigned char* ws; } p;
  p.ws = pin.ws;
  asm volatile("" : "+s"(p.ws));
  const u16* XN = (const u16*)(p.ws + WS_XN);
  jb.layer = layer; jb.gsB = 16; jb.tmB = 0;
  if (s == 1) {
    int g = w / 10;
    jb.A = (const u16*)(p.ws + WS_W1T) + ((size_t)layer * 32 + g) * 256 * 512;
    jb.Bt = (const u16*)(p.ws + WS_ASSM) + (size_t)w * 256 * ASTR;
    jb.lda = 512; jb.ldb = ASTR; jb.K = 512; jb.kind = EK_S; jb.tm = 0; jb.tn = w;
    return;
  }
  if (s == 3) {
    int gc = w >> 1, rt = w & 1, g = gc / 10;
    jb.A = (const u16*)(p.ws + WS_WYT) + (((size_t)layer * 32 + g) * 512 + rt * 256) * ASTR;
    jb.Bt = (const u16*)(p.ws + WS_ASSM) + (size_t)gc * 256 * ASTR;
    jb.lda = ASTR; jb.ldb = ASTR; jb.K = ASTR; jb.kind = EK_Y; jb.tm = rt; jb.tn = gc;
    return;
  }
  const int nft = (s == 0) ? 8 : (s == 6) ? 16 : 4;
  int tt, ft; tile_map(w, nft, tt, ft);
  jb.tm = ft; jb.tn = tt;
  jb.lda = 1024; jb.ldb = 1024; jb.K = 1024;
  if (s == 0) {
    const u16* W = (const u16*)(p.ws + WS_WT_IN) + (size_t)layer * 4096 * 1024 + (size_t)ft * 256 * 1024;
    const u16* X = XN + (size_t)tt * 256 * 1024;
    if (ft == 5) { jb.A = X; jb.Bt = W; jb.kind = EK_V; }
    else { jb.A = W; jb.Bt = X; jb.kind = ft < 4 ? EK_Q : ft == 4 ? EK_K : EK_U; }
  } else if (s == 4) {
    jb.kind = EK_M0 + step;
    if (step < 2) {
      jb.A = (const u16*)(p.ws + (step == 0 ? WS_WT_GB : WS_WT_GA)) + (size_t)layer * 1024 * 512 + (size_t)ft * 256 * 512;
      jb.Bt = (const u16*)(p.ws + WS_Y) + (size_t)tt * 256 * 16;
      jb.lda = 512; jb.ldb = 16; jb.gsB = NT * 16; jb.K = 512;
    } else if (step < 4) {
      jb.A = (const u16*)(p.ws + WS_WT_IN) + (size_t)layer * 4096 * 1024 + (size_t)((step == 2 ? 3072 : 2048) + ft * 256) * 1024;
      jb.Bt = XN + (size_t)tt * 256 * 1024;
    } else {
      jb.A = (const u16*)(p.ws + WS_WT_AP) + (size_t)layer * 1024 * 1024 + (size_t)ft * 256 * 1024;
      jb.Bt = (const u16*)(p.ws + WS_ATTO) + (size_t)tt * 256 * 1024;
    }
  } else if (s == 5) {
    jb.A = (const u16*)(p.ws + WS_WT_OUT) + (size_t)layer * 1024 * 1024 + (size_t)ft * 256 * 1024;
    jb.Bt = (const u16*)(p.ws + WS_Q) + (size_t)tt * 256 * 1024; jb.kind = EK_OUT;
  } else if (s == 6) {
    jb.A = (const u16*)(p.ws + WS_WT_FF1) + (size_t)layer * 4096 * 1024 + (size_t)ft * 256 * 1024;
    jb.Bt = XN + (size_t)tt * 256 * 1024; jb.kind = EK_FF1;
  } else {
    jb.A = (const u16*)(p.ws + WS_WT_FF2) + (size_t)layer * 1024 * 4096 + (size_t)ft * 256 * 4096;
    jb.Bt = (const u16*)(p.ws + WS_FF) + ((size_t)tt * 16 << 16);
    jb.lda = 4096; jb.ldb = 256; jb.tmB = 1; jb.K = 4096; jb.kind = EK_FF2;
  }
}

DI void phase_jobs(const P& p, int layer, int s, int probe = 0) {
  int nitems, nsteps = 1, nattn = 0;
  switch (s) {
    case 0: nitems = 2560; break;
    case 1: nitems = 320; break;
    case 3: nitems = 3200; nattn = 2560; break;
    case 4: nitems = 1280; nsteps = 5; break;
    case 5: nitems = 1280; break;
    case 6: nitems = 5120; break;
    default: nitems = 1280; break;
  }
#if STAGGER_SLEEP
  if (s != 3) {
    const int slot = (blockIdx.x >> 3) & 31;
    for (int i = 0; i < slot; ++i) __builtin_amdgcn_s_sleep(STAGGER_SLEEP);
  }
#endif
  for (int w = blockIdx.x; w < nitems; w += gridDim.x) {
    if (w < nattn) {
      int seq_start, L, head, qb;
      if (w < 512) {
        int xcd = w & 7, r = w >> 3;
        int seq = xcd >> 2, kvh = xcd & 3;
        seq_start = NTP + seq * 8192; L = 8192; head = kvh * 4 + (r >> 4); qb = r & 15;
      } else {
        int w2 = w - 512, xcd = w2 & 7, r = w2 >> 3;
        int grp = (r >> 5) * 8 + xcd, within = r & 31;
        int seq = grp >> 2, kvh = grp & 3;
        seq_start = seq * 4096; L = 4096; head = kvh * 4 + (within >> 3); qb = within & 7;
      }
      attn_item(p, seq_start, L, head, qb);
    } else {
      for (int step = 0; step < nsteps; ++step) {
        Job jb;
        make_job(p, layer, s, w - nattn, step, jb);
#if PROBE_MASK
        if (probe == 2 || probe == 3) jb.kind = -1;
        if (probe == 3) jb.K = jb.K / 2;
#endif
        gemm_tile(jb.A, jb.Bt, jb.lda, jb.ldb, jb.gsB, jb.tmB, jb.K, [&](AccT& acc) {
          int w2 = w - nattn, st2 = step;
          asm volatile("" : "+s"(w2), "+s"(st2));
          Job j2;
          make_job(p, layer, s, w2, st2, j2);
#if PROBE_MASK
          if (probe == 2 || probe == 3) j2.kind = -1;
          if (probe == 4) j2.kind = -2;
          if (probe == 6) j2.layer |= 256;
          if (probe == 7) j2.layer |= 512;
          if (probe == 8) j2.layer |= 1024 | 2048;
          if (probe == 9) j2.layer |= 1024;
          if (probe == 10) j2.layer |= 1024 | 4096;
          if (probe == 11) j2.layer |= 1024 | 8192;
          if (probe == 12) j2.layer |= 1024 | 2048 | 16384;
          if (probe == 5) j2.kind = -3;
#endif
          run_epilogue(p, j2, acc);
        });
      }
    }
  }
}

DI void run_phase(const P& pin, int ph, int probe = 0) {
  P p = pin;
  asm volatile("" : "+s"(p.ws), "+s"(p.out));
  int layer = (ph - 3) / 8, s = (ph - 3) % 8;
  if (s == 2) phase_scan(p, layer);
  else phase_jobs(p, layer, s, probe);
}

__global__ void __launch_bounds__(512, 2) mega_coop(P p) {
  cg::grid_group grid = cg::this_grid();
  phase_prep_a(p);
  grid.sync();
  phase_prep_b(p);
  grid.sync();
  phase_prep_c(p);
  phase_convert(p, p.in[0], p.in[1]);
  grid.sync();
  for (int ph = 3; ph < NPHASE; ++ph) {
    run_phase(p, ph);
#if PROBE_MASK
    {
      const int s_ = (ph - 3) % 8;
      bool rep = false;
      if ((PROBE_MASK & 1) && s_ == 3) rep = true;
      if ((PROBE_MASK & 2) && (s_ == 0 || s_ == 4 || s_ == 6)) rep = true;
      if ((PROBE_MASK & 4) && (s_ == 1 || s_ == 2)) rep = true;
      if ((PROBE_MASK & 8) && s_ == 6) run_phase(p, ph, (PROBE_MASK >> 4));
      if (rep) run_phase(p, ph);
    }
#endif
    if (ph + 1 < NPHASE) grid.sync();
  }
}
#if N_LAUNCH_MODE == 0
__global__ void __launch_bounds__(512, 2) mega_one(P p) {
  run_phase(p, p.ph_lo);
}
#endif

extern "C" void kernel_launch(void* const* d_in, const int* in_sizes, int n_in, void* d_out, int out_size, void* d_ws, size_t ws_size,
                              hipStream_t stream) {
  static int grid = 0;
  if (grid == 0) {
    if (n_in != 21 || ws_size < WS_END) { fprintf(stderr, "kernel_launch: unexpected n_in %d / ws_size %zu (need %zu)\n", n_in, ws_size, (size_t)WS_END); grid = -1; return; }
    int dev = 0, cus = 0, per_cu = 0;
    hipGetDevice(&dev);
    hipDeviceGetAttribute(&cus, hipDeviceAttributeMultiprocessorCount, dev);
    hipFuncSetAttribute((const void*)mega_coop, hipFuncAttributeMaxDynamicSharedMemorySize, LDS_BYTES);
#if N_LAUNCH_MODE == 0
    hipFuncSetAttribute((const void*)mega_one, hipFuncAttributeMaxDynamicSharedMemorySize, LDS_BYTES);
#endif
    hipOccupancyMaxActiveBlocksPerMultiprocessor(&per_cu, (const void*)mega_coop, 512, LDS_BYTES);
    if (per_cu < 1) { fprintf(stderr, "kernel_launch: occupancy query says %d blocks/CU\n", per_cu); per_cu = 1; }
    (void)hipGetLastError();
    grid = cus * 1;
  }
  if (grid < 0) return;
  P p{};
  for (int i = 0; i < 21; ++i) p.in[i] = (const float*)d_in[i];
  p.out = (float*)d_out;
  p.ws = (unsigned char*)d_ws;
#if N_LAUNCH_MODE == 1
  p.ph_lo = 0; p.ph_hi = NPHASE;
  void* args[] = {&p};
  hipError_t e = hipLaunchCooperativeKernel((const void*)mega_coop, dim3(grid), dim3(512), args, LDS_BYTES, stream);
  if (e != hipSuccess) fprintf(stderr, "cooperative launch failed: %s (grid %d)\n", hipGetErrorString(e), grid);
#else
  for (int ph = 0; ph < NPHASE; ++ph) {
    p.ph_lo = ph; p.ph_hi = ph + 1;
    hipLaunchKernelGGL(mega_one, dim3(grid), dim3(512), LDS_BYTES, stream, p);
  }
#endif
}
```

```cpp
#include <hip/hip_runtime.h>
#include <hip/hip_cooperative_groups.h>
#include <cstdio>
namespace cg = cooperative_groups;

typedef unsigned short u16;
typedef __attribute__((ext_vector_type(8))) short bf16x8;
typedef __attribute__((ext_vector_type(4))) float f32x4;
typedef __attribute__((ext_vector_type(16))) float f32x16;
typedef __attribute__((ext_vector_type(4))) unsigned u32x4;
typedef __attribute__((ext_vector_type(2))) unsigned u32x2;
typedef __attribute__((ext_vector_type(2))) float f32x2;
typedef __attribute__((ext_vector_type(2))) __bf16 bf16v2;

#define DI __device__ __forceinline__
#ifndef PROBE_MASK
#define PROBE_MASK 0
#endif
#ifndef STAGGER_SLEEP
#define STAGGER_SLEEP 0
#endif
#ifndef N_LAUNCH_MODE
#define N_LAUNCH_MODE 1
#endif

constexpr int NT = 81920;
constexpr int NTP = 65536;
constexpr int NCH = 2560;
constexpr int ASTR = 768;
constexpr int NPHASE = 19;
constexpr int LDS_BYTES = 131072 + 1024;

constexpr size_t MiB = 1ull << 20;
constexpr size_t WS_WT_IN = 0;
constexpr size_t WS_WT_AP = 16 * MiB;
constexpr size_t WS_WT_GA = 20 * MiB;
constexpr size_t WS_WT_GB = 22 * MiB;
constexpr size_t WS_WT_OUT = 24 * MiB;
constexpr size_t WS_WT_FF1 = 28 * MiB;
constexpr size_t WS_WT_FF2 = 44 * MiB;
constexpr size_t WS_W1T = 60 * MiB;
constexpr size_t WS_WYT = 76 * MiB;
constexpr size_t WS_LPOW = 124 * MiB;
constexpr size_t WS_BBAR = 127 * MiB;
constexpr size_t WS_KTAB = 128 * MiB;
constexpr size_t WS_ROPE = 132 * MiB;
constexpr size_t WS_SSQ = 133 * MiB;
constexpr size_t WS_XN = 135 * MiB;
constexpr size_t WS_BIG = 295 * MiB;
constexpr size_t WS_Q = WS_BIG;
constexpr size_t WS_K = WS_BIG + 160 * MiB;
constexpr size_t WS_VT = WS_BIG + 200 * MiB;
constexpr size_t WS_ASSM = WS_BIG + 240 * MiB;
constexpr size_t WS_S = WS_BIG + 360 * MiB;
constexpr size_t WS_Y = WS_BIG + 440 * MiB;
constexpr size_t WS_ATTO = WS_BIG + 520 * MiB;
constexpr size_t WS_FF = WS_BIG;
constexpr size_t WS_END = WS_BIG + 680 * MiB;

struct P {
  const float* in[21];
  float* out;
  unsigned char* ws;
  int ph_lo, ph_hi;
};

DI u16 f2bf(float f) { unsigned u = __float_as_uint(f); u += 0x7fffu + ((u >> 16) & 1u); return (u16)(u >> 16); }
DI float bf2f(u16 h) { return __uint_as_float(((unsigned)h) << 16); }
DI unsigned pk2(float a, float b) {
  f32x2 v; v[0] = a; v[1] = b;
  bf16v2 r = __builtin_convertvector(v, bf16v2);
  return __builtin_bit_cast(unsigned, r);
}
DI float sigmoidf_(float x) { return 1.0f / (1.0f + __expf(-x)); }
DI float gelu_tanh(float x) {
  float z = 0.7978845608028654f * (x + 0.044715f * x * x * x);
  float e = __expf(2.0f * z);
  return 0.5f * x * (2.0f - 2.0f / (e + 1.0f));
}


DI void sincos_d(double x, double* sn, double* cs) {
  const double TWO_PI_HI = 6.283185307179586232e+00, TWO_PI_LO = 2.449293598294706414e-16;
  double k = rint(x * 0.15915494309189534561);
  double r = (x - k * TWO_PI_HI) - k * TWO_PI_LO;
  r *= 0.25;
  double r2 = r * r;
  double s = 1.0, c = 1.0;
  s = 1.0 - r2 / (18.0 * 19.0);
  s = 1.0 - r2 / (16.0 * 17.0) * s;
  s = 1.0 - r2 / (14.0 * 15.0) * s;
  s = 1.0 - r2 / (12.0 * 13.0) * s;
  s = 1.0 - r2 / (10.0 * 11.0) * s;
  s = 1.0 - r2 / (8.0 * 9.0) * s;
  s = 1.0 - r2 / (6.0 * 7.0) * s;
  s = 1.0 - r2 / (4.0 * 5.0) * s;
  s = 1.0 - r2 / (2.0 * 3.0) * s;
  s *= r;
  c = 1.0 - r2 / (17.0 * 18.0);
  c = 1.0 - r2 / (15.0 * 16.0) * c;
  c = 1.0 - r2 / (13.0 * 14.0) * c;
  c = 1.0 - r2 / (11.0 * 12.0) * c;
  c = 1.0 - r2 / (9.0 * 10.0) * c;
  c = 1.0 - r2 / (7.0 * 8.0) * c;
  c = 1.0 - r2 / (5.0 * 6.0) * c;
  c = 1.0 - r2 / (3.0 * 4.0) * c;
  c = 1.0 - r2 / (1.0 * 2.0) * c;
  double s2 = 2.0 * s * c, c2 = c * c - s * s;
  *sn = 2.0 * s2 * c2; *cs = c2 * c2 - s2 * s2;
}

DI int opaque_tid() { int t = threadIdx.x; asm volatile("" : "+v"(t)); return t; }
DI const char* sgpr_ptr(const char* p) { asm("" : "+s"(p)); return p; }
#define WAIT_V(n) asm volatile("s_waitcnt vmcnt(" #n ")" ::: "memory")
#define WAIT_L(n) asm volatile("s_waitcnt lgkmcnt(" #n ")" ::: "memory")
#define BAR __builtin_amdgcn_s_barrier()
#define SCHED __builtin_amdgcn_sched_barrier(0)
#define GLDS(gp, lp) __builtin_amdgcn_global_load_lds((const unsigned*)(gp), (unsigned*)(lp), 16, 0, 0)

constexpr int GBK = 64, GHALF = 128, GHT = GHALF * GBK;
DI int lds_byte(int r, int c) {
  int st = (r >> 4) * 2 + (c >> 5), rr = r & 15, cc = c & 31, ob = rr * 64 + cc * 2;
  return st * 1024 + (ob ^ (((ob >> 9) & 1) << 5));
}
DI void stage_rc(int b, int& R, int& C) {
  int st = b / 1024, sb = b % 1024, swz = sb ^ (((sb >> 9) & 1) << 5);
  R = (st >> 1) * 16 + swz / 64; C = (st & 1) * 32 + (swz % 64) / 2;
}

typedef f32x4 AccT[2][2][4][2];

template <class Epi>
DI void gemm_tile(const u16* __restrict__ A, const u16* __restrict__ Bt, const int lda, const int ldb, const int gsB, const int tmB, const int K, Epi&& epi) {
  const int TID = opaque_tid();
  extern __shared__ __attribute__((aligned(16))) unsigned char smem[];
  u16* shm = (u16*)smem;
#define SA(b, h) (shm + ((b) * 2 + (h)) * GHT)
#define SB(b, h) (shm + (4 + (b) * 2 + (h)) * GHT)
  int R0, C0, R1, C1;
  stage_rc(TID * 16, R0, C0);
  stage_rc(TID * 16 + 8192, R1, C1);
  const unsigned voA0 = (unsigned)(R0 * lda + C0) * 2u, voA1 = (unsigned)(R1 * lda + C1) * 2u;
  const unsigned voB0 = (unsigned)(R0 * ldb + (C0 & 15) + (C0 >> 4) * gsB) * 2u, voB1 = (unsigned)(R1 * ldb + (C1 & 15) + (C1 >> 4) * gsB) * 2u;
  const int hA = GHALF * lda, hB = GHALF * ldb;
  const unsigned wid_u = __builtin_amdgcn_readfirstlane(TID >> 6);
#define STAGE_A(PTR, half, kt) do { const char* _g = sgpr_ptr((const char*)(A + (size_t)(half) * hA + (size_t)(kt) * GBK)); \
    char* _l = (char*)(PTR) + wid_u * 1024u; \
    GLDS(_g + voA0, _l); GLDS(_g + voA1, _l + 8192); } while (0)
#define STAGE_B(PTR, half, kt) do { const char* _g = sgpr_ptr((const char*)(Bt + (size_t)(half) * hB + (tmB ? (size_t)((((kt) >> 2) << 16) + (((kt) & 3) << 6)) : (size_t)(kt) * (size_t)(4 * gsB)))); \
    char* _l = (char*)(PTR) + wid_u * 1024u; \
    GLDS(_g + voB0, _l); GLDS(_g + voB1, _l + 8192); } while (0)
#define LDA(dst, b, h) for (int m = 0; m < 4; ++m) for (int k = 0; k < 2; ++k) \
    dst[m][k] = *reinterpret_cast<const bf16x8*>((char*)SA(b, h) + lds_byte(wr * 64 + m * 16 + fr, k * 32 + fq * 8))
#define LDB(dst, b, h) for (int n = 0; n < 2; ++n) for (int k = 0; k < 2; ++k) \
    dst[n][k] = *reinterpret_cast<const bf16x8*>((char*)SB(b, h) + lds_byte(wc * 32 + n * 16 + fr, k * 32 + fq * 8))
#define MMA(ai, bj, At, Bq) do { __builtin_amdgcn_s_setprio(1); \
    for (int m = 0; m < 4; ++m) for (int n = 0; n < 2; ++n) for (int k = 0; k < 2; ++k) \
      acc[ai][bj][m][n] = __builtin_amdgcn_mfma_f32_16x16x32_bf16(At[m][k], Bq[n][k], acc[ai][bj][m][n], 0, 0, 0); \
    __builtin_amdgcn_s_setprio(0); } while (0)

  const int wid = TID >> 6, lane = TID & 63, wr = wid >> 2, wc = wid & 3, fr = lane & 15, fq = lane >> 4;
  AccT acc;
#pragma unroll
  for (int a = 0; a < 2; ++a)
#pragma unroll
    for (int b = 0; b < 2; ++b)
#pragma unroll
      for (int m = 0; m < 4; ++m)
#pragma unroll
        for (int n = 0; n < 2; ++n) acc[a][b][m][n] = f32x4{0.f, 0.f, 0.f, 0.f};
  bf16x8 At[4][2], B0[2][2], B1[2][2];
  const int nt = K / GBK;
  STAGE_B(SB(0, 0), 0, 0); STAGE_A(SA(0, 0), 0, 0);
  STAGE_B(SB(0, 1), 1, 0); STAGE_A(SA(0, 1), 1, 0);
  if (wr == 1) BAR;
  WAIT_V(4); BAR;
  STAGE_B(SB(1, 0), 0, 1); STAGE_A(SA(1, 0), 0, 1); STAGE_B(SB(1, 1), 1, 1);
  WAIT_V(6); BAR;
  for (int t = 0; t < nt - 2; t += 2) {
    LDB(B0, 0, 0); SCHED; LDA(At, 0, 0); STAGE_A(SA(1, 1), 1, t + 1);
    WAIT_L(8); BAR; WAIT_L(0); MMA(0, 0, At, B0); BAR; SCHED;
    LDB(B1, 0, 1); STAGE_B(SB(0, 0), 0, t + 2);
    BAR; WAIT_L(0); MMA(0, 1, At, B1); BAR;
    LDA(At, 0, 1); STAGE_A(SA(0, 0), 0, t + 2);
    BAR; WAIT_L(0); MMA(1, 0, At, B0); BAR; SCHED;
    STAGE_B(SB(0, 1), 1, t + 2);
    WAIT_V(6); BAR; MMA(1, 1, At, B1); BAR;
    LDB(B0, 1, 0); SCHED; LDA(At, 1, 0); STAGE_A(SA(0, 1), 1, t + 2);
    WAIT_L(8); BAR; WAIT_L(0); MMA(0, 0, At, B0); BAR; SCHED;
    LDB(B1, 1, 1); STAGE_B(SB(1, 0), 0, t + 3);
    BAR; WAIT_L(0); MMA(0, 1, At, B1); BAR;
    LDA(At, 1, 1); STAGE_A(SA(1, 0), 0, t + 3);
    BAR; WAIT_L(0); MMA(1, 0, At, B0); BAR; SCHED;
    STAGE_B(SB(1, 1), 1, t + 3);
    WAIT_V(6); BAR; MMA(1, 1, At, B1); BAR;
  }
  { LDB(B0, 0, 0); LDA(At, 0, 0); STAGE_A(SA(1, 1), 1, nt - 1);
    BAR; WAIT_L(0); MMA(0, 0, At, B0); BAR;
    LDB(B1, 0, 1); BAR; WAIT_L(0); MMA(0, 1, At, B1); BAR;
    LDA(At, 0, 1); WAIT_V(4); BAR; WAIT_L(0); MMA(1, 0, At, B0); MMA(1, 1, At, B1); BAR; }
  { LDB(B0, 1, 0); LDA(At, 1, 0); WAIT_V(2); BAR; WAIT_L(0); MMA(0, 0, At, B0); BAR;
    LDB(B1, 1, 1); WAIT_V(0); BAR; WAIT_L(0); MMA(0, 1, At, B1); BAR;
    LDA(At, 1, 1); BAR; WAIT_L(0); MMA(1, 0, At, B0); MMA(1, 1, At, B1); BAR; }
  if (wr == 0) BAR;
  epi(acc);
#undef SA
#undef SB
}

template <class F>
DI void epi_for(AccT& acc, F&& f) {
  const int TID = opaque_tid();
  const int _wid = TID >> 6, _lane = TID & 63, _wr = _wid >> 2, _wc = _wid & 3, _fr = _lane & 15, _fq = _lane >> 4;
#pragma unroll
  for (int _ai = 0; _ai < 2; ++_ai)
#pragma unroll
    for (int _bj = 0; _bj < 2; ++_bj)
#pragma unroll
      for (int _m = 0; _m < 4; ++_m)
#pragma unroll
        for (int _n = 0; _n < 2; ++_n)
          f(_ai * 128 + _wr * 64 + _m * 16 + _fq * 4, _bj * 128 + _wc * 32 + _n * 16 + _fr, acc[_ai][_bj][_m][_n]);
}

DI void tile_map(int w, int ntn, int& tm, int& tn) {
  int xcd = w & 7, r = w >> 3;
  tn = r % ntn; tm = (r / ntn) * 8 + xcd;
}

DI void transpose_tile(const float* __restrict__ src, int N, u16* __restrict__ dst, int K, int tk, int tn, const float* __restrict__ gain) {
  const int TID = opaque_tid();
  extern __shared__ __attribute__((aligned(16))) unsigned char smem[];
  float* tile = (float*)smem;
  const int t = TID;
  {
    int rk = t >> 3, cs = (t & 7) * 8;
    const float4* s = (const float4*)(src + (size_t)(tk * 64 + rk) * N + tn * 64 + cs);
    float4 a = s[0], b = s[1];
    if (gain) { const float gk = gain[tk * 64 + rk]; a.x *= gk; a.y *= gk; a.z *= gk; a.w *= gk; b.x *= gk; b.y *= gk; b.z *= gk; b.w *= gk; }
    float* d = tile + rk * 65 + cs;
    d[0] = a.x; d[1] = a.y; d[2] = a.z; d[3] = a.w; d[4] = b.x; d[5] = b.y; d[6] = b.z; d[7] = b.w;
  }
  __syncthreads();
  {
    int n = t >> 3, ks = (t & 7) * 8;
    u32x4 o;
    o[0] = pk2(tile[(ks + 0) * 65 + n], tile[(ks + 1) * 65 + n]);
    o[1] = pk2(tile[(ks + 2) * 65 + n], tile[(ks + 3) * 65 + n]);
    o[2] = pk2(tile[(ks + 4) * 65 + n], tile[(ks + 5) * 65 + n]);
    o[3] = pk2(tile[(ks + 6) * 65 + n], tile[(ks + 7) * 65 + n]);
    *(u32x4*)(dst + (size_t)(tn * 64 + n) * K + tk * 64 + ks) = o;
  }
  __syncthreads();
}

DI void phase_prep_a(const P& p) {
  const int TID = opaque_tid();
  const int bid = blockIdx.x, nb = gridDim.x;
  for (int w = bid; w < 7680; w += nb) {
    int layer = w / 3840, r = w % 3840;
    const float* src; u16* dst; int K, N, tl; const float* gain = nullptr;
    if (r < 1024) { src = p.in[3] + (size_t)layer * 1024 * 4096; dst = (u16*)(p.ws + WS_WT_IN) + (size_t)layer * 4096 * 1024; K = 1024; N = 4096; tl = r; gain = p.in[2] + layer * 1024; }
    else if (r < 1280) { src = p.in[6] + (size_t)layer * 1024 * 1024; dst = (u16*)(p.ws + WS_WT_AP) + (size_t)layer * 1024 * 1024; K = 1024; N = 1024; tl = r - 1024; }
    else if (r < 1408) { src = p.in[15] + (size_t)layer * 512 * 1024; dst = (u16*)(p.ws + WS_WT_GA) + (size_t)layer * 1024 * 512; K = 512; N = 1024; tl = r - 1280; }
    else if (r < 1536) { src = p.in[16] + (size_t)layer * 512 * 1024; dst = (u16*)(p.ws + WS_WT_GB) + (size_t)layer * 1024 * 512; K = 512; N = 1024; tl = r - 1408; }
    else if (r < 1792) { src = p.in[17] + (size_t)layer * 1024 * 1024; dst = (u16*)(p.ws + WS_WT_OUT) + (size_t)layer * 1024 * 1024; K = 1024; N = 1024; tl = r - 1536; }
    else if (r < 2816) { src = p.in[19] + (size_t)layer * 1024 * 4096; dst = (u16*)(p.ws + WS_WT_FF1) + (size_t)layer * 4096 * 1024; K = 1024; N = 4096; tl = r - 1792; gain = p.in[18] + layer * 1024; }
    else { src = p.in[20] + (size_t)layer * 4096 * 1024; dst = (u16*)(p.ws + WS_WT_FF2) + (size_t)layer * 1024 * 4096; K = 4096; N = 1024; tl = r - 2816; }
    int ntn = N / 64;
    transpose_tile(src, N, dst, K, tl / ntn, tl % ntn, gain);
  }
  const int gtid = bid * 512 + TID, nth = nb * 512;
  float2* LP = (float2*)(p.ws + WS_LPOW);
  float2* BB = (float2*)(p.ws + WS_BBAR);
  for (int i = gtid; i < 8192; i += nth) {
    int lg = i >> 6;
    double step = exp((double)p.in[9][lg]);
    double lr = p.in[7][i], li = p.in[8][i];
    double zr = lr * step, zi = li * step;
    for (int tau = 0; tau <= 32; ++tau) {
      double e = exp(zr * tau), sn, cs;
      sincos_d(zi * tau, &sn, &cs);
      LP[(size_t)i * 33 + tau] = make_float2((float)(e * cs), (float)(e * sn));
    }
    double e = exp(zr), sn, cs;
    sincos_d(zi, &sn, &cs);
    double nr = e * cs - 1.0, ni = e * sn, den = lr * lr + li * li;
    double fr = (nr * lr + ni * li) / den, fi = (ni * lr - nr * li) / den;
    for (int ci = 0; ci < 16; ++ci) {
      double br = p.in[10][(size_t)i * 16 + ci], bi = p.in[11][(size_t)i * 16 + ci];
      BB[(size_t)i * 16 + ci] = make_float2((float)(fr * br - fi * bi), (float)(fr * bi + fi * br));
    }
  }
  float2* RP = (float2*)(p.ws + WS_ROPE);
  for (int i = gtid; i < 128 * 16; i += nth) {
    int pos = i >> 4, f = i & 15;
    double inv = exp(-(double)(2 * f) / 32.0 * 9.210340371976184);
    double sn, cs;
    sincos_d((double)pos * inv, &sn, &cs);
    RP[i] = make_float2((float)cs, (float)sn);
  }
}

DI void phase_prep_b(const P& p) {
  const int TID = opaque_tid();
  const int gtid = blockIdx.x * 512 + TID, nth = gridDim.x * 512;
  const float2* LP = (const float2*)(p.ws + WS_LPOW);
  const float2* BB = (const float2*)(p.ws + WS_BBAR);
  float* KT = (float*)(p.ws + WS_KTAB);
  const float* cre = p.in[12];
  const float* cim = p.in[13];
  for (int i = gtid; i < (1 << 20); i += nth) {
    int ci = i & 15, co = (i >> 4) & 15, tau = (i >> 8) & 31, lg = i >> 13;
    float s = 0.f;
    for (int pp = 0; pp < 64; ++pp) {
      float cr = cre[(size_t)(lg * 16 + co) * 64 + pp], cI = cim[(size_t)(lg * 16 + co) * 64 + pp];
      float2 l = LP[(size_t)(lg * 64 + pp) * 33 + tau];
      float2 b = BB[(size_t)(lg * 64 + pp) * 16 + ci];
      float xr = l.x * b.x - l.y * b.y, xi = l.x * b.y + l.y * b.x;
      s += cr * xr - cI * xi;
    }
    KT[i] = s;
  }
  u16* W1 = (u16*)(p.ws + WS_W1T);
  for (int i = gtid; i < (1 << 23); i += nth) {
    int k = i & 511, n = (i >> 9) & 255, g = (i >> 17) & 31, layer = i >> 22;
    int dir = n >> 7, pp = (n >> 1) & 63, ri = n & 1, s = k >> 4, ci = k & 15;
    int e = dir ? s : 31 - s;
    int lg = (layer * 2 + dir) * 32 + g;
    float2 l = LP[(size_t)(lg * 64 + pp) * 33 + e];
    float2 b = BB[(size_t)(lg * 64 + pp) * 16 + ci];
    float v = ri ? (l.x * b.y + l.y * b.x) : (l.x * b.x - l.y * b.y);
    W1[i] = f2bf(v);
  }
  u16* WY = (u16*)(p.ws + WS_WYT);
  for (int i = gtid; i < (1 << 23); i += nth) {
    int kk = i & 255, n = (i >> 8) & 511, g = (i >> 17) & 31, layer = i >> 22;
    int t = n >> 4, co = n & 15, dir = kk >> 7, pp = (kk >> 1) & 63, ri = kk & 1;
    int e = dir ? 32 - t : t + 1;
    int lg = (layer * 2 + dir) * 32 + g;
    float cr = cre[(size_t)(lg * 16 + co) * 64 + pp], cI = cim[(size_t)(lg * 16 + co) * 64 + pp];
    float2 l = LP[(size_t)(lg * 64 + pp) * 33 + e];
    float v = ri ? -(cr * l.y + cI * l.x) : (cr * l.x - cI * l.y);
    WY[((size_t)((layer * 32 + g) * 512 + n)) * ASTR + 512 + kk] = f2bf(v);
  }
}

DI void phase_prep_c(const P& p) {
  const int TID = opaque_tid();
#if PROBE_MASK & 64
  {
    u32x4* dst = (u32x4*)(p.ws + WS_FF);
    u32x4 z; z[0] = 1; z[1] = 2; z[2] = 3; z[3] = 4;
    for (unsigned i = blockIdx.x * 512 + TID; i < 640u * 65536u; i += gridDim.x * 512) { z[0] = i * 2654435761u; z[1] = z[0] ^ (i << 7); z[2] = z[1] * 40503u + i; z[3] = z[2] ^ z[0]; dst[i] = z; }
  }
#endif
  const int gtid = blockIdx.x * 512 + TID, nth = gridDim.x * 512;
  const float* KT = (const float*)(p.ws + WS_KTAB);
  u16* WY = (u16*)(p.ws + WS_WYT);
  for (int i = gtid; i < (1 << 21); i += nth) {
    int k8 = i & 63, n = (i >> 6) & 511, g = (i >> 15) & 31, layer = i >> 20;
    int t = n >> 4, co = n & 15, s = k8 >> 1, ci0 = (k8 & 1) * 8;
    int tau = t - s;
    float v[8];
    if (tau > 0) {
      const float* q = KT + ((((size_t)(layer * 2 + 0) * 32 + g) * 32 + tau) * 16 + co) * 16 + ci0;
#pragma unroll
      for (int j = 0; j < 8; ++j) v[j] = q[j];
    } else if (tau < 0) {
      const float* q = KT + ((((size_t)(layer * 2 + 1) * 32 + g) * 32 - tau) * 16 + co) * 16 + ci0;
#pragma unroll
      for (int j = 0; j < 8; ++j) v[j] = q[j];
    } else {
      const float* q0 = KT + ((((size_t)(layer * 2 + 0) * 32 + g) * 32) * 16 + co) * 16 + ci0;
      const float* q1 = KT + ((((size_t)(layer * 2 + 1) * 32 + g) * 32) * 16 + co) * 16 + ci0;
#pragma unroll
      for (int j = 0; j < 8; ++j) v[j] = q0[j] + q1[j];
    }
    u32x4 o;
    o[0] = pk2(v[0], v[1]); o[1] = pk2(v[2], v[3]); o[2] = pk2(v[4], v[5]); o[3] = pk2(v[6], v[7]);
    *(u32x4*)(WY + ((size_t)((layer * 32 + g) * 512 + n)) * ASTR + k8 * 8) = o;
  }
}

DI const float* xrow(const P& p, int layer, int tok) {
  if (layer == 0) return tok < NTP ? p.in[0] + (size_t)tok * 1024 : p.in[1] + (size_t)(tok - NTP) * 1024;
  return p.out + (size_t)tok * 1024;
}
DI void phase_convert(const P& p, const float* __restrict__ src0, const float* __restrict__ src1) {
  const int TID = opaque_tid();
  const int lane = TID & 63, wave = TID >> 6;
  u16* XN = (u16*)(p.ws + WS_XN);
  float* SSQ = (float*)(p.ws + WS_SSQ);
  for (int tok = blockIdx.x * 8 + wave; tok < NT; tok += gridDim.x * 8) {
    const float* x = tok < NTP ? src0 + (size_t)tok * 1024 : src1 + (size_t)(tok - NTP) * 1024;
    float4 v[4];
    float ss = 0.f;
#pragma unroll
    for (int i = 0; i < 4; ++i) {
      v[i] = *(const float4*)(x + i * 256 + lane * 4);
      ss += v[i].x * v[i].x + v[i].y * v[i].y + v[i].z * v[i].z + v[i].w * v[i].w;
    }
#pragma unroll
    for (int o = 32; o >= 1; o >>= 1) ss += __shfl_xor(ss, o);
    if (lane < 4) SSQ[(size_t)lane * NT + tok] = lane == 0 ? ss : 0.f;
#pragma unroll
    for (int i = 0; i < 4; ++i) {
      u32x2 o;
      o[0] = pk2(v[i].x, v[i].y);
      o[1] = pk2(v[i].z, v[i].w);
      *(u32x2*)(XN + (size_t)tok * 1024 + i * 256 + lane * 4) = o;
    }
  }
}

DI void phase_scan(const P& p, int layer) {
  const int TID = opaque_tid();
  const int gtid = blockIdx.x * 512 + TID, nth = gridDim.x * 512;
  const float2* LP = (const float2*)(p.ws + WS_LPOW);
  for (int i = gtid; i < 18 * 4096; i += nth) {
    int pp = i & 63, dir = (i >> 6) & 1, g = (i >> 7) & 31, seq = i >> 12;
    int c0 = seq < 16 ? seq * 128 : 2048 + (seq - 16) * 256;
    int nc = seq < 16 ? 128 : 256;
    float2 a = LP[(size_t)(((layer * 2 + dir) * 32 + g) * 64 + pp) * 33 + 32];
    const float2* S = (const float2*)(p.ws + WS_S) + ((size_t)(g * NCH + c0) * 256 + dir * 128 + pp * 2) / 2;
    unsigned* H = (unsigned*)((u16*)(p.ws + WS_ASSM) + (size_t)(g * NCH + c0) * ASTR + 512 + dir * 128 + pp * 2);
    float hr = 0.f, hi = 0.f;
    for (int cb = 0; cb < nc; cb += 16) {
      float2 sv[16];
#pragma unroll
      for (int k = 0; k < 16; ++k) {
        const int c = dir == 0 ? cb + k : nc - 1 - cb - k;
        sv[k] = S[(size_t)c * 128];
      }
#pragma unroll
      for (int k = 0; k < 16; ++k) {
        const int c = dir == 0 ? cb + k : nc - 1 - cb - k;
        H[(size_t)c * (ASTR / 2)] = pk2(hr, hi);
        const float nr = a.x * hr - a.y * hi + sv[k].x;
        hi = a.x * hi + a.y * hr + sv[k].y;
        hr = nr;
      }
    }
  }
}

#define MFMA32(a, b, c) __builtin_amdgcn_mfma_f32_32x32x16_bf16((a), (b), (c), 0, 0, 0)
DI void attn_item(const P& pin, int seq_start, int L, int head, int qb) {
  const int TID = opaque_tid();
  struct { unsigned char* ws; } p;
  p.ws = pin.ws;
  asm volatile("" : "+s"(p.ws));
  extern __shared__ __attribute__((aligned(16))) unsigned char smem[];
  const u16* Q = (const u16*)(p.ws + WS_Q);
  const u16* KB = (const u16*)(p.ws + WS_K);
  const u16* VT = (const u16*)(p.ws + WS_VT);
  u16* O = (u16*)(p.ws + WS_ATTO);
  const int tid = TID, wave = tid >> 6, lane = tid & 63, r = lane & 31, h = lane >> 5;
  const int kvh = head >> 2;
  const int q0 = seq_start + qb * 512 + wave * 64;
  bf16x8 qf[2][4];
#pragma unroll
  for (int nt = 0; nt < 2; ++nt)
#pragma unroll
    for (int ds = 0; ds < 4; ++ds)
      qf[nt][ds] = *(const bf16x8*)(Q + (size_t)(q0 + nt * 32 + r) * 1024 + head * 64 + ds * 16 + h * 8);
#pragma unroll
  for (int nt = 0; nt < 2; ++nt)
#pragma unroll
    for (int ds = 0; ds < 4; ++ds) asm volatile("" ::"v"(qf[nt][ds]));
  const int srow = tid >> 3, spos = tid & 7, scc = spos ^ ((srow >> 1) & 7);
  const u16* kg = KB + ((size_t)kvh * NT + seq_start + srow) * 64 + scc * 8;
  const u16* vg = VT + (size_t)(kvh * 64 + srow) * NT + seq_start + scc * 8;
  unsigned char* ldst = smem + tid * 16;
  const int nkt = L >> 6;
  const int pr = ((r >> 4) * 16) + (((r >> 2) & 1) * 8) + (((r >> 3) & 1) * 4) + (r & 3);
  int koff[4];
#pragma unroll
  for (int ds = 0; ds < 4; ++ds) koff[ds] = pr * 128 + (((ds * 2 + h) ^ ((pr >> 1) & 7)) << 4);
  const int vxh = ((r >> 1) & 7) >> 1;
  const int vbase = 8192 + r * 128 + ((h ^ ((r >> 1) & 1)) << 4);

  f32x16 o[2][2];
#pragma unroll
  for (int a = 0; a < 2; ++a)
#pragma unroll
    for (int b = 0; b < 2; ++b)
#pragma unroll
      for (int j = 0; j < 16; ++j) o[a][b][j] = 0.f;
  float mrun[2] = {0.f, 0.f}, lrun[2] = {0.f, 0.f};


#define ATT_STAGE(T, B) do { GLDS(kg + (size_t)(T) * 128 * 64, ldst + (B) * 32768); GLDS(vg + (T) * 128, ldst + (B) * 32768 + 8192); \
    GLDS(kg + (size_t)(T) * 128 * 64 + 64 * 64, ldst + (B) * 32768 + 16384); GLDS(vg + (T) * 128 + 64, ldst + (B) * 32768 + 16384 + 8192); } while (0)
  const int nst = nkt >> 1;
  ATT_STAGE(0, 0);
  ATT_STAGE(1, 1);
  int bcur = 0;
  for (int st = 0; st < nst; ++st) {
    if (st + 1 < nst) { WAIT_V(4); } else { WAIT_V(0); }
    BAR;
    if (st + 2 < nst) {
      int bn = bcur + 2; if (bn >= 3) bn -= 3;
      ATT_STAGE(st + 2, bn);
    }
    const unsigned char* sbase = smem + bcur * 32768;
    auto qk = [&](const int hx, f32x16 (&sc)[2]) {
      const unsigned char* kb = sbase + (hx >> 1) * 16384 + (hx & 1) * 4096;
      bf16x8 kf[4];
#pragma unroll
      for (int ds = 0; ds < 4; ++ds) kf[ds] = *(const bf16x8*)(kb + koff[ds]);
#pragma unroll
      for (int nt = 0; nt < 2; ++nt)
#pragma unroll
        for (int j = 0; j < 16; ++j) sc[nt][j] = -mrun[nt];
#pragma unroll
      for (int ds = 0; ds < 4; ++ds)
#pragma unroll
        for (int nt = 0; nt < 2; ++nt) sc[nt] = MFMA32(kf[ds], qf[nt][ds], sc[nt]);
    };
    auto sm_pv = [&](const int hx, f32x16 (&sc)[2], f32x16 (&pend)[2], const bool has_pend) {
      const unsigned char* kb = sbase + (hx >> 1) * 16384;
      const int kt = hx & 1;
      bf16x8 vf[2][2];
#pragma unroll
      for (int s2 = 0; s2 < 2; ++s2)
#pragma unroll
        for (int mt = 0; mt < 2; ++mt) vf[s2][mt] = *(const bf16x8*)(kb + vbase + (((kt * 2 + s2) ^ vxh) << 5) + mt * 4096);
      float mx[2];
#pragma unroll
      for (int nt = 0; nt < 2; ++nt) {
        float m0 = sc[nt][0];
#pragma unroll
        for (int j = 1; j < 16; ++j) m0 = fmaxf(m0, sc[nt][j]);
        mx[nt] = m0;
      }
      if (__any((fabsf(mx[0]) > 16.0f) | (fabsf(mx[1]) > 16.0f))) {
#pragma unroll
        for (int nt = 0; nt < 2; ++nt) {
          const float mp = fmaxf(mx[nt], __shfl_xor(mx[nt], 32));
          const float dm = (fabsf(mp) > 12.0f) ? mp : 0.0f;
          const float alpha = __builtin_amdgcn_exp2f(-dm);
          mrun[nt] += dm;
          lrun[nt] *= alpha;
#pragma unroll
          for (int j = 0; j < 16; ++j) sc[nt][j] -= dm;
          if (has_pend) {
#pragma unroll
            for (int j = 0; j < 16; ++j) pend[nt][j] -= dm;
          }
#pragma unroll
          for (int mt = 0; mt < 2; ++mt)
#pragma unroll
            for (int j = 0; j < 16; ++j) o[mt][nt][j] *= alpha;
        }
      }
#pragma unroll
      for (int nt = 0; nt < 2; ++nt) {
        float sum = 0.f;
#pragma unroll
        for (int j = 0; j < 16; ++j) { float pv = __builtin_amdgcn_exp2f(sc[nt][j]); sc[nt][j] = pv; sum += pv; }
        lrun[nt] += sum;
      }
#pragma unroll
      for (int s2 = 0; s2 < 2; ++s2) {
        bf16x8 pf[2];
#pragma unroll
        for (int nt = 0; nt < 2; ++nt) {
          u32x4 pk;
#pragma unroll
          for (int i = 0; i < 4; ++i) pk[i] = pk2(sc[nt][s2 * 8 + 2 * i], sc[nt][s2 * 8 + 2 * i + 1]);
          pf[nt] = __builtin_bit_cast(bf16x8, pk);
        }
#pragma unroll
        for (int mt = 0; mt < 2; ++mt)
#pragma unroll
          for (int nt = 0; nt < 2; ++nt) o[mt][nt] = MFMA32(vf[s2][mt], pf[nt], o[mt][nt]);
      }
    };
    f32x16 sa[2], sb[2];
    qk(0, sa);
    qk(1, sb); sm_pv(0, sa, sb, true);
    qk(2, sa); sm_pv(1, sb, sa, true);
    qk(3, sb); sm_pv(2, sa, sb, true);
    sm_pv(3, sb, sa, false);
    bcur = bcur + 1; if (bcur >= 3) bcur = 0;
  }
#pragma unroll
  for (int nt = 0; nt < 2; ++nt) {
    float l = lrun[nt] + __shfl_xor(lrun[nt], 32);
    float inv = 1.0f / l;
    const int tok = q0 + nt * 32 + r;
#pragma unroll
    for (int mt = 0; mt < 2; ++mt)
#pragma unroll
      for (int jg = 0; jg < 4; ++jg) {
        u32x2 ov;
        ov[0] = pk2(o[mt][nt][jg * 4 + 0] * inv, o[mt][nt][jg * 4 + 1] * inv);
        ov[1] = pk2(o[mt][nt][jg * 4 + 2] * inv, o[mt][nt][jg * 4 + 3] * inv);
        *(u32x2*)(O + (size_t)tok * 1024 + head * 64 + mt * 32 + jg * 8 + h * 4) = ov;
      }
  }
  WAIT_L(0);
  BAR;
}


enum { EK_Q = 0, EK_K, EK_V, EK_U, EK_S, EK_Y, EK_M0, EK_M1, EK_M2, EK_M3, EK_M4, EK_OUT, EK_FF1, EK_FF2 };
struct Job {
  const u16* A; const u16* Bt;
  int lda, ldb, gsB, tmB, K, kind, tm, tn, layer;
};

DI void stage_acc(AccT& acc, unsigned char* smem, const int tid, const int linear = 0) {
  const int wid = tid >> 6, lane = tid & 63, wr = wid >> 2, wc = wid & 3, fr = lane & 15, fq = lane >> 4;
#if PROBE_MASK
  if (linear) {
    int k = 0;
#pragma unroll
    for (int ai = 0; ai < 2; ++ai)
#pragma unroll
      for (int bj = 0; bj < 2; ++bj)
#pragma unroll
        for (int m = 0; m < 4; ++m)
#pragma unroll
          for (int n = 0; n < 2; ++n) {
            u32x2 w;
            w[0] = pk2(acc[ai][bj][m][n][0], acc[ai][bj][m][n][1]);
            w[1] = pk2(acc[ai][bj][m][n][2], acc[ai][bj][m][n][3]);
            *(u32x2*)(smem + tid * 8 + k * 4096) = w;
            ++k;
          }
    return;
  }
#endif
#pragma unroll
  for (int ai = 0; ai < 2; ++ai)
#pragma unroll
    for (int bj = 0; bj < 2; ++bj)
#pragma unroll
      for (int m = 0; m < 4; ++m)
#pragma unroll
        for (int n = 0; n < 2; ++n) {
          const int col = bj * 128 + wc * 32 + n * 16 + fr;
          const int row0 = ai * 128 + wr * 64 + m * 16 + fq * 4;
          u32x2 w;
          w[0] = pk2(acc[ai][bj][m][n][0], acc[ai][bj][m][n][1]);
          w[1] = pk2(acc[ai][bj][m][n][2], acc[ai][bj][m][n][3]);
          *(u32x2*)(smem + col * 512 + (((row0 >> 3) ^ (col & 31)) << 4) + ((row0 & 4) << 1)) = w;
        }
}
DI void unpack8(const u32x4 u, float* f) {
#pragma unroll
  for (int i = 0; i < 4; ++i) { f[2 * i] = __uint_as_float(u[i] << 16); f[2 * i + 1] = __uint_as_float(u[i] & 0xffff0000u); }
}
DI u32x4 pack8(const float* f) {
  u32x4 o;
#pragma unroll
  for (int i = 0; i < 4; ++i) o[i] = pk2(f[2 * i], f[2 * i + 1]);
  return o;
}

DI float tok_rstd(const unsigned char* ws, int tok) {
  const float* q = (const float*)(ws + WS_SSQ) + tok;
  return rsqrtf((q[0] + q[NT] + q[2 * NT] + q[3 * (size_t)NT]) * (1.0f / 1024.0f) + 1e-6f);
}
DI void run_epilogue(const P& pin, const Job& jb, AccT& acc) {
  extern __shared__ __attribute__((aligned(16))) unsigned char smem[];
  const int TID = opaque_tid();
  P p = pin;
  asm volatile("" : "+s"(p.ws), "+s"(p.out));
  const int tm = jb.tm, tn = jb.tn, layer = jb.layer & 255, kind = jb.kind;
  const int nit = (jb.layer & 256) ? 8 : (jb.layer & 512) ? 1 : (jb.layer & 1024) ? 0 : 16;
#if PROBE_MASK
  if (kind == -1) return;
  if (kind == -3) {
    u32x4 z; z[0] = acc[0][0][0][0][0] > 1e30f ? 1u : 0u; z[1] = 2; z[2] = 3; z[3] = 4;
    for (int it = 0; it < 16; ++it) {
      const int q = it * 512 + TID;
      *(u32x4*)((u16*)(p.ws + WS_FF) + (size_t)(tn * 256 + (q >> 5)) * 4096 + tm * 256 + (q & 31) * 8) = z;
    }
    return;
  }
#endif
  if (kind == EK_S) {
    float* Sg = (float*)(p.ws + WS_S) + (size_t)tn * 256 * 256;
    epi_for(acc, [&](const int row0, const int col, const f32x4 v) { *(f32x4*)(Sg + (size_t)col * 256 + row0) = v; });
    return;
  }
#if PROBE_MASK
  if (jb.layer & 16384) { if (acc[1][1][3][1][3] == 12345.678f) smem[TID] = 1; }
  if (!(jb.layer & 2048))
  for (int rep = (jb.layer & 8192) ? 4 : 1; rep > 0; --rep)
#endif
  stage_acc(acc, smem, TID, (jb.layer & 4096) ? 1 : 0);
  float* lrs = (float*)(smem + 131072);
  if ((kind <= EK_U || kind == EK_M2 || kind == EK_M3 || kind == EK_FF1) && TID < 256) lrs[TID] = tok_rstd(p.ws, tn * 256 + TID);
  __syncthreads();
#pragma unroll 2
  for (int it = 0; it < nit; ++it) {
    const int q = it * 512 + TID;
    int col = q >> 5, c = q & 31;
    if (kind == EK_U) { col = (q >> 1) & 255; c = ((q >> 9) << 1) | (q & 1); }
    const u32x4 sv = *(const u32x4*)(smem + col * 512 + ((c ^ (col & 31)) << 4));
    float f[8], r[8];
    unpack8(sv, f);
#if PROBE_MASK
    if (kind == -2) { if (f[0] > 1e30f) *(u32x4*)(p.ws + WS_FF) = sv; continue; }
#endif
    switch (kind) {
      case EK_Q: case EK_K: {
        const int tok = tn * 256 + col, hl = c >> 3, d0 = (c & 7) * 8;
        const float tr = lrs[col];
        float ss = 0.f;
#pragma unroll
        for (int i = 0; i < 8; ++i) { f[i] *= tr; ss += f[i] * f[i]; }
        ss += __shfl_xor(ss, 1); ss += __shfl_xor(ss, 2); ss += __shfl_xor(ss, 4);
        float rstd = rsqrtf(ss * (1.0f / 64.0f) + 1e-6f);
        if (kind == EK_Q) rstd *= 0.125f * 1.4426950408889634f;
        const float* gn = (kind == EK_Q ? p.in[4] : p.in[5]) + layer * 64 + d0;
        const f32x4 g0 = *(const f32x4*)gn, g1 = *(const f32x4*)(gn + 4);
        const int pos = tok < NTP ? (tok & 4095) : ((tok - NTP) & 8191);
        const int i0 = (c & 7) * 4;
        const float* rp = (const float*)(p.ws + WS_ROPE) + 2 * ((i0 < 16) ? (pos >> 6) * 16 + i0 : (pos & 63) * 16 + i0 - 16);
        const f32x4 cs0 = *(const f32x4*)rp, cs1 = *(const f32x4*)(rp + 4);
        const float x0 = f[0] * rstd * g0[0], x1 = f[1] * rstd * g0[1], x2 = f[2] * rstd * g0[2], x3 = f[3] * rstd * g0[3];
        const float x4 = f[4] * rstd * g1[0], x5 = f[5] * rstd * g1[1], x6 = f[6] * rstd * g1[2], x7 = f[7] * rstd * g1[3];
        r[0] = x0 * cs0[0] - x1 * cs0[1]; r[1] = x0 * cs0[1] + x1 * cs0[0];
        r[2] = x2 * cs0[2] - x3 * cs0[3]; r[3] = x2 * cs0[3] + x3 * cs0[2];
        r[4] = x4 * cs1[0] - x5 * cs1[1]; r[5] = x4 * cs1[1] + x5 * cs1[0];
        r[6] = x6 * cs1[2] - x7 * cs1[3]; r[7] = x6 * cs1[3] + x7 * cs1[2];
        u16* dst = (kind == EK_Q) ? (u16*)(p.ws + WS_Q) + (size_t)tok * 1024 + (tm * 4 + hl) * 64 + d0
                                  : (u16*)(p.ws + WS_K) + ((size_t)hl * NT + tok) * 64 + d0;
        *(u32x4*)dst = pack8(r);
      } break;
      case EK_V: {
        {
          const int tok0 = tn * 256 + c * 8;
#pragma unroll
          for (int i = 0; i < 8; ++i) r[i] = f[i] * lrs[c * 8 + i];
          *(u32x4*)((u16*)(p.ws + WS_VT) + (size_t)col * NT + tok0) = pack8(r);
        }
      } break;
      case EK_U: {
        const int tok = tn * 256 + col, g = (tm - 6) * 16 + (c >> 1);
        const float tr = lrs[col];
#pragma unroll
        for (int i = 0; i < 8; ++i) r[i] = f[i] * tr;
        *(u32x4*)((u16*)(p.ws + WS_ASSM) + ((size_t)g * NCH + (tok >> 5)) * ASTR + (tok & 31) * 16 + (c & 1) * 8) = pack8(r);
      } break;
      case EK_Y: {
        const int g = tn / 10, ch = (tn % 10) * 256 + col, r0 = tm * 256 + c * 8;
        const u32x4 uu = *(const u32x4*)((const u16*)(p.ws + WS_ASSM) + ((size_t)g * NCH + ch) * ASTR + r0);
        float u[8];
        unpack8(uu, u);
        const float* dsk = p.in[14] + layer * 512 + g * 16 + (c & 1) * 8;
        const f32x4 d0 = *(const f32x4*)dsk, d1 = *(const f32x4*)(dsk + 4);
#pragma unroll
        for (int i = 0; i < 4; ++i) { r[i] = gelu_tanh(f[i] + d0[i] * u[i]); r[4 + i] = gelu_tanh(f[4 + i] + d1[i] * u[4 + i]); }
        *(u32x4*)((u16*)(p.ws + WS_Y) + (size_t)g * NT * 16 + (size_t)ch * 512 + r0) = pack8(r);
      } break;
      case EK_M0: case EK_M1: case EK_M2: case EK_M3: case EK_M4: {
        const size_t o = (size_t)(tn * 256 + col) * 1024 + tm * 256 + c * 8;
        u16* t1 = (u16*)(p.ws + WS_Q) + o;
        u16* t2 = (u16*)(p.ws + WS_ASSM) + o;
        if (kind == EK_M2 || kind == EK_M3) {
          const float tr = lrs[col];
#pragma unroll
          for (int i = 0; i < 8; ++i) f[i] *= tr;
        }
        if (kind == EK_M0 || kind == EK_M3) {
#pragma unroll
          for (int i = 0; i < 8; ++i) r[i] = sigmoidf_(f[i]);
        } else {
          float a[8];
          unpack8(*(const u32x4*)t1, a);
          if (kind == EK_M1) {
#pragma unroll
            for (int i = 0; i < 8; ++i) r[i] = f[i] * a[i];
          } else if (kind == EK_M2) {
#pragma unroll
            for (int i = 0; i < 8; ++i) r[i] = sigmoidf_(f[i]) * a[i];
          } else {
            float b[8];
            unpack8(*(const u32x4*)t2, b);
#pragma unroll
            for (int i = 0; i < 8; ++i) r[i] = b[i] * f[i] + a[i];
          }
        }
        *(u32x4*)(kind == EK_M3 ? t2 : t1) = pack8(r);
      } break;
      case EK_OUT: case EK_FF2: {
        const int tok = tn * 256 + col, cc = tm * 256 + c * 8;
        const float* x = (kind == EK_OUT) ? xrow(p, layer, tok) + cc : p.out + (size_t)tok * 1024 + cc;
        float* o = p.out + (size_t)tok * 1024 + cc;
        const f32x4 x0 = *(const f32x4*)x, x1 = *(const f32x4*)(x + 4);
        f32x4 o0, o1;
        float ss = 0.f;
#pragma unroll
        for (int i = 0; i < 4; ++i) { o0[i] = x0[i] + f[i]; o1[i] = x1[i] + f[4 + i]; r[i] = o0[i]; r[4 + i] = o1[i]; ss += o0[i] * o0[i] + o1[i] * o1[i]; }
        *(f32x4*)o = o0; *(f32x4*)(o + 4) = o1;
        *(u32x4*)((u16*)(p.ws + WS_XN) + (size_t)tok * 1024 + cc) = pack8(r);
        ss += __shfl_xor(ss, 1); ss += __shfl_xor(ss, 2); ss += __shfl_xor(ss, 4); ss += __shfl_xor(ss, 8); ss += __shfl_xor(ss, 16);
        if (c == 0) ((float*)(p.ws + WS_SSQ))[(size_t)tm * NT + tok] = ss;
      } break;
      case EK_FF1: {
        const float tr = lrs[col];
#pragma unroll
        for (int i = 0; i < 8; ++i) { const float a = fmaxf(f[i] * tr, 0.f); r[i] = a * a; }
        *(u32x4*)((u16*)(p.ws + WS_FF) + ((size_t)(tn * 16 + tm) << 16) + col * 256 + c * 8) = pack8(r);
      } break;
    }
  }
  __syncthreads();
}

DI void make_job(const P& pin, int layer, int s, int w, int step, Job& jb) {
  struct { unsigned char* ws; } p;
  p.ws = pin.ws;
  asm volatile("" : "+s"(p.ws));
  const u16* XN = (const u16*)(p.ws + WS_XN);
  jb.layer = layer; jb.gsB = 16; jb.tmB = 0;
  if (s == 1) {
    int g = w / 10;
    jb.A = (const u16*)(p.ws + WS_W1T) + ((size_t)layer * 32 + g) * 256 * 512;
    jb.Bt = (const u16*)(p.ws + WS_ASSM) + (size_t)w * 256 * ASTR;
    jb.lda = 512; jb.ldb = ASTR; jb.K = 512; jb.kind = EK_S; jb.tm = 0; jb.tn = w;
    return;
  }
  if (s == 3) {
    int gc = w >> 1, rt = w & 1, g = gc / 10;
    jb.A = (const u16*)(p.ws + WS_WYT) + (((size_t)layer * 32 + g) * 512 + rt * 256) * ASTR;
    jb.Bt = (const u16*)(p.ws + WS_ASSM) + (size_t)gc * 256 * ASTR;
    jb.lda = ASTR; jb.ldb = ASTR; jb.K = ASTR; jb.kind = EK_Y; jb.tm = rt; jb.tn = gc;
    return;
  }
  const int nft = (s == 0) ? 8 : (s == 6) ? 16 : 4;
  int tt, ft; tile_map(w, nft, tt, ft);
  jb.tm = ft; jb.tn = tt;
  jb.lda = 1024; jb.ldb = 1024; jb.K = 1024;
  if (s == 0) {
    const u16* W = (const u16*)(p.ws + WS_WT_IN) + (size_t)layer * 4096 * 1024 + (size_t)ft * 256 * 1024;
    const u16* X = XN + (size_t)tt * 256 * 1024;
    if (ft == 5) { jb.A = X; jb.Bt = W; jb.kind = EK_V; }
    else { jb.A = W; jb.Bt = X; jb.kind = ft < 4 ? EK_Q : ft == 4 ? EK_K : EK_U; }
  } else if (s == 4) {
    jb.kind = EK_M0 + step;
    if (step < 2) {
      jb.A = (const u16*)(p.ws + (step == 0 ? WS_WT_GB : WS_WT_GA)) + (size_t)layer * 1024 * 512 + (size_t)ft * 256 * 512;
      jb.Bt = (const u16*)(p.ws + WS_Y) + (size_t)tt * 256 * 16;
      jb.lda = 512; jb.ldb = 16; jb.gsB = NT * 16; jb.K = 512;
    } else if (step < 4) {
      jb.A = (const u16*)(p.ws + WS_WT_IN) + (size_t)layer * 4096 * 1024 + (size_t)((step == 2 ? 3072 : 2048) + ft * 256) * 1024;
      jb.Bt = XN + (size_t)tt * 256 * 1024;
    } else {
      jb.A = (const u16*)(p.ws + WS_WT_AP) + (size_t)layer * 1024 * 1024 + (size_t)ft * 256 * 1024;
      jb.Bt = (const u16*)(p.ws + WS_ATTO) + (size_t)tt * 256 * 1024;
    }
  } else if (s == 5) {
    jb.A = (const u16*)(p.ws + WS_WT_OUT) + (size_t)layer * 1024 * 1024 + (size_t)ft * 256 * 1024;
    jb.Bt = (const u16*)(p.ws + WS_Q) + (size_t)tt * 256 * 1024; jb.kind = EK_OUT;
  } else if (s == 6) {
    jb.A = (const u16*)(p.ws + WS_WT_FF1) + (size_t)layer * 4096 * 1024 + (size_t)ft * 256 * 1024;
    jb.Bt = XN + (size_t)tt * 256 * 1024; jb.kind = EK_FF1;
  } else {
    jb.A = (const u16*)(p.ws + WS_WT_FF2) + (size_t)layer * 1024 * 4096 + (size_t)ft * 256 * 4096;
    jb.Bt = (const u16*)(p.ws + WS_FF) + ((size_t)tt * 16 << 16);
    jb.lda = 4096; jb.ldb = 256; jb.tmB = 1; jb.K = 4096; jb.kind = EK_FF2;
  }
}

DI void phase_jobs(const P& p, int layer, int s, int probe = 0) {
  int nitems, nsteps = 1, nattn = 0;
  switch (s) {
    case 0: nitems = 2560; break;
    case 1: nitems = 320; break;
    case 3: nitems = 3200; nattn = 2560; break;
    case 4: nitems = 1280; nsteps = 5; break;
    case 5: nitems = 1280; break;
    case 6: nitems = 5120; break;
    default: nitems = 1280; break;
  }
#if STAGGER_SLEEP
  if (s != 3) {
    const int slot = (blockIdx.x >> 3) & 31;
    for (int i = 0; i < slot; ++i) __builtin_amdgcn_s_sleep(STAGGER_SLEEP);
  }
#endif
  for (int w = blockIdx.x; w < nitems; w += gridDim.x) {
    if (w < nattn) {
      int seq_start, L, head, qb;
      if (w < 512) {
        int xcd = w & 7, r = w >> 3;
        int seq = xcd >> 2, kvh = xcd & 3;
        seq_start = NTP + seq * 8192; L = 8192; head = kvh * 4 + (r >> 4); qb = r & 15;
      } else {
        int w2 = w - 512, xcd = w2 & 7, r = w2 >> 3;
        int grp = (r >> 5) * 8 + xcd, within = r & 31;
        int seq = grp >> 2, kvh = grp & 3;
        seq_start = seq * 4096; L = 4096; head = kvh * 4 + (within >> 3); qb = within & 7;
      }
      attn_item(p, seq_start, L, head, qb);
    } else {
      for (int step = 0; step < nsteps; ++step) {
        Job jb;
        make_job(p, layer, s, w - nattn, step, jb);
#if PROBE_MASK
        if (probe == 2 || probe == 3) jb.kind = -1;
        if (probe == 3) jb.K = jb.K / 2;
#endif
        gemm_tile(jb.A, jb.Bt, jb.lda, jb.ldb, jb.gsB, jb.tmB, jb.K, [&](AccT& acc) {
          int w2 = w - nattn, st2 = step;
          asm volatile("" : "+s"(w2), "+s"(st2));
          Job j2;
          make_job(p, layer, s, w2, st2, j2);
#if PROBE_MASK
          if (probe == 2 || probe == 3) j2.kind = -1;
          if (probe == 4) j2.kind = -2;
          if (probe == 6) j2.layer |= 256;
          if (probe == 7) j2.layer |= 512;
          if (probe == 8) j2.layer |= 1024 | 2048;
          if (probe == 9) j2.layer |= 1024;
          if (probe == 10) j2.layer |= 1024 | 4096;
          if (probe == 11) j2.layer |= 1024 | 8192;
          if (probe == 12) j2.layer |= 1024 | 2048 | 16384;
          if (probe == 5) j2.kind = -3;
#endif
          run_epilogue(p, j2, acc);
        });
      }
    }
  }
}

DI void run_phase(const P& pin, int ph, int probe = 0) {
  P p = pin;
  asm volatile("" : "+s"(p.ws), "+s"(p.out));
  int layer = (ph - 3) / 8, s = (ph - 3) % 8;
  if (s == 2) phase_scan(p, layer);
  else phase_jobs(p, layer, s, probe);
}

__global__ void __launch_bounds__(512, 2) mega_coop(P p) {
  cg::grid_group grid = cg::this_grid();
  phase_prep_a(p);
  grid.sync();
  phase_prep_b(p);
  grid.sync();
  phase_prep_c(p);
  phase_convert(p, p.in[0], p.in[1]);
  grid.sync();
  for (int ph = 3; ph < NPHASE; ++ph) {
    run_phase(p, ph);
#if PROBE_MASK
    {
      const int s_ = (ph - 3) % 8;
      bool rep = false;
      if ((PROBE_MASK & 1) && s_ == 3) rep = true;
      if ((PROBE_MASK & 2) && (s_ == 0 || s_ == 4 || s_ == 6)) rep = true;
      if ((PROBE_MASK & 4) && (s_ == 1 || s_ == 2)) rep = true;
      if ((PROBE_MASK & 8) && s_ == 6) run_phase(p, ph, (PROBE_MASK >> 4));
      if (rep) run_phase(p, ph);
    }
#endif
    if (ph + 1 < NPHASE) grid.sync();
  }
}
#if N_LAUNCH_MODE == 0
__global__ void __launch_bounds__(512, 2) mega_one(P p) {
  run_phase(p, p.ph_lo);
}
#endif

extern "C" void kernel_launch(void* const* d_in, const int* in_sizes, int n_in, void* d_out, int out_size, void* d_ws, size_t ws_size,
                              hipStream_t stream) {
  static int grid = 0;
  if (grid == 0) {
    if (n_in != 21 || ws_size < WS_END) { fprintf(stderr, "kernel_launch: unexpected n_in %d / ws_size %zu (need %zu)\n", n_in, ws_size, (size_t)WS_END); grid = -1; return; }
    int dev = 0, cus = 0, per_cu = 0;
    hipGetDevice(&dev);
    hipDeviceGetAttribute(&cus, hipDeviceAttributeMultiprocessorCount, dev);
    hipFuncSetAttribute((const void*)mega_coop, hipFuncAttributeMaxDynamicSharedMemorySize, LDS_BYTES);
#if N_LAUNCH_MODE == 0
    hipFuncSetAttribute((const void*)mega_one, hipFuncAttributeMaxDynamicSharedMemorySize, LDS_BYTES);
#endif
    hipOccupancyMaxActiveBlocksPerMultiprocessor(&per_cu, (const void*)mega_coop, 512, LDS_BYTES);
    if (per_cu < 1) { fprintf(stderr, "kernel_launch: occupancy query says %d blocks/CU\n", per_cu); per_cu = 1; }
    (void)hipGetLastError();
    grid = cus * 1;
  }
  if (grid < 0) return;
  P p{};
  for (int i = 0; i < 21; ++i) p.in[i] = (const float*)d_in[i];
  p.out = (float*)d_out;
  p.ws = (unsigned char*)d_ws;
#if N_LAUNCH_MODE == 1
  p.ph_lo = 0; p.ph_hi = NPHASE;
  void* args[] = {&p};
  hipError_t e = hipLaunchCooperativeKernel((const void*)mega_coop, dim3(grid), dim3(512), args, LDS_BYTES, stream);
  if (e != hipSuccess) fprintf(stderr, "cooperative launch failed: %s (grid %d)\n", hipGetErrorString(e), grid);
#else
  for (int ph = 0; ph < NPHASE; ++ph) {
    p.ph_lo = ph; p.ph_hi = ph + 1;
    hipLaunchKernelGGL(mega_one, dim3(grid), dim3(512), LDS_BYTES, stream, p);
  }
#endif
}
```

```cpp
#include <hip/hip_runtime.h>
#include <hip/hip_cooperative_groups.h>
#include <cstdio>
namespace cg = cooperative_groups;

typedef unsigned short u16;
typedef __attribute__((ext_vector_type(8))) short bf16x8;
typedef __attribute__((ext_vector_type(4))) float f32x4;
typedef __attribute__((ext_vector_type(16))) float f32x16;
typedef __attribute__((ext_vector_type(4))) unsigned u32x4;
typedef __attribute__((ext_vector_type(2))) unsigned u32x2;
typedef __attribute__((ext_vector_type(2))) float f32x2;
typedef __attribute__((ext_vector_type(2))) __bf16 bf16v2;

#define DI __device__ __forceinline__
#ifndef PROBE_MASK
#define PROBE_MASK 0
#endif
#ifndef STAGGER_SLEEP
#define STAGGER_SLEEP 0
#endif
#ifndef N_LAUNCH_MODE
#define N_LAUNCH_MODE 1
#endif

constexpr int NT = 81920;
constexpr int NTP = 65536;
constexpr int NCH = 2560;
constexpr int ASTR = 768;
constexpr int NPHASE = 19;
constexpr int LDS_BYTES = 131072 + 1024;

constexpr size_t MiB = 1ull << 20;
constexpr size_t WS_WT_IN = 0;
constexpr size_t WS_WT_AP = 16 * MiB;
constexpr size_t WS_WT_GA = 20 * MiB;
constexpr size_t WS_WT_GB = 22 * MiB;
constexpr size_t WS_WT_OUT = 24 * MiB;
constexpr size_t WS_WT_FF1 = 28 * MiB;
constexpr size_t WS_WT_FF2 = 44 * MiB;
constexpr size_t WS_W1T = 60 * MiB;
constexpr size_t WS_WYT = 76 * MiB;
constexpr size_t WS_LPOW = 124 * MiB;
constexpr size_t WS_BBAR = 127 * MiB;
constexpr size_t WS_KTAB = 128 * MiB;
constexpr size_t WS_ROPE = 132 * MiB;
constexpr size_t WS_SSQ = 133 * MiB;
constexpr size_t WS_XN = 135 * MiB;
constexpr size_t WS_BIG = 295 * MiB;
constexpr size_t WS_Q = WS_BIG;
constexpr size_t WS_K = WS_BIG + 160 * MiB;
constexpr size_t WS_VT = WS_BIG + 200 * MiB;
constexpr size_t WS_ASSM = WS_BIG + 240 * MiB;
constexpr size_t WS_S = WS_BIG + 360 * MiB;
constexpr size_t WS_Y = WS_BIG + 440 * MiB;
constexpr size_t WS_ATTO = WS_BIG + 520 * MiB;
constexpr size_t WS_FF = WS_BIG;
constexpr size_t WS_END = WS_BIG + 680 * MiB;

struct P {
  const float* in[21];
  float* out;
  unsigned char* ws;
  int ph_lo, ph_hi;
};

DI u16 f2bf(float f) { unsigned u = __float_as_uint(f); u += 0x7fffu + ((u >> 16) & 1u); return (u16)(u >> 16); }
DI float bf2f(u16 h) { return __uint_as_float(((unsigned)h) << 16); }
DI unsigned pk2(float a, float b) {
  f32x2 v; v[0] = a; v[1] = b;
  bf16v2 r = __builtin_convertvector(v, bf16v2);
  return __builtin_bit_cast(unsigned, r);
}
DI float sigmoidf_(float x) { return 1.0f / (1.0f + __expf(-x)); }
DI float gelu_tanh(float x) {
  float z = 0.7978845608028654f * (x + 0.044715f * x * x * x);
  float e = __expf(2.0f * z);
  return 0.5f * x * (2.0f - 2.0f / (e + 1.0f));
}


DI void sincos_d(double x, double* sn, double* cs) {
  const double TWO_PI_HI = 6.283185307179586232e+00, TWO_PI_LO = 2.449293598294706414e-16;
  double k = rint(x * 0.15915494309189534561);
  double r = (x - k * TWO_PI_HI) - k * TWO_PI_LO;
  r *= 0.25;
  double r2 = r * r;
  double s = 1.0, c = 1.0;
  s = 1.0 - r2 / (18.0 * 19.0);
  s = 1.0 - r2 / (16.0 * 17.0) * s;
  s = 1.0 - r2 / (14.0 * 15.0) * s;
  s = 1.0 - r2 / (12.0 * 13.0) * s;
  s = 1.0 - r2 / (10.0 * 11.0) * s;
  s = 1.0 - r2 / (8.0 * 9.0) * s;
  s = 1.0 - r2 / (6.0 * 7.0) * s;
  s = 1.0 - r2 / (4.0 * 5.0) * s;
  s = 1.0 - r2 / (2.0 * 3.0) * s;
  s *= r;
  c = 1.0 - r2 / (17.0 * 18.0);
  c = 1.0 - r2 / (15.0 * 16.0) * c;
  c = 1.0 - r2 / (13.0 * 14.0) * c;
  c = 1.0 - r2 / (11.0 * 12.0) * c;
  c = 1.0 - r2 / (9.0 * 10.0) * c;
  c = 1.0 - r2 / (7.0 * 8.0) * c;
  c = 1.0 - r2 / (5.0 * 6.0) * c;
  c = 1.0 - r2 / (3.0 * 4.0) * c;
  c = 1.0 - r2 / (1.0 * 2.0) * c;
  double s2 = 2.0 * s * c, c2 = c * c - s * s;
  *sn = 2.0 * s2 * c2; *cs = c2 * c2 - s2 * s2;
}

template <class T> DI T gld(const void* q) { return *(const __attribute__((address_space(1))) T*)q; }
template <class T> DI void gst(void* q, const T v) { *(__attribute__((address_space(1))) T*)q = v; }
DI int opaque_tid() { int t = threadIdx.x; asm volatile("" : "+v"(t)); return t; }
DI const char* sgpr_ptr(const char* p) { asm("" : "+s"(p)); return p; }
#define WAIT_V(n) asm volatile("s_waitcnt vmcnt(" #n ")" ::: "memory")
#define WAIT_L(n) asm volatile("s_waitcnt lgkmcnt(" #n ")" ::: "memory")
#define BAR __builtin_amdgcn_s_barrier()
#define SCHED __builtin_amdgcn_sched_barrier(0)
#define GLDS(gp, lp) __builtin_amdgcn_global_load_lds((const unsigned*)(gp), (unsigned*)(lp), 16, 0, 0)

constexpr int GBK = 64, GHALF = 128, GHT = GHALF * GBK;
DI int lds_byte(int r, int c) {
  int st = (r >> 4) * 2 + (c >> 5), rr = r & 15, cc = c & 31, ob = rr * 64 + cc * 2;
  return st * 1024 + (ob ^ (((ob >> 9) & 1) << 5));
}
DI void stage_rc(int b, int& R, int& C) {
  int st = b / 1024, sb = b % 1024, swz = sb ^ (((sb >> 9) & 1) << 5);
  R = (st >> 1) * 16 + swz / 64; C = (st & 1) * 32 + (swz % 64) / 2;
}

typedef f32x4 AccT[2][2][4][2];

template <class Epi>
DI void gemm_tile(const u16* __restrict__ A, const u16* __restrict__ Bt, const int lda, const int ldb, const int gsB, const int tmB, const int K, Epi&& epi) {
  const int TID = opaque_tid();
  extern __shared__ __attribute__((aligned(16))) unsigned char smem[];
  u16* shm = (u16*)smem;
#define SA(b, h) (shm + ((b) * 2 + (h)) * GHT)
#define SB(b, h) (shm + (4 + (b) * 2 + (h)) * GHT)
  int R0, C0, R1, C1;
  stage_rc(TID * 16, R0, C0);
  stage_rc(TID * 16 + 8192, R1, C1);
  const unsigned voA0 = (unsigned)(R0 * lda + C0) * 2u, voA1 = (unsigned)(R1 * lda + C1) * 2u;
  const unsigned voB0 = (unsigned)(R0 * ldb + (C0 & 15) + (C0 >> 4) * gsB) * 2u, voB1 = (unsigned)(R1 * ldb + (C1 & 15) + (C1 >> 4) * gsB) * 2u;
  const int hA = GHALF * lda, hB = GHALF * ldb;
  const unsigned wid_u = __builtin_amdgcn_readfirstlane(TID >> 6);
#define STAGE_A(PTR, half, kt) do { const char* _g = sgpr_ptr((const char*)(A + (size_t)(half) * hA + (size_t)(kt) * GBK)); \
    char* _l = (char*)(PTR) + wid_u * 1024u; \
    GLDS(_g + voA0, _l); GLDS(_g + voA1, _l + 8192); } while (0)
#define STAGE_B(PTR, half, kt) do { const char* _g = sgpr_ptr((const char*)(Bt + (size_t)(half) * hB + (tmB ? (size_t)((((kt) >> 2) << 16) + (((kt) & 3) << 6)) : (size_t)(kt) * (size_t)(4 * gsB)))); \
    char* _l = (char*)(PTR) + wid_u * 1024u; \
    GLDS(_g + voB0, _l); GLDS(_g + voB1, _l + 8192); } while (0)
#define LDA(dst, b, h) for (int m = 0; m < 4; ++m) for (int k = 0; k < 2; ++k) \
    dst[m][k] = *reinterpret_cast<const bf16x8*>((char*)SA(b, h) + lds_byte(wr * 64 + m * 16 + fr, k * 32 + fq * 8))
#define LDB(dst, b, h) for (int n = 0; n < 2; ++n) for (int k = 0; k < 2; ++k) \
    dst[n][k] = *reinterpret_cast<const bf16x8*>((char*)SB(b, h) + lds_byte(wc * 32 + n * 16 + fr, k * 32 + fq * 8))
#define MMA(ai, bj, At, Bq) do { __builtin_amdgcn_s_setprio(1); \
    for (int m = 0; m < 4; ++m) for (int n = 0; n < 2; ++n) for (int k = 0; k < 2; ++k) \
      acc[ai][bj][m][n] = __builtin_amdgcn_mfma_f32_16x16x32_bf16(At[m][k], Bq[n][k], acc[ai][bj][m][n], 0, 0, 0); \
    __builtin_amdgcn_s_setprio(0); } while (0)

  const int wid = TID >> 6, lane = TID & 63, wr = wid >> 2, wc = wid & 3, fr = lane & 15, fq = lane >> 4;
  AccT acc;
#pragma unroll
  for (int a = 0; a < 2; ++a)
#pragma unroll
    for (int b = 0; b < 2; ++b)
#pragma unroll
      for (int m = 0; m < 4; ++m)
#pragma unroll
        for (int n = 0; n < 2; ++n) acc[a][b][m][n] = f32x4{0.f, 0.f, 0.f, 0.f};
  bf16x8 At[4][2], B0[2][2], B1[2][2];
  const int nt = K / GBK;
  STAGE_B(SB(0, 0), 0, 0); STAGE_A(SA(0, 0), 0, 0);
  STAGE_B(SB(0, 1), 1, 0); STAGE_A(SA(0, 1), 1, 0);
  if (wr == 1) BAR;
  WAIT_V(4); BAR;
  STAGE_B(SB(1, 0), 0, 1); STAGE_A(SA(1, 0), 0, 1); STAGE_B(SB(1, 1), 1, 1);
  WAIT_V(6); BAR;
  for (int t = 0; t < nt - 2; t += 2) {
    LDB(B0, 0, 0); SCHED; LDA(At, 0, 0); STAGE_A(SA(1, 1), 1, t + 1);
    WAIT_L(8); BAR; WAIT_L(0); MMA(0, 0, At, B0); BAR; SCHED;
    LDB(B1, 0, 1); STAGE_B(SB(0, 0), 0, t + 2);
    BAR; WAIT_L(0); MMA(0, 1, At, B1); BAR;
    LDA(At, 0, 1); STAGE_A(SA(0, 0), 0, t + 2);
    BAR; WAIT_L(0); MMA(1, 0, At, B0); BAR; SCHED;
    STAGE_B(SB(0, 1), 1, t + 2);
    WAIT_V(6); BAR; MMA(1, 1, At, B1); BAR;
    LDB(B0, 1, 0); SCHED; LDA(At, 1, 0); STAGE_A(SA(0, 1), 1, t + 2);
    WAIT_L(8); BAR; WAIT_L(0); MMA(0, 0, At, B0); BAR; SCHED;
    LDB(B1, 1, 1); STAGE_B(SB(1, 0), 0, t + 3);
    BAR; WAIT_L(0); MMA(0, 1, At, B1); BAR;
    LDA(At, 1, 1); STAGE_A(SA(1, 0), 0, t + 3);
    BAR; WAIT_L(0); MMA(1, 0, At, B0); BAR; SCHED;
    STAGE_B(SB(1, 1), 1, t + 3);
    WAIT_V(6); BAR; MMA(1, 1, At, B1); BAR;
  }
  { LDB(B0, 0, 0); LDA(At, 0, 0); STAGE_A(SA(1, 1), 1, nt - 1);
    BAR; WAIT_L(0); MMA(0, 0, At, B0); BAR;
    LDB(B1, 0, 1); BAR; WAIT_L(0); MMA(0, 1, At, B1); BAR;
    LDA(At, 0, 1); WAIT_V(4); BAR; WAIT_L(0); MMA(1, 0, At, B0); MMA(1, 1, At, B1); BAR; }
  { LDB(B0, 1, 0); LDA(At, 1, 0); WAIT_V(2); BAR; WAIT_L(0); MMA(0, 0, At, B0); BAR;
    LDB(B1, 1, 1); WAIT_V(0); BAR; WAIT_L(0); MMA(0, 1, At, B1); BAR;
    LDA(At, 1, 1); BAR; WAIT_L(0); MMA(1, 0, At, B0); MMA(1, 1, At, B1); BAR; }
  if (wr == 0) BAR;
  epi(acc);
#undef SA
#undef SB
}

template <class F>
DI void epi_for(AccT& acc, F&& f) {
  const int TID = opaque_tid();
  const int _wid = TID >> 6, _lane = TID & 63, _wr = _wid >> 2, _wc = _wid & 3, _fr = _lane & 15, _fq = _lane >> 4;
#pragma unroll
  for (int _ai = 0; _ai < 2; ++_ai)
#pragma unroll
    for (int _bj = 0; _bj < 2; ++_bj)
#pragma unroll
      for (int _m = 0; _m < 4; ++_m)
#pragma unroll
        for (int _n = 0; _n < 2; ++_n)
          f(_ai * 128 + _wr * 64 + _m * 16 + _fq * 4, _bj * 128 + _wc * 32 + _n * 16 + _fr, acc[_ai][_bj][_m][_n]);
}

DI void tile_map(int w, int ntn, int& tm, int& tn) {
  int xcd = w & 7, r = w >> 3;
  tn = r % ntn; tm = (r / ntn) * 8 + xcd;
}

DI void transpose_tile(const float* __restrict__ src, int N, u16* __restrict__ dst, int K, int tk, int tn, const float* __restrict__ gain) {
  const int TID = opaque_tid();
  extern __shared__ __attribute__((aligned(16))) unsigned char smem[];
  float* tile = (float*)smem;
  const int t = TID;
  {
    int rk = t >> 3, cs = (t & 7) * 8;
    const float4* s = (const float4*)(src + (size_t)(tk * 64 + rk) * N + tn * 64 + cs);
    float4 a = s[0], b = s[1];
    if (gain) { const float gk = gain[tk * 64 + rk]; a.x *= gk; a.y *= gk; a.z *= gk; a.w *= gk; b.x *= gk; b.y *= gk; b.z *= gk; b.w *= gk; }
    float* d = tile + rk * 65 + cs;
    d[0] = a.x; d[1] = a.y; d[2] = a.z; d[3] = a.w; d[4] = b.x; d[5] = b.y; d[6] = b.z; d[7] = b.w;
  }
  __syncthreads();
  {
    int n = t >> 3, ks = (t & 7) * 8;
    u32x4 o;
    o[0] = pk2(tile[(ks + 0) * 65 + n], tile[(ks + 1) * 65 + n]);
    o[1] = pk2(tile[(ks + 2) * 65 + n], tile[(ks + 3) * 65 + n]);
    o[2] = pk2(tile[(ks + 4) * 65 + n], tile[(ks + 5) * 65 + n]);
    o[3] = pk2(tile[(ks + 6) * 65 + n], tile[(ks + 7) * 65 + n]);
    *(u32x4*)(dst + (size_t)(tn * 64 + n) * K + tk * 64 + ks) = o;
  }
  __syncthreads();
}

DI void phase_prep_a(const P& p) {
  const int TID = opaque_tid();
  const int bid = blockIdx.x, nb = gridDim.x;
  for (int w = bid; w < 7680; w += nb) {
    int layer = w / 3840, r = w % 3840;
    const float* src; u16* dst; int K, N, tl; const float* gain = nullptr;
    if (r < 1024) { src = p.in[3] + (size_t)layer * 1024 * 4096; dst = (u16*)(p.ws + WS_WT_IN) + (size_t)layer * 4096 * 1024; K = 1024; N = 4096; tl = r; gain = p.in[2] + layer * 1024; }
    else if (r < 1280) { src = p.in[6] + (size_t)layer * 1024 * 1024; dst = (u16*)(p.ws + WS_WT_AP) + (size_t)layer * 1024 * 1024; K = 1024; N = 1024; tl = r - 1024; }
    else if (r < 1408) { src = p.in[15] + (size_t)layer * 512 * 1024; dst = (u16*)(p.ws + WS_WT_GA) + (size_t)layer * 1024 * 512; K = 512; N = 1024; tl = r - 1280; }
    else if (r < 1536) { src = p.in[16] + (size_t)layer * 512 * 1024; dst = (u16*)(p.ws + WS_WT_GB) + (size_t)layer * 1024 * 512; K = 512; N = 1024; tl = r - 1408; }
    else if (r < 1792) { src = p.in[17] + (size_t)layer * 1024 * 1024; dst = (u16*)(p.ws + WS_WT_OUT) + (size_t)layer * 1024 * 1024; K = 1024; N = 1024; tl = r - 1536; }
    else if (r < 2816) { src = p.in[19] + (size_t)layer * 1024 * 4096; dst = (u16*)(p.ws + WS_WT_FF1) + (size_t)layer * 4096 * 1024; K = 1024; N = 4096; tl = r - 1792; gain = p.in[18] + layer * 1024; }
    else { src = p.in[20] + (size_t)layer * 4096 * 1024; dst = (u16*)(p.ws + WS_WT_FF2) + (size_t)layer * 1024 * 4096; K = 4096; N = 1024; tl = r - 2816; }
    int ntn = N / 64;
    transpose_tile(src, N, dst, K, tl / ntn, tl % ntn, gain);
  }
  const int gtid = bid * 512 + TID, nth = nb * 512;
  float2* LP = (float2*)(p.ws + WS_LPOW);
  float2* BB = (float2*)(p.ws + WS_BBAR);
  for (int idx = gtid; idx < 8192 * 33; idx += nth) {
    const int i = idx / 33, tau = idx - i * 33, lg = i >> 6;
    const double step = exp((double)p.in[9][lg]);
    const double zr = (double)p.in[7][i] * step, zi = (double)p.in[8][i] * step;
    double e = exp(zr * tau), sn, cs;
    sincos_d(zi * tau, &sn, &cs);
    LP[idx] = make_float2((float)(e * cs), (float)(e * sn));
  }
  for (int idx = gtid; idx < 8192 * 16; idx += nth) {
    const int i = idx >> 4, ci = idx & 15, lg = i >> 6;
    const double step = exp((double)p.in[9][lg]);
    const double lr = p.in[7][i], li = p.in[8][i];
    const double zr = lr * step, zi = li * step;
    double e = exp(zr), sn, cs;
    sincos_d(zi, &sn, &cs);
    const double nr = e * cs - 1.0, ni = e * sn, den = lr * lr + li * li;
    const double fr = (nr * lr + ni * li) / den, fi = (ni * lr - nr * li) / den;
    const double br = p.in[10][idx], bi = p.in[11][idx];
    BB[idx] = make_float2((float)(fr * br - fi * bi), (float)(fr * bi + fi * br));
  }
  float2* RP = (float2*)(p.ws + WS_ROPE);
  for (int i = gtid; i < 128 * 16; i += nth) {
    int pos = i >> 4, f = i & 15;
    double inv = exp(-(double)(2 * f) / 32.0 * 9.210340371976184);
    double sn, cs;
    sincos_d((double)pos * inv, &sn, &cs);
    RP[i] = make_float2((float)cs, (float)sn);
  }
}

DI void phase_prep_b(const P& p) {
  const int TID = opaque_tid();
  const int gtid = blockIdx.x * 512 + TID, nth = gridDim.x * 512;
  const float2* LP = (const float2*)(p.ws + WS_LPOW);
  const float2* BB = (const float2*)(p.ws + WS_BBAR);
  float* KT = (float*)(p.ws + WS_KTAB);
  const float* cre = p.in[12];
  const float* cim = p.in[13];
  {
    extern __shared__ __attribute__((aligned(16))) unsigned char smem[];
    float2* Cs = (float2*)smem;
    float2* Bs = Cs + 1024;
    float2* Ls = Bs + 1024;
    for (int item = blockIdx.x; item < 256; item += gridDim.x) {
      const int lg = item >> 1, th = item & 1;
      for (int e = TID; e < 1024; e += 512) {
        Cs[e] = make_float2(cre[(size_t)lg * 1024 + e], cim[(size_t)lg * 1024 + e]);
        Bs[e] = BB[(size_t)lg * 1024 + e];
        Ls[e] = LP[(size_t)(lg * 64 + (e >> 4)) * 33 + th * 16 + (e & 15)];
      }
      __syncthreads();
      const int co = (TID >> 4) & 15, ci = TID & 15, tsel = TID >> 8;
      float a8[8];
#pragma unroll
      for (int k = 0; k < 8; ++k) a8[k] = 0.f;
      for (int pp = 0; pp < 64; ++pp) {
        const float2 c = Cs[co * 64 + pp], b = Bs[pp * 16 + ci];
        const float zr = c.x * b.x - c.y * b.y, zi = c.x * b.y + c.y * b.x;
#pragma unroll
        for (int k = 0; k < 8; ++k) { const float2 l = Ls[pp * 16 + tsel + 2 * k]; a8[k] += zr * l.x - zi * l.y; }
      }
#pragma unroll
      for (int k = 0; k < 8; ++k) KT[(((size_t)lg * 32 + th * 16 + tsel + 2 * k) * 16 + co) * 16 + ci] = a8[k];
      __syncthreads();
    }
  }
  u16* W1 = (u16*)(p.ws + WS_W1T);
  for (int i8 = gtid; i8 < (1 << 20); i8 += nth) {
    const int i = i8 << 3;
    const int k = i & 511, n = (i >> 9) & 255, g = (i >> 17) & 31, layer = i >> 22;
    const int dir = n >> 7, pp = (n >> 1) & 63, ri = n & 1, sidx = k >> 4, ci0 = k & 15;
    const int e = dir ? sidx : 31 - sidx;
    const int lg = (layer * 2 + dir) * 32 + g;
    const float2 l = LP[(size_t)(lg * 64 + pp) * 33 + e];
    const float2* b = BB + (size_t)(lg * 64 + pp) * 16 + ci0;
    float v[8];
#pragma unroll
    for (int q = 0; q < 8; ++q) { const float2 bq = b[q]; v[q] = ri ? (l.x * bq.y + l.y * bq.x) : (l.x * bq.x - l.y * bq.y); }
    u32x4 o;
    o[0] = pk2(v[0], v[1]); o[1] = pk2(v[2], v[3]); o[2] = pk2(v[4], v[5]); o[3] = pk2(v[6], v[7]);
    *(u32x4*)(W1 + i) = o;
  }
  u16* WY = (u16*)(p.ws + WS_WYT);
  for (int i8 = gtid; i8 < (1 << 20); i8 += nth) {
    const int i = i8 << 3;
    const int kk = i & 255, n = (i >> 8) & 511, g = (i >> 17) & 31, layer = i >> 22;
    const int t = n >> 4, co = n & 15, dir = kk >> 7, pp0 = (kk >> 1) & 63;
    const int e = dir ? 32 - t : t + 1;
    const int lg = (layer * 2 + dir) * 32 + g;
    float v[8];
#pragma unroll
    for (int q = 0; q < 4; ++q) {
      const float cr = cre[(size_t)(lg * 16 + co) * 64 + pp0 + q], cI = cim[(size_t)(lg * 16 + co) * 64 + pp0 + q];
      const float2 l = LP[(size_t)(lg * 64 + pp0 + q) * 33 + e];
      v[2 * q] = cr * l.x - cI * l.y;
      v[2 * q + 1] = -(cr * l.y + cI * l.x);
    }
    u32x4 o;
    o[0] = pk2(v[0], v[1]); o[1] = pk2(v[2], v[3]); o[2] = pk2(v[4], v[5]); o[3] = pk2(v[6], v[7]);
    *(u32x4*)(WY + ((size_t)((layer * 32 + g) * 512 + n)) * ASTR + 512 + kk) = o;
  }
}

DI void phase_prep_c(const P& p) {
  const int TID = opaque_tid();
#if PROBE_MASK & 64
  {
    u32x4* dst = (u32x4*)(p.ws + WS_FF);
    u32x4 z; z[0] = 1; z[1] = 2; z[2] = 3; z[3] = 4;
    for (unsigned i = blockIdx.x * 512 + TID; i < 640u * 65536u; i += gridDim.x * 512) { z[0] = i * 2654435761u; z[1] = z[0] ^ (i << 7); z[2] = z[1] * 40503u + i; z[3] = z[2] ^ z[0]; dst[i] = z; }
  }
#endif
  const int gtid = blockIdx.x * 512 + TID, nth = gridDim.x * 512;
  const float* KT = (const float*)(p.ws + WS_KTAB);
  u16* WY = (u16*)(p.ws + WS_WYT);
  for (int i = gtid; i < (1 << 21); i += nth) {
    int k8 = i & 63, n = (i >> 6) & 511, g = (i >> 15) & 31, layer = i >> 20;
    int t = n >> 4, co = n & 15, s = k8 >> 1, ci0 = (k8 & 1) * 8;
    int tau = t - s;
    float v[8];
    if (tau > 0) {
      const float* q = KT + ((((size_t)(layer * 2 + 0) * 32 + g) * 32 + tau) * 16 + co) * 16 + ci0;
#pragma unroll
      for (int j = 0; j < 8; ++j) v[j] = q[j];
    } else if (tau < 0) {
      const float* q = KT + ((((size_t)(layer * 2 + 1) * 32 + g) * 32 - tau) * 16 + co) * 16 + ci0;
#pragma unroll
      for (int j = 0; j < 8; ++j) v[j] = q[j];
    } else {
      const float* q0 = KT + ((((size_t)(layer * 2 + 0) * 32 + g) * 32) * 16 + co) * 16 + ci0;
      const float* q1 = KT + ((((size_t)(layer * 2 + 1) * 32 + g) * 32) * 16 + co) * 16 + ci0;
#pragma unroll
      for (int j = 0; j < 8; ++j) v[j] = q0[j] + q1[j];
    }
    u32x4 o;
    o[0] = pk2(v[0], v[1]); o[1] = pk2(v[2], v[3]); o[2] = pk2(v[4], v[5]); o[3] = pk2(v[6], v[7]);
    *(u32x4*)(WY + ((size_t)((layer * 32 + g) * 512 + n)) * ASTR + k8 * 8) = o;
  }
}

DI const float* xrow(const P& p, int layer, int tok) {
  if (layer == 0) return tok < NTP ? p.in[0] + (size_t)tok * 1024 : p.in[1] + (size_t)(tok - NTP) * 1024;
  return p.out + (size_t)tok * 1024;
}
DI void phase_convert(const P& p, const float* __restrict__ src0, const float* __restrict__ src1) {
  const int TID = opaque_tid();
  const int lane = TID & 63, wave = TID >> 6;
  u16* XN = (u16*)(p.ws + WS_XN);
  float* SSQ = (float*)(p.ws + WS_SSQ);
  for (int tok = blockIdx.x * 8 + wave; tok < NT; tok += gridDim.x * 8) {
    const float* x = tok < NTP ? src0 + (size_t)tok * 1024 : src1 + (size_t)(tok - NTP) * 1024;
    float4 v[4];
    float ss = 0.f;
#pragma unroll
    for (int i = 0; i < 4; ++i) {
      v[i] = *(const float4*)(x + i * 256 + lane * 4);
      ss += v[i].x * v[i].x + v[i].y * v[i].y + v[i].z * v[i].z + v[i].w * v[i].w;
    }
#pragma unroll
    for (int o = 32; o >= 1; o >>= 1) ss += __shfl_xor(ss, o);
    if (lane < 4) SSQ[(size_t)lane * NT + tok] = lane == 0 ? ss : 0.f;
#pragma unroll
    for (int i = 0; i < 4; ++i) {
      u32x2 o;
      o[0] = pk2(v[i].x, v[i].y);
      o[1] = pk2(v[i].z, v[i].w);
      *(u32x2*)(XN + (size_t)tok * 1024 + i * 256 + lane * 4) = o;
    }
  }
}

DI void phase_scan(const P& p, int layer) {
  const int TID = opaque_tid();
  const int gtid = blockIdx.x * 512 + TID, nth = gridDim.x * 512;
  const float2* LP = (const float2*)(p.ws + WS_LPOW);
  for (int i = gtid; i < 18 * 4096; i += nth) {
    int pp = i & 63, dir = (i >> 6) & 1, g = (i >> 7) & 31, seq = i >> 12;
    int c0 = seq < 16 ? seq * 128 : 2048 + (seq - 16) * 256;
    int nc = seq < 16 ? 128 : 256;
    float2 a = LP[(size_t)(((layer * 2 + dir) * 32 + g) * 64 + pp) * 33 + 32];
    const float2* S = (const float2*)(p.ws + WS_S) + ((size_t)(g * NCH + c0) * 256 + dir * 128 + pp * 2) / 2;
    unsigned* H = (unsigned*)((u16*)(p.ws + WS_ASSM) + (size_t)(g * NCH + c0) * ASTR + 512 + dir * 128 + pp * 2);
    float hr = 0.f, hi = 0.f;
    for (int cb = 0; cb < nc; cb += 16) {
      float2 sv[16];
#pragma unroll
      for (int k = 0; k < 16; ++k) {
        const int c = dir == 0 ? cb + k : nc - 1 - cb - k;
        sv[k] = S[(size_t)c * 128];
      }
#pragma unroll
      for (int k = 0; k < 16; ++k) {
        const int c = dir == 0 ? cb + k : nc - 1 - cb - k;
        H[(size_t)c * (ASTR / 2)] = pk2(hr, hi);
        const float nr = a.x * hr - a.y * hi + sv[k].x;
        hi = a.x * hi + a.y * hr + sv[k].y;
        hr = nr;
      }
    }
  }
}

#define MFMA32(a, b, c) __builtin_amdgcn_mfma_f32_32x32x16_bf16((a), (b), (c), 0, 0, 0)
DI void attn_item(const P& pin, int seq_start, int L, int head, int qb) {
  const int TID = opaque_tid();
  struct { unsigned char* ws; } p;
  p.ws = pin.ws;
  asm volatile("" : "+s"(p.ws));
  extern __shared__ __attribute__((aligned(16))) unsigned char smem[];
  const u16* Q = (const u16*)(p.ws + WS_Q);
  const u16* KB = (const u16*)(p.ws + WS_K);
  const u16* VT = (const u16*)(p.ws + WS_VT);
  u16* O = (u16*)(p.ws + WS_ATTO);
  const int tid = TID, wave = tid >> 6, lane = tid & 63, r = lane & 31, h = lane >> 5;
  const int kvh = head >> 2;
  const int q0 = seq_start + qb * 512 + wave * 64;
  bf16x8 qf[2][4];
#pragma unroll
  for (int nt = 0; nt < 2; ++nt)
#pragma unroll
    for (int ds = 0; ds < 4; ++ds)
      qf[nt][ds] = gld<bf16x8>(Q + (size_t)(q0 + nt * 32 + r) * 1024 + head * 64 + ds * 16 + h * 8);
#pragma unroll
  for (int nt = 0; nt < 2; ++nt)
#pragma unroll
    for (int ds = 0; ds < 4; ++ds) asm volatile("" ::"v"(qf[nt][ds]));
  const int srow = tid >> 3, spos = tid & 7, scc = spos ^ ((srow >> 1) & 7);
  const u16* kg = KB + ((size_t)kvh * NT + seq_start + srow) * 64 + scc * 8;
  const u16* vg = VT + (size_t)(kvh * 64 + srow) * NT + seq_start + scc * 8;
  unsigned char* ldst = smem + tid * 16;
  const int nkt = L >> 6;
  const int pr = ((r >> 4) * 16) + (((r >> 2) & 1) * 8) + (((r >> 3) & 1) * 4) + (r & 3);
  int koff[4];
#pragma unroll
  for (int ds = 0; ds < 4; ++ds) koff[ds] = pr * 128 + (((ds * 2 + h) ^ ((pr >> 1) & 7)) << 4);
  const int vxh = ((r >> 1) & 7) >> 1;
  const int vbase = 8192 + r * 128 + ((h ^ ((r >> 1) & 1)) << 4);

  f32x16 o[2][2];
#pragma unroll
  for (int a = 0; a < 2; ++a)
#pragma unroll
    for (int b = 0; b < 2; ++b)
#pragma unroll
      for (int j = 0; j < 16; ++j) o[a][b][j] = 0.f;
  float mrun[2] = {0.f, 0.f}, lrun[2] = {0.f, 0.f};


#define ATT_STAGE(T, B) do { GLDS(kg + (size_t)(T) * 128 * 64, ldst + (B) * 32768); GLDS(vg + (T) * 128, ldst + (B) * 32768 + 8192); \
    GLDS(kg + (size_t)(T) * 128 * 64 + 64 * 64, ldst + (B) * 32768 + 16384); GLDS(vg + (T) * 128 + 64, ldst + (B) * 32768 + 16384 + 8192); } while (0)
  const int nst = nkt >> 1;
  ATT_STAGE(0, 0);
  ATT_STAGE(1, 1);
  int bcur = 0;
  for (int st = 0; st < nst; ++st) {
    if (st + 1 < nst) { WAIT_V(4); } else { WAIT_V(0); }
    BAR;
    if (st + 2 < nst) {
      int bn = bcur + 2; if (bn >= 3) bn -= 3;
      ATT_STAGE(st + 2, bn);
    }
    const unsigned char* sbase = smem + bcur * 32768;
    auto qk = [&](const int hx, f32x16 (&sc)[2]) {
      const unsigned char* kb = sbase + (hx >> 1) * 16384 + (hx & 1) * 4096;
      bf16x8 kf[4];
#pragma unroll
      for (int ds = 0; ds < 4; ++ds) kf[ds] = *(const bf16x8*)(kb + koff[ds]);
#pragma unroll
      for (int nt = 0; nt < 2; ++nt)
#pragma unroll
        for (int j = 0; j < 16; ++j) sc[nt][j] = -mrun[nt];
#pragma unroll
      for (int ds = 0; ds < 4; ++ds)
#pragma unroll
        for (int nt = 0; nt < 2; ++nt) sc[nt] = MFMA32(kf[ds], qf[nt][ds], sc[nt]);
    };
    auto sm_pv = [&](const int hx, f32x16 (&sc)[2], f32x16 (&pend)[2], const bool has_pend) {
      const unsigned char* kb = sbase + (hx >> 1) * 16384;
      const int kt = hx & 1;
      bf16x8 vf[2][2];
#pragma unroll
      for (int s2 = 0; s2 < 2; ++s2)
#pragma unroll
        for (int mt = 0; mt < 2; ++mt) vf[s2][mt] = *(const bf16x8*)(kb + vbase + (((kt * 2 + s2) ^ vxh) << 5) + mt * 4096);
      float mx[2];
#pragma unroll
      for (int nt = 0; nt < 2; ++nt) {
        float m0 = sc[nt][0];
#pragma unroll
        for (int j = 1; j < 16; ++j) m0 = fmaxf(m0, sc[nt][j]);
        mx[nt] = m0;
      }
      if (__any((fabsf(mx[0]) > 16.0f) | (fabsf(mx[1]) > 16.0f))) {
#pragma unroll
        for (int nt = 0; nt < 2; ++nt) {
          const float mp = fmaxf(mx[nt], __shfl_xor(mx[nt], 32));
          const float dm = (fabsf(mp) > 12.0f) ? mp : 0.0f;
          const float alpha = __builtin_amdgcn_exp2f(-dm);
          mrun[nt] += dm;
          lrun[nt] *= alpha;
#pragma unroll
          for (int j = 0; j < 16; ++j) sc[nt][j] -= dm;
          if (has_pend) {
#pragma unroll
            for (int j = 0; j < 16; ++j) pend[nt][j] -= dm;
          }
#pragma unroll
          for (int mt = 0; mt < 2; ++mt)
#pragma unroll
            for (int j = 0; j < 16; ++j) o[mt][nt][j] *= alpha;
        }
      }
#pragma unroll
      for (int nt = 0; nt < 2; ++nt) {
        float sum = 0.f;
#pragma unroll
        for (int j = 0; j < 16; ++j) { float pv = __builtin_amdgcn_exp2f(sc[nt][j]); sc[nt][j] = pv; sum += pv; }
        lrun[nt] += sum;
      }
#pragma unroll
      for (int s2 = 0; s2 < 2; ++s2) {
        bf16x8 pf[2];
#pragma unroll
        for (int nt = 0; nt < 2; ++nt) {
          u32x4 pk;
#pragma unroll
          for (int i = 0; i < 4; ++i) pk[i] = pk2(sc[nt][s2 * 8 + 2 * i], sc[nt][s2 * 8 + 2 * i + 1]);
          pf[nt] = __builtin_bit_cast(bf16x8, pk);
        }
#pragma unroll
        for (int mt = 0; mt < 2; ++mt)
#pragma unroll
          for (int nt = 0; nt < 2; ++nt) o[mt][nt] = MFMA32(vf[s2][mt], pf[nt], o[mt][nt]);
      }
    };
    f32x16 sa[2], sb[2];
    qk(0, sa);
    qk(1, sb); sm_pv(0, sa, sb, true);
    qk(2, sa); sm_pv(1, sb, sa, true);
    qk(3, sb); sm_pv(2, sa, sb, true);
    sm_pv(3, sb, sa, false);
    bcur = bcur + 1; if (bcur >= 3) bcur = 0;
  }
#pragma unroll
  for (int nt = 0; nt < 2; ++nt) {
    float l = lrun[nt] + __shfl_xor(lrun[nt], 32);
    float inv = 1.0f / l;
    const int tok = q0 + nt * 32 + r;
#pragma unroll
    for (int mt = 0; mt < 2; ++mt)
#pragma unroll
      for (int jg = 0; jg < 4; ++jg) {
        u32x2 ov;
        ov[0] = pk2(o[mt][nt][jg * 4 + 0] * inv, o[mt][nt][jg * 4 + 1] * inv);
        ov[1] = pk2(o[mt][nt][jg * 4 + 2] * inv, o[mt][nt][jg * 4 + 3] * inv);
        gst<u32x2>(O + (size_t)tok * 1024 + head * 64 + mt * 32 + jg * 8 + h * 4, ov);
      }
  }
  WAIT_L(0);
  BAR;
}


enum { EK_Q = 0, EK_K, EK_V, EK_U, EK_S, EK_Y, EK_M0, EK_M1, EK_M2, EK_M3, EK_M4, EK_OUT, EK_FF1, EK_FF2 };
struct Job {
  const u16* A; const u16* Bt;
  int lda, ldb, gsB, tmB, K, kind, tm, tn, layer;
};

DI void stage_acc(AccT& acc, unsigned char* smem, const int tid, const int linear = 0) {
  const int wid = tid >> 6, lane = tid & 63, wr = wid >> 2, wc = wid & 3, fr = lane & 15, fq = lane >> 4;
#if PROBE_MASK
  if (linear) {
    int k = 0;
#pragma unroll
    for (int ai = 0; ai < 2; ++ai)
#pragma unroll
      for (int bj = 0; bj < 2; ++bj)
#pragma unroll
        for (int m = 0; m < 4; ++m)
#pragma unroll
          for (int n = 0; n < 2; ++n) {
            u32x2 w;
            w[0] = pk2(acc[ai][bj][m][n][0], acc[ai][bj][m][n][1]);
            w[1] = pk2(acc[ai][bj][m][n][2], acc[ai][bj][m][n][3]);
            *(u32x2*)(smem + tid * 8 + k * 4096) = w;
            ++k;
          }
    return;
  }
#endif
#pragma unroll
  for (int ai = 0; ai < 2; ++ai)
#pragma unroll
    for (int bj = 0; bj < 2; ++bj)
#pragma unroll
      for (int m = 0; m < 4; ++m)
#pragma unroll
        for (int n = 0; n < 2; ++n) {
          const int col = bj * 128 + wc * 32 + n * 16 + fr;
          const int row0 = ai * 128 + wr * 64 + m * 16 + fq * 4;
          u32x2 w;
          w[0] = pk2(acc[ai][bj][m][n][0], acc[ai][bj][m][n][1]);
          w[1] = pk2(acc[ai][bj][m][n][2], acc[ai][bj][m][n][3]);
          *(u32x2*)(smem + col * 512 + (((row0 >> 3) ^ (col & 31)) << 4) + ((row0 & 4) << 1)) = w;
        }
}
DI void unpack8(const u32x4 u, float* f) {
#pragma unroll
  for (int i = 0; i < 4; ++i) { f[2 * i] = __uint_as_float(u[i] << 16); f[2 * i + 1] = __uint_as_float(u[i] & 0xffff0000u); }
}
DI u32x4 pack8(const float* f) {
  u32x4 o;
#pragma unroll
  for (int i = 0; i < 4; ++i) o[i] = pk2(f[2 * i], f[2 * i + 1]);
  return o;
}

DI float tok_rstd(const unsigned char* ws, int tok) {
  const float* q = (const float*)(ws + WS_SSQ) + tok;
  return rsqrtf((q[0] + q[NT] + q[2 * NT] + q[3 * (size_t)NT]) * (1.0f / 1024.0f) + 1e-6f);
}
DI void run_epilogue(const P& pin, const Job& jb, AccT& acc) {
  extern __shared__ __attribute__((aligned(16))) unsigned char smem[];
  const int TID = opaque_tid();
  P p = pin;
  asm volatile("" : "+s"(p.ws), "+s"(p.out));
  const int tm = jb.tm, tn = jb.tn, layer = jb.layer & 255, kind = jb.kind;
  const int nit = (jb.layer & 256) ? 8 : (jb.layer & 512) ? 1 : (jb.layer & 1024) ? 0 : 16;
#if PROBE_MASK
  if (kind == -1) return;
  if (kind == -3) {
    u32x4 z; z[0] = acc[0][0][0][0][0] > 1e30f ? 1u : 0u; z[1] = 2; z[2] = 3; z[3] = 4;
    for (int it = 0; it < 16; ++it) {
      const int q = it * 512 + TID;
      *(u32x4*)((u16*)(p.ws + WS_FF) + (size_t)(tn * 256 + (q >> 5)) * 4096 + tm * 256 + (q & 31) * 8) = z;
    }
    return;
  }
#endif
  if (kind == EK_S) {
    float* Sg = (float*)(p.ws + WS_S) + (size_t)tn * 256 * 256;
    epi_for(acc, [&](const int row0, const int col, const f32x4 v) { *(f32x4*)(Sg + (size_t)col * 256 + row0) = v; });
    return;
  }
#if PROBE_MASK
  if (jb.layer & 16384) { if (acc[1][1][3][1][3] == 12345.678f) smem[TID] = 1; }
  if (!(jb.layer & 2048))
  for (int rep = (jb.layer & 8192) ? 4 : 1; rep > 0; --rep)
#endif
  stage_acc(acc, smem, TID, (jb.layer & 4096) ? 1 : 0);
  float* lrs = (float*)(smem + 131072);
  if ((kind <= EK_U || kind == EK_M2 || kind == EK_M3 || kind == EK_FF1) && TID < 256) lrs[TID] = tok_rstd(p.ws, tn * 256 + TID);
  __syncthreads();
  const bool two_pass = kind == EK_Q || kind == EK_K || kind == EK_Y || kind == EK_M1 || kind == EK_M2 || kind == EK_M4;
  if (two_pass) {
    auto slot_of = [&](const int it, int& col, int& c) -> unsigned char* {
      const int q = it * 512 + TID;
      col = q >> 5; c = q & 31;
      return smem + col * 512 + ((c ^ (col & 31)) << 4);
    };
    if (kind == EK_M1 || kind == EK_M2 || kind == EK_M4) {
      const u16* T1 = (const u16*)(p.ws + WS_Q) + (size_t)(tn * 256) * 1024 + tm * 256;
      const u16* T2 = (const u16*)(p.ws + WS_ASSM) + (size_t)(tn * 256) * 1024 + tm * 256;
      if (kind == EK_M1) {
#pragma unroll 8
        for (int it = 0; it < 16; ++it) {
          int col, c; unsigned char* sl = slot_of(it, col, c);
          float f[8], a[8], r[8];
          unpack8(gld<u32x4>(T1 + (size_t)col * 1024 + c * 8), a);
          unpack8(*(const u32x4*)sl, f);
#pragma unroll
          for (int i = 0; i < 8; ++i) r[i] = f[i] * a[i];
          *(u32x4*)sl = pack8(r);
        }
      } else if (kind == EK_M2) {
#pragma unroll 8
        for (int it = 0; it < 16; ++it) {
          int col, c; unsigned char* sl = slot_of(it, col, c);
          float f[8], a[8], r[8];
          unpack8(gld<u32x4>(T1 + (size_t)col * 1024 + c * 8), a);
          unpack8(*(const u32x4*)sl, f);
          const float tr = lrs[col];
#pragma unroll
          for (int i = 0; i < 8; ++i) r[i] = sigmoidf_(f[i] * tr) * a[i];
          *(u32x4*)sl = pack8(r);
        }
      } else {
#pragma unroll 8
        for (int it = 0; it < 16; ++it) {
          int col, c; unsigned char* sl = slot_of(it, col, c);
          float f[8], a[8], b[8], r[8];
          unpack8(gld<u32x4>(T1 + (size_t)col * 1024 + c * 8), a);
          unpack8(gld<u32x4>(T2 + (size_t)col * 1024 + c * 8), b);
          unpack8(*(const u32x4*)sl, f);
#pragma unroll
          for (int i = 0; i < 8; ++i) r[i] = b[i] * f[i] + a[i];
          *(u32x4*)sl = pack8(r);
        }
      }
    } else if (kind == EK_Y) {
      const int g = tn / 10, ch0 = (tn % 10) * 256;
      const float* dsk = p.in[14] + layer * 512 + g * 16 + (TID & 1) * 8;
      const f32x4 d0 = *(const f32x4*)dsk, d1 = *(const f32x4*)(dsk + 4);
      const u16* UU = (const u16*)(p.ws + WS_ASSM) + ((size_t)g * NCH + ch0) * ASTR + tm * 256;
#pragma unroll 8
      for (int it = 0; it < 16; ++it) {
        int col, c; unsigned char* sl = slot_of(it, col, c);
        float f[8], u[8], r[8];
        unpack8(gld<u32x4>(UU + (size_t)col * ASTR + c * 8), u);
        unpack8(*(const u32x4*)sl, f);
#pragma unroll
        for (int i = 0; i < 4; ++i) { r[i] = gelu_tanh(f[i] + d0[i] * u[i]); r[4 + i] = gelu_tanh(f[4 + i] + d1[i] * u[4 + i]); }
        *(u32x4*)sl = pack8(r);
      }
    } else {
      const float* gn = (kind == EK_Q ? p.in[4] : p.in[5]) + layer * 64 + (TID & 7) * 8;
      const f32x4 g0 = *(const f32x4*)gn, g1 = *(const f32x4*)(gn + 4);
      const float qs = (kind == EK_Q) ? 0.125f * 1.4426950408889634f : 1.0f;
      const int i0 = (TID & 7) * 4;
#pragma unroll 4
      for (int it = 0; it < 16; ++it) {
        int col, c; unsigned char* sl = slot_of(it, col, c);
        const int tok = tn * 256 + col;
        const int pos = tok < NTP ? (tok & 4095) : ((tok - NTP) & 8191);
        const float* rp = (const float*)(p.ws + WS_ROPE) + 2 * ((i0 < 16) ? (pos >> 6) * 16 + i0 : (pos & 63) * 16 + i0 - 16);
        const f32x4 cs0 = gld<f32x4>(rp), cs1 = gld<f32x4>(rp + 4);
        float f[8], r[8];
        unpack8(*(const u32x4*)sl, f);
        const float tr = lrs[col];
        float ss = 0.f;
#pragma unroll
        for (int i = 0; i < 8; ++i) { f[i] *= tr; ss += f[i] * f[i]; }
        ss += __shfl_xor(ss, 1); ss += __shfl_xor(ss, 2); ss += __shfl_xor(ss, 4);
        const float rstd = rsqrtf(ss * (1.0f / 64.0f) + 1e-6f) * qs;
        const float x0 = f[0] * rstd * g0[0], x1 = f[1] * rstd * g0[1], x2 = f[2] * rstd * g0[2], x3 = f[3] * rstd * g0[3];
        const float x4 = f[4] * rstd * g1[0], x5 = f[5] * rstd * g1[1], x6 = f[6] * rstd * g1[2], x7 = f[7] * rstd * g1[3];
        r[0] = x0 * cs0[0] - x1 * cs0[1]; r[1] = x0 * cs0[1] + x1 * cs0[0];
        r[2] = x2 * cs0[2] - x3 * cs0[3]; r[3] = x2 * cs0[3] + x3 * cs0[2];
        r[4] = x4 * cs1[0] - x5 * cs1[1]; r[5] = x4 * cs1[1] + x5 * cs1[0];
        r[6] = x6 * cs1[2] - x7 * cs1[3]; r[7] = x6 * cs1[3] + x7 * cs1[2];
        *(u32x4*)sl = pack8(r);
      }
    }
#pragma unroll 4
    for (int it = 0; it < 16; ++it) {
      int col, c; unsigned char* sl = slot_of(it, col, c);
      const u32x4 v = *(const u32x4*)sl;
      u16* dst;
      if (kind == EK_Q) dst = (u16*)(p.ws + WS_Q) + (size_t)(tn * 256 + col) * 1024 + (tm * 4 + (c >> 3)) * 64 + (c & 7) * 8;
      else if (kind == EK_K) dst = (u16*)(p.ws + WS_K) + ((size_t)(c >> 3) * NT + tn * 256 + col) * 64 + (c & 7) * 8;
      else if (kind == EK_Y) dst = (u16*)(p.ws + WS_Y) + (size_t)(tn / 10) * NT * 16 + (size_t)((tn % 10) * 256 + col) * 512 + tm * 256 + c * 8;
      else dst = (u16*)(p.ws + WS_Q) + (size_t)(tn * 256 + col) * 1024 + tm * 256 + c * 8;
      gst<u32x4>(dst, v);
    }
    __syncthreads();
    return;
  }
  if (kind == EK_OUT || kind == EK_FF2) {
    const int cc = tm * 256 + (TID & 31) * 8;
#pragma unroll 1
    for (int it0 = 0; it0 < 16; it0 += 4) {
      f32x4 X0[4], X1[4];
#pragma unroll
      for (int k = 0; k < 4; ++k) {
        const int tok = tn * 256 + (((it0 + k) * 512 + TID) >> 5);
        const float* x = (kind == EK_OUT) ? xrow(p, layer, tok) + cc : p.out + (size_t)tok * 1024 + cc;
        X0[k] = gld<f32x4>(x); X1[k] = gld<f32x4>(x + 4);
      }
#pragma unroll
      for (int k = 0; k < 4; ++k) {
        const int q = (it0 + k) * 512 + TID;
        const int col = q >> 5, c = q & 31;
        const int tok = tn * 256 + col;
        float f[8], r[8];
        unpack8(*(const u32x4*)(smem + col * 512 + ((c ^ (col & 31)) << 4)), f);
        float* o = p.out + (size_t)tok * 1024 + cc;
        f32x4 o0, o1;
        float ss = 0.f;
#pragma unroll
        for (int i = 0; i < 4; ++i) { o0[i] = X0[k][i] + f[i]; o1[i] = X1[k][i] + f[4 + i]; r[i] = o0[i]; r[4 + i] = o1[i]; ss += o0[i] * o0[i] + o1[i] * o1[i]; }
        gst<f32x4>(o, o0); gst<f32x4>(o + 4, o1);
        gst<u32x4>((u16*)(p.ws + WS_XN) + (size_t)tok * 1024 + cc, pack8(r));
        ss += __shfl_xor(ss, 1); ss += __shfl_xor(ss, 2); ss += __shfl_xor(ss, 4); ss += __shfl_xor(ss, 8); ss += __shfl_xor(ss, 16);
        if (c == 0) ((float*)(p.ws + WS_SSQ))[(size_t)tm * NT + tok] = ss;
      }
    }
    __syncthreads();
    return;
  }
#pragma unroll 2
  for (int it = 0; it < nit; ++it) {
    const int q = it * 512 + TID;
    int col = q >> 5, c = q & 31;
    if (kind == EK_U) { col = (q >> 1) & 255; c = ((q >> 9) << 1) | (q & 1); }
    const u32x4 sv = *(const u32x4*)(smem + col * 512 + ((c ^ (col & 31)) << 4));
    float f[8], r[8];
    unpack8(sv, f);
#if PROBE_MASK
    if (kind == -2) { if (f[0] > 1e30f) *(u32x4*)(p.ws + WS_FF) = sv; continue; }
#endif
    switch (kind) {
      case EK_V: {
        {
          const int tok0 = tn * 256 + c * 8;
#pragma unroll
          for (int i = 0; i < 8; ++i) r[i] = f[i] * lrs[c * 8 + i];
          gst<u32x4>((u16*)(p.ws + WS_VT) + (size_t)col * NT + tok0, pack8(r));
        }
      } break;
      case EK_U: {
        const int tok = tn * 256 + col, g = (tm - 6) * 16 + (c >> 1);
        const float tr = lrs[col];
#pragma unroll
        for (int i = 0; i < 8; ++i) r[i] = f[i] * tr;
        gst<u32x4>((u16*)(p.ws + WS_ASSM) + ((size_t)g * NCH + (tok >> 5)) * ASTR + (tok & 31) * 16 + (c & 1) * 8, pack8(r));
      } break;
      case EK_M0: case EK_M3: {
        const size_t o = (size_t)(tn * 256 + col) * 1024 + tm * 256 + c * 8;
        const float tr = (kind == EK_M3) ? lrs[col] : 1.0f;
#pragma unroll
        for (int i = 0; i < 8; ++i) r[i] = sigmoidf_(f[i] * tr);
        gst<u32x4>((kind == EK_M3 ? (u16*)(p.ws + WS_ASSM) : (u16*)(p.ws + WS_Q)) + o, pack8(r));
      } break;
      case EK_FF1: {
        const float tr = lrs[col];
#pragma unroll
        for (int i = 0; i < 8; ++i) { const float a = fmaxf(f[i] * tr, 0.f); r[i] = a * a; }
        gst<u32x4>((u16*)(p.ws + WS_FF) + ((size_t)(tn * 16 + tm) << 16) + col * 256 + c * 8, pack8(r));
      } break;
    }
  }
  __syncthreads();
}

DI void make_job(const P& pin, int layer, int s, int w, int step, Job& jb) {
  struct { unsigned char* ws; } p;
  p.ws = pin.ws;
  asm volatile("" : "+s"(p.ws));
  const u16* XN = (const u16*)(p.ws + WS_XN);
  jb.layer = layer; jb.gsB = 16; jb.tmB = 0;
  if (s == 1) {
    int g = w / 10;
    jb.A = (const u16*)(p.ws + WS_W1T) + ((size_t)layer * 32 + g) * 256 * 512;
    jb.Bt = (const u16*)(p.ws + WS_ASSM) + (size_t)w * 256 * ASTR;
    jb.lda = 512; jb.ldb = ASTR; jb.K = 512; jb.kind = EK_S; jb.tm = 0; jb.tn = w;
    return;
  }
  if (s == 3) {
    int gc = w >> 1, rt = w & 1, g = gc / 10;
    jb.A = (const u16*)(p.ws + WS_WYT) + (((size_t)layer * 32 + g) * 512 + rt * 256) * ASTR;
    jb.Bt = (const u16*)(p.ws + WS_ASSM) + (size_t)gc * 256 * ASTR;
    jb.lda = ASTR; jb.ldb = ASTR; jb.K = ASTR; jb.kind = EK_Y; jb.tm = rt; jb.tn = gc;
    return;
  }
  const int nft = (s == 0) ? 8 : (s == 6) ? 16 : 4;
  int tt, ft; tile_map(w, nft, tt, ft);
  jb.tm = ft; jb.tn = tt;
  jb.lda = 1024; jb.ldb = 1024; jb.K = 1024;
  if (s == 0) {
    const u16* W = (const u16*)(p.ws + WS_WT_IN) + (size_t)layer * 4096 * 1024 + (size_t)ft * 256 * 1024;
    const u16* X = XN + (size_t)tt * 256 * 1024;
    if (ft == 5) { jb.A = X; jb.Bt = W; jb.kind = EK_V; }
    else { jb.A = W; jb.Bt = X; jb.kind = ft < 4 ? EK_Q : ft == 4 ? EK_K : EK_U; }
  } else if (s == 4) {
    jb.kind = EK_M0 + step;
    if (step < 2) {
      jb.A = (const u16*)(p.ws + (step == 0 ? WS_WT_GB : WS_WT_GA)) + (size_t)layer * 1024 * 512 + (size_t)ft * 256 * 512;
      jb.Bt = (const u16*)(p.ws + WS_Y) + (size_t)tt * 256 * 16;
      jb.lda = 512; jb.ldb = 16; jb.gsB = NT * 16; jb.K = 512;
    } else if (step < 4) {
      jb.A = (const u16*)(p.ws + WS_WT_IN) + (size_t)layer * 4096 * 1024 + (size_t)((step == 2 ? 3072 : 2048) + ft * 256) * 1024;
      jb.Bt = XN + (size_t)tt * 256 * 1024;
    } else {
      jb.A = (const u16*)(p.ws + WS_WT_AP) + (size_t)layer * 1024 * 1024 + (size_t)ft * 256 * 1024;
      jb.Bt = (const u16*)(p.ws + WS_ATTO) + (size_t)tt * 256 * 1024;
    }
  } else if (s == 5) {
    jb.A = (const u16*)(p.ws + WS_WT_OUT) + (size_t)layer * 1024 * 1024 + (size_t)ft * 256 * 1024;
    jb.Bt = (const u16*)(p.ws + WS_Q) + (size_t)tt * 256 * 1024; jb.kind = EK_OUT;
  } else if (s == 6) {
    jb.A = (const u16*)(p.ws + WS_WT_FF1) + (size_t)layer * 4096 * 1024 + (size_t)ft * 256 * 1024;
    jb.Bt = XN + (size_t)tt * 256 * 1024; jb.kind = EK_FF1;
  } else {
    jb.A = (const u16*)(p.ws + WS_WT_FF2) + (size_t)layer * 1024 * 4096 + (size_t)ft * 256 * 4096;
    jb.Bt = (const u16*)(p.ws + WS_FF) + ((size_t)tt * 16 << 16);
    jb.lda = 4096; jb.ldb = 256; jb.tmB = 1; jb.K = 4096; jb.kind = EK_FF2;
  }
}

DI void phase_jobs(const P& p, int layer, int s, int probe = 0) {
  int nitems, nsteps = 1, nattn = 0;
  switch (s) {
    case 0: nitems = 2560; break;
    case 1: nitems = 320; break;
    case 3: nitems = 3200; nattn = 2560; break;
    case 4: nitems = 1280; nsteps = 5; break;
    case 5: nitems = 1280; break;
    case 6: nitems = 5120; break;
    default: nitems = 1280; break;
  }
#if STAGGER_SLEEP
  if (s != 3) {
    const int slot = (blockIdx.x >> 3) & 31;
    for (int i = 0; i < slot; ++i) __builtin_amdgcn_s_sleep(STAGGER_SLEEP);
  }
#endif
  for (int w = blockIdx.x; w < nitems; w += gridDim.x) {
    if (w < nattn) {
      int seq_start, L, head, qb;
      if (w < 512) {
        int xcd = w & 7, r = w >> 3;
        int seq = xcd >> 2, kvh = xcd & 3;
        seq_start = NTP + seq * 8192; L = 8192; head = kvh * 4 + (r >> 4); qb = r & 15;
      } else {
        int w2 = w - 512, xcd = w2 & 7, r = w2 >> 3;
        int grp = (r >> 5) * 8 + xcd, within = r & 31;
        int seq = grp >> 2, kvh = grp & 3;
        seq_start = seq * 4096; L = 4096; head = kvh * 4 + (within >> 3); qb = within & 7;
      }
      attn_item(p, seq_start, L, head, qb);
    } else {
      for (int step = 0; step < nsteps; ++step) {
        Job jb;
        make_job(p, layer, s, w - nattn, step, jb);
#if PROBE_MASK
        if (probe == 2 || probe == 3) jb.kind = -1;
        if (probe == 3) jb.K = jb.K / 2;
#endif
        gemm_tile(jb.A, jb.Bt, jb.lda, jb.ldb, jb.gsB, jb.tmB, jb.K, [&](AccT& acc) {
          int w2 = w - nattn, st2 = step;
          asm volatile("" : "+s"(w2), "+s"(st2));
          Job j2;
          make_job(p, layer, s, w2, st2, j2);
#if PROBE_MASK
          if (probe == 2 || probe == 3) j2.kind = -1;
          if (probe == 4) j2.kind = -2;
          if (probe == 6) j2.layer |= 256;
          if (probe == 7) j2.layer |= 512;
          if (probe == 8) j2.layer |= 1024 | 2048;
          if (probe == 9) j2.layer |= 1024;
          if (probe == 10) j2.layer |= 1024 | 4096;
          if (probe == 11) j2.layer |= 1024 | 8192;
          if (probe == 12) j2.layer |= 1024 | 2048 | 16384;
          if (probe == 5) j2.kind = -3;
#endif
          run_epilogue(p, j2, acc);
        });
      }
    }
  }
}

DI void run_phase(const P& pin, int ph, int probe = 0) {
  P p = pin;
  asm volatile("" : "+s"(p.ws), "+s"(p.out));
  int layer = (ph - 3) / 8, s = (ph - 3) % 8;
  if (s == 2) phase_scan(p, layer);
  else phase_jobs(p, layer, s, probe);
}

__global__ void __launch_bounds__(512, 2) mega_coop(P p) {
  cg::grid_group grid = cg::this_grid();
  phase_prep_a(p);
  grid.sync();
  phase_prep_b(p);
  grid.sync();
  phase_prep_c(p);
  phase_convert(p, p.in[0], p.in[1]);
  grid.sync();
  for (int ph = 3; ph < NPHASE; ++ph) {
    run_phase(p, ph);
#if PROBE_MASK
    {
      const int s_ = (ph - 3) % 8;
      bool rep = false;
      if ((PROBE_MASK & 1) && s_ == 3) rep = true;
      if ((PROBE_MASK & 2) && (s_ == 0 || s_ == 4 || s_ == 6)) rep = true;
      if ((PROBE_MASK & 4) && (s_ == 1 || s_ == 2)) rep = true;
      if ((PROBE_MASK & 8) && s_ == 6) run_phase(p, ph, (PROBE_MASK >> 4));
      if (rep) run_phase(p, ph);
    }
#endif
    if (ph + 1 < NPHASE) grid.sync();
  }
}
#if N_LAUNCH_MODE == 0
__global__ void __launch_bounds__(512, 2) mega_one(P p) {
  run_phase(p, p.ph_lo);
}
#endif

extern "C" void kernel_launch(void* const* d_in, const int* in_sizes, int n_in, void* d_out, int out_size, void* d_ws, size_t ws_size,
                              hipStream_t stream) {
  static int grid = 0;
  if (grid == 0) {
    if (n_in != 21 || ws_size < WS_END) { fprintf(stderr, "kernel_launch: unexpected n_in %d / ws_size %zu (need %zu)\n", n_in, ws_size, (size_t)WS_END); grid = -1; return; }
    int dev = 0, cus = 0, per_cu = 0;
    hipGetDevice(&dev);
    hipDeviceGetAttribute(&cus, hipDeviceAttributeMultiprocessorCount, dev);
    hipFuncSetAttribute((const void*)mega_coop, hipFuncAttributeMaxDynamicSharedMemorySize, LDS_BYTES);
#if N_LAUNCH_MODE == 0
    hipFuncSetAttribute((const void*)mega_one, hipFuncAttributeMaxDynamicSharedMemorySize, LDS_BYTES);
#endif
    hipOccupancyMaxActiveBlocksPerMultiprocessor(&per_cu, (const void*)mega_coop, 512, LDS_BYTES);
    if (per_cu < 1) { fprintf(stderr, "kernel_launch: occupancy query says %d blocks/CU\n", per_cu); per_cu = 1; }
    (void)hipGetLastError();
    grid = cus * 1;
  }
  if (grid < 0) return;
  P p{};
  for (int i = 0; i < 21; ++i) p.in[i] = (const float*)d_in[i];
  p.out = (float*)d_out;
  p.ws = (unsigned char*)d_ws;
#if N_LAUNCH_MODE == 1
  p.ph_lo = 0; p.ph_hi = NPHASE;
  void* args[] = {&p};
  hipError_t e = hipLaunchCooperativeKernel((const void*)mega_coop, dim3(grid), dim3(512), args, LDS_BYTES, stream);
  if (e != hipSuccess) fprintf(stderr, "cooperative launch failed: %s (grid %d)\n", hipGetErrorString(e), grid);
#else
  for (int ph = 0; ph < NPHASE; ++ph) {
    p.ph_lo = ph; p.ph_hi = ph + 1;
    hipLaunchKernelGGL(mega_one, dim3(grid), dim3(512), LDS_BYTES, stream, p);
  }
#endif
}
```

```cpp
#include <hip/hip_runtime.h>
#include <hip/hip_cooperative_groups.h>
#include <cstdio>
namespace cg = cooperative_groups;

typedef unsigned short u16;
typedef __attribute__((ext_vector_type(8))) short bf16x8;
typedef __attribute__((ext_vector_type(4))) float f32x4;
typedef __attribute__((ext_vector_type(16))) float f32x16;
typedef __attribute__((ext_vector_type(4))) unsigned u32x4;
typedef __attribute__((ext_vector_type(2))) unsigned u32x2;
typedef __attribute__((ext_vector_type(2))) float f32x2;
typedef __attribute__((ext_vector_type(2))) __bf16 bf16v2;

#define DI __device__ __forceinline__
#ifndef PROBE_MASK
#define PROBE_MASK 0
#endif
#ifndef STAGGER_SLEEP
#define STAGGER_SLEEP 0
#endif
#ifndef N_LAUNCH_MODE
#define N_LAUNCH_MODE 1
#endif

constexpr int NT = 81920;
constexpr int NTP = 65536;
constexpr int NCH = 2560;
constexpr int ASTR = 768;
constexpr int NPHASE = 19;
constexpr int LDS_BYTES = 131072 + 1024;

constexpr size_t MiB = 1ull << 20;
constexpr size_t WS_WT_IN = 0;
constexpr size_t WS_WT_AP = 16 * MiB;
constexpr size_t WS_WT_GA = 20 * MiB;
constexpr size_t WS_WT_GB = 22 * MiB;
constexpr size_t WS_WT_OUT = 24 * MiB;
constexpr size_t WS_WT_FF1 = 28 * MiB;
constexpr size_t WS_WT_FF2 = 44 * MiB;
constexpr size_t WS_W1T = 60 * MiB;
constexpr size_t WS_WYT = 76 * MiB;
constexpr size_t WS_LPOW = 124 * MiB;
constexpr size_t WS_BBAR = 127 * MiB;
constexpr size_t WS_KTAB = 128 * MiB;
constexpr size_t WS_ROPE = 132 * MiB;
constexpr size_t WS_SSQ = 133 * MiB;
constexpr size_t WS_XN = 135 * MiB;
constexpr size_t WS_BIG = 295 * MiB;
constexpr size_t WS_Q = WS_BIG;
constexpr size_t WS_K = WS_BIG + 160 * MiB;
constexpr size_t WS_VT = WS_BIG + 200 * MiB;
constexpr size_t WS_ASSM = WS_BIG + 240 * MiB;
constexpr size_t WS_S = WS_BIG + 360 * MiB;
constexpr size_t WS_Y = WS_BIG + 440 * MiB;
constexpr size_t WS_ATTO = WS_BIG + 520 * MiB;
constexpr size_t WS_FF = WS_BIG;
constexpr size_t WS_END = WS_BIG + 680 * MiB;

struct P {
  const float* in[21];
  float* out;
  unsigned char* ws;
  int ph_lo, ph_hi;
};

DI u16 f2bf(float f) { unsigned u = __float_as_uint(f); u += 0x7fffu + ((u >> 16) & 1u); return (u16)(u >> 16); }
DI float bf2f(u16 h) { return __uint_as_float(((unsigned)h) << 16); }
DI unsigned pk2(float a, float b) {
  f32x2 v; v[0] = a; v[1] = b;
  bf16v2 r = __builtin_convertvector(v, bf16v2);
  return __builtin_bit_cast(unsigned, r);
}
DI float sigmoidf_(float x) { return 1.0f / (1.0f + __expf(-x)); }
DI float gelu_tanh(float x) {
  float z = 0.7978845608028654f * (x + 0.044715f * x * x * x);
  float e = __expf(2.0f * z);
  return 0.5f * x * (2.0f - 2.0f / (e + 1.0f));
}


DI void sincos_d(double x, double* sn, double* cs) {
  const double TWO_PI_HI = 6.283185307179586232e+00, TWO_PI_LO = 2.449293598294706414e-16;
  double k = rint(x * 0.15915494309189534561);
  double r = (x - k * TWO_PI_HI) - k * TWO_PI_LO;
  r *= 0.25;
  double r2 = r * r;
  double s = 1.0, c = 1.0;
  s = 1.0 - r2 / (18.0 * 19.0);
  s = 1.0 - r2 / (16.0 * 17.0) * s;
  s = 1.0 - r2 / (14.0 * 15.0) * s;
  s = 1.0 - r2 / (12.0 * 13.0) * s;
  s = 1.0 - r2 / (10.0 * 11.0) * s;
  s = 1.0 - r2 / (8.0 * 9.0) * s;
  s = 1.0 - r2 / (6.0 * 7.0) * s;
  s = 1.0 - r2 / (4.0 * 5.0) * s;
  s = 1.0 - r2 / (2.0 * 3.0) * s;
  s *= r;
  c = 1.0 - r2 / (17.0 * 18.0);
  c = 1.0 - r2 / (15.0 * 16.0) * c;
  c = 1.0 - r2 / (13.0 * 14.0) * c;
  c = 1.0 - r2 / (11.0 * 12.0) * c;
  c = 1.0 - r2 / (9.0 * 10.0) * c;
  c = 1.0 - r2 / (7.0 * 8.0) * c;
  c = 1.0 - r2 / (5.0 * 6.0) * c;
  c = 1.0 - r2 / (3.0 * 4.0) * c;
  c = 1.0 - r2 / (1.0 * 2.0) * c;
  double s2 = 2.0 * s * c, c2 = c * c - s * s;
  *sn = 2.0 * s2 * c2; *cs = c2 * c2 - s2 * s2;
}

template <class T> DI T gld(const void* q) { return *(const __attribute__((address_space(1))) T*)q; }
template <class T> DI void gst(void* q, const T v) { *(__attribute__((address_space(1))) T*)q = v; }
DI int opaque_tid() { int t = threadIdx.x; asm volatile("" : "+v"(t)); return t; }
DI const char* sgpr_ptr(const char* p) { asm("" : "+s"(p)); return p; }
#define WAIT_V(n) asm volatile("s_waitcnt vmcnt(" #n ")" ::: "memory")
#define WAIT_L(n) asm volatile("s_waitcnt lgkmcnt(" #n ")" ::: "memory")
#define BAR __builtin_amdgcn_s_barrier()
#define SCHED __builtin_amdgcn_sched_barrier(0)
#define GLDS(gp, lp) __builtin_amdgcn_global_load_lds((const unsigned*)(gp), (unsigned*)(lp), 16, 0, 0)

constexpr int GBK = 64, GHALF = 128, GHT = GHALF * GBK;
DI int lds_byte(int r, int c) {
  int st = (r >> 4) * 2 + (c >> 5), rr = r & 15, cc = c & 31, ob = rr * 64 + cc * 2;
  return st * 1024 + (ob ^ (((ob >> 9) & 1) << 5));
}
DI void stage_rc(int b, int& R, int& C) {
  int st = b / 1024, sb = b % 1024, swz = sb ^ (((sb >> 9) & 1) << 5);
  R = (st >> 1) * 16 + swz / 64; C = (st & 1) * 32 + (swz % 64) / 2;
}

typedef f32x4 AccT[2][2][4][2];

template <class Epi>
DI void gemm_tile(const u16* __restrict__ A, const u16* __restrict__ Bt, const int lda, const int ldb, const int gsB, const int tmB, const int K, Epi&& epi) {
  const int TID = opaque_tid();
  extern __shared__ __attribute__((aligned(16))) unsigned char smem[];
  u16* shm = (u16*)smem;
#define SA(b, h) (shm + ((b) * 2 + (h)) * GHT)
#define SB(b, h) (shm + (4 + (b) * 2 + (h)) * GHT)
  int R0, C0, R1, C1;
  stage_rc(TID * 16, R0, C0);
  stage_rc(TID * 16 + 8192, R1, C1);
  const unsigned voA0 = (unsigned)(R0 * lda + C0) * 2u, voA1 = (unsigned)(R1 * lda + C1) * 2u;
  const unsigned voB0 = (unsigned)(R0 * ldb + (C0 & 15) + (C0 >> 4) * gsB) * 2u, voB1 = (unsigned)(R1 * ldb + (C1 & 15) + (C1 >> 4) * gsB) * 2u;
  const int hA = GHALF * lda, hB = GHALF * ldb;
  const unsigned wid_u = __builtin_amdgcn_readfirstlane(TID >> 6);
#define STAGE_A(PTR, half, kt) do { const char* _g = sgpr_ptr((const char*)(A + (size_t)(half) * hA + (size_t)(kt) * GBK)); \
    char* _l = (char*)(PTR) + wid_u * 1024u; \
    GLDS(_g + voA0, _l); GLDS(_g + voA1, _l + 8192); } while (0)
#define STAGE_B(PTR, half, kt) do { const char* _g = sgpr_ptr((const char*)(Bt + (size_t)(half) * hB + (tmB ? (size_t)((((kt) >> 2) << 16) + (((kt) & 3) << 6)) : (size_t)(kt) * (size_t)(4 * gsB)))); \
    char* _l = (char*)(PTR) + wid_u * 1024u; \
    GLDS(_g + voB0, _l); GLDS(_g + voB1, _l + 8192); } while (0)
#define LDA(dst, b, h) for (int m = 0; m < 4; ++m) for (int k = 0; k < 2; ++k) \
    dst[m][k] = *reinterpret_cast<const bf16x8*>((char*)SA(b, h) + lds_byte(wr * 64 + m * 16 + fr, k * 32 + fq * 8))
#define LDB(dst, b, h) for (int n = 0; n < 2; ++n) for (int k = 0; k < 2; ++k) \
    dst[n][k] = *reinterpret_cast<const bf16x8*>((char*)SB(b, h) + lds_byte(wc * 32 + n * 16 + fr, k * 32 + fq * 8))
#define MMA(ai, bj, At, Bq) do { __builtin_amdgcn_s_setprio(1); \
    for (int m = 0; m < 4; ++m) for (int n = 0; n < 2; ++n) for (int k = 0; k < 2; ++k) \
      acc[ai][bj][m][n] = __builtin_amdgcn_mfma_f32_16x16x32_bf16(At[m][k], Bq[n][k], acc[ai][bj][m][n], 0, 0, 0); \
    __builtin_amdgcn_s_setprio(0); } while (0)

  const int wid = TID >> 6, lane = TID & 63, wr = wid >> 2, wc = wid & 3, fr = lane & 15, fq = lane >> 4;
  AccT acc;
#pragma unroll
  for (int a = 0; a < 2; ++a)
#pragma unroll
    for (int b = 0; b < 2; ++b)
#pragma unroll
      for (int m = 0; m < 4; ++m)
#pragma unroll
        for (int n = 0; n < 2; ++n) acc[a][b][m][n] = f32x4{0.f, 0.f, 0.f, 0.f};
  bf16x8 At[4][2], B0[2][2], B1[2][2];
  const int nt = K / GBK;
  STAGE_B(SB(0, 0), 0, 0); STAGE_A(SA(0, 0), 0, 0);
  STAGE_B(SB(0, 1), 1, 0); STAGE_A(SA(0, 1), 1, 0);
  if (wr == 1) BAR;
  WAIT_V(4); BAR;
  STAGE_B(SB(1, 0), 0, 1); STAGE_A(SA(1, 0), 0, 1); STAGE_B(SB(1, 1), 1, 1);
  WAIT_V(6); BAR;
  for (int t = 0; t < nt - 2; t += 2) {
    LDB(B0, 0, 0); SCHED; LDA(At, 0, 0); STAGE_A(SA(1, 1), 1, t + 1);
    WAIT_L(8); BAR; WAIT_L(0); MMA(0, 0, At, B0); BAR; SCHED;
    LDB(B1, 0, 1); STAGE_B(SB(0, 0), 0, t + 2);
    BAR; WAIT_L(0); MMA(0, 1, At, B1); BAR;
    LDA(At, 0, 1); STAGE_A(SA(0, 0), 0, t + 2);
    BAR; WAIT_L(0); MMA(1, 0, At, B0); BAR; SCHED;
    STAGE_B(SB(0, 1), 1, t + 2);
    WAIT_V(6); BAR; MMA(1, 1, At, B1); BAR;
    LDB(B0, 1, 0); SCHED; LDA(At, 1, 0); STAGE_A(SA(0, 1), 1, t + 2);
    WAIT_L(8); BAR; WAIT_L(0); MMA(0, 0, At, B0); BAR; SCHED;
    LDB(B1, 1, 1); STAGE_B(SB(1, 0), 0, t + 3);
    BAR; WAIT_L(0); MMA(0, 1, At, B1); BAR;
    LDA(At, 1, 1); STAGE_A(SA(1, 0), 0, t + 3);
    BAR; WAIT_L(0); MMA(1, 0, At, B0); BAR; SCHED;
    STAGE_B(SB(1, 1), 1, t + 3);
    WAIT_V(6); BAR; MMA(1, 1, At, B1); BAR;
  }
  { LDB(B0, 0, 0); LDA(At, 0, 0); STAGE_A(SA(1, 1), 1, nt - 1);
    BAR; WAIT_L(0); MMA(0, 0, At, B0); BAR;
    LDB(B1, 0, 1); BAR; WAIT_L(0); MMA(0, 1, At, B1); BAR;
    LDA(At, 0, 1); WAIT_V(4); BAR; WAIT_L(0); MMA(1, 0, At, B0); MMA(1, 1, At, B1); BAR; }
  { LDB(B0, 1, 0); LDA(At, 1, 0); WAIT_V(2); BAR; WAIT_L(0); MMA(0, 0, At, B0); BAR;
    LDB(B1, 1, 1); WAIT_V(0); BAR; WAIT_L(0); MMA(0, 1, At, B1); BAR;
    LDA(At, 1, 1); BAR; WAIT_L(0); MMA(1, 0, At, B0); MMA(1, 1, At, B1); BAR; }
  if (wr == 0) BAR;
  epi(acc);
#undef SA
#undef SB
}

template <class F>
DI void epi_for(AccT& acc, F&& f) {
  const int TID = opaque_tid();
  const int _wid = TID >> 6, _lane = TID & 63, _wr = _wid >> 2, _wc = _wid & 3, _fr = _lane & 15, _fq = _lane >> 4;
#pragma unroll
  for (int _ai = 0; _ai < 2; ++_ai)
#pragma unroll
    for (int _bj = 0; _bj < 2; ++_bj)
#pragma unroll
      for (int _m = 0; _m < 4; ++_m)
#pragma unroll
        for (int _n = 0; _n < 2; ++_n)
          f(_ai * 128 + _wr * 64 + _m * 16 + _fq * 4, _bj * 128 + _wc * 32 + _n * 16 + _fr, acc[_ai][_bj][_m][_n]);
}

DI void tile_map(int w, int ntn, int& tm, int& tn) {
  int xcd = w & 7, r = w >> 3;
  tn = r % ntn; tm = (r / ntn) * 8 + xcd;
}

DI void transpose_tile(const float* __restrict__ src, int N, u16* __restrict__ dst, int K, int tk, int tn, const float* __restrict__ gain) {
  const int TID = opaque_tid();
  extern __shared__ __attribute__((aligned(16))) unsigned char smem[];
  float* tile = (float*)smem;
  const int t = TID;
  {
    int rk = t >> 3, cs = (t & 7) * 8;
    const float4* s = (const float4*)(src + (size_t)(tk * 64 + rk) * N + tn * 64 + cs);
    float4 a = s[0], b = s[1];
    if (gain) { const float gk = gain[tk * 64 + rk]; a.x *= gk; a.y *= gk; a.z *= gk; a.w *= gk; b.x *= gk; b.y *= gk; b.z *= gk; b.w *= gk; }
    float* d = tile + rk * 65 + cs;
    d[0] = a.x; d[1] = a.y; d[2] = a.z; d[3] = a.w; d[4] = b.x; d[5] = b.y; d[6] = b.z; d[7] = b.w;
  }
  __syncthreads();
  {
    int n = t >> 3, ks = (t & 7) * 8;
    u32x4 o;
    o[0] = pk2(tile[(ks + 0) * 65 + n], tile[(ks + 1) * 65 + n]);
    o[1] = pk2(tile[(ks + 2) * 65 + n], tile[(ks + 3) * 65 + n]);
    o[2] = pk2(tile[(ks + 4) * 65 + n], tile[(ks + 5) * 65 + n]);
    o[3] = pk2(tile[(ks + 6) * 65 + n], tile[(ks + 7) * 65 + n]);
    *(u32x4*)(dst + (size_t)(tn * 64 + n) * K + tk * 64 + ks) = o;
  }
  __syncthreads();
}

DI void phase_prep_a(const P& p) {
  const int TID = opaque_tid();
  const int bid = blockIdx.x, nb = gridDim.x;
  for (int w = bid; w < 7680; w += nb) {
    int layer = w / 3840, r = w % 3840;
    const float* src; u16* dst; int K, N, tl; const float* gain = nullptr;
    if (r < 1024) { src = p.in[3] + (size_t)layer * 1024 * 4096; dst = (u16*)(p.ws + WS_WT_IN) + (size_t)layer * 4096 * 1024; K = 1024; N = 4096; tl = r; gain = p.in[2] + layer * 1024; }
    else if (r < 1280) { src = p.in[6] + (size_t)layer * 1024 * 1024; dst = (u16*)(p.ws + WS_WT_AP) + (size_t)layer * 1024 * 1024; K = 1024; N = 1024; tl = r - 1024; }
    else if (r < 1408) { src = p.in[15] + (size_t)layer * 512 * 1024; dst = (u16*)(p.ws + WS_WT_GA) + (size_t)layer * 1024 * 512; K = 512; N = 1024; tl = r - 1280; }
    else if (r < 1536) { src = p.in[16] + (size_t)layer * 512 * 1024; dst = (u16*)(p.ws + WS_WT_GB) + (size_t)layer * 1024 * 512; K = 512; N = 1024; tl = r - 1408; }
    else if (r < 1792) { src = p.in[17] + (size_t)layer * 1024 * 1024; dst = (u16*)(p.ws + WS_WT_OUT) + (size_t)layer * 1024 * 1024; K = 1024; N = 1024; tl = r - 1536; }
    else if (r < 2816) { src = p.in[19] + (size_t)layer * 1024 * 4096; dst = (u16*)(p.ws + WS_WT_FF1) + (size_t)layer * 4096 * 1024; K = 1024; N = 4096; tl = r - 1792; gain = p.in[18] + layer * 1024; }
    else { src = p.in[20] + (size_t)layer * 4096 * 1024; dst = (u16*)(p.ws + WS_WT_FF2) + (size_t)layer * 1024 * 4096; K = 4096; N = 1024; tl = r - 2816; }
    int ntn = N / 64;
    transpose_tile(src, N, dst, K, tl / ntn, tl % ntn, gain);
  }
  const int gtid = bid * 512 + TID, nth = nb * 512;
  float2* LP = (float2*)(p.ws + WS_LPOW);
  float2* BB = (float2*)(p.ws + WS_BBAR);
  for (int idx = gtid; idx < 8192 * 33; idx += nth) {
    const int i = idx / 33, tau = idx - i * 33, lg = i >> 6;
    const double step = exp((double)p.in[9][lg]);
    const double zr = (double)p.in[7][i] * step, zi = (double)p.in[8][i] * step;
    double e = exp(zr * tau), sn, cs;
    sincos_d(zi * tau, &sn, &cs);
    LP[idx] = make_float2((float)(e * cs), (float)(e * sn));
  }
  for (int idx = gtid; idx < 8192 * 16; idx += nth) {
    const int i = idx >> 4, ci = idx & 15, lg = i >> 6;
    const double step = exp((double)p.in[9][lg]);
    const double lr = p.in[7][i], li = p.in[8][i];
    const double zr = lr * step, zi = li * step;
    double e = exp(zr), sn, cs;
    sincos_d(zi, &sn, &cs);
    const double nr = e * cs - 1.0, ni = e * sn, den = lr * lr + li * li;
    const double fr = (nr * lr + ni * li) / den, fi = (ni * lr - nr * li) / den;
    const double br = p.in[10][idx], bi = p.in[11][idx];
    BB[idx] = make_float2((float)(fr * br - fi * bi), (float)(fr * bi + fi * br));
  }
  float2* RP = (float2*)(p.ws + WS_ROPE);
  for (int i = gtid; i < 128 * 16; i += nth) {
    int pos = i >> 4, f = i & 15;
    double inv = exp(-(double)(2 * f) / 32.0 * 9.210340371976184);
    double sn, cs;
    sincos_d((double)pos * inv, &sn, &cs);
    RP[i] = make_float2((float)cs, (float)sn);
  }
}

DI void phase_prep_b(const P& p) {
  const int TID = opaque_tid();
  const int gtid = blockIdx.x * 512 + TID, nth = gridDim.x * 512;
  const float2* LP = (const float2*)(p.ws + WS_LPOW);
  const float2* BB = (const float2*)(p.ws + WS_BBAR);
  float* KT = (float*)(p.ws + WS_KTAB);
  const float* cre = p.in[12];
  const float* cim = p.in[13];
  {
    extern __shared__ __attribute__((aligned(16))) unsigned char smem[];
    float2* Cs = (float2*)smem;
    float2* Bs = Cs + 1024;
    float2* Ls = Bs + 1024;
    for (int item = blockIdx.x; item < 256; item += gridDim.x) {
      const int lg = item >> 1, th = item & 1;
      for (int e = TID; e < 1024; e += 512) {
        Cs[e] = make_float2(cre[(size_t)lg * 1024 + e], cim[(size_t)lg * 1024 + e]);
        Bs[e] = BB[(size_t)lg * 1024 + e];
        Ls[e] = LP[(size_t)(lg * 64 + (e >> 4)) * 33 + th * 16 + (e & 15)];
      }
      __syncthreads();
      const int co = (TID >> 4) & 15, ci = TID & 15, tsel = TID >> 8;
      float a8[8];
#pragma unroll
      for (int k = 0; k < 8; ++k) a8[k] = 0.f;
      for (int pp = 0; pp < 64; ++pp) {
        const float2 c = Cs[co * 64 + pp], b = Bs[pp * 16 + ci];
        const float zr = c.x * b.x - c.y * b.y, zi = c.x * b.y + c.y * b.x;
#pragma unroll
        for (int k = 0; k < 8; ++k) { const float2 l = Ls[pp * 16 + tsel + 2 * k]; a8[k] += zr * l.x - zi * l.y; }
      }
#pragma unroll
      for (int k = 0; k < 8; ++k) KT[(((size_t)lg * 32 + th * 16 + tsel + 2 * k) * 16 + co) * 16 + ci] = a8[k];
      __syncthreads();
    }
  }
  u16* W1 = (u16*)(p.ws + WS_W1T);
  for (int i8 = gtid; i8 < (1 << 20); i8 += nth) {
    const int i = i8 << 3;
    const int k = i & 511, n = (i >> 9) & 255, g = (i >> 17) & 31, layer = i >> 22;
    const int dir = n >> 7, pp = (n >> 1) & 63, ri = n & 1, sidx = k >> 4, ci0 = k & 15;
    const int e = dir ? sidx : 31 - sidx;
    const int lg = (layer * 2 + dir) * 32 + g;
    const float2 l = LP[(size_t)(lg * 64 + pp) * 33 + e];
    const float2* b = BB + (size_t)(lg * 64 + pp) * 16 + ci0;
    float v[8];
#pragma unroll
    for (int q = 0; q < 8; ++q) { const float2 bq = b[q]; v[q] = ri ? (l.x * bq.y + l.y * bq.x) : (l.x * bq.x - l.y * bq.y); }
    u32x4 o;
    o[0] = pk2(v[0], v[1]); o[1] = pk2(v[2], v[3]); o[2] = pk2(v[4], v[5]); o[3] = pk2(v[6], v[7]);
    *(u32x4*)(W1 + i) = o;
  }
  u16* WY = (u16*)(p.ws + WS_WYT);
  for (int i8 = gtid; i8 < (1 << 20); i8 += nth) {
    const int i = i8 << 3;
    const int kk = i & 255, n = (i >> 8) & 511, g = (i >> 17) & 31, layer = i >> 22;
    const int t = n >> 4, co = n & 15, dir = kk >> 7, pp0 = (kk >> 1) & 63;
    const int e = dir ? 32 - t : t + 1;
    const int lg = (layer * 2 + dir) * 32 + g;
    float v[8];
#pragma unroll
    for (int q = 0; q < 4; ++q) {
      const float cr = cre[(size_t)(lg * 16 + co) * 64 + pp0 + q], cI = cim[(size_t)(lg * 16 + co) * 64 + pp0 + q];
      const float2 l = LP[(size_t)(lg * 64 + pp0 + q) * 33 + e];
      v[2 * q] = cr * l.x - cI * l.y;
      v[2 * q + 1] = -(cr * l.y + cI * l.x);
    }
    u32x4 o;
    o[0] = pk2(v[0], v[1]); o[1] = pk2(v[2], v[3]); o[2] = pk2(v[4], v[5]); o[3] = pk2(v[6], v[7]);
    *(u32x4*)(WY + ((size_t)((layer * 32 + g) * 512 + n)) * ASTR + 512 + kk) = o;
  }
}

DI void phase_prep_c(const P& p) {
  const int TID = opaque_tid();
#if PROBE_MASK & 64
  {
    u32x4* dst = (u32x4*)(p.ws + WS_FF);
    u32x4 z; z[0] = 1; z[1] = 2; z[2] = 3; z[3] = 4;
    for (unsigned i = blockIdx.x * 512 + TID; i < 640u * 65536u; i += gridDim.x * 512) { z[0] = i * 2654435761u; z[1] = z[0] ^ (i << 7); z[2] = z[1] * 40503u + i; z[3] = z[2] ^ z[0]; dst[i] = z; }
  }
#endif
  const int gtid = blockIdx.x * 512 + TID, nth = gridDim.x * 512;
  const float* KT = (const float*)(p.ws + WS_KTAB);
  u16* WY = (u16*)(p.ws + WS_WYT);
  for (int i = gtid; i < (1 << 21); i += nth) {
    int k8 = i & 63, n = (i >> 6) & 511, g = (i >> 15) & 31, layer = i >> 20;
    int t = n >> 4, co = n & 15, s = k8 >> 1, ci0 = (k8 & 1) * 8;
    int tau = t - s;
    float v[8];
    if (tau > 0) {
      const float* q = KT + ((((size_t)(layer * 2 + 0) * 32 + g) * 32 + tau) * 16 + co) * 16 + ci0;
#pragma unroll
      for (int j = 0; j < 8; ++j) v[j] = q[j];
    } else if (tau < 0) {
      const float* q = KT + ((((size_t)(layer * 2 + 1) * 32 + g) * 32 - tau) * 16 + co) * 16 + ci0;
#pragma unroll
      for (int j = 0; j < 8; ++j) v[j] = q[j];
    } else {
      const float* q0 = KT + ((((size_t)(layer * 2 + 0) * 32 + g) * 32) * 16 + co) * 16 + ci0;
      const float* q1 = KT + ((((size_t)(layer * 2 + 1) * 32 + g) * 32) * 16 + co) * 16 + ci0;
#pragma unroll
      for (int j = 0; j < 8; ++j) v[j] = q0[j] + q1[j];
    }
    u32x4 o;
    o[0] = pk2(v[0], v[1]); o[1] = pk2(v[2], v[3]); o[2] = pk2(v[4], v[5]); o[3] = pk2(v[6], v[7]);
    *(u32x4*)(WY + ((size_t)((layer * 32 + g) * 512 + n)) * ASTR + k8 * 8) = o;
  }
}

DI const float* xrow(const P& p, int layer, int tok) {
  if (layer == 0) return tok < NTP ? p.in[0] + (size_t)tok * 1024 : p.in[1] + (size_t)(tok - NTP) * 1024;
  return p.out + (size_t)tok * 1024;
}
DI void phase_convert(const P& p, const float* __restrict__ src0, const float* __restrict__ src1) {
  const int TID = opaque_tid();
  const int lane = TID & 63, wave = TID >> 6;
  u16* XN = (u16*)(p.ws + WS_XN);
  float* SSQ = (float*)(p.ws + WS_SSQ);
  for (int tok = blockIdx.x * 8 + wave; tok < NT; tok += gridDim.x * 8) {
    const float* x = tok < NTP ? src0 + (size_t)tok * 1024 : src1 + (size_t)(tok - NTP) * 1024;
    float4 v[4];
    float ss = 0.f;
#pragma unroll
    for (int i = 0; i < 4; ++i) {
      v[i] = *(const float4*)(x + i * 256 + lane * 4);
      ss += v[i].x * v[i].x + v[i].y * v[i].y + v[i].z * v[i].z + v[i].w * v[i].w;
    }
#pragma unroll
    for (int o = 32; o >= 1; o >>= 1) ss += __shfl_xor(ss, o);
    if (lane < 4) SSQ[(size_t)lane * NT + tok] = lane == 0 ? ss : 0.f;
#pragma unroll
    for (int i = 0; i < 4; ++i) {
      u32x2 o;
      o[0] = pk2(v[i].x, v[i].y);
      o[1] = pk2(v[i].z, v[i].w);
      *(u32x2*)(XN + (size_t)tok * 1024 + i * 256 + lane * 4) = o;
    }
  }
}

DI void phase_scan(const P& p, int layer) {
  const int TID = opaque_tid();
  const int gtid = blockIdx.x * 512 + TID, nth = gridDim.x * 512;
  const float2* LP = (const float2*)(p.ws + WS_LPOW);
  for (int i = gtid; i < 18 * 4096; i += nth) {
    int pp = i & 63, dir = (i >> 6) & 1, g = (i >> 7) & 31, seq = i >> 12;
    int c0 = seq < 16 ? seq * 128 : 2048 + (seq - 16) * 256;
    int nc = seq < 16 ? 128 : 256;
    float2 a = LP[(size_t)(((layer * 2 + dir) * 32 + g) * 64 + pp) * 33 + 32];
    const float2* S = (const float2*)(p.ws + WS_S) + ((size_t)(g * NCH + c0) * 256 + dir * 128 + pp * 2) / 2;
    unsigned* H = (unsigned*)((u16*)(p.ws + WS_ASSM) + (size_t)(g * NCH + c0) * ASTR + 512 + dir * 128 + pp * 2);
    float hr = 0.f, hi = 0.f;
    for (int cb = 0; cb < nc; cb += 16) {
      float2 sv[16];
#pragma unroll
      for (int k = 0; k < 16; ++k) {
        const int c = dir == 0 ? cb + k : nc - 1 - cb - k;
        sv[k] = S[(size_t)c * 128];
      }
#pragma unroll
      for (int k = 0; k < 16; ++k) {
        const int c = dir == 0 ? cb + k : nc - 1 - cb - k;
        H[(size_t)c * (ASTR / 2)] = pk2(hr, hi);
        const float nr = a.x * hr - a.y * hi + sv[k].x;
        hi = a.x * hi + a.y * hr + sv[k].y;
        hr = nr;
      }
    }
  }
}

#define MFMA32(a, b, c) __builtin_amdgcn_mfma_f32_32x32x16_bf16((a), (b), (c), 0, 0, 0)
DI void attn_item(const P& pin, int layer, int seq_start, int L, int head, int qb) {
  const int TID = opaque_tid();
  struct { unsigned char* ws; } p;
  p.ws = pin.ws;
  asm volatile("" : "+s"(p.ws));
  extern __shared__ __attribute__((aligned(16))) unsigned char smem[];
  const u16* Q = (const u16*)(p.ws + WS_Q);
  const u16* KB = (const u16*)(p.ws + WS_K);
  const u16* VT = (const u16*)(p.ws + WS_VT);
  const int tid = TID, wave = tid >> 6, lane = tid & 63, r = lane & 31, h = lane >> 5;
  const int kvh = head >> 2;
  const int q0 = seq_start + qb * 512 + wave * 64;
  bf16x8 qf[2][4];
#pragma unroll
  for (int nt = 0; nt < 2; ++nt)
#pragma unroll
    for (int ds = 0; ds < 4; ++ds)
      qf[nt][ds] = gld<bf16x8>(Q + (size_t)(q0 + nt * 32 + r) * 1024 + head * 64 + ds * 16 + h * 8);
#pragma unroll
  for (int nt = 0; nt < 2; ++nt)
#pragma unroll
    for (int ds = 0; ds < 4; ++ds) asm volatile("" ::"v"(qf[nt][ds]));
  bool no_check;
  {
    float gq = fabsf(pin.in[4][layer * 64 + lane]), gk = fabsf(pin.in[5][layer * 64 + lane]);
#pragma unroll
    for (int o = 32; o >= 1; o >>= 1) { gq = fmaxf(gq, __shfl_xor(gq, o)); gk = fmaxf(gk, __shfl_xor(gk, o)); }
    no_check = __builtin_amdgcn_readfirstlane(11.5416f * 1.01f * gq * gk <= 15.5f ? 1 : 0) != 0;
  }
  const int srow = tid >> 3, spos = tid & 7, scc = spos ^ ((srow >> 1) & 7);
  const u16* kg = KB + ((size_t)kvh * NT + seq_start + srow) * 64 + scc * 8;
  const u16* vg = VT + (size_t)(kvh * 64 + srow) * NT + seq_start + scc * 8;
  unsigned char* ldst = smem + tid * 16;
  const int nkt = L >> 6;
  const int pr = ((r >> 4) * 16) + (((r >> 2) & 1) * 8) + (((r >> 3) & 1) * 4) + (r & 3);
  int koff[4];
#pragma unroll
  for (int ds = 0; ds < 4; ++ds) koff[ds] = pr * 128 + (((ds * 2 + h) ^ ((pr >> 1) & 7)) << 4);
  const int vxh = ((r >> 1) & 7) >> 1;
  const int vbase = 8192 + r * 128 + ((h ^ ((r >> 1) & 1)) << 4);

  f32x16 o[2][2];
#pragma unroll
  for (int a = 0; a < 2; ++a)
#pragma unroll
    for (int b = 0; b < 2; ++b)
#pragma unroll
      for (int j = 0; j < 16; ++j) o[a][b][j] = 0.f;
  float mrun[2] = {0.f, 0.f}, lrun[2] = {0.f, 0.f};


#define ATT_STAGE(T, B) do { GLDS(kg + (size_t)(T) * 128 * 64, ldst + (B) * 32768); GLDS(vg + (T) * 128, ldst + (B) * 32768 + 8192); \
    GLDS(kg + (size_t)(T) * 128 * 64 + 64 * 64, ldst + (B) * 32768 + 16384); GLDS(vg + (T) * 128 + 64, ldst + (B) * 32768 + 16384 + 8192); } while (0)
  const int nst = nkt >> 1;
  ATT_STAGE(0, 0);
  ATT_STAGE(1, 1);
  int bcur = 0;
  for (int st = 0; st < nst; ++st) {
    if (st + 1 < nst) { WAIT_V(4); } else { WAIT_V(0); }
    BAR;
    if (st + 2 < nst) {
      int bn = bcur + 2; if (bn >= 3) bn -= 3;
      ATT_STAGE(st + 2, bn);
    }
    const unsigned char* sbase = smem + bcur * 32768;
    auto qk = [&](const int hx, f32x16 (&sc)[2]) {
      const unsigned char* kb = sbase + (hx >> 1) * 16384 + (hx & 1) * 4096;
      bf16x8 kf[4];
#pragma unroll
      for (int ds = 0; ds < 4; ++ds) kf[ds] = *(const bf16x8*)(kb + koff[ds]);
#pragma unroll
      for (int nt = 0; nt < 2; ++nt)
#pragma unroll
        for (int j = 0; j < 16; ++j) sc[nt][j] = -mrun[nt];
#pragma unroll
      for (int ds = 0; ds < 4; ++ds)
#pragma unroll
        for (int nt = 0; nt < 2; ++nt) sc[nt] = MFMA32(kf[ds], qf[nt][ds], sc[nt]);
    };
    auto sm_pv = [&](const int hx, f32x16 (&sc)[2], f32x16 (&pend)[2], const bool has_pend) {
      const bool chk = !no_check;
      const unsigned char* kb = sbase + (hx >> 1) * 16384;
      const int kt = hx & 1;
      bf16x8 vf[2][2];
#pragma unroll
      for (int s2 = 0; s2 < 2; ++s2)
#pragma unroll
        for (int mt = 0; mt < 2; ++mt) vf[s2][mt] = *(const bf16x8*)(kb + vbase + (((kt * 2 + s2) ^ vxh) << 5) + mt * 4096);
      float mx[2] = {0.f, 0.f};
      if (chk) {
#pragma unroll
        for (int nt = 0; nt < 2; ++nt) {
          float m0 = sc[nt][0];
#pragma unroll
          for (int j = 1; j < 16; ++j) m0 = fmaxf(m0, sc[nt][j]);
          mx[nt] = m0;
        }
      }
      if (chk && __any((fabsf(mx[0]) > 16.0f) | (fabsf(mx[1]) > 16.0f))) {
#pragma unroll
        for (int nt = 0; nt < 2; ++nt) {
          const float mp = fmaxf(mx[nt], __shfl_xor(mx[nt], 32));
          const float dm = (fabsf(mp) > 12.0f) ? mp : 0.0f;
          const float alpha = __builtin_amdgcn_exp2f(-dm);
          mrun[nt] += dm;
          lrun[nt] *= alpha;
#pragma unroll
          for (int j = 0; j < 16; ++j) sc[nt][j] -= dm;
          if (has_pend) {
#pragma unroll
            for (int j = 0; j < 16; ++j) pend[nt][j] -= dm;
          }
#pragma unroll
          for (int mt = 0; mt < 2; ++mt)
#pragma unroll
            for (int j = 0; j < 16; ++j) o[mt][nt][j] *= alpha;
        }
      }
#pragma unroll
      for (int nt = 0; nt < 2; ++nt) {
        float sum = 0.f;
#pragma unroll
        for (int j = 0; j < 16; ++j) { float pv = __builtin_amdgcn_exp2f(sc[nt][j]); sc[nt][j] = pv; sum += pv; }
        lrun[nt] += sum;
      }
#pragma unroll
      for (int s2 = 0; s2 < 2; ++s2) {
        bf16x8 pf[2];
#pragma unroll
        for (int nt = 0; nt < 2; ++nt) {
          u32x4 pk;
#pragma unroll
          for (int i = 0; i < 4; ++i) pk[i] = pk2(sc[nt][s2 * 8 + 2 * i], sc[nt][s2 * 8 + 2 * i + 1]);
          pf[nt] = __builtin_bit_cast(bf16x8, pk);
        }
#pragma unroll
        for (int mt = 0; mt < 2; ++mt)
#pragma unroll
          for (int nt = 0; nt < 2; ++nt) o[mt][nt] = MFMA32(vf[s2][mt], pf[nt], o[mt][nt]);
      }
    };
    f32x16 sa[2], sb[2];
    qk(0, sa);
    qk(1, sb); sm_pv(0, sa, sb, true);
    qk(2, sa); sm_pv(1, sb, sa, true);
    qk(3, sb); sm_pv(2, sa, sb, true);
    sm_pv(3, sb, sa, false);
    bcur = bcur + 1; if (bcur >= 3) bcur = 0;
  }
  unsigned char* ws2 = pin.ws;
  asm volatile("" : "+s"(ws2));
  u16* O = (u16*)(ws2 + WS_ATTO);
  const int tid2 = opaque_tid();
  const int r2 = tid2 & 31, h2 = (tid2 >> 5) & 1;
  const int q0b = seq_start + qb * 512 + (tid2 >> 6) * 64;
#pragma unroll
  for (int nt = 0; nt < 2; ++nt) {
    float l = lrun[nt] + __shfl_xor(lrun[nt], 32);
    float inv = 1.0f / l;
    const int tok = q0b + nt * 32 + r2;
#pragma unroll
    for (int mt = 0; mt < 2; ++mt)
#pragma unroll
      for (int jg = 0; jg < 4; ++jg) {
        u32x2 ov;
        ov[0] = pk2(o[mt][nt][jg * 4 + 0] * inv, o[mt][nt][jg * 4 + 1] * inv);
        ov[1] = pk2(o[mt][nt][jg * 4 + 2] * inv, o[mt][nt][jg * 4 + 3] * inv);
        gst<u32x2>(O + (size_t)tok * 1024 + head * 64 + mt * 32 + jg * 8 + h2 * 4, ov);
      }
  }
  WAIT_L(0);
  BAR;
}


enum { EK_Q = 0, EK_K, EK_V, EK_U, EK_S, EK_Y, EK_M0, EK_M1, EK_M2, EK_M3, EK_M4, EK_OUT, EK_FF1, EK_FF2 };
struct Job {
  const u16* A; const u16* Bt;
  int lda, ldb, gsB, tmB, K, kind, tm, tn, layer;
};

DI void stage_acc(AccT& acc, unsigned char* smem, const int tid, const int linear = 0) {
  const int wid = tid >> 6, lane = tid & 63, wr = wid >> 2, wc = wid & 3, fr = lane & 15, fq = lane >> 4;
#if PROBE_MASK
  if (linear) {
    int k = 0;
#pragma unroll
    for (int ai = 0; ai < 2; ++ai)
#pragma unroll
      for (int bj = 0; bj < 2; ++bj)
#pragma unroll
        for (int m = 0; m < 4; ++m)
#pragma unroll
          for (int n = 0; n < 2; ++n) {
            u32x2 w;
            w[0] = pk2(acc[ai][bj][m][n][0], acc[ai][bj][m][n][1]);
            w[1] = pk2(acc[ai][bj][m][n][2], acc[ai][bj][m][n][3]);
            *(u32x2*)(smem + tid * 8 + k * 4096) = w;
            ++k;
          }
    return;
  }
#endif
#pragma unroll
  for (int ai = 0; ai < 2; ++ai)
#pragma unroll
    for (int bj = 0; bj < 2; ++bj)
#pragma unroll
      for (int m = 0; m < 4; ++m)
#pragma unroll
        for (int n = 0; n < 2; ++n) {
          const int col = bj * 128 + wc * 32 + n * 16 + fr;
          const int row0 = ai * 128 + wr * 64 + m * 16 + fq * 4;
          u32x2 w;
          w[0] = pk2(acc[ai][bj][m][n][0], acc[ai][bj][m][n][1]);
          w[1] = pk2(acc[ai][bj][m][n][2], acc[ai][bj][m][n][3]);
          *(u32x2*)(smem + col * 512 + (((row0 >> 3) ^ (col & 31)) << 4) + ((row0 & 4) << 1)) = w;
        }
}
DI void unpack8(const u32x4 u, float* f) {
#pragma unroll
  for (int i = 0; i < 4; ++i) { f[2 * i] = __uint_as_float(u[i] << 16); f[2 * i + 1] = __uint_as_float(u[i] & 0xffff0000u); }
}
DI u32x4 pack8(const float* f) {
  u32x4 o;
#pragma unroll
  for (int i = 0; i < 4; ++i) o[i] = pk2(f[2 * i], f[2 * i + 1]);
  return o;
}

DI float tok_rstd(const unsigned char* ws, int tok) {
  const float* q = (const float*)(ws + WS_SSQ) + tok;
  return rsqrtf((q[0] + q[NT] + q[2 * NT] + q[3 * (size_t)NT]) * (1.0f / 1024.0f) + 1e-6f);
}
DI void run_epilogue(const P& pin, const Job& jb, AccT& acc) {
  extern __shared__ __attribute__((aligned(16))) unsigned char smem[];
  const int TID = opaque_tid();
  P p = pin;
  asm volatile("" : "+s"(p.ws), "+s"(p.out));
  const int tm = jb.tm, tn = jb.tn, layer = jb.layer & 255, kind = jb.kind;
  const int nit = (jb.layer & 256) ? 8 : (jb.layer & 512) ? 1 : (jb.layer & 1024) ? 0 : 16;
#if PROBE_MASK
  if (kind == -1) return;
  if (kind == -3) {
    u32x4 z; z[0] = acc[0][0][0][0][0] > 1e30f ? 1u : 0u; z[1] = 2; z[2] = 3; z[3] = 4;
    for (int it = 0; it < 16; ++it) {
      const int q = it * 512 + TID;
      *(u32x4*)((u16*)(p.ws + WS_FF) + (size_t)(tn * 256 + (q >> 5)) * 4096 + tm * 256 + (q & 31) * 8) = z;
    }
    return;
  }
#endif
  if (kind == EK_S) {
    float* Sg = (float*)(p.ws + WS_S) + (size_t)tn * 256 * 256;
    epi_for(acc, [&](const int row0, const int col, const f32x4 v) { *(f32x4*)(Sg + (size_t)col * 256 + row0) = v; });
    return;
  }
#if PROBE_MASK
  if (jb.layer & 16384) { if (acc[1][1][3][1][3] == 12345.678f) smem[TID] = 1; }
  if (!(jb.layer & 2048))
  for (int rep = (jb.layer & 8192) ? 4 : 1; rep > 0; --rep)
#endif
  stage_acc(acc, smem, TID, (jb.layer & 4096) ? 1 : 0);
  float* lrs = (float*)(smem + 131072);
  if ((kind <= EK_U || kind == EK_M2 || kind == EK_M3 || kind == EK_FF1) && TID < 256) lrs[TID] = tok_rstd(p.ws, tn * 256 + TID);
  __syncthreads();
  const bool two_pass = kind == EK_Q || kind == EK_K || kind == EK_Y || kind == EK_M1 || kind == EK_M2 || kind == EK_M4;
  if (two_pass) {
    auto slot_of = [&](const int it, int& col, int& c) -> unsigned char* {
      const int q = it * 512 + TID;
      col = q >> 5; c = q & 31;
      return smem + col * 512 + ((c ^ (col & 31)) << 4);
    };
    if (kind == EK_M1 || kind == EK_M2 || kind == EK_M4) {
      const u16* T1 = (const u16*)(p.ws + WS_Q) + (size_t)(tn * 256) * 1024 + tm * 256;
      const u16* T2 = (const u16*)(p.ws + WS_ASSM) + (size_t)(tn * 256) * 1024 + tm * 256;
      if (kind == EK_M1) {
#pragma unroll 8
        for (int it = 0; it < 16; ++it) {
          int col, c; unsigned char* sl = slot_of(it, col, c);
          float f[8], a[8], r[8];
          unpack8(gld<u32x4>(T1 + (size_t)col * 1024 + c * 8), a);
          unpack8(*(const u32x4*)sl, f);
#pragma unroll
          for (int i = 0; i < 8; ++i) r[i] = f[i] * a[i];
          *(u32x4*)sl = pack8(r);
        }
      } else if (kind == EK_M2) {
#pragma unroll 8
        for (int it = 0; it < 16; ++it) {
          int col, c; unsigned char* sl = slot_of(it, col, c);
          float f[8], a[8], r[8];
          unpack8(gld<u32x4>(T1 + (size_t)col * 1024 + c * 8), a);
          unpack8(*(const u32x4*)sl, f);
          const float tr = lrs[col];
#pragma unroll
          for (int i = 0; i < 8; ++i) r[i] = sigmoidf_(f[i] * tr) * a[i];
          *(u32x4*)sl = pack8(r);
        }
      } else {
#pragma unroll 8
        for (int it = 0; it < 16; ++it) {
          int col, c; unsigned char* sl = slot_of(it, col, c);
          float f[8], a[8], b[8], r[8];
          unpack8(gld<u32x4>(T1 + (size_t)col * 1024 + c * 8), a);
          unpack8(gld<u32x4>(T2 + (size_t)col * 1024 + c * 8), b);
          unpack8(*(const u32x4*)sl, f);
#pragma unroll
          for (int i = 0; i < 8; ++i) r[i] = b[i] * f[i] + a[i];
          *(u32x4*)sl = pack8(r);
        }
      }
    } else if (kind == EK_Y) {
      const int g = tn / 10, ch0 = (tn % 10) * 256;
      const float* dsk = p.in[14] + layer * 512 + g * 16 + (TID & 1) * 8;
      const f32x4 d0 = *(const f32x4*)dsk, d1 = *(const f32x4*)(dsk + 4);
      const u16* UU = (const u16*)(p.ws + WS_ASSM) + ((size_t)g * NCH + ch0) * ASTR + tm * 256;
#pragma unroll 8
      for (int it = 0; it < 16; ++it) {
        int col, c; unsigned char* sl = slot_of(it, col, c);
        float f[8], u[8], r[8];
        unpack8(gld<u32x4>(UU + (size_t)col * ASTR + c * 8), u);
        unpack8(*(const u32x4*)sl, f);
#pragma unroll
        for (int i = 0; i < 4; ++i) { r[i] = gelu_tanh(f[i] + d0[i] * u[i]); r[4 + i] = gelu_tanh(f[4 + i] + d1[i] * u[4 + i]); }
        *(u32x4*)sl = pack8(r);
      }
    } else {
      const float* gn = (kind == EK_Q ? p.in[4] : p.in[5]) + layer * 64 + (TID & 7) * 8;
      const f32x4 g0 = *(const f32x4*)gn, g1 = *(const f32x4*)(gn + 4);
      const float qs = (kind == EK_Q) ? 0.125f * 1.4426950408889634f : 1.0f;
      const int i0 = (TID & 7) * 4;
#pragma unroll 4
      for (int it = 0; it < 16; ++it) {
        int col, c; unsigned char* sl = slot_of(it, col, c);
        const int tok = tn * 256 + col;
        const int pos = tok < NTP ? (tok & 4095) : ((tok - NTP) & 8191);
        const float* rp = (const float*)(p.ws + WS_ROPE) + 2 * ((i0 < 16) ? (pos >> 6) * 16 + i0 : (pos & 63) * 16 + i0 - 16);
        const f32x4 cs0 = gld<f32x4>(rp), cs1 = gld<f32x4>(rp + 4);
        float f[8], r[8];
        unpack8(*(const u32x4*)sl, f);
        const float tr = lrs[col];
        float ss = 0.f;
#pragma unroll
        for (int i = 0; i < 8; ++i) { f[i] *= tr; ss += f[i] * f[i]; }
        ss += __shfl_xor(ss, 1); ss += __shfl_xor(ss, 2); ss += __shfl_xor(ss, 4);
        const float rstd = rsqrtf(ss * (1.0f / 64.0f) + 1e-6f) * qs;
        const float x0 = f[0] * rstd * g0[0], x1 = f[1] * rstd * g0[1], x2 = f[2] * rstd * g0[2], x3 = f[3] * rstd * g0[3];
        const float x4 = f[4] * rstd * g1[0], x5 = f[5] * rstd * g1[1], x6 = f[6] * rstd * g1[2], x7 = f[7] * rstd * g1[3];
        r[0] = x0 * cs0[0] - x1 * cs0[1]; r[1] = x0 * cs0[1] + x1 * cs0[0];
        r[2] = x2 * cs0[2] - x3 * cs0[3]; r[3] = x2 * cs0[3] + x3 * cs0[2];
        r[4] = x4 * cs1[0] - x5 * cs1[1]; r[5] = x4 * cs1[1] + x5 * cs1[0];
        r[6] = x6 * cs1[2] - x7 * cs1[3]; r[7] = x6 * cs1[3] + x7 * cs1[2];
        *(u32x4*)sl = pack8(r);
      }
    }
#pragma unroll 4
    for (int it = 0; it < 16; ++it) {
      int col, c; unsigned char* sl = slot_of(it, col, c);
      const u32x4 v = *(const u32x4*)sl;
      u16* dst;
      if (kind == EK_Q) dst = (u16*)(p.ws + WS_Q) + (size_t)(tn * 256 + col) * 1024 + (tm * 4 + (c >> 3)) * 64 + (c & 7) * 8;
      else if (kind == EK_K) dst = (u16*)(p.ws + WS_K) + ((size_t)(c >> 3) * NT + tn * 256 + col) * 64 + (c & 7) * 8;
      else if (kind == EK_Y) dst = (u16*)(p.ws + WS_Y) + (size_t)(tn / 10) * NT * 16 + (size_t)((tn % 10) * 256 + col) * 512 + tm * 256 + c * 8;
      else dst = (u16*)(p.ws + WS_Q) + (size_t)(tn * 256 + col) * 1024 + tm * 256 + c * 8;
      gst<u32x4>(dst, v);
    }
    __syncthreads();
    return;
  }
  if (kind == EK_OUT || kind == EK_FF2) {
    const int cc = tm * 256 + (TID & 31) * 8;
#pragma unroll 1
    for (int it0 = 0; it0 < 16; it0 += 4) {
      f32x4 X0[4], X1[4];
#pragma unroll
      for (int k = 0; k < 4; ++k) {
        const int tok = tn * 256 + (((it0 + k) * 512 + TID) >> 5);
        const float* x = (kind == EK_OUT) ? xrow(p, layer, tok) + cc : p.out + (size_t)tok * 1024 + cc;
        X0[k] = gld<f32x4>(x); X1[k] = gld<f32x4>(x + 4);
      }
#pragma unroll
      for (int k = 0; k < 4; ++k) {
        const int q = (it0 + k) * 512 + TID;
        const int col = q >> 5, c = q & 31;
        const int tok = tn * 256 + col;
        float f[8], r[8];
        unpack8(*(const u32x4*)(smem + col * 512 + ((c ^ (col & 31)) << 4)), f);
        float* o = p.out + (size_t)tok * 1024 + cc;
        f32x4 o0, o1;
        float ss = 0.f;
#pragma unroll
        for (int i = 0; i < 4; ++i) { o0[i] = X0[k][i] + f[i]; o1[i] = X1[k][i] + f[4 + i]; r[i] = o0[i]; r[4 + i] = o1[i]; ss += o0[i] * o0[i] + o1[i] * o1[i]; }
        gst<f32x4>(o, o0); gst<f32x4>(o + 4, o1);
        gst<u32x4>((u16*)(p.ws + WS_XN) + (size_t)tok * 1024 + cc, pack8(r));
        ss += __shfl_xor(ss, 1); ss += __shfl_xor(ss, 2); ss += __shfl_xor(ss, 4); ss += __shfl_xor(ss, 8); ss += __shfl_xor(ss, 16);
        if (c == 0) ((float*)(p.ws + WS_SSQ))[(size_t)tm * NT + tok] = ss;
      }
    }
    __syncthreads();
    return;
  }
#pragma unroll 2
  for (int it = 0; it < nit; ++it) {
    const int q = it * 512 + TID;
    int col = q >> 5, c = q & 31;
    if (kind == EK_U) { col = (q >> 1) & 255; c = ((q >> 9) << 1) | (q & 1); }
    const u32x4 sv = *(const u32x4*)(smem + col * 512 + ((c ^ (col & 31)) << 4));
    float f[8], r[8];
    unpack8(sv, f);
#if PROBE_MASK
    if (kind == -2) { if (f[0] > 1e30f) *(u32x4*)(p.ws + WS_FF) = sv; continue; }
#endif
    switch (kind) {
      case EK_V: {
        {
          const int tok0 = tn * 256 + c * 8;
#pragma unroll
          for (int i = 0; i < 8; ++i) r[i] = f[i] * lrs[c * 8 + i];
          gst<u32x4>((u16*)(p.ws + WS_VT) + (size_t)col * NT + tok0, pack8(r));
        }
      } break;
      case EK_U: {
        const int tok = tn * 256 + col, g = (tm - 6) * 16 + (c >> 1);
        const float tr = lrs[col];
#pragma unroll
        for (int i = 0; i < 8; ++i) r[i] = f[i] * tr;
        gst<u32x4>((u16*)(p.ws + WS_ASSM) + ((size_t)g * NCH + (tok >> 5)) * ASTR + (tok & 31) * 16 + (c & 1) * 8, pack8(r));
      } break;
      case EK_M0: case EK_M3: {
        const size_t o = (size_t)(tn * 256 + col) * 1024 + tm * 256 + c * 8;
        const float tr = (kind == EK_M3) ? lrs[col] : 1.0f;
#pragma unroll
        for (int i = 0; i < 8; ++i) r[i] = sigmoidf_(f[i] * tr);
        gst<u32x4>((kind == EK_M3 ? (u16*)(p.ws + WS_ASSM) : (u16*)(p.ws + WS_Q)) + o, pack8(r));
      } break;
      case EK_FF1: {
        const float tr = lrs[col];
#pragma unroll
        for (int i = 0; i < 8; ++i) { const float a = fmaxf(f[i] * tr, 0.f); r[i] = a * a; }
        gst<u32x4>((u16*)(p.ws + WS_FF) + ((size_t)(tn * 16 + tm) << 16) + col * 256 + c * 8, pack8(r));
      } break;
    }
  }
  __syncthreads();
}

DI void make_job(const P& pin, int layer, int s, int w, int step, Job& jb) {
  struct { unsigned char* ws; } p;
  p.ws = pin.ws;
  asm volatile("" : "+s"(p.ws));
  const u16* XN = (const u16*)(p.ws + WS_XN);
  jb.layer = layer; jb.gsB = 16; jb.tmB = 0;
  if (s == 1) {
    int g = w / 10;
    jb.A = (const u16*)(p.ws + WS_W1T) + ((size_t)layer * 32 + g) * 256 * 512;
    jb.Bt = (const u16*)(p.ws + WS_ASSM) + (size_t)w * 256 * ASTR;
    jb.lda = 512; jb.ldb = ASTR; jb.K = 512; jb.kind = EK_S; jb.tm = 0; jb.tn = w;
    return;
  }
  if (s == 3) {
    int gc = w >> 1, rt = w & 1, g = gc / 10;
    jb.A = (const u16*)(p.ws + WS_WYT) + (((size_t)layer * 32 + g) * 512 + rt * 256) * ASTR;
    jb.Bt = (const u16*)(p.ws + WS_ASSM) + (size_t)gc * 256 * ASTR;
    jb.lda = ASTR; jb.ldb = ASTR; jb.K = ASTR; jb.kind = EK_Y; jb.tm = rt; jb.tn = gc;
    return;
  }
  const int nft = (s == 0) ? 8 : (s == 6) ? 16 : 4;
  int tt, ft; tile_map(w, nft, tt, ft);
  jb.tm = ft; jb.tn = tt;
  jb.lda = 1024; jb.ldb = 1024; jb.K = 1024;
  if (s == 0) {
    const u16* W = (const u16*)(p.ws + WS_WT_IN) + (size_t)layer * 4096 * 1024 + (size_t)ft * 256 * 1024;
    const u16* X = XN + (size_t)tt * 256 * 1024;
    if (ft == 5) { jb.A = X; jb.Bt = W; jb.kind = EK_V; }
    else { jb.A = W; jb.Bt = X; jb.kind = ft < 4 ? EK_Q : ft == 4 ? EK_K : EK_U; }
  } else if (s == 4) {
    jb.kind = EK_M0 + step;
    if (step < 2) {
      jb.A = (const u16*)(p.ws + (step == 0 ? WS_WT_GB : WS_WT_GA)) + (size_t)layer * 1024 * 512 + (size_t)ft * 256 * 512;
      jb.Bt = (const u16*)(p.ws + WS_Y) + (size_t)tt * 256 * 16;
      jb.lda = 512; jb.ldb = 16; jb.gsB = NT * 16; jb.K = 512;
    } else if (step < 4) {
      jb.A = (const u16*)(p.ws + WS_WT_IN) + (size_t)layer * 4096 * 1024 + (size_t)((step == 2 ? 3072 : 2048) + ft * 256) * 1024;
      jb.Bt = XN + (size_t)tt * 256 * 1024;
    } else {
      jb.A = (const u16*)(p.ws + WS_WT_AP) + (size_t)layer * 1024 * 1024 + (size_t)ft * 256 * 1024;
      jb.Bt = (const u16*)(p.ws + WS_ATTO) + (size_t)tt * 256 * 1024;
    }
  } else if (s == 5) {
    jb.A = (const u16*)(p.ws + WS_WT_OUT) + (size_t)layer * 1024 * 1024 + (size_t)ft * 256 * 1024;
    jb.Bt = (const u16*)(p.ws + WS_Q) + (size_t)tt * 256 * 1024; jb.kind = EK_OUT;
  } else if (s == 6) {
    jb.A = (const u16*)(p.ws + WS_WT_FF1) + (size_t)layer * 4096 * 1024 + (size_t)ft * 256 * 1024;
    jb.Bt = XN + (size_t)tt * 256 * 1024; jb.kind = EK_FF1;
  } else {
    jb.A = (const u16*)(p.ws + WS_WT_FF2) + (size_t)layer * 1024 * 4096 + (size_t)ft * 256 * 4096;
    jb.Bt = (const u16*)(p.ws + WS_FF) + ((size_t)tt * 16 << 16);
    jb.lda = 4096; jb.ldb = 256; jb.tmB = 1; jb.K = 4096; jb.kind = EK_FF2;
  }
}

DI void phase_jobs(const P& p, int layer, int s, int probe = 0) {
  int nitems, nsteps = 1, nattn = 0;
  switch (s) {
    case 0: nitems = 2560; break;
    case 1: nitems = 320; break;
    case 3: nitems = 3200; nattn = 2560; break;
    case 4: nitems = 1280; nsteps = 5; break;
    case 5: nitems = 1280; break;
    case 6: nitems = 5120; break;
    default: nitems = 1280; break;
  }
#if STAGGER_SLEEP
  if (s != 3) {
    const int slot = (blockIdx.x >> 3) & 31;
    for (int i = 0; i < slot; ++i) __builtin_amdgcn_s_sleep(STAGGER_SLEEP);
  }
#endif
  for (int w = blockIdx.x; w < nitems; w += gridDim.x) {
    if (w < nattn) {
      int seq_start, L, head, qb;
      if (w < 512) {
        int xcd = w & 7, r = w >> 3;
        int seq = xcd >> 2, kvh = xcd & 3;
        seq_start = NTP + seq * 8192; L = 8192; head = kvh * 4 + (r >> 4); qb = r & 15;
      } else {
        int w2 = w - 512, xcd = w2 & 7, r = w2 >> 3;
        int grp = (r >> 5) * 8 + xcd, within = r & 31;
        int seq = grp >> 2, kvh = grp & 3;
        seq_start = seq * 4096; L = 4096; head = kvh * 4 + (within >> 3); qb = within & 7;
      }
      attn_item(p, layer, seq_start, L, head, qb);
    } else {
      for (int step = 0; step < nsteps; ++step) {
        Job jb;
        make_job(p, layer, s, w - nattn, step, jb);
#if PROBE_MASK
        if (probe == 2 || probe == 3) jb.kind = -1;
        if (probe == 3) jb.K = jb.K / 2;
#endif
        gemm_tile(jb.A, jb.Bt, jb.lda, jb.ldb, jb.gsB, jb.tmB, jb.K, [&](AccT& acc) {
          int w2 = w - nattn, st2 = step;
          asm volatile("" : "+s"(w2), "+s"(st2));
          Job j2;
          make_job(p, layer, s, w2, st2, j2);
#if PROBE_MASK
          if (probe == 2 || probe == 3) j2.kind = -1;
          if (probe == 4) j2.kind = -2;
          if (probe == 6) j2.layer |= 256;
          if (probe == 7) j2.layer |= 512;
          if (probe == 8) j2.layer |= 1024 | 2048;
          if (probe == 9) j2.layer |= 1024;
          if (probe == 10) j2.layer |= 1024 | 4096;
          if (probe == 11) j2.layer |= 1024 | 8192;
          if (probe == 12) j2.layer |= 1024 | 2048 | 16384;
          if (probe == 5) j2.kind = -3;
#endif
          run_epilogue(p, j2, acc);
        });
      }
    }
  }
}

DI void run_phase(const P& pin, int ph, int probe = 0) {
  P p = pin;
  asm volatile("" : "+s"(p.ws), "+s"(p.out));
  int layer = (ph - 3) / 8, s = (ph - 3) % 8;
  if (s == 2) phase_scan(p, layer);
  else phase_jobs(p, layer, s, probe);
}

__global__ void __launch_bounds__(512, 2) mega_coop(P p) {
  cg::grid_group grid = cg::this_grid();
  phase_prep_a(p);
  grid.sync();
  phase_prep_b(p);
  grid.sync();
  phase_prep_c(p);
  phase_convert(p, p.in[0], p.in[1]);
  grid.sync();
  for (int ph = 3; ph < NPHASE; ++ph) {
    run_phase(p, ph);
#if PROBE_MASK
    {
      const int s_ = (ph - 3) % 8;
      bool rep = false;
      if ((PROBE_MASK & 1) && s_ == 3) rep = true;
      if ((PROBE_MASK & 2) && (s_ == 0 || s_ == 4 || s_ == 6)) rep = true;
      if ((PROBE_MASK & 4) && (s_ == 1 || s_ == 2)) rep = true;
      if ((PROBE_MASK & 8) && s_ == 6) run_phase(p, ph, (PROBE_MASK >> 4));
      if (rep) run_phase(p, ph);
    }
#endif
    if (ph + 1 < NPHASE) grid.sync();
  }
}
#if N_LAUNCH_MODE == 0
__global__ void __launch_bounds__(512, 2) mega_one(P p) {
  run_phase(p, p.ph_lo);
}
#endif

extern "C" void kernel_launch(void* const* d_in, const int* in_sizes, int n_in, void* d_out, int out_size, void* d_ws, size_t ws_size,
                              hipStream_t stream) {
  static int grid = 0;
  if (grid == 0) {
    if (n_in != 21 || ws_size < WS_END) { fprintf(stderr, "kernel_launch: unexpected n_in %d / ws_size %zu (need %zu)\n", n_in, ws_size, (size_t)WS_END); grid = -1; return; }
    int dev = 0, cus = 0, per_cu = 0;
    hipGetDevice(&dev);
    hipDeviceGetAttribute(&cus, hipDeviceAttributeMultiprocessorCount, dev);
    hipFuncSetAttribute((const void*)mega_coop, hipFuncAttributeMaxDynamicSharedMemorySize, LDS_BYTES);
#if N_LAUNCH_MODE == 0
    hipFuncSetAttribute((const void*)mega_one, hipFuncAttributeMaxDynamicSharedMemorySize, LDS_BYTES);
#endif
    hipOccupancyMaxActiveBlocksPerMultiprocessor(&per_cu, (const void*)mega_coop, 512, LDS_BYTES);
    if (per_cu < 1) { fprintf(stderr, "kernel_launch: occupancy query says %d blocks/CU\n", per_cu); per_cu = 1; }
    (void)hipGetLastError();
    grid = cus * 1;
  }
  if (grid < 0) return;
  P p{};
  for (int i = 0; i < 21; ++i) p.in[i] = (const float*)d_in[i];
  p.out = (float*)d_out;
  p.ws = (unsigned char*)d_ws;
#if N_LAUNCH_MODE == 1
  p.ph_lo = 0; p.ph_hi = NPHASE;
  void* args[] = {&p};
  hipError_t e = hipLaunchCooperativeKernel((const void*)mega_coop, dim3(grid), dim3(512), args, LDS_BYTES, stream);
  if (e != hipSuccess) fprintf(stderr, "cooperative launch failed: %s (grid %d)\n", hipGetErrorString(e), grid);
#else
  for (int ph = 0; ph < NPHASE; ++ph) {
    p.ph_lo = ph; p.ph_hi = ph + 1;
    hipLaunchKernelGGL(mega_one, dim3(grid), dim3(512), LDS_BYTES, stream, p);
  }
#endif
}
```

```cpp
#include <hip/hip_runtime.h>
#include <hip/hip_cooperative_groups.h>
#include <cstdio>
namespace cg = cooperative_groups;

typedef unsigned short u16;
typedef __attribute__((ext_vector_type(8))) short bf16x8;
typedef __attribute__((ext_vector_type(4))) float f32x4;
typedef __attribute__((ext_vector_type(16))) float f32x16;
typedef __attribute__((ext_vector_type(4))) unsigned u32x4;
typedef __attribute__((ext_vector_type(2))) unsigned u32x2;
typedef __attribute__((ext_vector_type(2))) float f32x2;
typedef __attribute__((ext_vector_type(2))) __bf16 bf16v2;

#define DI __device__ __forceinline__
#ifndef PROBE_MASK
#define PROBE_MASK 0
#endif
#ifndef STAGGER_SLEEP
#define STAGGER_SLEEP 0
#endif
#ifndef N_LAUNCH_MODE
#define N_LAUNCH_MODE 1
#endif

constexpr int NT = 81920;
constexpr int NTP = 65536;
constexpr int NCH = 2560;
constexpr int ASTR = 768;
constexpr int NPHASE = 19;
constexpr int LDS_BYTES = 131072 + 1024;

constexpr size_t MiB = 1ull << 20;
constexpr size_t WS_WT_IN = 0;
constexpr size_t WS_WT_AP = 16 * MiB;
constexpr size_t WS_WT_GA = 20 * MiB;
constexpr size_t WS_WT_GB = 22 * MiB;
constexpr size_t WS_WT_OUT = 24 * MiB;
constexpr size_t WS_WT_FF1 = 28 * MiB;
constexpr size_t WS_WT_FF2 = 44 * MiB;
constexpr size_t WS_W1T = 60 * MiB;
constexpr size_t WS_WYT = 76 * MiB;
constexpr size_t WS_LPOW = 124 * MiB;
constexpr size_t WS_BBAR = 127 * MiB;
constexpr size_t WS_KTAB = 128 * MiB;
constexpr size_t WS_ROPE = 132 * MiB;
constexpr size_t WS_SSQ = 133 * MiB;
constexpr size_t WS_XN = 135 * MiB;
constexpr size_t WS_BIG = 295 * MiB;
constexpr size_t WS_Q = WS_BIG;
constexpr size_t WS_K = WS_BIG + 160 * MiB;
constexpr size_t WS_VT = WS_BIG + 200 * MiB;
constexpr size_t WS_ASSM = WS_BIG + 240 * MiB;
constexpr size_t WS_S = WS_BIG + 360 * MiB;
constexpr size_t WS_Y = WS_BIG + 440 * MiB;
constexpr size_t WS_ATTO = WS_BIG + 520 * MiB;
constexpr size_t WS_FF = WS_BIG;
constexpr size_t WS_END = WS_BIG + 680 * MiB;

struct P {
  const float* in[21];
  float* out;
  unsigned char* ws;
  int ph_lo, ph_hi;
};

DI u16 f2bf(float f) { unsigned u = __float_as_uint(f); u += 0x7fffu + ((u >> 16) & 1u); return (u16)(u >> 16); }
DI float bf2f(u16 h) { return __uint_as_float(((unsigned)h) << 16); }
DI unsigned pk2(float a, float b) {
  f32x2 v; v[0] = a; v[1] = b;
  bf16v2 r = __builtin_convertvector(v, bf16v2);
  return __builtin_bit_cast(unsigned, r);
}
DI float sigmoidf_(float x) { return 1.0f / (1.0f + __expf(-x)); }
DI float gelu_tanh(float x) {
  float z = 0.7978845608028654f * (x + 0.044715f * x * x * x);
  float e = __expf(2.0f * z);
  return 0.5f * x * (2.0f - 2.0f / (e + 1.0f));
}


DI void sincos_d(double x, double* sn, double* cs) {
  const double TWO_PI_HI = 6.283185307179586232e+00, TWO_PI_LO = 2.449293598294706414e-16;
  double k = rint(x * 0.15915494309189534561);
  double r = (x - k * TWO_PI_HI) - k * TWO_PI_LO;
  r *= 0.25;
  double r2 = r * r;
  double s = 1.0, c = 1.0;
  s = 1.0 - r2 / (18.0 * 19.0);
  s = 1.0 - r2 / (16.0 * 17.0) * s;
  s = 1.0 - r2 / (14.0 * 15.0) * s;
  s = 1.0 - r2 / (12.0 * 13.0) * s;
  s = 1.0 - r2 / (10.0 * 11.0) * s;
  s = 1.0 - r2 / (8.0 * 9.0) * s;
  s = 1.0 - r2 / (6.0 * 7.0) * s;
  s = 1.0 - r2 / (4.0 * 5.0) * s;
  s = 1.0 - r2 / (2.0 * 3.0) * s;
  s *= r;
  c = 1.0 - r2 / (17.0 * 18.0);
  c = 1.0 - r2 / (15.0 * 16.0) * c;
  c = 1.0 - r2 / (13.0 * 14.0) * c;
  c = 1.0 - r2 / (11.0 * 12.0) * c;
  c = 1.0 - r2 / (9.0 * 10.0) * c;
  c = 1.0 - r2 / (7.0 * 8.0) * c;
  c = 1.0 - r2 / (5.0 * 6.0) * c;
  c = 1.0 - r2 / (3.0 * 4.0) * c;
  c = 1.0 - r2 / (1.0 * 2.0) * c;
  double s2 = 2.0 * s * c, c2 = c * c - s * s;
  *sn = 2.0 * s2 * c2; *cs = c2 * c2 - s2 * s2;
}

template <class T> DI T gld(const void* q) { return *(const __attribute__((address_space(1))) T*)q; }
template <class T> DI void gst(void* q, const T v) { *(__attribute__((address_space(1))) T*)q = v; }
DI int opaque_tid() { int t = threadIdx.x; asm volatile("" : "+v"(t)); return t; }
DI const char* sgpr_ptr(const char* p) { asm("" : "+s"(p)); return p; }
#define WAIT_V(n) asm volatile("s_waitcnt vmcnt(" #n ")" ::: "memory")
#define WAIT_L(n) asm volatile("s_waitcnt lgkmcnt(" #n ")" ::: "memory")
#define BAR __builtin_amdgcn_s_barrier()
#define SCHED __builtin_amdgcn_sched_barrier(0)
#define GLDS(gp, lp) __builtin_amdgcn_global_load_lds((const unsigned*)(gp), (unsigned*)(lp), 16, 0, 0)

constexpr int GBK = 64, GHALF = 128, GHT = GHALF * GBK;
DI int lds_byte(int r, int c) {
  int st = (r >> 4) * 2 + (c >> 5), rr = r & 15, cc = c & 31, ob = rr * 64 + cc * 2;
  return st * 1024 + (ob ^ (((ob >> 9) & 1) << 5));
}
DI void stage_rc(int b, int& R, int& C) {
  int st = b / 1024, sb = b % 1024, swz = sb ^ (((sb >> 9) & 1) << 5);
  R = (st >> 1) * 16 + swz / 64; C = (st & 1) * 32 + (swz % 64) / 2;
}

typedef f32x4 AccT[2][2][4][2];

template <class Epi>
DI void gemm_tile(const u16* __restrict__ A, const u16* __restrict__ Bt, const int lda, const int ldb, const int gsB, const int tmB, const int K, Epi&& epi) {
  const int TID = opaque_tid();
  extern __shared__ __attribute__((aligned(16))) unsigned char smem[];
  u16* shm = (u16*)smem;
#define SA(b, h) (shm + ((b) * 2 + (h)) * GHT)
#define SB(b, h) (shm + (4 + (b) * 2 + (h)) * GHT)
  int R0, C0, R1, C1;
  stage_rc(TID * 16, R0, C0);
  stage_rc(TID * 16 + 8192, R1, C1);
  const unsigned voA0 = (unsigned)(R0 * lda + C0) * 2u, voA1 = (unsigned)(R1 * lda + C1) * 2u;
  const unsigned voB0 = (unsigned)(R0 * ldb + (C0 & 15) + (C0 >> 4) * gsB) * 2u, voB1 = (unsigned)(R1 * ldb + (C1 & 15) + (C1 >> 4) * gsB) * 2u;
  const int hA = GHALF * lda, hB = GHALF * ldb;
  const unsigned wid_u = __builtin_amdgcn_readfirstlane(TID >> 6);
#define STAGE_A(PTR, half, kt) do { const char* _g = sgpr_ptr((const char*)(A + (size_t)(half) * hA + (size_t)(kt) * GBK)); \
    char* _l = (char*)(PTR) + wid_u * 1024u; \
    GLDS(_g + voA0, _l); GLDS(_g + voA1, _l + 8192); } while (0)
#define STAGE_B(PTR, half, kt) do { const char* _g = sgpr_ptr((const char*)(Bt + (size_t)(half) * hB + (tmB ? (size_t)((((kt) >> 2) << 16) + (((kt) & 3) << 6)) : (size_t)(kt) * (size_t)(4 * gsB)))); \
    char* _l = (char*)(PTR) + wid_u * 1024u; \
    GLDS(_g + voB0, _l); GLDS(_g + voB1, _l + 8192); } while (0)
#define LDA(dst, b, h) for (int m = 0; m < 4; ++m) for (int k = 0; k < 2; ++k) \
    dst[m][k] = *reinterpret_cast<const bf16x8*>((char*)SA(b, h) + lds_byte(wr * 64 + m * 16 + fr, k * 32 + fq * 8))
#define LDB(dst, b, h) for (int n = 0; n < 2; ++n) for (int k = 0; k < 2; ++k) \
    dst[n][k] = *reinterpret_cast<const bf16x8*>((char*)SB(b, h) + lds_byte(wc * 32 + n * 16 + fr, k * 32 + fq * 8))
#define MMA(ai, bj, At, Bq) do { __builtin_amdgcn_s_setprio(1); \
    for (int m = 0; m < 4; ++m) for (int n = 0; n < 2; ++n) for (int k = 0; k < 2; ++k) \
      acc[ai][bj][m][n] = __builtin_amdgcn_mfma_f32_16x16x32_bf16(At[m][k], Bq[n][k], acc[ai][bj][m][n], 0, 0, 0); \
    __builtin_amdgcn_s_setprio(0); } while (0)

  const int wid = TID >> 6, lane = TID & 63, wr = wid >> 2, wc = wid & 3, fr = lane & 15, fq = lane >> 4;
  AccT acc;
#pragma unroll
  for (int a = 0; a < 2; ++a)
#pragma unroll
    for (int b = 0; b < 2; ++b)
#pragma unroll
      for (int m = 0; m < 4; ++m)
#pragma unroll
        for (int n = 0; n < 2; ++n) acc[a][b][m][n] = f32x4{0.f, 0.f, 0.f, 0.f};
  bf16x8 At[4][2], B0[2][2], B1[2][2];
  const int nt = K / GBK;
  STAGE_B(SB(0, 0), 0, 0); STAGE_A(SA(0, 0), 0, 0);
  STAGE_B(SB(0, 1), 1, 0); STAGE_A(SA(0, 1), 1, 0);
  if (wr == 1) BAR;
  WAIT_V(4); BAR;
  STAGE_B(SB(1, 0), 0, 1); STAGE_A(SA(1, 0), 0, 1); STAGE_B(SB(1, 1), 1, 1);
  WAIT_V(6); BAR;
  for (int t = 0; t < nt - 2; t += 2) {
    LDB(B0, 0, 0); SCHED; LDA(At, 0, 0); STAGE_A(SA(1, 1), 1, t + 1);
    WAIT_L(8); BAR; WAIT_L(0); MMA(0, 0, At, B0); BAR; SCHED;
    LDB(B1, 0, 1); STAGE_B(SB(0, 0), 0, t + 2);
    BAR; WAIT_L(0); MMA(0, 1, At, B1); BAR;
    LDA(At, 0, 1); STAGE_A(SA(0, 0), 0, t + 2);
    BAR; WAIT_L(0); MMA(1, 0, At, B0); BAR; SCHED;
    STAGE_B(SB(0, 1), 1, t + 2);
    WAIT_V(6); BAR; MMA(1, 1, At, B1); BAR;
    LDB(B0, 1, 0); SCHED; LDA(At, 1, 0); STAGE_A(SA(0, 1), 1, t + 2);
    WAIT_L(8); BAR; WAIT_L(0); MMA(0, 0, At, B0); BAR; SCHED;
    LDB(B1, 1, 1); STAGE_B(SB(1, 0), 0, t + 3);
    BAR; WAIT_L(0); MMA(0, 1, At, B1); BAR;
    LDA(At, 1, 1); STAGE_A(SA(1, 0), 0, t + 3);
    BAR; WAIT_L(0); MMA(1, 0, At, B0); BAR; SCHED;
    STAGE_B(SB(1, 1), 1, t + 3);
    WAIT_V(6); BAR; MMA(1, 1, At, B1); BAR;
  }
  { LDB(B0, 0, 0); LDA(At, 0, 0); STAGE_A(SA(1, 1), 1, nt - 1);
    BAR; WAIT_L(0); MMA(0, 0, At, B0); BAR;
    LDB(B1, 0, 1); BAR; WAIT_L(0); MMA(0, 1, At, B1); BAR;
    LDA(At, 0, 1); WAIT_V(4); BAR; WAIT_L(0); MMA(1, 0, At, B0); MMA(1, 1, At, B1); BAR; }
  { LDB(B0, 1, 0); LDA(At, 1, 0); WAIT_V(2); BAR; WAIT_L(0); MMA(0, 0, At, B0); BAR;
    LDB(B1, 1, 1); WAIT_V(0); BAR; WAIT_L(0); MMA(0, 1, At, B1); BAR;
    LDA(At, 1, 1); BAR; WAIT_L(0); MMA(1, 0, At, B0); MMA(1, 1, At, B1); BAR; }
  if (wr == 0) BAR;
  epi(acc);
#undef SA
#undef SB
}

template <class F>
DI void epi_for(AccT& acc, F&& f) {
  const int TID = opaque_tid();
  const int _wid = TID >> 6, _lane = TID & 63, _wr = _wid >> 2, _wc = _wid & 3, _fr = _lane & 15, _fq = _lane >> 4;
#pragma unroll
  for (int _ai = 0; _ai < 2; ++_ai)
#pragma unroll
    for (int _bj = 0; _bj < 2; ++_bj)
#pragma unroll
      for (int _m = 0; _m < 4; ++_m)
#pragma unroll
        for (int _n = 0; _n < 2; ++_n)
          f(_ai * 128 + _wr * 64 + _m * 16 + _fq * 4, _bj * 128 + _wc * 32 + _n * 16 + _fr, acc[_ai][_bj][_m][_n]);
}

DI void tile_map(int w, int ntn, int& tm, int& tn) {
  int xcd = w & 7, r = w >> 3;
  tn = r % ntn; tm = (r / ntn) * 8 + xcd;
}

DI void transpose_tile(const float* __restrict__ src, int N, u16* __restrict__ dst, int K, int tk, int tn, const float* __restrict__ gain) {
  const int TID = opaque_tid();
  extern __shared__ __attribute__((aligned(16))) unsigned char smem[];
  float* tile = (float*)smem;
  const int t = TID;
  {
    int rk = t >> 3, cs = (t & 7) * 8;
    const float4* s = (const float4*)(src + (size_t)(tk * 64 + rk) * N + tn * 64 + cs);
    float4 a = s[0], b = s[1];
    if (gain) { const float gk = gain[tk * 64 + rk]; a.x *= gk; a.y *= gk; a.z *= gk; a.w *= gk; b.x *= gk; b.y *= gk; b.z *= gk; b.w *= gk; }
    float* d = tile + rk * 65 + cs;
    d[0] = a.x; d[1] = a.y; d[2] = a.z; d[3] = a.w; d[4] = b.x; d[5] = b.y; d[6] = b.z; d[7] = b.w;
  }
  __syncthreads();
  {
    int n = t >> 3, ks = (t & 7) * 8;
    u32x4 o;
    o[0] = pk2(tile[(ks + 0) * 65 + n], tile[(ks + 1) * 65 + n]);
    o[1] = pk2(tile[(ks + 2) * 65 + n], tile[(ks + 3) * 65 + n]);
    o[2] = pk2(tile[(ks + 4) * 65 + n], tile[(ks + 5) * 65 + n]);
    o[3] = pk2(tile[(ks + 6) * 65 + n], tile[(ks + 7) * 65 + n]);
    *(u32x4*)(dst + (size_t)(tn * 64 + n) * K + tk * 64 + ks) = o;
  }
  __syncthreads();
}

DI void phase_prep_a(const P& p) {
  const int TID = opaque_tid();
  const int bid = blockIdx.x, nb = gridDim.x;
  for (int w = bid; w < 7680; w += nb) {
    int layer = w / 3840, r = w % 3840;
    const float* src; u16* dst; int K, N, tl; const float* gain = nullptr;
    if (r < 1024) { src = p.in[3] + (size_t)layer * 1024 * 4096; dst = (u16*)(p.ws + WS_WT_IN) + (size_t)layer * 4096 * 1024; K = 1024; N = 4096; tl = r; gain = p.in[2] + layer * 1024; }
    else if (r < 1280) { src = p.in[6] + (size_t)layer * 1024 * 1024; dst = (u16*)(p.ws + WS_WT_AP) + (size_t)layer * 1024 * 1024; K = 1024; N = 1024; tl = r - 1024; }
    else if (r < 1408) { src = p.in[15] + (size_t)layer * 512 * 1024; dst = (u16*)(p.ws + WS_WT_GA) + (size_t)layer * 1024 * 512; K = 512; N = 1024; tl = r - 1280; }
    else if (r < 1536) { src = p.in[16] + (size_t)layer * 512 * 1024; dst = (u16*)(p.ws + WS_WT_GB) + (size_t)layer * 1024 * 512; K = 512; N = 1024; tl = r - 1408; }
    else if (r < 1792) { src = p.in[17] + (size_t)layer * 1024 * 1024; dst = (u16*)(p.ws + WS_WT_OUT) + (size_t)layer * 1024 * 1024; K = 1024; N = 1024; tl = r - 1536; }
    else if (r < 2816) { src = p.in[19] + (size_t)layer * 1024 * 4096; dst = (u16*)(p.ws + WS_WT_FF1) + (size_t)layer * 4096 * 1024; K = 1024; N = 4096; tl = r - 1792; gain = p.in[18] + layer * 1024; }
    else { src = p.in[20] + (size_t)layer * 4096 * 1024; dst = (u16*)(p.ws + WS_WT_FF2) + (size_t)layer * 1024 * 4096; K = 4096; N = 1024; tl = r - 2816; }
    int ntn = N / 64;
    transpose_tile(src, N, dst, K, tl / ntn, tl % ntn, gain);
  }
  const int gtid = bid * 512 + TID, nth = nb * 512;
  float2* LP = (float2*)(p.ws + WS_LPOW);
  float2* BB = (float2*)(p.ws + WS_BBAR);
  for (int idx = gtid; idx < 8192 * 33; idx += nth) {
    const int i = idx / 33, tau = idx - i * 33, lg = i >> 6;
    const double step = exp((double)p.in[9][lg]);
    const double zr = (double)p.in[7][i] * step, zi = (double)p.in[8][i] * step;
    double e = exp(zr * tau), sn, cs;
    sincos_d(zi * tau, &sn, &cs);
    LP[idx] = make_float2((float)(e * cs), (float)(e * sn));
  }
  for (int idx = gtid; idx < 8192 * 16; idx += nth) {
    const int i = idx >> 4, ci = idx & 15, lg = i >> 6;
    const double step = exp((double)p.in[9][lg]);
    const double lr = p.in[7][i], li = p.in[8][i];
    const double zr = lr * step, zi = li * step;
    double e = exp(zr), sn, cs;
    sincos_d(zi, &sn, &cs);
    const double nr = e * cs - 1.0, ni = e * sn, den = lr * lr + li * li;
    const double fr = (nr * lr + ni * li) / den, fi = (ni * lr - nr * li) / den;
    const double br = p.in[10][idx], bi = p.in[11][idx];
    BB[idx] = make_float2((float)(fr * br - fi * bi), (float)(fr * bi + fi * br));
  }
  float2* RP = (float2*)(p.ws + WS_ROPE);
  for (int i = gtid; i < 128 * 16; i += nth) {
    int pos = i >> 4, f = i & 15;
    double inv = exp(-(double)(2 * f) / 32.0 * 9.210340371976184);
    double sn, cs;
    sincos_d((double)pos * inv, &sn, &cs);
    RP[i] = make_float2((float)cs, (float)sn);
  }
}

DI void phase_prep_b(const P& p) {
  const int TID = opaque_tid();
  const int gtid = blockIdx.x * 512 + TID, nth = gridDim.x * 512;
  const float2* LP = (const float2*)(p.ws + WS_LPOW);
  const float2* BB = (const float2*)(p.ws + WS_BBAR);
  float* KT = (float*)(p.ws + WS_KTAB);
  const float* cre = p.in[12];
  const float* cim = p.in[13];
  {
    extern __shared__ __attribute__((aligned(16))) unsigned char smem[];
    float2* Cs = (float2*)smem;
    float2* Bs = Cs + 1024;
    float2* Ls = Bs + 1024;
    for (int item = blockIdx.x; item < 256; item += gridDim.x) {
      const int lg = item >> 1, th = item & 1;
      for (int e = TID; e < 1024; e += 512) {
        Cs[e] = make_float2(cre[(size_t)lg * 1024 + e], cim[(size_t)lg * 1024 + e]);
        Bs[e] = BB[(size_t)lg * 1024 + e];
        Ls[e] = LP[(size_t)(lg * 64 + (e >> 4)) * 33 + th * 16 + (e & 15)];
      }
      __syncthreads();
      const int co = (TID >> 4) & 15, ci = TID & 15, tsel = TID >> 8;
      float a8[8];
#pragma unroll
      for (int k = 0; k < 8; ++k) a8[k] = 0.f;
      for (int pp = 0; pp < 64; ++pp) {
        const float2 c = Cs[co * 64 + pp], b = Bs[pp * 16 + ci];
        const float zr = c.x * b.x - c.y * b.y, zi = c.x * b.y + c.y * b.x;
#pragma unroll
        for (int k = 0; k < 8; ++k) { const float2 l = Ls[pp * 16 + tsel + 2 * k]; a8[k] += zr * l.x - zi * l.y; }
      }
#pragma unroll
      for (int k = 0; k < 8; ++k) KT[(((size_t)lg * 32 + th * 16 + tsel + 2 * k) * 16 + co) * 16 + ci] = a8[k];
      __syncthreads();
    }
  }
  u16* W1 = (u16*)(p.ws + WS_W1T);
  for (int i8 = gtid; i8 < (1 << 20); i8 += nth) {
    const int i = i8 << 3;
    const int k = i & 511, n = (i >> 9) & 255, g = (i >> 17) & 31, layer = i >> 22;
    const int dir = n >> 7, pp = (n >> 1) & 63, ri = n & 1, sidx = k >> 4, ci0 = k & 15;
    const int e = dir ? sidx : 31 - sidx;
    const int lg = (layer * 2 + dir) * 32 + g;
    const float2 l = LP[(size_t)(lg * 64 + pp) * 33 + e];
    const float2* b = BB + (size_t)(lg * 64 + pp) * 16 + ci0;
    float v[8];
#pragma unroll
    for (int q = 0; q < 8; ++q) { const float2 bq = b[q]; v[q] = ri ? (l.x * bq.y + l.y * bq.x) : (l.x * bq.x - l.y * bq.y); }
    u32x4 o;
    o[0] = pk2(v[0], v[1]); o[1] = pk2(v[2], v[3]); o[2] = pk2(v[4], v[5]); o[3] = pk2(v[6], v[7]);
    *(u32x4*)(W1 + i) = o;
  }
  u16* WY = (u16*)(p.ws + WS_WYT);
  for (int i8 = gtid; i8 < (1 << 20); i8 += nth) {
    const int i = i8 << 3;
    const int kk = i & 255, n = (i >> 8) & 511, g = (i >> 17) & 31, layer = i >> 22;
    const int t = n >> 4, co = n & 15, dir = kk >> 7, pp0 = (kk >> 1) & 63;
    const int e = dir ? 32 - t : t + 1;
    const int lg = (layer * 2 + dir) * 32 + g;
    float v[8];
#pragma unroll
    for (int q = 0; q < 4; ++q) {
      const float cr = cre[(size_t)(lg * 16 + co) * 64 + pp0 + q], cI = cim[(size_t)(lg * 16 + co) * 64 + pp0 + q];
      const float2 l = LP[(size_t)(lg * 64 + pp0 + q) * 33 + e];
      v[2 * q] = cr * l.x - cI * l.y;
      v[2 * q + 1] = -(cr * l.y + cI * l.x);
    }
    u32x4 o;
    o[0] = pk2(v[0], v[1]); o[1] = pk2(v[2], v[3]); o[2] = pk2(v[4], v[5]); o[3] = pk2(v[6], v[7]);
    *(u32x4*)(WY + ((size_t)((layer * 32 + g) * 512 + n)) * ASTR + 512 + kk) = o;
  }
}

DI void phase_prep_c(const P& p) {
  const int TID = opaque_tid();
#if PROBE_MASK & 64
  {
    u32x4* dst = (u32x4*)(p.ws + WS_FF);
    u32x4 z; z[0] = 1; z[1] = 2; z[2] = 3; z[3] = 4;
    for (unsigned i = blockIdx.x * 512 + TID; i < 640u * 65536u; i += gridDim.x * 512) { z[0] = i * 2654435761u; z[1] = z[0] ^ (i << 7); z[2] = z[1] * 40503u + i; z[3] = z[2] ^ z[0]; dst[i] = z; }
  }
#endif
  const int gtid = blockIdx.x * 512 + TID, nth = gridDim.x * 512;
  const float* KT = (const float*)(p.ws + WS_KTAB);
  u16* WY = (u16*)(p.ws + WS_WYT);
  for (int i = gtid; i < (1 << 21); i += nth) {
    int k8 = i & 63, n = (i >> 6) & 511, g = (i >> 15) & 31, layer = i >> 20;
    int t = n >> 4, co = n & 15, s = k8 >> 1, ci0 = (k8 & 1) * 8;
    int tau = t - s;
    float v[8];
    if (tau > 0) {
      const float* q = KT + ((((size_t)(layer * 2 + 0) * 32 + g) * 32 + tau) * 16 + co) * 16 + ci0;
#pragma unroll
      for (int j = 0; j < 8; ++j) v[j] = q[j];
    } else if (tau < 0) {
      const float* q = KT + ((((size_t)(layer * 2 + 1) * 32 + g) * 32 - tau) * 16 + co) * 16 + ci0;
#pragma unroll
      for (int j = 0; j < 8; ++j) v[j] = q[j];
    } else {
      const float* q0 = KT + ((((size_t)(layer * 2 + 0) * 32 + g) * 32) * 16 + co) * 16 + ci0;
      const float* q1 = KT + ((((size_t)(layer * 2 + 1) * 32 + g) * 32) * 16 + co) * 16 + ci0;
#pragma unroll
      for (int j = 0; j < 8; ++j) v[j] = q0[j] + q1[j];
    }
    u32x4 o;
    o[0] = pk2(v[0], v[1]); o[1] = pk2(v[2], v[3]); o[2] = pk2(v[4], v[5]); o[3] = pk2(v[6], v[7]);
    *(u32x4*)(WY + ((size_t)((layer * 32 + g) * 512 + n)) * ASTR + k8 * 8) = o;
  }
}

DI const float* xrow(const P& p, int layer, int tok) {
  if (layer == 0) return tok < NTP ? p.in[0] + (size_t)tok * 1024 : p.in[1] + (size_t)(tok - NTP) * 1024;
  return p.out + (size_t)tok * 1024;
}
DI void phase_convert(const P& p, const float* __restrict__ src0, const float* __restrict__ src1) {
  const int TID = opaque_tid();
  const int lane = TID & 63, wave = TID >> 6;
  u16* XN = (u16*)(p.ws + WS_XN);
  float* SSQ = (float*)(p.ws + WS_SSQ);
  for (int tok = blockIdx.x * 8 + wave; tok < NT; tok += gridDim.x * 8) {
    const float* x = tok < NTP ? src0 + (size_t)tok * 1024 : src1 + (size_t)(tok - NTP) * 1024;
    float4 v[4];
    float ss = 0.f;
#pragma unroll
    for (int i = 0; i < 4; ++i) {
      v[i] = *(const float4*)(x + i * 256 + lane * 4);
      ss += v[i].x * v[i].x + v[i].y * v[i].y + v[i].z * v[i].z + v[i].w * v[i].w;
    }
#pragma unroll
    for (int o = 32; o >= 1; o >>= 1) ss += __shfl_xor(ss, o);
    if (lane < 4) SSQ[(size_t)lane * NT + tok] = lane == 0 ? ss : 0.f;
#pragma unroll
    for (int i = 0; i < 4; ++i) {
      u32x2 o;
      o[0] = pk2(v[i].x, v[i].y);
      o[1] = pk2(v[i].z, v[i].w);
      *(u32x2*)(XN + (size_t)tok * 1024 + i * 256 + lane * 4) = o;
    }
  }
}

DI void phase_scan(const P& p, int layer) {
  const int TID = opaque_tid();
  const int gtid = blockIdx.x * 512 + TID, nth = gridDim.x * 512;
  const float2* LP = (const float2*)(p.ws + WS_LPOW);
  for (int i = gtid; i < 18 * 4096; i += nth) {
    int pp = i & 63, dir = (i >> 6) & 1, g = (i >> 7) & 31, seq = i >> 12;
    int c0 = seq < 16 ? seq * 128 : 2048 + (seq - 16) * 256;
    int nc = seq < 16 ? 128 : 256;
    float2 a = LP[(size_t)(((layer * 2 + dir) * 32 + g) * 64 + pp) * 33 + 32];
    const float2* S = (const float2*)(p.ws + WS_S) + ((size_t)(g * NCH + c0) * 256 + dir * 128 + pp * 2) / 2;
    unsigned* H = (unsigned*)((u16*)(p.ws + WS_ASSM) + (size_t)(g * NCH + c0) * ASTR + 512 + dir * 128 + pp * 2);
    float hr = 0.f, hi = 0.f;
    for (int cb = 0; cb < nc; cb += 16) {
      float2 sv[16];
#pragma unroll
      for (int k = 0; k < 16; ++k) {
        const int c = dir == 0 ? cb + k : nc - 1 - cb - k;
        sv[k] = S[(size_t)c * 128];
      }
#pragma unroll
      for (int k = 0; k < 16; ++k) {
        const int c = dir == 0 ? cb + k : nc - 1 - cb - k;
        H[(size_t)c * (ASTR / 2)] = pk2(hr, hi);
        const float nr = a.x * hr - a.y * hi + sv[k].x;
        hi = a.x * hi + a.y * hr + sv[k].y;
        hr = nr;
      }
    }
  }
}

#define MFMA32(a, b, c) __builtin_amdgcn_mfma_f32_32x32x16_bf16((a), (b), (c), 0, 0, 0)
DI void attn_item(const P& pin, int layer, int seq_start, int L, int head, int qb) {
  const int TID = opaque_tid();
  struct { unsigned char* ws; } p;
  p.ws = pin.ws;
  asm volatile("" : "+s"(p.ws));
  extern __shared__ __attribute__((aligned(16))) unsigned char smem[];
  const u16* Q = (const u16*)(p.ws + WS_Q);
  const u16* KB = (const u16*)(p.ws + WS_K);
  const u16* VT = (const u16*)(p.ws + WS_VT);
  const int tid = TID, wave = tid >> 6, lane = tid & 63, r = lane & 31, h = lane >> 5;
  const int kvh = head >> 2;
  const int q0 = seq_start + qb * 512 + wave * 64;
  bf16x8 qf[2][4];
#pragma unroll
  for (int nt = 0; nt < 2; ++nt)
#pragma unroll
    for (int ds = 0; ds < 4; ++ds)
      qf[nt][ds] = gld<bf16x8>(Q + (size_t)(q0 + nt * 32 + r) * 1024 + head * 64 + ds * 16 + h * 8);
#pragma unroll
  for (int nt = 0; nt < 2; ++nt)
#pragma unroll
    for (int ds = 0; ds < 4; ++ds) asm volatile("" ::"v"(qf[nt][ds]));
  bool no_check;
  {
    float gq = fabsf(pin.in[4][layer * 64 + lane]), gk = fabsf(pin.in[5][layer * 64 + lane]);
#pragma unroll
    for (int o = 32; o >= 1; o >>= 1) { gq = fmaxf(gq, __shfl_xor(gq, o)); gk = fmaxf(gk, __shfl_xor(gk, o)); }
    no_check = __builtin_amdgcn_readfirstlane(11.5416f * 1.01f * gq * gk <= 15.5f ? 1 : 0) != 0;
  }
  const int srow = tid >> 3, spos = tid & 7, scc = spos ^ ((srow >> 1) & 7);
  const u16* kg = KB + ((size_t)kvh * NT + seq_start + srow) * 64 + scc * 8;
  const u16* vg = VT + (size_t)(kvh * 64 + srow) * NT + seq_start + scc * 8;
  unsigned char* ldst = smem + tid * 16;
  const int nkt = L >> 6;
  const int pr = ((r >> 4) * 16) + (((r >> 2) & 1) * 8) + (((r >> 3) & 1) * 4) + (r & 3);
  int koff[4];
#pragma unroll
  for (int ds = 0; ds < 4; ++ds) koff[ds] = pr * 128 + (((ds * 2 + h) ^ ((pr >> 1) & 7)) << 4);
  const int vxh = ((r >> 1) & 7) >> 1;
  const int vbase = 8192 + r * 128 + ((h ^ ((r >> 1) & 1)) << 4);

  f32x16 o[2][2];
#pragma unroll
  for (int a = 0; a < 2; ++a)
#pragma unroll
    for (int b = 0; b < 2; ++b)
#pragma unroll
      for (int j = 0; j < 16; ++j) o[a][b][j] = 0.f;
  float mrun[2] = {0.f, 0.f}, lrun[2] = {0.f, 0.f};


#define ATT_STAGE(T, B) do { GLDS(kg + (size_t)(T) * 128 * 64, ldst + (B) * 32768); GLDS(vg + (T) * 128, ldst + (B) * 32768 + 8192); \
    GLDS(kg + (size_t)(T) * 128 * 64 + 64 * 64, ldst + (B) * 32768 + 16384); GLDS(vg + (T) * 128 + 64, ldst + (B) * 32768 + 16384 + 8192); } while (0)
  const int nst = nkt >> 1;
  ATT_STAGE(0, 0);
  ATT_STAGE(1, 1);
  int bcur = 0;
  for (int st = 0; st < nst; ++st) {
    if (st + 1 < nst) { WAIT_V(4); } else { WAIT_V(0); }
    BAR;
    if (st + 2 < nst) {
      int bn = bcur + 2; if (bn >= 3) bn -= 3;
      ATT_STAGE(st + 2, bn);
    }
    const unsigned char* sbase = smem + bcur * 32768;
    auto qk = [&](const int hx, f32x16 (&sc)[2]) {
      const unsigned char* kb = sbase + (hx >> 1) * 16384 + (hx & 1) * 4096;
      bf16x8 kf[4];
#pragma unroll
      for (int ds = 0; ds < 4; ++ds) kf[ds] = *(const bf16x8*)(kb + koff[ds]);
      if (no_check) {
        f32x16 z16;
#pragma unroll
        for (int j = 0; j < 16; ++j) z16[j] = 0.f;
#pragma unroll
        for (int nt = 0; nt < 2; ++nt) sc[nt] = MFMA32(kf[0], qf[nt][0], z16);
      } else {
#pragma unroll
        for (int nt = 0; nt < 2; ++nt) {
#pragma unroll
          for (int j = 0; j < 16; ++j) sc[nt][j] = -mrun[nt];
          sc[nt] = MFMA32(kf[0], qf[nt][0], sc[nt]);
        }
      }
#pragma unroll
      for (int ds = 1; ds < 4; ++ds)
#pragma unroll
        for (int nt = 0; nt < 2; ++nt) sc[nt] = MFMA32(kf[ds], qf[nt][ds], sc[nt]);
    };
    auto sm_pv = [&](const int hx, f32x16 (&sc)[2], f32x16 (&pend)[2], const bool has_pend) {
      const bool chk = !no_check;
      const unsigned char* kb = sbase + (hx >> 1) * 16384;
      const int kt = hx & 1;
      bf16x8 vf[2][2];
#pragma unroll
      for (int s2 = 0; s2 < 2; ++s2)
#pragma unroll
        for (int mt = 0; mt < 2; ++mt) vf[s2][mt] = *(const bf16x8*)(kb + vbase + (((kt * 2 + s2) ^ vxh) << 5) + mt * 4096);
      float mx[2] = {0.f, 0.f};
      if (chk) {
#pragma unroll
        for (int nt = 0; nt < 2; ++nt) {
          float m0 = sc[nt][0];
#pragma unroll
          for (int j = 1; j < 16; ++j) m0 = fmaxf(m0, sc[nt][j]);
          mx[nt] = m0;
        }
      }
      if (chk && __any((fabsf(mx[0]) > 16.0f) | (fabsf(mx[1]) > 16.0f))) {
#pragma unroll
        for (int nt = 0; nt < 2; ++nt) {
          const float mp = fmaxf(mx[nt], __shfl_xor(mx[nt], 32));
          const float dm = (fabsf(mp) > 12.0f) ? mp : 0.0f;
          const float alpha = __builtin_amdgcn_exp2f(-dm);
          mrun[nt] += dm;
          lrun[nt] *= alpha;
#pragma unroll
          for (int j = 0; j < 16; ++j) sc[nt][j] -= dm;
          if (has_pend) {
#pragma unroll
            for (int j = 0; j < 16; ++j) pend[nt][j] -= dm;
          }
#pragma unroll
          for (int mt = 0; mt < 2; ++mt)
#pragma unroll
            for (int j = 0; j < 16; ++j) o[mt][nt][j] *= alpha;
        }
      }
#pragma unroll
      for (int nt = 0; nt < 2; ++nt) {
        float sum = 0.f;
#pragma unroll
        for (int j = 0; j < 16; ++j) { float pv = __builtin_amdgcn_exp2f(sc[nt][j]); sc[nt][j] = pv; sum += pv; }
        lrun[nt] += sum;
      }
#pragma unroll
      for (int s2 = 0; s2 < 2; ++s2) {
        bf16x8 pf[2];
#pragma unroll
        for (int nt = 0; nt < 2; ++nt) {
          u32x4 pk;
#pragma unroll
          for (int i = 0; i < 4; ++i) pk[i] = pk2(sc[nt][s2 * 8 + 2 * i], sc[nt][s2 * 8 + 2 * i + 1]);
          pf[nt] = __builtin_bit_cast(bf16x8, pk);
        }
#pragma unroll
        for (int mt = 0; mt < 2; ++mt)
#pragma unroll
          for (int nt = 0; nt < 2; ++nt) o[mt][nt] = MFMA32(vf[s2][mt], pf[nt], o[mt][nt]);
      }
    };
    f32x16 sa[2], sb[2];
    qk(0, sa);
    qk(1, sb); sm_pv(0, sa, sb, true);
    qk(2, sa); sm_pv(1, sb, sa, true);
    qk(3, sb); sm_pv(2, sa, sb, true);
    sm_pv(3, sb, sa, false);
    bcur = bcur + 1; if (bcur >= 3) bcur = 0;
  }
  unsigned char* ws2 = pin.ws;
  asm volatile("" : "+s"(ws2));
  u16* O = (u16*)(ws2 + WS_ATTO);
  const int tid2 = opaque_tid();
  const int r2 = tid2 & 31, h2 = (tid2 >> 5) & 1;
  const int q0b = seq_start + qb * 512 + (tid2 >> 6) * 64;
#pragma unroll
  for (int nt = 0; nt < 2; ++nt) {
    float l = lrun[nt] + __shfl_xor(lrun[nt], 32);
    float inv = 1.0f / l;
    const int tok = q0b + nt * 32 + r2;
#pragma unroll
    for (int mt = 0; mt < 2; ++mt)
#pragma unroll
      for (int jg = 0; jg < 4; ++jg) {
        u32x2 ov;
        ov[0] = pk2(o[mt][nt][jg * 4 + 0] * inv, o[mt][nt][jg * 4 + 1] * inv);
        ov[1] = pk2(o[mt][nt][jg * 4 + 2] * inv, o[mt][nt][jg * 4 + 3] * inv);
        gst<u32x2>(O + (size_t)tok * 1024 + head * 64 + mt * 32 + jg * 8 + h2 * 4, ov);
      }
  }
  WAIT_L(0);
  BAR;
}


enum { EK_Q = 0, EK_K, EK_V, EK_U, EK_S, EK_Y, EK_M0, EK_M1, EK_M2, EK_M3, EK_M4, EK_OUT, EK_FF1, EK_FF2 };
struct Job {
  const u16* A; const u16* Bt;
  int lda, ldb, gsB, tmB, K, kind, tm, tn, layer;
};

DI void stage_acc(AccT& acc, unsigned char* smem, const int tid, const int linear = 0) {
  const int wid = tid >> 6, lane = tid & 63, wr = wid >> 2, wc = wid & 3, fr = lane & 15, fq = lane >> 4;
#if PROBE_MASK
  if (linear) {
    int k = 0;
#pragma unroll
    for (int ai = 0; ai < 2; ++ai)
#pragma unroll
      for (int bj = 0; bj < 2; ++bj)
#pragma unroll
        for (int m = 0; m < 4; ++m)
#pragma unroll
          for (int n = 0; n < 2; ++n) {
            u32x2 w;
            w[0] = pk2(acc[ai][bj][m][n][0], acc[ai][bj][m][n][1]);
            w[1] = pk2(acc[ai][bj][m][n][2], acc[ai][bj][m][n][3]);
            *(u32x2*)(smem + tid * 8 + k * 4096) = w;
            ++k;
          }
    return;
  }
#endif
#pragma unroll
  for (int ai = 0; ai < 2; ++ai)
#pragma unroll
    for (int bj = 0; bj < 2; ++bj)
#pragma unroll
      for (int m = 0; m < 4; ++m)
#pragma unroll
        for (int n = 0; n < 2; ++n) {
          const int col = bj * 128 + wc * 32 + n * 16 + fr;
          const int row0 = ai * 128 + wr * 64 + m * 16 + fq * 4;
          u32x2 w;
          w[0] = pk2(acc[ai][bj][m][n][0], acc[ai][bj][m][n][1]);
          w[1] = pk2(acc[ai][bj][m][n][2], acc[ai][bj][m][n][3]);
          *(u32x2*)(smem + col * 512 + (((row0 >> 3) ^ (col & 31)) << 4) + ((row0 & 4) << 1)) = w;
        }
}
DI void unpack8(const u32x4 u, float* f) {
#pragma unroll
  for (int i = 0; i < 4; ++i) { f[2 * i] = __uint_as_float(u[i] << 16); f[2 * i + 1] = __uint_as_float(u[i] & 0xffff0000u); }
}
DI u32x4 pack8(const float* f) {
  u32x4 o;
#pragma unroll
  for (int i = 0; i < 4; ++i) o[i] = pk2(f[2 * i], f[2 * i + 1]);
  return o;
}

DI float tok_rstd(const unsigned char* ws, int tok) {
  const float* q = (const float*)(ws + WS_SSQ) + tok;
  return rsqrtf((q[0] + q[NT] + q[2 * NT] + q[3 * (size_t)NT]) * (1.0f / 1024.0f) + 1e-6f);
}
DI void run_epilogue(const P& pin, const Job& jb, AccT& acc) {
  extern __shared__ __attribute__((aligned(16))) unsigned char smem[];
  const int TID = opaque_tid();
  P p = pin;
  asm volatile("" : "+s"(p.ws), "+s"(p.out));
  const int tm = jb.tm, tn = jb.tn, layer = jb.layer & 255, kind = jb.kind;
  const int nit = (jb.layer & 256) ? 8 : (jb.layer & 512) ? 1 : (jb.layer & 1024) ? 0 : 16;
#if PROBE_MASK
  if (kind == -1) return;
  if (kind == -3) {
    u32x4 z; z[0] = acc[0][0][0][0][0] > 1e30f ? 1u : 0u; z[1] = 2; z[2] = 3; z[3] = 4;
    for (int it = 0; it < 16; ++it) {
      const int q = it * 512 + TID;
      *(u32x4*)((u16*)(p.ws + WS_FF) + (size_t)(tn * 256 + (q >> 5)) * 4096 + tm * 256 + (q & 31) * 8) = z;
    }
    return;
  }
#endif
  if (kind == EK_S) {
    float* Sg = (float*)(p.ws + WS_S) + (size_t)tn * 256 * 256;
    epi_for(acc, [&](const int row0, const int col, const f32x4 v) { *(f32x4*)(Sg + (size_t)col * 256 + row0) = v; });
    return;
  }
#if PROBE_MASK
  if (jb.layer & 16384) { if (acc[1][1][3][1][3] == 12345.678f) smem[TID] = 1; }
  if (!(jb.layer & 2048))
  for (int rep = (jb.layer & 8192) ? 4 : 1; rep > 0; --rep)
#endif
  stage_acc(acc, smem, TID, (jb.layer & 4096) ? 1 : 0);
  float* lrs = (float*)(smem + 131072);
  if ((kind <= EK_U || kind == EK_M2 || kind == EK_M3 || kind == EK_FF1) && TID < 256) lrs[TID] = tok_rstd(p.ws, tn * 256 + TID);
  __syncthreads();
  const bool two_pass = kind == EK_Q || kind == EK_K || kind == EK_Y || kind == EK_M1 || kind == EK_M2 || kind == EK_M4;
  if (two_pass) {
    auto slot_of = [&](const int it, int& col, int& c) -> unsigned char* {
      const int q = it * 512 + TID;
      col = q >> 5; c = q & 31;
      return smem + col * 512 + ((c ^ (col & 31)) << 4);
    };
    if (kind == EK_M1 || kind == EK_M2 || kind == EK_M4) {
      const u16* T1 = (const u16*)(p.ws + WS_Q) + (size_t)(tn * 256) * 1024 + tm * 256;
      const u16* T2 = (const u16*)(p.ws + WS_ASSM) + (size_t)(tn * 256) * 1024 + tm * 256;
      if (kind == EK_M1) {
#pragma unroll 8
        for (int it = 0; it < 16; ++it) {
          int col, c; unsigned char* sl = slot_of(it, col, c);
          float f[8], a[8], r[8];
          unpack8(gld<u32x4>(T1 + (size_t)col * 1024 + c * 8), a);
          unpack8(*(const u32x4*)sl, f);
#pragma unroll
          for (int i = 0; i < 8; ++i) r[i] = f[i] * a[i];
          *(u32x4*)sl = pack8(r);
        }
      } else if (kind == EK_M2) {
#pragma unroll 8
        for (int it = 0; it < 16; ++it) {
          int col, c; unsigned char* sl = slot_of(it, col, c);
          float f[8], a[8], r[8];
          unpack8(gld<u32x4>(T1 + (size_t)col * 1024 + c * 8), a);
          unpack8(*(const u32x4*)sl, f);
          const float tr = lrs[col];
#pragma unroll
          for (int i = 0; i < 8; ++i) r[i] = sigmoidf_(f[i] * tr) * a[i];
          *(u32x4*)sl = pack8(r);
        }
      } else {
#pragma unroll 8
        for (int it = 0; it < 16; ++it) {
          int col, c; unsigned char* sl = slot_of(it, col, c);
          float f[8], a[8], b[8], r[8];
          unpack8(gld<u32x4>(T1 + (size_t)col * 1024 + c * 8), a);
          unpack8(gld<u32x4>(T2 + (size_t)col * 1024 + c * 8), b);
          unpack8(*(const u32x4*)sl, f);
#pragma unroll
          for (int i = 0; i < 8; ++i) r[i] = b[i] * f[i] + a[i];
          *(u32x4*)sl = pack8(r);
        }
      }
    } else if (kind == EK_Y) {
      const int g = tn / 10, ch0 = (tn % 10) * 256;
      const float* dsk = p.in[14] + layer * 512 + g * 16 + (TID & 1) * 8;
      const f32x4 d0 = *(const f32x4*)dsk, d1 = *(const f32x4*)(dsk + 4);
      const u16* UU = (const u16*)(p.ws + WS_ASSM) + ((size_t)g * NCH + ch0) * ASTR + tm * 256;
#pragma unroll 8
      for (int it = 0; it < 16; ++it) {
        int col, c; unsigned char* sl = slot_of(it, col, c);
        float f[8], u[8], r[8];
        unpack8(gld<u32x4>(UU + (size_t)col * ASTR + c * 8), u);
        unpack8(*(const u32x4*)sl, f);
#pragma unroll
        for (int i = 0; i < 4; ++i) { r[i] = gelu_tanh(f[i] + d0[i] * u[i]); r[4 + i] = gelu_tanh(f[4 + i] + d1[i] * u[4 + i]); }
        *(u32x4*)sl = pack8(r);
      }
    } else {
      const float* gn = (kind == EK_Q ? p.in[4] : p.in[5]) + layer * 64 + (TID & 7) * 8;
      const f32x4 g0 = *(const f32x4*)gn, g1 = *(const f32x4*)(gn + 4);
      const float qs = (kind == EK_Q) ? 0.125f * 1.4426950408889634f : 1.0f;
      const int i0 = (TID & 7) * 4;
#pragma unroll 4
      for (int it = 0; it < 16; ++it) {
        int col, c; unsigned char* sl = slot_of(it, col, c);
        const int tok = tn * 256 + col;
        const int pos = tok < NTP ? (tok & 4095) : ((tok - NTP) & 8191);
        const float* rp = (const float*)(p.ws + WS_ROPE) + 2 * ((i0 < 16) ? (pos >> 6) * 16 + i0 : (pos & 63) * 16 + i0 - 16);
        const f32x4 cs0 = gld<f32x4>(rp), cs1 = gld<f32x4>(rp + 4);
        float f[8], r[8];
        unpack8(*(const u32x4*)sl, f);
        const float tr = lrs[col];
        float ss = 0.f;
#pragma unroll
        for (int i = 0; i < 8; ++i) { f[i] *= tr; ss += f[i] * f[i]; }
        ss += __shfl_xor(ss, 1); ss += __shfl_xor(ss, 2); ss += __shfl_xor(ss, 4);
        const float rstd = rsqrtf(ss * (1.0f / 64.0f) + 1e-6f) * qs;
        const float x0 = f[0] * rstd * g0[0], x1 = f[1] * rstd * g0[1], x2 = f[2] * rstd * g0[2], x3 = f[3] * rstd * g0[3];
        const float x4 = f[4] * rstd * g1[0], x5 = f[5] * rstd * g1[1], x6 = f[6] * rstd * g1[2], x7 = f[7] * rstd * g1[3];
        r[0] = x0 * cs0[0] - x1 * cs0[1]; r[1] = x0 * cs0[1] + x1 * cs0[0];
        r[2] = x2 * cs0[2] - x3 * cs0[3]; r[3] = x2 * cs0[3] + x3 * cs0[2];
        r[4] = x4 * cs1[0] - x5 * cs1[1]; r[5] = x4 * cs1[1] + x5 * cs1[0];
        r[6] = x6 * cs1[2] - x7 * cs1[3]; r[7] = x6 * cs1[3] + x7 * cs1[2];
        *(u32x4*)sl = pack8(r);
      }
    }
#pragma unroll 4
    for (int it = 0; it < 16; ++it) {
      int col, c; unsigned char* sl = slot_of(it, col, c);
      const u32x4 v = *(const u32x4*)sl;
      u16* dst;
      if (kind == EK_Q) dst = (u16*)(p.ws + WS_Q) + (size_t)(tn * 256 + col) * 1024 + (tm * 4 + (c >> 3)) * 64 + (c & 7) * 8;
      else if (kind == EK_K) dst = (u16*)(p.ws + WS_K) + ((size_t)(c >> 3) * NT + tn * 256 + col) * 64 + (c & 7) * 8;
      else if (kind == EK_Y) dst = (u16*)(p.ws + WS_Y) + (size_t)(tn / 10) * NT * 16 + (size_t)((tn % 10) * 256 + col) * 512 + tm * 256 + c * 8;
      else dst = (u16*)(p.ws + WS_Q) + (size_t)(tn * 256 + col) * 1024 + tm * 256 + c * 8;
      gst<u32x4>(dst, v);
    }
    __syncthreads();
    return;
  }
  if (kind == EK_OUT || kind == EK_FF2) {
    const int cc = tm * 256 + (TID & 31) * 8;
#pragma unroll 1
    for (int it0 = 0; it0 < 16; it0 += 4) {
      f32x4 X0[4], X1[4];
#pragma unroll
      for (int k = 0; k < 4; ++k) {
        const int tok = tn * 256 + (((it0 + k) * 512 + TID) >> 5);
        const float* x = (kind == EK_OUT) ? xrow(p, layer, tok) + cc : p.out + (size_t)tok * 1024 + cc;
        X0[k] = gld<f32x4>(x); X1[k] = gld<f32x4>(x + 4);
      }
#pragma unroll
      for (int k = 0; k < 4; ++k) {
        const int q = (it0 + k) * 512 + TID;
        const int col = q >> 5, c = q & 31;
        const int tok = tn * 256 + col;
        float f[8], r[8];
        unpack8(*(const u32x4*)(smem + col * 512 + ((c ^ (col & 31)) << 4)), f);
        float* o = p.out + (size_t)tok * 1024 + cc;
        f32x4 o0, o1;
        float ss = 0.f;
#pragma unroll
        for (int i = 0; i < 4; ++i) { o0[i] = X0[k][i] + f[i]; o1[i] = X1[k][i] + f[4 + i]; r[i] = o0[i]; r[4 + i] = o1[i]; ss += o0[i] * o0[i] + o1[i] * o1[i]; }
        gst<f32x4>(o, o0); gst<f32x4>(o + 4, o1);
        gst<u32x4>((u16*)(p.ws + WS_XN) + (size_t)tok * 1024 + cc, pack8(r));
        ss += __shfl_xor(ss, 1); ss += __shfl_xor(ss, 2); ss += __shfl_xor(ss, 4); ss += __shfl_xor(ss, 8); ss += __shfl_xor(ss, 16);
        if (c == 0) ((float*)(p.ws + WS_SSQ))[(size_t)tm * NT + tok] = ss;
      }
    }
    __syncthreads();
    return;
  }
#pragma unroll 2
  for (int it = 0; it < nit; ++it) {
    const int q = it * 512 + TID;
    int col = q >> 5, c = q & 31;
    if (kind == EK_U) { col = (q >> 1) & 255; c = ((q >> 9) << 1) | (q & 1); }
    const u32x4 sv = *(const u32x4*)(smem + col * 512 + ((c ^ (col & 31)) << 4));
    float f[8], r[8];
    unpack8(sv, f);
#if PROBE_MASK
    if (kind == -2) { if (f[0] > 1e30f) *(u32x4*)(p.ws + WS_FF) = sv; continue; }
#endif
    switch (kind) {
      case EK_V: {
        {
          const int tok0 = tn * 256 + c * 8;
#pragma unroll
          for (int i = 0; i < 8; ++i) r[i] = f[i] * lrs[c * 8 + i];
          gst<u32x4>((u16*)(p.ws + WS_VT) + (size_t)col * NT + tok0, pack8(r));
        }
      } break;
      case EK_U: {
        const int tok = tn * 256 + col, g = (tm - 6) * 16 + (c >> 1);
        const float tr = lrs[col];
#pragma unroll
        for (int i = 0; i < 8; ++i) r[i] = f[i] * tr;
        gst<u32x4>((u16*)(p.ws + WS_ASSM) + ((size_t)g * NCH + (tok >> 5)) * ASTR + (tok & 31) * 16 + (c & 1) * 8, pack8(r));
      } break;
      case EK_M0: case EK_M3: {
        const size_t o = (size_t)(tn * 256 + col) * 1024 + tm * 256 + c * 8;
        const float tr = (kind == EK_M3) ? lrs[col] : 1.0f;
#pragma unroll
        for (int i = 0; i < 8; ++i) r[i] = sigmoidf_(f[i] * tr);
        gst<u32x4>((kind == EK_M3 ? (u16*)(p.ws + WS_ASSM) : (u16*)(p.ws + WS_Q)) + o, pack8(r));
      } break;
      case EK_FF1: {
        const float tr = lrs[col];
#pragma unroll
        for (int i = 0; i < 8; ++i) { const float a = fmaxf(f[i] * tr, 0.f); r[i] = a * a; }
        gst<u32x4>((u16*)(p.ws + WS_FF) + ((size_t)(tn * 16 + tm) << 16) + col * 256 + c * 8, pack8(r));
      } break;
    }
  }
  __syncthreads();
}

DI void make_job(const P& pin, int layer, int s, int w, int step, Job& jb) {
  struct { unsigned char* ws; } p;
  p.ws = pin.ws;
  asm volatile("" : "+s"(p.ws));
  const u16* XN = (const u16*)(p.ws + WS_XN);
  jb.layer = layer; jb.gsB = 16; jb.tmB = 0;
  if (s == 1) {
    int g = w / 10;
    jb.A = (const u16*)(p.ws + WS_W1T) + ((size_t)layer * 32 + g) * 256 * 512;
    jb.Bt = (const u16*)(p.ws + WS_ASSM) + (size_t)w * 256 * ASTR;
    jb.lda = 512; jb.ldb = ASTR; jb.K = 512; jb.kind = EK_S; jb.tm = 0; jb.tn = w;
    return;
  }
  if (s == 3) {
    int gc = w >> 1, rt = w & 1, g = gc / 10;
    jb.A = (const u16*)(p.ws + WS_WYT) + (((size_t)layer * 32 + g) * 512 + rt * 256) * ASTR;
    jb.Bt = (const u16*)(p.ws + WS_ASSM) + (size_t)gc * 256 * ASTR;
    jb.lda = ASTR; jb.ldb = ASTR; jb.K = ASTR; jb.kind = EK_Y; jb.tm = rt; jb.tn = gc;
    return;
  }
  const int nft = (s == 0) ? 8 : (s == 6) ? 16 : 4;
  int tt, ft; tile_map(w, nft, tt, ft);
  jb.tm = ft; jb.tn = tt;
  jb.lda = 1024; jb.ldb = 1024; jb.K = 1024;
  if (s == 0) {
    const u16* W = (const u16*)(p.ws + WS_WT_IN) + (size_t)layer * 4096 * 1024 + (size_t)ft * 256 * 1024;
    const u16* X = XN + (size_t)tt * 256 * 1024;
    if (ft == 5) { jb.A = X; jb.Bt = W; jb.kind = EK_V; }
    else { jb.A = W; jb.Bt = X; jb.kind = ft < 4 ? EK_Q : ft == 4 ? EK_K : EK_U; }
  } else if (s == 4) {
    jb.kind = EK_M0 + step;
    if (step < 2) {
      jb.A = (const u16*)(p.ws + (step == 0 ? WS_WT_GB : WS_WT_GA)) + (size_t)layer * 1024 * 512 + (size_t)ft * 256 * 512;
      jb.Bt = (const u16*)(p.ws + WS_Y) + (size_t)tt * 256 * 16;
      jb.lda = 512; jb.ldb = 16; jb.gsB = NT * 16; jb.K = 512;
    } else if (step < 4) {
      jb.A = (const u16*)(p.ws + WS_WT_IN) + (size_t)layer * 4096 * 1024 + (size_t)((step == 2 ? 3072 : 2048) + ft * 256) * 1024;
      jb.Bt = XN + (size_t)tt * 256 * 1024;
    } else {
      jb.A = (const u16*)(p.ws + WS_WT_AP) + (size_t)layer * 1024 * 1024 + (size_t)ft * 256 * 1024;
      jb.Bt = (const u16*)(p.ws + WS_ATTO) + (size_t)tt * 256 * 1024;
    }
  } else if (s == 5) {
    jb.A = (const u16*)(p.ws + WS_WT_OUT) + (size_t)layer * 1024 * 1024 + (size_t)ft * 256 * 1024;
    jb.Bt = (const u16*)(p.ws + WS_Q) + (size_t)tt * 256 * 1024; jb.kind = EK_OUT;
  } else if (s == 6) {
    jb.A = (const u16*)(p.ws + WS_WT_FF1) + (size_t)layer * 4096 * 1024 + (size_t)ft * 256 * 1024;
    jb.Bt = XN + (size_t)tt * 256 * 1024; jb.kind = EK_FF1;
  } else {
    jb.A = (const u16*)(p.ws + WS_WT_FF2) + (size_t)layer * 1024 * 4096 + (size_t)ft * 256 * 4096;
    jb.Bt = (const u16*)(p.ws + WS_FF) + ((size_t)tt * 16 << 16);
    jb.lda = 4096; jb.ldb = 256; jb.tmB = 1; jb.K = 4096; jb.kind = EK_FF2;
  }
}

DI void phase_jobs(const P& p, int layer, int s, int probe = 0) {
  int nitems, nsteps = 1, nattn = 0;
  switch (s) {
    case 0: nitems = 2560; break;
    case 1: nitems = 320; break;
    case 3: nitems = 3200; nattn = 2560; break;
    case 4: nitems = 1280; nsteps = 5; break;
    case 5: nitems = 1280; break;
    case 6: nitems = 5120; break;
    default: nitems = 1280; break;
  }
#if STAGGER_SLEEP
  if (s != 3) {
    const int slot = (blockIdx.x >> 3) & 31;
    for (int i = 0; i < slot; ++i) __builtin_amdgcn_s_sleep(STAGGER_SLEEP);
  }
#endif
  for (int w = blockIdx.x; w < nitems; w += gridDim.x) {
    if (w < nattn) {
      int seq_start, L, head, qb;
      if (w < 512) {
        int xcd = w & 7, r = w >> 3;
        int seq = xcd >> 2, kvh = xcd & 3;
        seq_start = NTP + seq * 8192; L = 8192; head = kvh * 4 + (r >> 4); qb = r & 15;
      } else {
        int w2 = w - 512, xcd = w2 & 7, r = w2 >> 3;
        int grp = (r >> 5) * 8 + xcd, within = r & 31;
        int seq = grp >> 2, kvh = grp & 3;
        seq_start = seq * 4096; L = 4096; head = kvh * 4 + (within >> 3); qb = within & 7;
      }
      attn_item(p, layer, seq_start, L, head, qb);
    } else {
      for (int step = 0; step < nsteps; ++step) {
        Job jb;
        make_job(p, layer, s, w - nattn, step, jb);
#if PROBE_MASK
        if (probe == 2 || probe == 3) jb.kind = -1;
        if (probe == 3) jb.K = jb.K / 2;
#endif
        gemm_tile(jb.A, jb.Bt, jb.lda, jb.ldb, jb.gsB, jb.tmB, jb.K, [&](AccT& acc) {
          int w2 = w - nattn, st2 = step;
          asm volatile("" : "+s"(w2), "+s"(st2));
          Job j2;
          make_job(p, layer, s, w2, st2, j2);
#if PROBE_MASK
          if (probe == 2 || probe == 3) j2.kind = -1;
          if (probe == 4) j2.kind = -2;
          if (probe == 6) j2.layer |= 256;
          if (probe == 7) j2.layer |= 512;
          if (probe == 8) j2.layer |= 1024 | 2048;
          if (probe == 9) j2.layer |= 1024;
          if (probe == 10) j2.layer |= 1024 | 4096;
          if (probe == 11) j2.layer |= 1024 | 8192;
          if (probe == 12) j2.layer |= 1024 | 2048 | 16384;
          if (probe == 5) j2.kind = -3;
#endif
          run_epilogue(p, j2, acc);
        });
      }
    }
  }
}

DI void run_phase(const P& pin, int ph, int probe = 0) {
  P p = pin;
  asm volatile("" : "+s"(p.ws), "+s"(p.out));
  int layer = (ph - 3) / 8, s = (ph - 3) % 8;
  if (s == 2) phase_scan(p, layer);
  else phase_jobs(p, layer, s, probe);
}

__global__ void __launch_bounds__(512, 2) mega_coop(P p) {
  cg::grid_group grid = cg::this_grid();
  phase_prep_a(p);
  grid.sync();
  phase_prep_b(p);
  grid.sync();
  phase_prep_c(p);
  phase_convert(p, p.in[0], p.in[1]);
  grid.sync();
  for (int ph = 3; ph < NPHASE; ++ph) {
    run_phase(p, ph);
#if PROBE_MASK
    {
      const int s_ = (ph - 3) % 8;
      bool rep = false;
      if ((PROBE_MASK & 1) && s_ == 3) rep = true;
      if ((PROBE_MASK & 2) && (s_ == 0 || s_ == 4 || s_ == 6)) rep = true;
      if ((PROBE_MASK & 4) && (s_ == 1 || s_ == 2)) rep = true;
      if ((PROBE_MASK & 8) && s_ == 6) run_phase(p, ph, (PROBE_MASK >> 4));
      if (rep) run_phase(p, ph);
    }
#endif
    if (ph + 1 < NPHASE) grid.sync();
  }
}
#if N_LAUNCH_MODE == 0
__global__ void __launch_bounds__(512, 2) mega_one(P p) {
  run_phase(p, p.ph_lo);
}
#endif

extern "C" void kernel_launch(void* const* d_in, const int* in_sizes, int n_in, void* d_out, int out_size, void* d_ws, size_t ws_size,
                              hipStream_t stream) {
  static int grid = 0;
  if (grid == 0) {
    if (n_in != 21 || ws_size < WS_END) { fprintf(stderr, "kernel_launch: unexpected n_in %d / ws_size %zu (need %zu)\n", n_in, ws_size, (size_t)WS_END); grid = -1; return; }
    int dev = 0, cus = 0, per_cu = 0;
    hipGetDevice(&dev);
    hipDeviceGetAttribute(&cus, hipDeviceAttributeMultiprocessorCount, dev);
    hipFuncSetAttribute((const void*)mega_coop, hipFuncAttributeMaxDynamicSharedMemorySize, LDS_BYTES);
#if N_LAUNCH_MODE == 0
    hipFuncSetAttribute((const void*)mega_one, hipFuncAttributeMaxDynamicSharedMemorySize, LDS_BYTES);
#endif
    hipOccupancyMaxActiveBlocksPerMultiprocessor(&per_cu, (const void*)mega_coop, 512, LDS_BYTES);
    if (per_cu < 1) { fprintf(stderr, "kernel_launch: occupancy query says %d blocks/CU\n", per_cu); per_cu = 1; }
    (void)hipGetLastError();
    grid = cus * 1;
  }
  if (grid < 0) return;
  P p{};
  for (int i = 0; i < 21; ++i) p.in[i] = (const float*)d_in[i];
  p.out = (float*)d_out;
  p.ws = (unsigned char*)d_ws;
#if N_LAUNCH_MODE == 1
  p.ph_lo = 0; p.ph_hi = NPHASE;
  void* args[] = {&p};
  hipError_t e = hipLaunchCooperativeKernel((const void*)mega_coop, dim3(grid), dim3(512), args, LDS_BYTES, stream);
  if (e != hipSuccess) fprintf(stderr, "cooperative launch failed: %s (grid %d)\n", hipGetErrorString(e), grid);
#else
  for (int ph = 0; ph < NPHASE; ++ph) {
    p.ph_lo = ph; p.ph_hi = ph + 1;
    hipLaunchKernelGGL(mega_one, dim3(grid), dim3(512), LDS_BYTES, stream, p);
  }
#endif
}
```

```cpp
#include <hip/hip_runtime.h>
#include <hip/hip_cooperative_groups.h>
#include <cstdio>
namespace cg = cooperative_groups;

typedef unsigned short u16;
typedef __attribute__((ext_vector_type(8))) short bf16x8;
typedef __attribute__((ext_vector_type(4))) float f32x4;
typedef __attribute__((ext_vector_type(16))) float f32x16;
typedef __attribute__((ext_vector_type(4))) unsigned u32x4;
typedef __attribute__((ext_vector_type(2))) unsigned u32x2;
typedef __attribute__((ext_vector_type(2))) float f32x2;
typedef __attribute__((ext_vector_type(2))) __bf16 bf16v2;

#define DI __device__ __forceinline__
#ifndef PROBE_MASK
#define PROBE_MASK 0
#endif
#ifndef STAGGER_SLEEP
#define STAGGER_SLEEP 0
#endif
#ifndef N_LAUNCH_MODE
#define N_LAUNCH_MODE 1
#endif

constexpr int NT = 81920;
constexpr int NTP = 65536;
constexpr int NCH = 2560;
constexpr int ASTR = 768;
constexpr int NPHASE = 19;
constexpr int LDS_BYTES = 131072 + 1024;

constexpr size_t MiB = 1ull << 20;
constexpr size_t WS_WT_IN = 0;
constexpr size_t WS_WT_AP = 16 * MiB;
constexpr size_t WS_WT_GA = 20 * MiB;
constexpr size_t WS_WT_GB = 22 * MiB;
constexpr size_t WS_WT_OUT = 24 * MiB;
constexpr size_t WS_WT_FF1 = 28 * MiB;
constexpr size_t WS_WT_FF2 = 44 * MiB;
constexpr size_t WS_W1T = 60 * MiB;
constexpr size_t WS_WYT = 76 * MiB;
constexpr size_t WS_LPOW = 124 * MiB;
constexpr size_t WS_BBAR = 127 * MiB;
constexpr size_t WS_KTAB = 128 * MiB;
constexpr size_t WS_ROPE = 132 * MiB;
constexpr size_t WS_SSQ = 133 * MiB;
constexpr size_t WS_XN = 135 * MiB;
constexpr size_t WS_BIG = 295 * MiB;
constexpr size_t WS_Q = WS_BIG;
constexpr size_t WS_K = WS_BIG + 160 * MiB;
constexpr size_t WS_VT = WS_BIG + 200 * MiB;
constexpr size_t WS_ASSM = WS_BIG + 240 * MiB;
constexpr size_t WS_S = WS_BIG + 360 * MiB;
constexpr size_t WS_Y = WS_BIG + 440 * MiB;
constexpr size_t WS_ATTO = WS_BIG + 520 * MiB;
constexpr size_t WS_FF = WS_BIG;
constexpr size_t WS_END = WS_BIG + 680 * MiB;

struct P {
  const float* in[21];
  float* out;
  unsigned char* ws;
  int ph_lo, ph_hi;
};

DI u16 f2bf(float f) { unsigned u = __float_as_uint(f); u += 0x7fffu + ((u >> 16) & 1u); return (u16)(u >> 16); }
DI float bf2f(u16 h) { return __uint_as_float(((unsigned)h) << 16); }
DI unsigned pk2(float a, float b) {
  f32x2 v; v[0] = a; v[1] = b;
  bf16v2 r = __builtin_convertvector(v, bf16v2);
  return __builtin_bit_cast(unsigned, r);
}
DI float sigmoidf_(float x) { return 1.0f / (1.0f + __expf(-x)); }
DI float gelu_tanh(float x) {
  float z = 0.7978845608028654f * (x + 0.044715f * x * x * x);
  float e = __expf(2.0f * z);
  return 0.5f * x * (2.0f - 2.0f / (e + 1.0f));
}


DI void sincos_d(double x, double* sn, double* cs) {
  const double TWO_PI_HI = 6.283185307179586232e+00, TWO_PI_LO = 2.449293598294706414e-16;
  double k = rint(x * 0.15915494309189534561);
  double r = (x - k * TWO_PI_HI) - k * TWO_PI_LO;
  r *= 0.25;
  double r2 = r * r;
  double s = 1.0, c = 1.0;
  s = 1.0 - r2 / (18.0 * 19.0);
  s = 1.0 - r2 / (16.0 * 17.0) * s;
  s = 1.0 - r2 / (14.0 * 15.0) * s;
  s = 1.0 - r2 / (12.0 * 13.0) * s;
  s = 1.0 - r2 / (10.0 * 11.0) * s;
  s = 1.0 - r2 / (8.0 * 9.0) * s;
  s = 1.0 - r2 / (6.0 * 7.0) * s;
  s = 1.0 - r2 / (4.0 * 5.0) * s;
  s = 1.0 - r2 / (2.0 * 3.0) * s;
  s *= r;
  c = 1.0 - r2 / (17.0 * 18.0);
  c = 1.0 - r2 / (15.0 * 16.0) * c;
  c = 1.0 - r2 / (13.0 * 14.0) * c;
  c = 1.0 - r2 / (11.0 * 12.0) * c;
  c = 1.0 - r2 / (9.0 * 10.0) * c;
  c = 1.0 - r2 / (7.0 * 8.0) * c;
  c = 1.0 - r2 / (5.0 * 6.0) * c;
  c = 1.0 - r2 / (3.0 * 4.0) * c;
  c = 1.0 - r2 / (1.0 * 2.0) * c;
  double s2 = 2.0 * s * c, c2 = c * c - s * s;
  *sn = 2.0 * s2 * c2; *cs = c2 * c2 - s2 * s2;
}

template <class T> DI T gld(const void* q) { return *(const __attribute__((address_space(1))) T*)q; }
template <class T> DI void gst(void* q, const T v) { *(__attribute__((address_space(1))) T*)q = v; }
DI int opaque_tid() { int t = threadIdx.x; asm volatile("" : "+v"(t)); return t; }
DI const char* sgpr_ptr(const char* p) { asm("" : "+s"(p)); return p; }
#define WAIT_V(n) asm volatile("s_waitcnt vmcnt(" #n ")" ::: "memory")
#define WAIT_L(n) asm volatile("s_waitcnt lgkmcnt(" #n ")" ::: "memory")
#define BAR __builtin_amdgcn_s_barrier()
#define SCHED __builtin_amdgcn_sched_barrier(0)
#define GLDS(gp, lp) __builtin_amdgcn_global_load_lds((const unsigned*)(gp), (unsigned*)(lp), 16, 0, 0)

constexpr int GBK = 64, GHALF = 128, GHT = GHALF * GBK;
DI int lds_byte(int r, int c) {
  int st = (r >> 4) * 2 + (c >> 5), rr = r & 15, cc = c & 31, ob = rr * 64 + cc * 2;
  return st * 1024 + (ob ^ (((ob >> 9) & 1) << 5));
}
DI void stage_rc(int b, int& R, int& C) {
  int st = b / 1024, sb = b % 1024, swz = sb ^ (((sb >> 9) & 1) << 5);
  R = (st >> 1) * 16 + swz / 64; C = (st & 1) * 32 + (swz % 64) / 2;
}

typedef f32x4 AccT[2][2][4][2];

template <class Epi>
DI void gemm_tile(const u16* __restrict__ A, const u16* __restrict__ Bt, const int lda, const int ldb, const int gsB, const int tmB, const int K, Epi&& epi) {
  const int TID = opaque_tid();
  extern __shared__ __attribute__((aligned(16))) unsigned char smem[];
  u16* shm = (u16*)smem;
#define SA(b, h) (shm + ((b) * 2 + (h)) * GHT)
#define SB(b, h) (shm + (4 + (b) * 2 + (h)) * GHT)
  int R0, C0, R1, C1;
  stage_rc(TID * 16, R0, C0);
  stage_rc(TID * 16 + 8192, R1, C1);
  const unsigned voA0 = (unsigned)(R0 * lda + C0) * 2u, voA1 = (unsigned)(R1 * lda + C1) * 2u;
  const unsigned voB0 = (unsigned)(R0 * ldb + (C0 & 15) + (C0 >> 4) * gsB) * 2u, voB1 = (unsigned)(R1 * ldb + (C1 & 15) + (C1 >> 4) * gsB) * 2u;
  const int hA = GHALF * lda, hB = GHALF * ldb;
  const unsigned wid_u = __builtin_amdgcn_readfirstlane(TID >> 6);
#define STAGE_A(PTR, half, kt) do { const char* _g = sgpr_ptr((const char*)(A + (size_t)(half) * hA + (size_t)(kt) * GBK)); \
    char* _l = (char*)(PTR) + wid_u * 1024u; \
    GLDS(_g + voA0, _l); GLDS(_g + voA1, _l + 8192); } while (0)
#define STAGE_B(PTR, half, kt) do { const char* _g = sgpr_ptr((const char*)(Bt + (size_t)(half) * hB + (tmB ? (size_t)((((kt) >> 2) << 16) + (((kt) & 3) << 6)) : (size_t)(kt) * (size_t)(4 * gsB)))); \
    char* _l = (char*)(PTR) + wid_u * 1024u; \
    GLDS(_g + voB0, _l); GLDS(_g + voB1, _l + 8192); } while (0)
#define LDA(dst, b, h) for (int m = 0; m < 4; ++m) for (int k = 0; k < 2; ++k) \
    dst[m][k] = *reinterpret_cast<const bf16x8*>((char*)SA(b, h) + lds_byte(wr * 64 + m * 16 + fr, k * 32 + fq * 8))
#define LDB(dst, b, h) for (int n = 0; n < 2; ++n) for (int k = 0; k < 2; ++k) \
    dst[n][k] = *reinterpret_cast<const bf16x8*>((char*)SB(b, h) + lds_byte(wc * 32 + n * 16 + fr, k * 32 + fq * 8))
#define MMA(ai, bj, At, Bq) do { __builtin_amdgcn_s_setprio(1); \
    for (int m = 0; m < 4; ++m) for (int n = 0; n < 2; ++n) for (int k = 0; k < 2; ++k) \
      acc[ai][bj][m][n] = __builtin_amdgcn_mfma_f32_16x16x32_bf16(At[m][k], Bq[n][k], acc[ai][bj][m][n], 0, 0, 0); \
    __builtin_amdgcn_s_setprio(0); } while (0)

  const int wid = TID >> 6, lane = TID & 63, wr = wid >> 2, wc = wid & 3, fr = lane & 15, fq = lane >> 4;
  AccT acc;
#pragma unroll
  for (int a = 0; a < 2; ++a)
#pragma unroll
    for (int b = 0; b < 2; ++b)
#pragma unroll
      for (int m = 0; m < 4; ++m)
#pragma unroll
        for (int n = 0; n < 2; ++n) acc[a][b][m][n] = f32x4{0.f, 0.f, 0.f, 0.f};
  bf16x8 At[4][2], B0[2][2], B1[2][2];
  const int nt = K / GBK;
  STAGE_B(SB(0, 0), 0, 0); STAGE_A(SA(0, 0), 0, 0);
  STAGE_B(SB(0, 1), 1, 0); STAGE_A(SA(0, 1), 1, 0);
  if (wr == 1) BAR;
  WAIT_V(4); BAR;
  STAGE_B(SB(1, 0), 0, 1); STAGE_A(SA(1, 0), 0, 1); STAGE_B(SB(1, 1), 1, 1);
  WAIT_V(6); BAR;
  for (int t = 0; t < nt - 2; t += 2) {
    LDB(B0, 0, 0); SCHED; LDA(At, 0, 0); STAGE_A(SA(1, 1), 1, t + 1);
    WAIT_L(8); BAR; WAIT_L(0); MMA(0, 0, At, B0); BAR; SCHED;
    LDB(B1, 0, 1); STAGE_B(SB(0, 0), 0, t + 2);
    BAR; WAIT_L(0); MMA(0, 1, At, B1); BAR;
    LDA(At, 0, 1); STAGE_A(SA(0, 0), 0, t + 2);
    BAR; WAIT_L(0); MMA(1, 0, At, B0); BAR; SCHED;
    STAGE_B(SB(0, 1), 1, t + 2);
    WAIT_V(6); BAR; MMA(1, 1, At, B1); BAR;
    LDB(B0, 1, 0); SCHED; LDA(At, 1, 0); STAGE_A(SA(0, 1), 1, t + 2);
    WAIT_L(8); BAR; WAIT_L(0); MMA(0, 0, At, B0); BAR; SCHED;
    LDB(B1, 1, 1); STAGE_B(SB(1, 0), 0, t + 3);
    BAR; WAIT_L(0); MMA(0, 1, At, B1); BAR;
    LDA(At, 1, 1); STAGE_A(SA(1, 0), 0, t + 3);
    BAR; WAIT_L(0); MMA(1, 0, At, B0); BAR; SCHED;
    STAGE_B(SB(1, 1), 1, t + 3);
    WAIT_V(6); BAR; MMA(1, 1, At, B1); BAR;
  }
  { LDB(B0, 0, 0); LDA(At, 0, 0); STAGE_A(SA(1, 1), 1, nt - 1);
    BAR; WAIT_L(0); MMA(0, 0, At, B0); BAR;
    LDB(B1, 0, 1); BAR; WAIT_L(0); MMA(0, 1, At, B1); BAR;
    LDA(At, 0, 1); WAIT_V(4); BAR; WAIT_L(0); MMA(1, 0, At, B0); MMA(1, 1, At, B1); BAR; }
  { LDB(B0, 1, 0); LDA(At, 1, 0); WAIT_V(2); BAR; WAIT_L(0); MMA(0, 0, At, B0); BAR;
    LDB(B1, 1, 1); WAIT_V(0); BAR; WAIT_L(0); MMA(0, 1, At, B1); BAR;
    LDA(At, 1, 1); BAR; WAIT_L(0); MMA(1, 0, At, B0); MMA(1, 1, At, B1); BAR; }
  if (wr == 0) BAR;
  epi(acc);
#undef SA
#undef SB
}

template <class F>
DI void epi_for(AccT& acc, F&& f) {
  const int TID = opaque_tid();
  const int _wid = TID >> 6, _lane = TID & 63, _wr = _wid >> 2, _wc = _wid & 3, _fr = _lane & 15, _fq = _lane >> 4;
#pragma unroll
  for (int _ai = 0; _ai < 2; ++_ai)
#pragma unroll
    for (int _bj = 0; _bj < 2; ++_bj)
#pragma unroll
      for (int _m = 0; _m < 4; ++_m)
#pragma unroll
        for (int _n = 0; _n < 2; ++_n)
          f(_ai * 128 + _wr * 64 + _m * 16 + _fq * 4, _bj * 128 + _wc * 32 + _n * 16 + _fr, acc[_ai][_bj][_m][_n]);
}

DI void tile_map(int w, int ntn, int& tm, int& tn) {
  int xcd = w & 7, r = w >> 3;
  tn = r % ntn; tm = (r / ntn) * 8 + xcd;
}

DI void transpose_tile(const float* __restrict__ src, int N, u16* __restrict__ dst, int K, int tk, int tn, const float* __restrict__ gain) {
  const int TID = opaque_tid();
  extern __shared__ __attribute__((aligned(16))) unsigned char smem[];
  float* tile = (float*)smem;
  const int t = TID;
  {
    int rk = t >> 3, cs = (t & 7) * 8;
    const float4* s = (const float4*)(src + (size_t)(tk * 64 + rk) * N + tn * 64 + cs);
    float4 a = s[0], b = s[1];
    if (gain) { const float gk = gain[tk * 64 + rk]; a.x *= gk; a.y *= gk; a.z *= gk; a.w *= gk; b.x *= gk; b.y *= gk; b.z *= gk; b.w *= gk; }
    float* d = tile + rk * 65 + cs;
    d[0] = a.x; d[1] = a.y; d[2] = a.z; d[3] = a.w; d[4] = b.x; d[5] = b.y; d[6] = b.z; d[7] = b.w;
  }
  __syncthreads();
  {
    int n = t >> 3, ks = (t & 7) * 8;
    u32x4 o;
    o[0] = pk2(tile[(ks + 0) * 65 + n], tile[(ks + 1) * 65 + n]);
    o[1] = pk2(tile[(ks + 2) * 65 + n], tile[(ks + 3) * 65 + n]);
    o[2] = pk2(tile[(ks + 4) * 65 + n], tile[(ks + 5) * 65 + n]);
    o[3] = pk2(tile[(ks + 6) * 65 + n], tile[(ks + 7) * 65 + n]);
    *(u32x4*)(dst + (size_t)(tn * 64 + n) * K + tk * 64 + ks) = o;
  }
  __syncthreads();
}

DI void phase_prep_a(const P& p) {
  const int TID = opaque_tid();
  const int bid = blockIdx.x, nb = gridDim.x;
  for (int w = bid; w < 7680; w += nb) {
    int layer = w / 3840, r = w % 3840;
    const float* src; u16* dst; int K, N, tl; const float* gain = nullptr;
    if (r < 1024) { src = p.in[3] + (size_t)layer * 1024 * 4096; dst = (u16*)(p.ws + WS_WT_IN) + (size_t)layer * 4096 * 1024; K = 1024; N = 4096; tl = r; gain = p.in[2] + layer * 1024; }
    else if (r < 1280) { src = p.in[6] + (size_t)layer * 1024 * 1024; dst = (u16*)(p.ws + WS_WT_AP) + (size_t)layer * 1024 * 1024; K = 1024; N = 1024; tl = r - 1024; }
    else if (r < 1408) { src = p.in[15] + (size_t)layer * 512 * 1024; dst = (u16*)(p.ws + WS_WT_GA) + (size_t)layer * 1024 * 512; K = 512; N = 1024; tl = r - 1280; }
    else if (r < 1536) { src = p.in[16] + (size_t)layer * 512 * 1024; dst = (u16*)(p.ws + WS_WT_GB) + (size_t)layer * 1024 * 512; K = 512; N = 1024; tl = r - 1408; }
    else if (r < 1792) { src = p.in[17] + (size_t)layer * 1024 * 1024; dst = (u16*)(p.ws + WS_WT_OUT) + (size_t)layer * 1024 * 1024; K = 1024; N = 1024; tl = r - 1536; }
    else if (r < 2816) { src = p.in[19] + (size_t)layer * 1024 * 4096; dst = (u16*)(p.ws + WS_WT_FF1) + (size_t)layer * 4096 * 1024; K = 1024; N = 4096; tl = r - 1792; gain = p.in[18] + layer * 1024; }
    else { src = p.in[20] + (size_t)layer * 4096 * 1024; dst = (u16*)(p.ws + WS_WT_FF2) + (size_t)layer * 1024 * 4096; K = 4096; N = 1024; tl = r - 2816; }
    int ntn = N / 64;
    transpose_tile(src, N, dst, K, tl / ntn, tl % ntn, gain);
  }
  const int gtid = bid * 512 + TID, nth = nb * 512;
  float2* LP = (float2*)(p.ws + WS_LPOW);
  float2* BB = (float2*)(p.ws + WS_BBAR);
  for (int idx = gtid; idx < 8192 * 33; idx += nth) {
    const int i = idx / 33, tau = idx - i * 33, lg = i >> 6;
    const double step = exp((double)p.in[9][lg]);
    const double zr = (double)p.in[7][i] * step, zi = (double)p.in[8][i] * step;
    double e = exp(zr * tau), sn, cs;
    sincos_d(zi * tau, &sn, &cs);
    LP[idx] = make_float2((float)(e * cs), (float)(e * sn));
  }
  for (int idx = gtid; idx < 8192 * 16; idx += nth) {
    const int i = idx >> 4, ci = idx & 15, lg = i >> 6;
    const double step = exp((double)p.in[9][lg]);
    const double lr = p.in[7][i], li = p.in[8][i];
    const double zr = lr * step, zi = li * step;
    double e = exp(zr), sn, cs;
    sincos_d(zi, &sn, &cs);
    const double nr = e * cs - 1.0, ni = e * sn, den = lr * lr + li * li;
    const double fr = (nr * lr + ni * li) / den, fi = (ni * lr - nr * li) / den;
    const double br = p.in[10][idx], bi = p.in[11][idx];
    BB[idx] = make_float2((float)(fr * br - fi * bi), (float)(fr * bi + fi * br));
  }
  float2* RP = (float2*)(p.ws + WS_ROPE);
  for (int i = gtid; i < 128 * 16; i += nth) {
    int pos = i >> 4, f = i & 15;
    double inv = exp(-(double)(2 * f) / 32.0 * 9.210340371976184);
    double sn, cs;
    sincos_d((double)pos * inv, &sn, &cs);
    RP[i] = make_float2((float)cs, (float)sn);
  }
}

DI void phase_prep_b(const P& p) {
  const int TID = opaque_tid();
  const int gtid = blockIdx.x * 512 + TID, nth = gridDim.x * 512;
  const float2* LP = (const float2*)(p.ws + WS_LPOW);
  const float2* BB = (const float2*)(p.ws + WS_BBAR);
  float* KT = (float*)(p.ws + WS_KTAB);
  const float* cre = p.in[12];
  const float* cim = p.in[13];
  {
    extern __shared__ __attribute__((aligned(16))) unsigned char smem[];
    float2* Cs = (float2*)smem;
    float2* Bs = Cs + 1024;
    float2* Ls = Bs + 1024;
    for (int item = blockIdx.x; item < 256; item += gridDim.x) {
      const int lg = item >> 1, th = item & 1;
      for (int e = TID; e < 1024; e += 512) {
        Cs[e] = make_float2(cre[(size_t)lg * 1024 + e], cim[(size_t)lg * 1024 + e]);
        Bs[e] = BB[(size_t)lg * 1024 + e];
        Ls[e] = LP[(size_t)(lg * 64 + (e >> 4)) * 33 + th * 16 + (e & 15)];
      }
      __syncthreads();
      const int co = (TID >> 4) & 15, ci = TID & 15, tsel = TID >> 8;
      float a8[8];
#pragma unroll
      for (int k = 0; k < 8; ++k) a8[k] = 0.f;
      for (int pp = 0; pp < 64; ++pp) {
        const float2 c = Cs[co * 64 + pp], b = Bs[pp * 16 + ci];
        const float zr = c.x * b.x - c.y * b.y, zi = c.x * b.y + c.y * b.x;
#pragma unroll
        for (int k = 0; k < 8; ++k) { const float2 l = Ls[pp * 16 + tsel + 2 * k]; a8[k] += zr * l.x - zi * l.y; }
      }
#pragma unroll
      for (int k = 0; k < 8; ++k) KT[(((size_t)lg * 32 + th * 16 + tsel + 2 * k) * 16 + co) * 16 + ci] = a8[k];
      __syncthreads();
    }
  }
  u16* W1 = (u16*)(p.ws + WS_W1T);
  for (int i8 = gtid; i8 < (1 << 20); i8 += nth) {
    const int i = i8 << 3;
    const int k = i & 511, n = (i >> 9) & 255, g = (i >> 17) & 31, layer = i >> 22;
    const int dir = n >> 7, pp = (n >> 1) & 63, ri = n & 1, sidx = k >> 4, ci0 = k & 15;
    const int e = dir ? sidx : 31 - sidx;
    const int lg = (layer * 2 + dir) * 32 + g;
    const float2 l = LP[(size_t)(lg * 64 + pp) * 33 + e];
    const float2* b = BB + (size_t)(lg * 64 + pp) * 16 + ci0;
    float v[8];
#pragma unroll
    for (int q = 0; q < 8; ++q) { const float2 bq = b[q]; v[q] = ri ? (l.x * bq.y + l.y * bq.x) : (l.x * bq.x - l.y * bq.y); }
    u32x4 o;
    o[0] = pk2(v[0], v[1]); o[1] = pk2(v[2], v[3]); o[2] = pk2(v[4], v[5]); o[3] = pk2(v[6], v[7]);
    *(u32x4*)(W1 + i) = o;
  }
  u16* WY = (u16*)(p.ws + WS_WYT);
  for (int i8 = gtid; i8 < (1 << 20); i8 += nth) {
    const int i = i8 << 3;
    const int kk = i & 255, n = (i >> 8) & 511, g = (i >> 17) & 31, layer = i >> 22;
    const int t = n >> 4, co = n & 15, dir = kk >> 7, pp0 = (kk >> 1) & 63;
    const int e = dir ? 32 - t : t + 1;
    const int lg = (layer * 2 + dir) * 32 + g;
    float v[8];
#pragma unroll
    for (int q = 0; q < 4; ++q) {
      const float cr = cre[(size_t)(lg * 16 + co) * 64 + pp0 + q], cI = cim[(size_t)(lg * 16 + co) * 64 + pp0 + q];
      const float2 l = LP[(size_t)(lg * 64 + pp0 + q) * 33 + e];
      v[2 * q] = cr * l.x - cI * l.y;
      v[2 * q + 1] = -(cr * l.y + cI * l.x);
    }
    u32x4 o;
    o[0] = pk2(v[0], v[1]); o[1] = pk2(v[2], v[3]); o[2] = pk2(v[4], v[5]); o[3] = pk2(v[6], v[7]);
    *(u32x4*)(WY + ((size_t)((layer * 32 + g) * 512 + n)) * ASTR + 512 + kk) = o;
  }
}

DI void phase_prep_c(const P& p) {
  const int TID = opaque_tid();
#if PROBE_MASK & 64
  {
    u32x4* dst = (u32x4*)(p.ws + WS_FF);
    u32x4 z; z[0] = 1; z[1] = 2; z[2] = 3; z[3] = 4;
    for (unsigned i = blockIdx.x * 512 + TID; i < 640u * 65536u; i += gridDim.x * 512) { z[0] = i * 2654435761u; z[1] = z[0] ^ (i << 7); z[2] = z[1] * 40503u + i; z[3] = z[2] ^ z[0]; dst[i] = z; }
  }
#endif
  const int gtid = blockIdx.x * 512 + TID, nth = gridDim.x * 512;
  const float* KT = (const float*)(p.ws + WS_KTAB);
  u16* WY = (u16*)(p.ws + WS_WYT);
  for (int i = gtid; i < (1 << 21); i += nth) {
    int k8 = i & 63, n = (i >> 6) & 511, g = (i >> 15) & 31, layer = i >> 20;
    int t = n >> 4, co = n & 15, s = k8 >> 1, ci0 = (k8 & 1) * 8;
    int tau = t - s;
    float v[8];
    if (tau > 0) {
      const float* q = KT + ((((size_t)(layer * 2 + 0) * 32 + g) * 32 + tau) * 16 + co) * 16 + ci0;
#pragma unroll
      for (int j = 0; j < 8; ++j) v[j] = q[j];
    } else if (tau < 0) {
      const float* q = KT + ((((size_t)(layer * 2 + 1) * 32 + g) * 32 - tau) * 16 + co) * 16 + ci0;
#pragma unroll
      for (int j = 0; j < 8; ++j) v[j] = q[j];
    } else {
      const float* q0 = KT + ((((size_t)(layer * 2 + 0) * 32 + g) * 32) * 16 + co) * 16 + ci0;
      const float* q1 = KT + ((((size_t)(layer * 2 + 1) * 32 + g) * 32) * 16 + co) * 16 + ci0;
#pragma unroll
      for (int j = 0; j < 8; ++j) v[j] = q0[j] + q1[j];
    }
    u32x4 o;
    o[0] = pk2(v[0], v[1]); o[1] = pk2(v[2], v[3]); o[2] = pk2(v[4], v[5]); o[3] = pk2(v[6], v[7]);
    *(u32x4*)(WY + ((size_t)((layer * 32 + g) * 512 + n)) * ASTR + k8 * 8) = o;
  }
}

DI const float* xrow(const P& p, int layer, int tok) {
  if (layer == 0) return tok < NTP ? p.in[0] + (size_t)tok * 1024 : p.in[1] + (size_t)(tok - NTP) * 1024;
  return p.out + (size_t)tok * 1024;
}
DI void phase_convert(const P& p, const float* __restrict__ src0, const float* __restrict__ src1) {
  const int TID = opaque_tid();
  const int lane = TID & 63, wave = TID >> 6;
  u16* XN = (u16*)(p.ws + WS_XN);
  float* SSQ = (float*)(p.ws + WS_SSQ);
  for (int tok = blockIdx.x * 8 + wave; tok < NT; tok += gridDim.x * 8) {
    const float* x = tok < NTP ? src0 + (size_t)tok * 1024 : src1 + (size_t)(tok - NTP) * 1024;
    float4 v[4];
    float ss = 0.f;
#pragma unroll
    for (int i = 0; i < 4; ++i) {
      v[i] = *(const float4*)(x + i * 256 + lane * 4);
      ss += v[i].x * v[i].x + v[i].y * v[i].y + v[i].z * v[i].z + v[i].w * v[i].w;
    }
#pragma unroll
    for (int o = 32; o >= 1; o >>= 1) ss += __shfl_xor(ss, o);
    if (lane < 4) SSQ[(size_t)lane * NT + tok] = lane == 0 ? ss : 0.f;
#pragma unroll
    for (int i = 0; i < 4; ++i) {
      u32x2 o;
      o[0] = pk2(v[i].x, v[i].y);
      o[1] = pk2(v[i].z, v[i].w);
      *(u32x2*)(XN + (size_t)tok * 1024 + i * 256 + lane * 4) = o;
    }
  }
}

DI void phase_scan(const P& p, int layer) {
  const int TID = opaque_tid();
  const int gtid = blockIdx.x * 512 + TID, nth = gridDim.x * 512;
  const float2* LP = (const float2*)(p.ws + WS_LPOW);
  for (int i = gtid; i < 18 * 4096; i += nth) {
    int pp = i & 63, dir = (i >> 6) & 1, g = (i >> 7) & 31, seq = i >> 12;
    int c0 = seq < 16 ? seq * 128 : 2048 + (seq - 16) * 256;
    int nc = seq < 16 ? 128 : 256;
    float2 a = LP[(size_t)(((layer * 2 + dir) * 32 + g) * 64 + pp) * 33 + 32];
    const float2* S = (const float2*)(p.ws + WS_S) + ((size_t)(g * NCH + c0) * 256 + dir * 128 + pp * 2) / 2;
    unsigned* H = (unsigned*)((u16*)(p.ws + WS_ASSM) + (size_t)(g * NCH + c0) * ASTR + 512 + dir * 128 + pp * 2);
    float hr = 0.f, hi = 0.f;
    for (int cb = 0; cb < nc; cb += 16) {
      float2 sv[16];
#pragma unroll
      for (int k = 0; k < 16; ++k) {
        const int c = dir == 0 ? cb + k : nc - 1 - cb - k;
        sv[k] = S[(size_t)c * 128];
      }
#pragma unroll
      for (int k = 0; k < 16; ++k) {
        const int c = dir == 0 ? cb + k : nc - 1 - cb - k;
        H[(size_t)c * (ASTR / 2)] = pk2(hr, hi);
        const float nr = a.x * hr - a.y * hi + sv[k].x;
        hi = a.x * hi + a.y * hr + sv[k].y;
        hr = nr;
      }
    }
  }
}

#define MFMA32(a, b, c) __builtin_amdgcn_mfma_f32_32x32x16_bf16((a), (b), (c), 0, 0, 0)
DI void attn_item(const P& pin, int layer, int seq_start, int L, int head, int qb) {
  const int TID = opaque_tid();
  struct { unsigned char* ws; } p;
  p.ws = pin.ws;
  asm volatile("" : "+s"(p.ws));
  extern __shared__ __attribute__((aligned(16))) unsigned char smem[];
  const u16* Q = (const u16*)(p.ws + WS_Q);
  const u16* KB = (const u16*)(p.ws + WS_K);
  const u16* VT = (const u16*)(p.ws + WS_VT);
  const int tid = TID, wave = tid >> 6, lane = tid & 63, r = lane & 31, h = lane >> 5;
  const int kvh = head >> 2;
  const int q0 = seq_start + qb * 512 + wave * 64;
  bf16x8 qf[2][4];
#pragma unroll
  for (int nt = 0; nt < 2; ++nt)
#pragma unroll
    for (int ds = 0; ds < 4; ++ds)
      qf[nt][ds] = gld<bf16x8>(Q + (size_t)(q0 + nt * 32 + r) * 1024 + head * 64 + ds * 16 + h * 8);
#pragma unroll
  for (int nt = 0; nt < 2; ++nt)
#pragma unroll
    for (int ds = 0; ds < 4; ++ds) asm volatile("" ::"v"(qf[nt][ds]));
  bool no_check;
  {
    float gq = fabsf(pin.in[4][layer * 64 + lane]), gk = fabsf(pin.in[5][layer * 64 + lane]);
#pragma unroll
    for (int o = 32; o >= 1; o >>= 1) { gq = fmaxf(gq, __shfl_xor(gq, o)); gk = fmaxf(gk, __shfl_xor(gk, o)); }
    no_check = __builtin_amdgcn_readfirstlane(11.5416f * 1.01f * gq * gk <= 15.5f ? 1 : 0) != 0;
  }
  const int srow = tid >> 3, spos = tid & 7, scc = spos ^ ((srow >> 1) & 7);
  const u16* kg = KB + ((size_t)kvh * NT + seq_start + srow) * 64 + scc * 8;
  const u16* vg = VT + (size_t)(kvh * 64 + srow) * NT + seq_start + scc * 8;
  unsigned char* ldst = smem + tid * 16;
  const int nkt = L >> 6;
  const int pr = ((r >> 4) * 16) + (((r >> 2) & 1) * 8) + (((r >> 3) & 1) * 4) + (r & 3);
  int koff[4];
#pragma unroll
  for (int ds = 0; ds < 4; ++ds) koff[ds] = pr * 128 + (((ds * 2 + h) ^ ((pr >> 1) & 7)) << 4);
  const int vxh = ((r >> 1) & 7) >> 1;
  const int vbase = 8192 + r * 128 + ((h ^ ((r >> 1) & 1)) << 4);

  f32x16 o[2][2];
#pragma unroll
  for (int a = 0; a < 2; ++a)
#pragma unroll
    for (int b = 0; b < 2; ++b)
#pragma unroll
      for (int j = 0; j < 16; ++j) o[a][b][j] = 0.f;
  float mrun[2] = {0.f, 0.f}, lrun[2] = {0.f, 0.f};


#define ATT_STAGE(T, B) do { GLDS(kg + (size_t)(T) * 128 * 64, ldst + (B) * 32768); GLDS(vg + (T) * 128, ldst + (B) * 32768 + 8192); \
    GLDS(kg + (size_t)(T) * 128 * 64 + 64 * 64, ldst + (B) * 32768 + 16384); GLDS(vg + (T) * 128 + 64, ldst + (B) * 32768 + 16384 + 8192); } while (0)
  const int nst = nkt >> 1;
  ATT_STAGE(0, 0);
  ATT_STAGE(1, 1);
  int bcur = 0;
  for (int st = 0; st < nst; ++st) {
    if (st + 1 < nst) { WAIT_V(4); } else { WAIT_V(0); }
    BAR;
    if (st + 2 < nst) {
      int bn = bcur + 2; if (bn >= 3) bn -= 3;
      ATT_STAGE(st + 2, bn);
    }
    const unsigned char* sbase = smem + bcur * 32768;
    auto qk = [&](const int hx, f32x16 (&sc)[2]) {
      const unsigned char* kb = sbase + (hx >> 1) * 16384 + (hx & 1) * 4096;
      bf16x8 kf[4];
#pragma unroll
      for (int ds = 0; ds < 4; ++ds) kf[ds] = *(const bf16x8*)(kb + koff[ds]);
      if (no_check) {
        f32x16 z16;
#pragma unroll
        for (int j = 0; j < 16; ++j) z16[j] = 0.f;
#pragma unroll
        for (int nt = 0; nt < 2; ++nt) sc[nt] = MFMA32(kf[0], qf[nt][0], z16);
      } else {
#pragma unroll
        for (int nt = 0; nt < 2; ++nt) {
#pragma unroll
          for (int j = 0; j < 16; ++j) sc[nt][j] = -mrun[nt];
          sc[nt] = MFMA32(kf[0], qf[nt][0], sc[nt]);
        }
      }
#pragma unroll
      for (int ds = 1; ds < 4; ++ds)
#pragma unroll
        for (int nt = 0; nt < 2; ++nt) sc[nt] = MFMA32(kf[ds], qf[nt][ds], sc[nt]);
    };
    auto sm_pv = [&](const int hx, f32x16 (&sc)[2], f32x16 (&pend)[2], const bool has_pend) {
      const bool chk = !no_check;
      const unsigned char* kb = sbase + (hx >> 1) * 16384;
      const int kt = hx & 1;
      bf16x8 vf[2][2];
#pragma unroll
      for (int s2 = 0; s2 < 2; ++s2)
#pragma unroll
        for (int mt = 0; mt < 2; ++mt) vf[s2][mt] = *(const bf16x8*)(kb + vbase + (((kt * 2 + s2) ^ vxh) << 5) + mt * 4096);
      float mx[2] = {0.f, 0.f};
      if (chk) {
#pragma unroll
        for (int nt = 0; nt < 2; ++nt) {
          float m0 = sc[nt][0];
#pragma unroll
          for (int j = 1; j < 16; ++j) m0 = fmaxf(m0, sc[nt][j]);
          mx[nt] = m0;
        }
      }
      if (chk && __any((fabsf(mx[0]) > 16.0f) | (fabsf(mx[1]) > 16.0f))) {
#pragma unroll
        for (int nt = 0; nt < 2; ++nt) {
          const float mp = fmaxf(mx[nt], __shfl_xor(mx[nt], 32));
          const float dm = (fabsf(mp) > 12.0f) ? mp : 0.0f;
          const float alpha = __builtin_amdgcn_exp2f(-dm);
          mrun[nt] += dm;
          lrun[nt] *= alpha;
#pragma unroll
          for (int j = 0; j < 16; ++j) sc[nt][j] -= dm;
          if (has_pend) {
#pragma unroll
            for (int j = 0; j < 16; ++j) pend[nt][j] -= dm;
          }
#pragma unroll
          for (int mt = 0; mt < 2; ++mt)
#pragma unroll
            for (int j = 0; j < 16; ++j) o[mt][nt][j] *= alpha;
        }
      }
#pragma unroll
      for (int nt = 0; nt < 2; ++nt) {
        float sum = 0.f;
#pragma unroll
        for (int j = 0; j < 16; ++j) { float pv = __builtin_amdgcn_exp2f(sc[nt][j]); sc[nt][j] = pv; sum += pv; }
        lrun[nt] += sum;
      }
#pragma unroll
      for (int s2 = 0; s2 < 2; ++s2) {
        bf16x8 pf[2];
#pragma unroll
        for (int nt = 0; nt < 2; ++nt) {
          u32x4 pk;
#pragma unroll
          for (int i = 0; i < 4; ++i) pk[i] = pk2(sc[nt][s2 * 8 + 2 * i], sc[nt][s2 * 8 + 2 * i + 1]);
          pf[nt] = __builtin_bit_cast(bf16x8, pk);
        }
#pragma unroll
        for (int mt = 0; mt < 2; ++mt)
#pragma unroll
          for (int nt = 0; nt < 2; ++nt) o[mt][nt] = MFMA32(vf[s2][mt], pf[nt], o[mt][nt]);
      }
    };
    f32x16 sa[2], sb[2];
    qk(0, sa);
    qk(1, sb); sm_pv(0, sa, sb, true);
    qk(2, sa); sm_pv(1, sb, sa, true);
    qk(3, sb); sm_pv(2, sa, sb, true);
    sm_pv(3, sb, sa, false);
    bcur = bcur + 1; if (bcur >= 3) bcur = 0;
  }
  unsigned char* ws2 = pin.ws;
  asm volatile("" : "+s"(ws2));
  u16* O = (u16*)(ws2 + WS_ATTO);
  const int tid2 = opaque_tid();
  const int r2 = tid2 & 31, h2 = (tid2 >> 5) & 1;
  const int q0b = seq_start + qb * 512 + (tid2 >> 6) * 64;
#pragma unroll
  for (int nt = 0; nt < 2; ++nt) {
    float l = lrun[nt] + __shfl_xor(lrun[nt], 32);
    float inv = 1.0f / l;
    const int tok = q0b + nt * 32 + r2;
#pragma unroll
    for (int mt = 0; mt < 2; ++mt)
#pragma unroll
      for (int jg = 0; jg < 4; ++jg) {
        u32x2 ov;
        ov[0] = pk2(o[mt][nt][jg * 4 + 0] * inv, o[mt][nt][jg * 4 + 1] * inv);
        ov[1] = pk2(o[mt][nt][jg * 4 + 2] * inv, o[mt][nt][jg * 4 + 3] * inv);
        gst<u32x2>(O + (size_t)tok * 1024 + head * 64 + mt * 32 + jg * 8 + h2 * 4, ov);
      }
  }
  WAIT_L(0);
  BAR;
}


enum { EK_Q = 0, EK_K, EK_V, EK_U, EK_S, EK_Y, EK_M0, EK_M1, EK_M2, EK_M3, EK_M4, EK_OUT, EK_FF1, EK_FF2 };
struct Job {
  const u16* A; const u16* Bt;
  int lda, ldb, gsB, tmB, K, kind, tm, tn, layer;
};

DI void stage_acc(AccT& acc, unsigned char* smem, const int tid, const int linear = 0) {
  const int wid = tid >> 6, lane = tid & 63, wr = wid >> 2, wc = wid & 3, fr = lane & 15, fq = lane >> 4;
#if PROBE_MASK
  if (linear) {
    int k = 0;
#pragma unroll
    for (int ai = 0; ai < 2; ++ai)
#pragma unroll
      for (int bj = 0; bj < 2; ++bj)
#pragma unroll
        for (int m = 0; m < 4; ++m)
#pragma unroll
          for (int n = 0; n < 2; ++n) {
            u32x2 w;
            w[0] = pk2(acc[ai][bj][m][n][0], acc[ai][bj][m][n][1]);
            w[1] = pk2(acc[ai][bj][m][n][2], acc[ai][bj][m][n][3]);
            *(u32x2*)(smem + tid * 8 + k * 4096) = w;
            ++k;
          }
    return;
  }
#endif
#pragma unroll
  for (int ai = 0; ai < 2; ++ai)
#pragma unroll
    for (int bj = 0; bj < 2; ++bj)
#pragma unroll
      for (int m = 0; m < 4; ++m)
#pragma unroll
        for (int n = 0; n < 2; ++n) {
          const int col = bj * 128 + wc * 32 + n * 16 + fr;
          const int row0 = ai * 128 + wr * 64 + m * 16 + fq * 4;
          u32x2 w;
          w[0] = pk2(acc[ai][bj][m][n][0], acc[ai][bj][m][n][1]);
          w[1] = pk2(acc[ai][bj][m][n][2], acc[ai][bj][m][n][3]);
          *(u32x2*)(smem + col * 512 + (((row0 >> 3) ^ (col & 31)) << 4) + ((row0 & 4) << 1)) = w;
        }
}
DI void unpack8(const u32x4 u, float* f) {
#pragma unroll
  for (int i = 0; i < 4; ++i) { f[2 * i] = __uint_as_float(u[i] << 16); f[2 * i + 1] = __uint_as_float(u[i] & 0xffff0000u); }
}
DI u32x4 pack8(const float* f) {
  u32x4 o;
#pragma unroll
  for (int i = 0; i < 4; ++i) o[i] = pk2(f[2 * i], f[2 * i + 1]);
  return o;
}

DI float bflo(unsigned u) { return __uint_as_float(u << 16); }
DI float bfhi(unsigned u) { return __uint_as_float(u & 0xffff0000u); }
DI float tok_rstd(const unsigned char* ws, int tok) {
  const float* q = (const float*)(ws + WS_SSQ) + tok;
  return rsqrtf((q[0] + q[NT] + q[2 * NT] + q[3 * (size_t)NT]) * (1.0f / 1024.0f) + 1e-6f);
}
DI void run_epilogue(const P& pin, const Job& jb, AccT& acc) {
  extern __shared__ __attribute__((aligned(16))) unsigned char smem[];
  const int TID = opaque_tid();
  P p = pin;
  asm volatile("" : "+s"(p.ws), "+s"(p.out));
  const int tm = jb.tm, tn = jb.tn, layer = jb.layer & 255, kind = jb.kind;
  const int nit = (jb.layer & 256) ? 8 : (jb.layer & 512) ? 1 : (jb.layer & 1024) ? 0 : 16;
#if PROBE_MASK
  if (kind == -1) return;
  if (kind == -3) {
    u32x4 z; z[0] = acc[0][0][0][0][0] > 1e30f ? 1u : 0u; z[1] = 2; z[2] = 3; z[3] = 4;
    for (int it = 0; it < 16; ++it) {
      const int q = it * 512 + TID;
      *(u32x4*)((u16*)(p.ws + WS_FF) + (size_t)(tn * 256 + (q >> 5)) * 4096 + tm * 256 + (q & 31) * 8) = z;
    }
    return;
  }
#endif
  if (kind == EK_S) {
    stage_acc(acc, smem, TID);
    __syncthreads();
    const int g = tn / 10, ct = tn % 10;
    const int pp = TID & 63, dir = (TID >> 6) & 1, sq = TID >> 7;
    const int nseq = ct < 8 ? 2 : 1, nc = ct < 8 ? 128 : 256;
    if (sq < nseq) {
      const float2 a = ((const float2*)(p.ws + WS_LPOW))[(size_t)(((layer * 2 + dir) * 32 + g) * 64 + pp) * 33 + 32];
      const int n = dir * 128 + pp * 2;
      unsigned* H = (unsigned*)((u16*)(p.ws + WS_ASSM) + ((size_t)g * NCH + ct * 256 + sq * nc) * ASTR + 512 + n);
      float hr = 0.f, hi = 0.f;
#pragma unroll 8
      for (int k = 0; k < nc; ++k) {
        const int c = dir == 0 ? k : nc - 1 - k;
        const int col = sq * nc + c;
        gst<unsigned>(H + (size_t)c * (ASTR / 2), pk2(hr, hi));
        const unsigned sv = *(const unsigned*)(smem + col * 512 + (((n >> 3) ^ (col & 31)) << 4) + (n & 7) * 2);
        const float nr = a.x * hr - a.y * hi + bflo(sv);
        hi = a.x * hi + a.y * hr + bfhi(sv);
        hr = nr;
      }
    }
    __syncthreads();
    return;
  }
#if PROBE_MASK
  if (jb.layer & 16384) { if (acc[1][1][3][1][3] == 12345.678f) smem[TID] = 1; }
  if (!(jb.layer & 2048))
  for (int rep = (jb.layer & 8192) ? 4 : 1; rep > 0; --rep)
#endif
  stage_acc(acc, smem, TID, (jb.layer & 4096) ? 1 : 0);
  float* lrs = (float*)(smem + 131072);
  if ((kind <= EK_U || kind == EK_M2 || kind == EK_M3 || kind == EK_FF1) && TID < 256) lrs[TID] = tok_rstd(p.ws, tn * 256 + TID);
  __syncthreads();
  const bool two_pass = kind == EK_Q || kind == EK_K || kind == EK_Y || kind == EK_M1 || kind == EK_M2 || kind == EK_M4;
  if (two_pass) {
    auto slot_of = [&](const int it, int& col, int& c) -> unsigned char* {
      const int q = it * 512 + TID;
      col = q >> 5; c = q & 31;
      return smem + col * 512 + ((c ^ (col & 31)) << 4);
    };
    if (kind == EK_M1 || kind == EK_M2 || kind == EK_M4) {
      const u16* T1 = (const u16*)(p.ws + WS_Q) + (size_t)(tn * 256) * 1024 + tm * 256;
      const u16* T2 = (const u16*)(p.ws + WS_ASSM) + (size_t)(tn * 256) * 1024 + tm * 256;
      if (kind == EK_M1) {
#pragma unroll 8
        for (int it = 0; it < 16; ++it) {
          int col, c; unsigned char* sl = slot_of(it, col, c);
          float f[8], a[8], r[8];
          unpack8(gld<u32x4>(T1 + (size_t)col * 1024 + c * 8), a);
          unpack8(*(const u32x4*)sl, f);
#pragma unroll
          for (int i = 0; i < 8; ++i) r[i] = f[i] * a[i];
          *(u32x4*)sl = pack8(r);
        }
      } else if (kind == EK_M2) {
#pragma unroll 8
        for (int it = 0; it < 16; ++it) {
          int col, c; unsigned char* sl = slot_of(it, col, c);
          float f[8], a[8], r[8];
          unpack8(gld<u32x4>(T1 + (size_t)col * 1024 + c * 8), a);
          unpack8(*(const u32x4*)sl, f);
          const float tr = lrs[col];
#pragma unroll
          for (int i = 0; i < 8; ++i) r[i] = sigmoidf_(f[i] * tr) * a[i];
          *(u32x4*)sl = pack8(r);
        }
      } else {
#pragma unroll 8
        for (int it = 0; it < 16; ++it) {
          int col, c; unsigned char* sl = slot_of(it, col, c);
          float f[8], a[8], b[8], r[8];
          unpack8(gld<u32x4>(T1 + (size_t)col * 1024 + c * 8), a);
          unpack8(gld<u32x4>(T2 + (size_t)col * 1024 + c * 8), b);
          unpack8(*(const u32x4*)sl, f);
#pragma unroll
          for (int i = 0; i < 8; ++i) r[i] = b[i] * f[i] + a[i];
          *(u32x4*)sl = pack8(r);
        }
      }
    } else if (kind == EK_Y) {
      const int g = tn / 10, ch0 = (tn % 10) * 256;
      const float* dsk = p.in[14] + layer * 512 + g * 16 + (TID & 1) * 8;
      const f32x4 d0 = *(const f32x4*)dsk, d1 = *(const f32x4*)(dsk + 4);
      const u16* UU = (const u16*)(p.ws + WS_ASSM) + ((size_t)g * NCH + ch0) * ASTR + tm * 256;
#pragma unroll 8
      for (int it = 0; it < 16; ++it) {
        int col, c; unsigned char* sl = slot_of(it, col, c);
        float f[8], u[8], r[8];
        unpack8(gld<u32x4>(UU + (size_t)col * ASTR + c * 8), u);
        unpack8(*(const u32x4*)sl, f);
#pragma unroll
        for (int i = 0; i < 4; ++i) { r[i] = gelu_tanh(f[i] + d0[i] * u[i]); r[4 + i] = gelu_tanh(f[4 + i] + d1[i] * u[4 + i]); }
        *(u32x4*)sl = pack8(r);
      }
    } else {
      const float* gn = (kind == EK_Q ? p.in[4] : p.in[5]) + layer * 64 + (TID & 7) * 8;
      const f32x4 g0 = *(const f32x4*)gn, g1 = *(const f32x4*)(gn + 4);
      const float qs = (kind == EK_Q) ? 0.125f * 1.4426950408889634f : 1.0f;
      const int i0 = (TID & 7) * 4;
#pragma unroll 4
      for (int it = 0; it < 16; ++it) {
        int col, c; unsigned char* sl = slot_of(it, col, c);
        const int tok = tn * 256 + col;
        const int pos = tok < NTP ? (tok & 4095) : ((tok - NTP) & 8191);
        const float* rp = (const float*)(p.ws + WS_ROPE) + 2 * ((i0 < 16) ? (pos >> 6) * 16 + i0 : (pos & 63) * 16 + i0 - 16);
        const f32x4 cs0 = gld<f32x4>(rp), cs1 = gld<f32x4>(rp + 4);
        float f[8], r[8];
        unpack8(*(const u32x4*)sl, f);
        const float tr = lrs[col];
        float ss = 0.f;
#pragma unroll
        for (int i = 0; i < 8; ++i) { f[i] *= tr; ss += f[i] * f[i]; }
        ss += __shfl_xor(ss, 1); ss += __shfl_xor(ss, 2); ss += __shfl_xor(ss, 4);
        const float rstd = rsqrtf(ss * (1.0f / 64.0f) + 1e-6f) * qs;
        const float x0 = f[0] * rstd * g0[0], x1 = f[1] * rstd * g0[1], x2 = f[2] * rstd * g0[2], x3 = f[3] * rstd * g0[3];
        const float x4 = f[4] * rstd * g1[0], x5 = f[5] * rstd * g1[1], x6 = f[6] * rstd * g1[2], x7 = f[7] * rstd * g1[3];
        r[0] = x0 * cs0[0] - x1 * cs0[1]; r[1] = x0 * cs0[1] + x1 * cs0[0];
        r[2] = x2 * cs0[2] - x3 * cs0[3]; r[3] = x2 * cs0[3] + x3 * cs0[2];
        r[4] = x4 * cs1[0] - x5 * cs1[1]; r[5] = x4 * cs1[1] + x5 * cs1[0];
        r[6] = x6 * cs1[2] - x7 * cs1[3]; r[7] = x6 * cs1[3] + x7 * cs1[2];
        *(u32x4*)sl = pack8(r);
      }
    }
#pragma unroll 4
    for (int it = 0; it < 16; ++it) {
      int col, c; unsigned char* sl = slot_of(it, col, c);
      const u32x4 v = *(const u32x4*)sl;
      u16* dst;
      if (kind == EK_Q) dst = (u16*)(p.ws + WS_Q) + (size_t)(tn * 256 + col) * 1024 + (tm * 4 + (c >> 3)) * 64 + (c & 7) * 8;
      else if (kind == EK_K) dst = (u16*)(p.ws + WS_K) + ((size_t)(c >> 3) * NT + tn * 256 + col) * 64 + (c & 7) * 8;
      else if (kind == EK_Y) dst = (u16*)(p.ws + WS_Y) + (size_t)(tn / 10) * NT * 16 + (size_t)((tn % 10) * 256 + col) * 512 + tm * 256 + c * 8;
      else dst = (u16*)(p.ws + WS_Q) + (size_t)(tn * 256 + col) * 1024 + tm * 256 + c * 8;
      gst<u32x4>(dst, v);
    }
    __syncthreads();
    return;
  }
  if (kind == EK_OUT || kind == EK_FF2) {
    const int cc = tm * 256 + (TID & 31) * 8;
#pragma unroll 1
    for (int it0 = 0; it0 < 16; it0 += 4) {
      f32x4 X0[4], X1[4];
#pragma unroll
      for (int k = 0; k < 4; ++k) {
        const int tok = tn * 256 + (((it0 + k) * 512 + TID) >> 5);
        const float* x = (kind == EK_OUT) ? xrow(p, layer, tok) + cc : p.out + (size_t)tok * 1024 + cc;
        X0[k] = gld<f32x4>(x); X1[k] = gld<f32x4>(x + 4);
      }
#pragma unroll
      for (int k = 0; k < 4; ++k) {
        const int q = (it0 + k) * 512 + TID;
        const int col = q >> 5, c = q & 31;
        const int tok = tn * 256 + col;
        float f[8], r[8];
        unpack8(*(const u32x4*)(smem + col * 512 + ((c ^ (col & 31)) << 4)), f);
        float* o = p.out + (size_t)tok * 1024 + cc;
        f32x4 o0, o1;
        float ss = 0.f;
#pragma unroll
        for (int i = 0; i < 4; ++i) { o0[i] = X0[k][i] + f[i]; o1[i] = X1[k][i] + f[4 + i]; r[i] = o0[i]; r[4 + i] = o1[i]; ss += o0[i] * o0[i] + o1[i] * o1[i]; }
        gst<f32x4>(o, o0); gst<f32x4>(o + 4, o1);
        gst<u32x4>((u16*)(p.ws + WS_XN) + (size_t)tok * 1024 + cc, pack8(r));
        ss += __shfl_xor(ss, 1); ss += __shfl_xor(ss, 2); ss += __shfl_xor(ss, 4); ss += __shfl_xor(ss, 8); ss += __shfl_xor(ss, 16);
        if (c == 0) ((float*)(p.ws + WS_SSQ))[(size_t)tm * NT + tok] = ss;
      }
    }
    __syncthreads();
    return;
  }
#pragma unroll 2
  for (int it = 0; it < nit; ++it) {
    const int q = it * 512 + TID;
    int col = q >> 5, c = q & 31;
    if (kind == EK_U) { col = (q >> 1) & 255; c = ((q >> 9) << 1) | (q & 1); }
    const u32x4 sv = *(const u32x4*)(smem + col * 512 + ((c ^ (col & 31)) << 4));
    float f[8], r[8];
    unpack8(sv, f);
#if PROBE_MASK
    if (kind == -2) { if (f[0] > 1e30f) *(u32x4*)(p.ws + WS_FF) = sv; continue; }
#endif
    switch (kind) {
      case EK_V: {
        {
          const int tok0 = tn * 256 + c * 8;
#pragma unroll
          for (int i = 0; i < 8; ++i) r[i] = f[i] * lrs[c * 8 + i];
          gst<u32x4>((u16*)(p.ws + WS_VT) + (size_t)col * NT + tok0, pack8(r));
        }
      } break;
      case EK_U: {
        const int tok = tn * 256 + col, g = (tm - 6) * 16 + (c >> 1);
        const float tr = lrs[col];
#pragma unroll
        for (int i = 0; i < 8; ++i) r[i] = f[i] * tr;
        gst<u32x4>((u16*)(p.ws + WS_ASSM) + ((size_t)g * NCH + (tok >> 5)) * ASTR + (tok & 31) * 16 + (c & 1) * 8, pack8(r));
      } break;
      case EK_M0: case EK_M3: {
        const size_t o = (size_t)(tn * 256 + col) * 1024 + tm * 256 + c * 8;
        const float tr = (kind == EK_M3) ? lrs[col] : 1.0f;
#pragma unroll
        for (int i = 0; i < 8; ++i) r[i] = sigmoidf_(f[i] * tr);
        gst<u32x4>((kind == EK_M3 ? (u16*)(p.ws + WS_ASSM) : (u16*)(p.ws + WS_Q)) + o, pack8(r));
      } break;
      case EK_FF1: {
        const float tr = lrs[col];
#pragma unroll
        for (int i = 0; i < 8; ++i) { const float a = fmaxf(f[i] * tr, 0.f); r[i] = a * a; }
        gst<u32x4>((u16*)(p.ws + WS_FF) + ((size_t)(tn * 16 + tm) << 16) + col * 256 + c * 8, pack8(r));
      } break;
    }
  }
  __syncthreads();
}

DI void make_job(const P& pin, int layer, int s, int w, int step, Job& jb) {
  struct { unsigned char* ws; } p;
  p.ws = pin.ws;
  asm volatile("" : "+s"(p.ws));
  const u16* XN = (const u16*)(p.ws + WS_XN);
  jb.layer = layer; jb.gsB = 16; jb.tmB = 0;
  if (s == 1) {
    int g = w / 10;
    jb.A = (const u16*)(p.ws + WS_W1T) + ((size_t)layer * 32 + g) * 256 * 512;
    jb.Bt = (const u16*)(p.ws + WS_ASSM) + (size_t)w * 256 * ASTR;
    jb.lda = 512; jb.ldb = ASTR; jb.K = 512; jb.kind = EK_S; jb.tm = 0; jb.tn = w;
    return;
  }
  if (s == 3) {
    int gc = w >> 1, rt = w & 1, g = gc / 10;
    jb.A = (const u16*)(p.ws + WS_WYT) + (((size_t)layer * 32 + g) * 512 + rt * 256) * ASTR;
    jb.Bt = (const u16*)(p.ws + WS_ASSM) + (size_t)gc * 256 * ASTR;
    jb.lda = ASTR; jb.ldb = ASTR; jb.K = ASTR; jb.kind = EK_Y; jb.tm = rt; jb.tn = gc;
    return;
  }
  const int nft = (s == 0) ? 8 : (s == 6) ? 16 : 4;
  int tt, ft; tile_map(w, nft, tt, ft);
  if (s == 6) {
    const int xcd = w & 7, r = w >> 3, blk = r >> 5, i = r & 31;
    ft = (blk & 1) * 8 + (i & 7);
    tt = ((blk >> 1) * 4 + (i >> 3)) * 8 + xcd;
  }
  jb.tm = ft; jb.tn = tt;
  jb.lda = 1024; jb.ldb = 1024; jb.K = 1024;
  if (s == 0) {
    const u16* W = (const u16*)(p.ws + WS_WT_IN) + (size_t)layer * 4096 * 1024 + (size_t)ft * 256 * 1024;
    const u16* X = XN + (size_t)tt * 256 * 1024;
    if (ft == 5) { jb.A = X; jb.Bt = W; jb.kind = EK_V; }
    else { jb.A = W; jb.Bt = X; jb.kind = ft < 4 ? EK_Q : ft == 4 ? EK_K : EK_U; }
  } else if (s == 4) {
    jb.kind = EK_M0 + step;
    if (step < 2) {
      jb.A = (const u16*)(p.ws + (step == 0 ? WS_WT_GB : WS_WT_GA)) + (size_t)layer * 1024 * 512 + (size_t)ft * 256 * 512;
      jb.Bt = (const u16*)(p.ws + WS_Y) + (size_t)tt * 256 * 16;
      jb.lda = 512; jb.ldb = 16; jb.gsB = NT * 16; jb.K = 512;
    } else if (step < 4) {
      jb.A = (const u16*)(p.ws + WS_WT_IN) + (size_t)layer * 4096 * 1024 + (size_t)((step == 2 ? 3072 : 2048) + ft * 256) * 1024;
      jb.Bt = XN + (size_t)tt * 256 * 1024;
    } else {
      jb.A = (const u16*)(p.ws + WS_WT_AP) + (size_t)layer * 1024 * 1024 + (size_t)ft * 256 * 1024;
      jb.Bt = (const u16*)(p.ws + WS_ATTO) + (size_t)tt * 256 * 1024;
    }
  } else if (s == 5) {
    jb.A = (const u16*)(p.ws + WS_WT_OUT) + (size_t)layer * 1024 * 1024 + (size_t)ft * 256 * 1024;
    jb.Bt = (const u16*)(p.ws + WS_Q) + (size_t)tt * 256 * 1024; jb.kind = EK_OUT;
  } else if (s == 6) {
    jb.A = (const u16*)(p.ws + WS_WT_FF1) + (size_t)layer * 4096 * 1024 + (size_t)ft * 256 * 1024;
    jb.Bt = XN + (size_t)tt * 256 * 1024; jb.kind = EK_FF1;
  } else {
    jb.A = (const u16*)(p.ws + WS_WT_FF2) + (size_t)layer * 1024 * 4096 + (size_t)ft * 256 * 4096;
    jb.Bt = (const u16*)(p.ws + WS_FF) + ((size_t)tt * 16 << 16);
    jb.lda = 4096; jb.ldb = 256; jb.tmB = 1; jb.K = 4096; jb.kind = EK_FF2;
  }
}

DI void phase_jobs(const P& p, int layer, int s, int probe = 0) {
  int nitems, nsteps = 1, nattn = 0;
  switch (s) {
    case 0: nitems = 2560; break;
    case 1: nitems = 320; break;
    case 3: nitems = 3200; nattn = 2560; break;
    case 4: nitems = 1280; nsteps = 5; break;
    case 5: nitems = 1280; break;
    case 6: nitems = 5120; break;
    default: nitems = 1280; break;
  }
#if STAGGER_SLEEP
  if (s != 3) {
    const int slot = (blockIdx.x >> 3) & 31;
    for (int i = 0; i < slot; ++i) __builtin_amdgcn_s_sleep(STAGGER_SLEEP);
  }
#endif
  for (int w = blockIdx.x; w < nitems; w += gridDim.x) {
    if (w < nattn) {
      int seq_start, L, head, qb;
      if (w < 512) {
        int xcd = w & 7, r = w >> 3;
        int seq = xcd >> 2, kvh = xcd & 3;
        seq_start = NTP + seq * 8192; L = 8192; head = kvh * 4 + (r >> 4); qb = r & 15;
      } else {
        int w2 = w - 512, xcd = w2 & 7, r = w2 >> 3;
        int grp = (r >> 5) * 8 + xcd, within = r & 31;
        int seq = grp >> 2, kvh = grp & 3;
        seq_start = seq * 4096; L = 4096; head = kvh * 4 + (within >> 3); qb = within & 7;
      }
      attn_item(p, layer, seq_start, L, head, qb);
    } else {
      for (int step = 0; step < nsteps; ++step) {
        Job jb;
        make_job(p, layer, s, w - nattn, step, jb);
#if PROBE_MASK
        if (probe == 2 || probe == 3) jb.kind = -1;
        if (probe == 3) jb.K = jb.K / 2;
#endif
        gemm_tile(jb.A, jb.Bt, jb.lda, jb.ldb, jb.gsB, jb.tmB, jb.K, [&](AccT& acc) {
          int w2 = w - nattn, st2 = step;
          asm volatile("" : "+s"(w2), "+s"(st2));
          Job j2;
          make_job(p, layer, s, w2, st2, j2);
#if PROBE_MASK
          if (probe == 2 || probe == 3) j2.kind = -1;
          if (probe == 4) j2.kind = -2;
          if (probe == 6) j2.layer |= 256;
          if (probe == 7) j2.layer |= 512;
          if (probe == 8) j2.layer |= 1024 | 2048;
          if (probe == 9) j2.layer |= 1024;
          if (probe == 10) j2.layer |= 1024 | 4096;
          if (probe == 11) j2.layer |= 1024 | 8192;
          if (probe == 12) j2.layer |= 1024 | 2048 | 16384;
          if (probe == 5) j2.kind = -3;
#endif
          run_epilogue(p, j2, acc);
        });
      }
    }
  }
}

DI void run_phase(const P& pin, int ph, int probe = 0) {
  P p = pin;
  asm volatile("" : "+s"(p.ws), "+s"(p.out));
  int layer = (ph - 3) / 8, s = (ph - 3) % 8;
  if (s == 2) phase_scan(p, layer);
  else phase_jobs(p, layer, s, probe);
}

__global__ void __launch_bounds__(512, 2) mega_coop(P p) {
  cg::grid_group grid = cg::this_grid();
  phase_prep_a(p);
  grid.sync();
  phase_prep_b(p);
  grid.sync();
  phase_prep_c(p);
  phase_convert(p, p.in[0], p.in[1]);
  grid.sync();
  for (int ph = 3; ph < NPHASE; ++ph) {
    if ((ph - 3) % 8 == 2) continue;
    run_phase(p, ph);
#if PROBE_MASK
    {
      const int s_ = (ph - 3) % 8;
      bool rep = false;
      if ((PROBE_MASK & 1) && s_ == 3) rep = true;
      if ((PROBE_MASK & 2) && (s_ == 0 || s_ == 4 || s_ == 6)) rep = true;
      if ((PROBE_MASK & 4) && (s_ == 1 || s_ == 2)) rep = true;
      if ((PROBE_MASK & 8) && s_ == 6) run_phase(p, ph, (PROBE_MASK >> 4));
      if (rep) run_phase(p, ph);
    }
#endif
    if (ph + 1 < NPHASE) grid.sync();
  }
}
#if N_LAUNCH_MODE == 0
__global__ void __launch_bounds__(512, 2) mega_one(P p) {
  run_phase(p, p.ph_lo);
}
#endif

extern "C" void kernel_launch(void* const* d_in, const int* in_sizes, int n_in, void* d_out, int out_size, void* d_ws, size_t ws_size,
                              hipStream_t stream) {
  static int grid = 0;
  if (grid == 0) {
    if (n_in != 21 || ws_size < WS_END) { fprintf(stderr, "kernel_launch: unexpected n_in %d / ws_size %zu (need %zu)\n", n_in, ws_size, (size_t)WS_END); grid = -1; return; }
    int dev = 0, cus = 0, per_cu = 0;
    hipGetDevice(&dev);
    hipDeviceGetAttribute(&cus, hipDeviceAttributeMultiprocessorCount, dev);
    hipFuncSetAttribute((const void*)mega_coop, hipFuncAttributeMaxDynamicSharedMemorySize, LDS_BYTES);
#if N_LAUNCH_MODE == 0
    hipFuncSetAttribute((const void*)mega_one, hipFuncAttributeMaxDynamicSharedMemorySize, LDS_BYTES);
#endif
    hipOccupancyMaxActiveBlocksPerMultiprocessor(&per_cu, (const void*)mega_coop, 512, LDS_BYTES);
    if (per_cu < 1) { fprintf(stderr, "kernel_launch: occupancy query says %d blocks/CU\n", per_cu); per_cu = 1; }
    (void)hipGetLastError();
    grid = cus * 1;
  }
  if (grid < 0) return;
  P p{};
  for (int i = 0; i < 21; ++i) p.in[i] = (const float*)d_in[i];
  p.out = (float*)d_out;
  p.ws = (unsigned char*)d_ws;
#if N_LAUNCH_MODE == 1
  p.ph_lo = 0; p.ph_hi = NPHASE;
  void* args[] = {&p};
  hipError_t e = hipLaunchCooperativeKernel((const void*)mega_coop, dim3(grid), dim3(512), args, LDS_BYTES, stream);
  if (e != hipSuccess) fprintf(stderr, "cooperative launch failed: %s (grid %d)\n", hipGetErrorString(e), grid);
#else
  for (int ph = 0; ph < NPHASE; ++ph) {
    p.ph_lo = ph; p.ph_hi = ph + 1;
    hipLaunchKernelGGL(mega_one, dim3(grid), dim3(512), LDS_BYTES, stream, p);
  }
#endif
}
```

```cpp
#include <hip/hip_runtime.h>
#include <hip/hip_cooperative_groups.h>
#include <cstdio>
namespace cg = cooperative_groups;

typedef unsigned short u16;
typedef __attribute__((ext_vector_type(8))) short bf16x8;
typedef __attribute__((ext_vector_type(4))) float f32x4;
typedef __attribute__((ext_vector_type(16))) float f32x16;
typedef __attribute__((ext_vector_type(4))) unsigned u32x4;
typedef __attribute__((ext_vector_type(2))) unsigned u32x2;
typedef __attribute__((ext_vector_type(2))) float f32x2;
typedef __attribute__((ext_vector_type(2))) __bf16 bf16v2;

#define DI __device__ __forceinline__
#ifndef PROBE_MASK
#define PROBE_MASK 0
#endif
#ifndef STAGGER_SLEEP
#define STAGGER_SLEEP 0
#endif
#ifndef N_LAUNCH_MODE
#define N_LAUNCH_MODE 1
#endif

constexpr int NT = 81920;
constexpr int NTP = 65536;
constexpr int NCH = 2560;
constexpr int ASTR = 768;
constexpr int NPHASE = 19;
constexpr int LDS_BYTES = 131072 + 1024;

constexpr size_t MiB = 1ull << 20;
constexpr size_t WS_WT_IN = 0;
constexpr size_t WS_WT_AP = 16 * MiB;
constexpr size_t WS_WT_GA = 20 * MiB;
constexpr size_t WS_WT_GB = 22 * MiB;
constexpr size_t WS_WT_OUT = 24 * MiB;
constexpr size_t WS_WT_FF1 = 28 * MiB;
constexpr size_t WS_WT_FF2 = 44 * MiB;
constexpr size_t WS_W1T = 60 * MiB;
constexpr size_t WS_WYT = 76 * MiB;
constexpr size_t WS_LPOW = 124 * MiB;
constexpr size_t WS_BBAR = 127 * MiB;
constexpr size_t WS_KTAB = 128 * MiB;
constexpr size_t WS_ROPE = 132 * MiB;
constexpr size_t WS_SSQ = 133 * MiB;
constexpr size_t WS_XN = 135 * MiB;
constexpr size_t WS_BIG = 295 * MiB;
constexpr size_t WS_Q = WS_BIG;
constexpr size_t WS_K = WS_BIG + 160 * MiB;
constexpr size_t WS_VT = WS_BIG + 200 * MiB;
constexpr size_t WS_ASSM = WS_BIG + 240 * MiB;
constexpr size_t WS_S = WS_BIG + 360 * MiB;
constexpr size_t WS_Y = WS_BIG + 440 * MiB;
constexpr size_t WS_ATTO = WS_BIG + 520 * MiB;
constexpr size_t WS_FF = WS_BIG;
constexpr size_t WS_END = WS_BIG + 680 * MiB;

struct P {
  const float* in[21];
  float* out;
  unsigned char* ws;
  int ph_lo, ph_hi;
};

DI u16 f2bf(float f) { unsigned u = __float_as_uint(f); u += 0x7fffu + ((u >> 16) & 1u); return (u16)(u >> 16); }
DI float bf2f(u16 h) { return __uint_as_float(((unsigned)h) << 16); }
DI unsigned pk2(float a, float b) {
  f32x2 v; v[0] = a; v[1] = b;
  bf16v2 r = __builtin_convertvector(v, bf16v2);
  return __builtin_bit_cast(unsigned, r);
}
DI float sigmoidf_(float x) { return 1.0f / (1.0f + __expf(-x)); }
DI float gelu_tanh(float x) {
  float z = 0.7978845608028654f * (x + 0.044715f * x * x * x);
  float e = __expf(2.0f * z);
  return 0.5f * x * (2.0f - 2.0f / (e + 1.0f));
}


DI void sincos_d(double x, double* sn, double* cs) {
  const double TWO_PI_HI = 6.283185307179586232e+00, TWO_PI_LO = 2.449293598294706414e-16;
  double k = rint(x * 0.15915494309189534561);
  double r = (x - k * TWO_PI_HI) - k * TWO_PI_LO;
  r *= 0.25;
  double r2 = r * r;
  double s = 1.0, c = 1.0;
  s = 1.0 - r2 / (18.0 * 19.0);
  s = 1.0 - r2 / (16.0 * 17.0) * s;
  s = 1.0 - r2 / (14.0 * 15.0) * s;
  s = 1.0 - r2 / (12.0 * 13.0) * s;
  s = 1.0 - r2 / (10.0 * 11.0) * s;
  s = 1.0 - r2 / (8.0 * 9.0) * s;
  s = 1.0 - r2 / (6.0 * 7.0) * s;
  s = 1.0 - r2 / (4.0 * 5.0) * s;
  s = 1.0 - r2 / (2.0 * 3.0) * s;
  s *= r;
  c = 1.0 - r2 / (17.0 * 18.0);
  c = 1.0 - r2 / (15.0 * 16.0) * c;
  c = 1.0 - r2 / (13.0 * 14.0) * c;
  c = 1.0 - r2 / (11.0 * 12.0) * c;
  c = 1.0 - r2 / (9.0 * 10.0) * c;
  c = 1.0 - r2 / (7.0 * 8.0) * c;
  c = 1.0 - r2 / (5.0 * 6.0) * c;
  c = 1.0 - r2 / (3.0 * 4.0) * c;
  c = 1.0 - r2 / (1.0 * 2.0) * c;
  double s2 = 2.0 * s * c, c2 = c * c - s * s;
  *sn = 2.0 * s2 * c2; *cs = c2 * c2 - s2 * s2;
}

template <class T> DI T gld(const void* q) { return *(const __attribute__((address_space(1))) T*)q; }
template <class T> DI void gst(void* q, const T v) { *(__attribute__((address_space(1))) T*)q = v; }
DI int opaque_tid() { int t = threadIdx.x; asm volatile("" : "+v"(t)); return t; }
DI const char* sgpr_ptr(const char* p) { asm("" : "+s"(p)); return p; }
#define WAIT_V(n) asm volatile("s_waitcnt vmcnt(" #n ")" ::: "memory")
#define WAIT_L(n) asm volatile("s_waitcnt lgkmcnt(" #n ")" ::: "memory")
#define BAR __builtin_amdgcn_s_barrier()
#define SCHED __builtin_amdgcn_sched_barrier(0)
#define GLDS(gp, lp) __builtin_amdgcn_global_load_lds((const unsigned*)(gp), (unsigned*)(lp), 16, 0, 0)

constexpr int GBK = 64, GHALF = 128, GHT = GHALF * GBK;
DI int lds_byte(int r, int c) {
  int st = (r >> 4) * 2 + (c >> 5), rr = r & 15, cc = c & 31, ob = rr * 64 + cc * 2;
  return st * 1024 + (ob ^ (((ob >> 9) & 1) << 5));
}
DI void stage_rc(int b, int& R, int& C) {
  int st = b / 1024, sb = b % 1024, swz = sb ^ (((sb >> 9) & 1) << 5);
  R = (st >> 1) * 16 + swz / 64; C = (st & 1) * 32 + (swz % 64) / 2;
}

typedef f32x4 AccT[2][2][4][2];

template <class Epi>
DI void gemm_tile(const u16* __restrict__ A, const u16* __restrict__ Bt, const int lda, const int ldb, const int gsB, const int tmB, const int K, Epi&& epi) {
  const int TID = opaque_tid();
  extern __shared__ __attribute__((aligned(16))) unsigned char smem[];
  u16* shm = (u16*)smem;
#define SA(b, h) (shm + ((b) * 2 + (h)) * GHT)
#define SB(b, h) (shm + (4 + (b) * 2 + (h)) * GHT)
  int R0, C0, R1, C1;
  stage_rc(TID * 16, R0, C0);
  stage_rc(TID * 16 + 8192, R1, C1);
  const unsigned voA0 = (unsigned)(R0 * lda + C0) * 2u, voA1 = (unsigned)(R1 * lda + C1) * 2u;
  const unsigned voB0 = (unsigned)(R0 * ldb + (C0 & 15) + (C0 >> 4) * gsB) * 2u, voB1 = (unsigned)(R1 * ldb + (C1 & 15) + (C1 >> 4) * gsB) * 2u;
  const int hA = GHALF * lda, hB = GHALF * ldb;
  const unsigned wid_u = __builtin_amdgcn_readfirstlane(TID >> 6);
#define STAGE_A(PTR, half, kt) do { const char* _g = sgpr_ptr((const char*)(A + (size_t)(half) * hA + (size_t)(kt) * GBK)); \
    char* _l = (char*)(PTR) + wid_u * 1024u; \
    GLDS(_g + voA0, _l); GLDS(_g + voA1, _l + 8192); } while (0)
#define STAGE_B(PTR, half, kt) do { const char* _g = sgpr_ptr((const char*)(Bt + (size_t)(half) * hB + (tmB ? (size_t)((((kt) >> 2) << 16) + (((kt) & 3) << 6)) : (size_t)(kt) * (size_t)(4 * gsB)))); \
    char* _l = (char*)(PTR) + wid_u * 1024u; \
    GLDS(_g + voB0, _l); GLDS(_g + voB1, _l + 8192); } while (0)
#define LDA(dst, b, h) for (int m = 0; m < 4; ++m) for (int k = 0; k < 2; ++k) \
    dst[m][k] = *reinterpret_cast<const bf16x8*>((char*)SA(b, h) + lds_byte(wr * 64 + m * 16 + fr, k * 32 + fq * 8))
#define LDB(dst, b, h) for (int n = 0; n < 2; ++n) for (int k = 0; k < 2; ++k) \
    dst[n][k] = *reinterpret_cast<const bf16x8*>((char*)SB(b, h) + lds_byte(wc * 32 + n * 16 + fr, k * 32 + fq * 8))
#define MMA(ai, bj, At, Bq) do { __builtin_amdgcn_s_setprio(1); \
    for (int m = 0; m < 4; ++m) for (int n = 0; n < 2; ++n) for (int k = 0; k < 2; ++k) \
      acc[ai][bj][m][n] = __builtin_amdgcn_mfma_f32_16x16x32_bf16(At[m][k], Bq[n][k], acc[ai][bj][m][n], 0, 0, 0); \
    __builtin_amdgcn_s_setprio(0); } while (0)

  const int wid = TID >> 6, lane = TID & 63, wr = wid >> 2, wc = wid & 3, fr = lane & 15, fq = lane >> 4;
  AccT acc;
#pragma unroll
  for (int a = 0; a < 2; ++a)
#pragma unroll
    for (int b = 0; b < 2; ++b)
#pragma unroll
      for (int m = 0; m < 4; ++m)
#pragma unroll
        for (int n = 0; n < 2; ++n) acc[a][b][m][n] = f32x4{0.f, 0.f, 0.f, 0.f};
  bf16x8 At[4][2], B0[2][2], B1[2][2];
  const int nt = K / GBK;
  STAGE_B(SB(0, 0), 0, 0); STAGE_A(SA(0, 0), 0, 0);
  STAGE_B(SB(0, 1), 1, 0); STAGE_A(SA(0, 1), 1, 0);
  if (wr == 1) BAR;
  WAIT_V(4); BAR;
  STAGE_B(SB(1, 0), 0, 1); STAGE_A(SA(1, 0), 0, 1); STAGE_B(SB(1, 1), 1, 1);
  WAIT_V(6); BAR;
  for (int t = 0; t < nt - 2; t += 2) {
    LDB(B0, 0, 0); SCHED; LDA(At, 0, 0); STAGE_A(SA(1, 1), 1, t + 1);
    WAIT_L(8); BAR; WAIT_L(0); MMA(0, 0, At, B0); BAR; SCHED;
    LDB(B1, 0, 1); STAGE_B(SB(0, 0), 0, t + 2);
    BAR; WAIT_L(0); MMA(0, 1, At, B1); BAR;
    LDA(At, 0, 1); STAGE_A(SA(0, 0), 0, t + 2);
    BAR; WAIT_L(0); MMA(1, 0, At, B0); BAR; SCHED;
    STAGE_B(SB(0, 1), 1, t + 2);
    WAIT_V(6); BAR; MMA(1, 1, At, B1); BAR;
    LDB(B0, 1, 0); SCHED; LDA(At, 1, 0); STAGE_A(SA(0, 1), 1, t + 2);
    WAIT_L(8); BAR; WAIT_L(0); MMA(0, 0, At, B0); BAR; SCHED;
    LDB(B1, 1, 1); STAGE_B(SB(1, 0), 0, t + 3);
    BAR; WAIT_L(0); MMA(0, 1, At, B1); BAR;
    LDA(At, 1, 1); STAGE_A(SA(1, 0), 0, t + 3);
    BAR; WAIT_L(0); MMA(1, 0, At, B0); BAR; SCHED;
    STAGE_B(SB(1, 1), 1, t + 3);
    WAIT_V(6); BAR; MMA(1, 1, At, B1); BAR;
  }
  { LDB(B0, 0, 0); LDA(At, 0, 0); STAGE_A(SA(1, 1), 1, nt - 1);
    BAR; WAIT_L(0); MMA(0, 0, At, B0); BAR;
    LDB(B1, 0, 1); BAR; WAIT_L(0); MMA(0, 1, At, B1); BAR;
    LDA(At, 0, 1); WAIT_V(4); BAR; WAIT_L(0); MMA(1, 0, At, B0); MMA(1, 1, At, B1); BAR; }
  { LDB(B0, 1, 0); LDA(At, 1, 0); WAIT_V(2); BAR; WAIT_L(0); MMA(0, 0, At, B0); BAR;
    LDB(B1, 1, 1); WAIT_V(0); BAR; WAIT_L(0); MMA(0, 1, At, B1); BAR;
    LDA(At, 1, 1); BAR; WAIT_L(0); MMA(1, 0, At, B0); MMA(1, 1, At, B1); BAR; }
  if (wr == 0) BAR;
  epi(acc);
#undef SA
#undef SB
}

template <class F>
DI void epi_for(AccT& acc, F&& f) {
  const int TID = opaque_tid();
  const int _wid = TID >> 6, _lane = TID & 63, _wr = _wid >> 2, _wc = _wid & 3, _fr = _lane & 15, _fq = _lane >> 4;
#pragma unroll
  for (int _ai = 0; _ai < 2; ++_ai)
#pragma unroll
    for (int _bj = 0; _bj < 2; ++_bj)
#pragma unroll
      for (int _m = 0; _m < 4; ++_m)
#pragma unroll
        for (int _n = 0; _n < 2; ++_n)
          f(_ai * 128 + _wr * 64 + _m * 16 + _fq * 4, _bj * 128 + _wc * 32 + _n * 16 + _fr, acc[_ai][_bj][_m][_n]);
}

DI void tile_map(int w, int ntn, int& tm, int& tn) {
  int xcd = w & 7, r = w >> 3;
  tn = r % ntn; tm = (r / ntn) * 8 + xcd;
}

DI void transpose_tile(const float* __restrict__ src, int N, u16* __restrict__ dst, int K, int tk, int tn, const float* __restrict__ gain) {
  const int TID = opaque_tid();
  extern __shared__ __attribute__((aligned(16))) unsigned char smem[];
  float* tile = (float*)smem;
  const int t = TID;
  {
    const int cs = (t & 15) * 4;
    float4 v[8];
#pragma unroll
    for (int i = 0; i < 8; ++i) v[i] = *(const float4*)(src + (size_t)(tk * 256 + (t >> 4) + 32 * i) * N + tn * 64 + cs);
#pragma unroll
    for (int i = 0; i < 8; ++i) {
      const int rk = (t >> 4) + 32 * i;
      const float gk = gain ? gain[tk * 256 + rk] : 1.0f;
      float* d = tile + rk * 65 + cs;
      d[0] = v[i].x * gk; d[1] = v[i].y * gk; d[2] = v[i].z * gk; d[3] = v[i].w * gk;
    }
  }
  __syncthreads();
  {
    const int n = t >> 3, ks = (t & 7) * 32;
#pragma unroll
    for (int j = 0; j < 4; ++j) {
      const float* q = tile + (ks + 8 * j) * 65 + n;
      u32x4 o;
      o[0] = pk2(q[0], q[65]); o[1] = pk2(q[130], q[195]); o[2] = pk2(q[260], q[325]); o[3] = pk2(q[390], q[455]);
      *(u32x4*)(dst + (size_t)(tn * 64 + n) * K + tk * 256 + ks + 8 * j) = o;
    }
  }
  __syncthreads();
}

DI void phase_prep_a(const P& p) {
  const int TID = opaque_tid();
  const int bid = blockIdx.x, nb = gridDim.x;
  for (int w = bid; w < 1920; w += nb) {
    int layer = w / 960, r = w % 960;
    const float* src; u16* dst; int K, N, tl; const float* gain = nullptr;
    if (r < 256) { src = p.in[3] + (size_t)layer * 1024 * 4096; dst = (u16*)(p.ws + WS_WT_IN) + (size_t)layer * 4096 * 1024; K = 1024; N = 4096; tl = r; gain = p.in[2] + layer * 1024; }
    else if (r < 320) { src = p.in[6] + (size_t)layer * 1024 * 1024; dst = (u16*)(p.ws + WS_WT_AP) + (size_t)layer * 1024 * 1024; K = 1024; N = 1024; tl = r - 256; }
    else if (r < 352) { src = p.in[15] + (size_t)layer * 512 * 1024; dst = (u16*)(p.ws + WS_WT_GA) + (size_t)layer * 1024 * 512; K = 512; N = 1024; tl = r - 320; }
    else if (r < 384) { src = p.in[16] + (size_t)layer * 512 * 1024; dst = (u16*)(p.ws + WS_WT_GB) + (size_t)layer * 1024 * 512; K = 512; N = 1024; tl = r - 352; }
    else if (r < 448) { src = p.in[17] + (size_t)layer * 1024 * 1024; dst = (u16*)(p.ws + WS_WT_OUT) + (size_t)layer * 1024 * 1024; K = 1024; N = 1024; tl = r - 384; }
    else if (r < 704) { src = p.in[19] + (size_t)layer * 1024 * 4096; dst = (u16*)(p.ws + WS_WT_FF1) + (size_t)layer * 4096 * 1024; K = 1024; N = 4096; tl = r - 448; gain = p.in[18] + layer * 1024; }
    else { src = p.in[20] + (size_t)layer * 4096 * 1024; dst = (u16*)(p.ws + WS_WT_FF2) + (size_t)layer * 1024 * 4096; K = 4096; N = 1024; tl = r - 704; }
    int ntn = N / 64;
    transpose_tile(src, N, dst, K, tl / ntn, tl % ntn, gain);
  }
  const int gtid = bid * 512 + TID, nth = nb * 512;
  float2* LP = (float2*)(p.ws + WS_LPOW);
  float2* BB = (float2*)(p.ws + WS_BBAR);
  for (int idx = gtid; idx < 8192 * 33; idx += nth) {
    const int i = idx / 33, tau = idx - i * 33, lg = i >> 6;
    const double step = exp((double)p.in[9][lg]);
    const double zr = (double)p.in[7][i] * step, zi = (double)p.in[8][i] * step;
    double e = exp(zr * tau), sn, cs;
    sincos_d(zi * tau, &sn, &cs);
    LP[idx] = make_float2((float)(e * cs), (float)(e * sn));
  }
  for (int idx = gtid; idx < 8192 * 16; idx += nth) {
    const int i = idx >> 4, ci = idx & 15, lg = i >> 6;
    const double step = exp((double)p.in[9][lg]);
    const double lr = p.in[7][i], li = p.in[8][i];
    const double zr = lr * step, zi = li * step;
    double e = exp(zr), sn, cs;
    sincos_d(zi, &sn, &cs);
    const double nr = e * cs - 1.0, ni = e * sn, den = lr * lr + li * li;
    const double fr = (nr * lr + ni * li) / den, fi = (ni * lr - nr * li) / den;
    const double br = p.in[10][idx], bi = p.in[11][idx];
    BB[idx] = make_float2((float)(fr * br - fi * bi), (float)(fr * bi + fi * br));
  }
  float2* RP = (float2*)(p.ws + WS_ROPE);
  for (int i = gtid; i < 128 * 16; i += nth) {
    int pos = i >> 4, f = i & 15;
    double inv = exp(-(double)(2 * f) / 32.0 * 9.210340371976184);
    double sn, cs;
    sincos_d((double)pos * inv, &sn, &cs);
    RP[i] = make_float2((float)cs, (float)sn);
  }
}

DI void phase_prep_b(const P& p) {
  const int TID = opaque_tid();
  const int gtid = blockIdx.x * 512 + TID, nth = gridDim.x * 512;
  const float2* LP = (const float2*)(p.ws + WS_LPOW);
  const float2* BB = (const float2*)(p.ws + WS_BBAR);
  float* KT = (float*)(p.ws + WS_KTAB);
  const float* cre = p.in[12];
  const float* cim = p.in[13];
  {
    extern __shared__ __attribute__((aligned(16))) unsigned char smem[];
    float2* Cs = (float2*)smem;
    float2* Bs = Cs + 1024;
    float2* Ls = Bs + 1024;
    for (int item = blockIdx.x; item < 256; item += gridDim.x) {
      const int lg = item >> 1, th = item & 1;
      for (int e = TID; e < 1024; e += 512) {
        Cs[e] = make_float2(cre[(size_t)lg * 1024 + e], cim[(size_t)lg * 1024 + e]);
        Bs[e] = BB[(size_t)lg * 1024 + e];
        Ls[e] = LP[(size_t)(lg * 64 + (e >> 4)) * 33 + th * 16 + (e & 15)];
      }
      __syncthreads();
      const int co = (TID >> 4) & 15, ci = TID & 15, tsel = TID >> 8;
      float a8[8];
#pragma unroll
      for (int k = 0; k < 8; ++k) a8[k] = 0.f;
      for (int pp = 0; pp < 64; ++pp) {
        const float2 c = Cs[co * 64 + pp], b = Bs[pp * 16 + ci];
        const float zr = c.x * b.x - c.y * b.y, zi = c.x * b.y + c.y * b.x;
#pragma unroll
        for (int k = 0; k < 8; ++k) { const float2 l = Ls[pp * 16 + tsel + 2 * k]; a8[k] += zr * l.x - zi * l.y; }
      }
#pragma unroll
      for (int k = 0; k < 8; ++k) KT[(((size_t)lg * 32 + th * 16 + tsel + 2 * k) * 16 + co) * 16 + ci] = a8[k];
      __syncthreads();
    }
  }
  u16* W1 = (u16*)(p.ws + WS_W1T);
  for (int i8 = gtid; i8 < (1 << 20); i8 += nth) {
    const int i = i8 << 3;
    const int k = i & 511, n = (i >> 9) & 255, g = (i >> 17) & 31, layer = i >> 22;
    const int dir = n >> 7, pp = (n >> 1) & 63, ri = n & 1, sidx = k >> 4, ci0 = k & 15;
    const int e = dir ? sidx : 31 - sidx;
    const int lg = (layer * 2 + dir) * 32 + g;
    const float2 l = LP[(size_t)(lg * 64 + pp) * 33 + e];
    const float2* b = BB + (size_t)(lg * 64 + pp) * 16 + ci0;
    float v[8];
#pragma unroll
    for (int q = 0; q < 8; ++q) { const float2 bq = b[q]; v[q] = ri ? (l.x * bq.y + l.y * bq.x) : (l.x * bq.x - l.y * bq.y); }
    u32x4 o;
    o[0] = pk2(v[0], v[1]); o[1] = pk2(v[2], v[3]); o[2] = pk2(v[4], v[5]); o[3] = pk2(v[6], v[7]);
    *(u32x4*)(W1 + i) = o;
  }
  u16* WY = (u16*)(p.ws + WS_WYT);
  for (int i8 = gtid; i8 < (1 << 20); i8 += nth) {
    const int i = i8 << 3;
    const int kk = i & 255, n = (i >> 8) & 511, g = (i >> 17) & 31, layer = i >> 22;
    const int t = n >> 4, co = n & 15, dir = kk >> 7, pp0 = (kk >> 1) & 63;
    const int e = dir ? 32 - t : t + 1;
    const int lg = (layer * 2 + dir) * 32 + g;
    float v[8];
#pragma unroll
    for (int q = 0; q < 4; ++q) {
      const float cr = cre[(size_t)(lg * 16 + co) * 64 + pp0 + q], cI = cim[(size_t)(lg * 16 + co) * 64 + pp0 + q];
      const float2 l = LP[(size_t)(lg * 64 + pp0 + q) * 33 + e];
      v[2 * q] = cr * l.x - cI * l.y;
      v[2 * q + 1] = -(cr * l.y + cI * l.x);
    }
    u32x4 o;
    o[0] = pk2(v[0], v[1]); o[1] = pk2(v[2], v[3]); o[2] = pk2(v[4], v[5]); o[3] = pk2(v[6], v[7]);
    *(u32x4*)(WY + ((size_t)((layer * 32 + g) * 512 + n)) * ASTR + 512 + kk) = o;
  }
}

DI void phase_prep_c(const P& p) {
  const int TID = opaque_tid();
#if PROBE_MASK & 64
  {
    u32x4* dst = (u32x4*)(p.ws + WS_FF);
    u32x4 z; z[0] = 1; z[1] = 2; z[2] = 3; z[3] = 4;
    for (unsigned i = blockIdx.x * 512 + TID; i < 640u * 65536u; i += gridDim.x * 512) { z[0] = i * 2654435761u; z[1] = z[0] ^ (i << 7); z[2] = z[1] * 40503u + i; z[3] = z[2] ^ z[0]; dst[i] = z; }
  }
#endif
  const int gtid = blockIdx.x * 512 + TID, nth = gridDim.x * 512;
  const float* KT = (const float*)(p.ws + WS_KTAB);
  u16* WY = (u16*)(p.ws + WS_WYT);
  for (int i = gtid; i < (1 << 21); i += nth) {
    int k8 = i & 63, n = (i >> 6) & 511, g = (i >> 15) & 31, layer = i >> 20;
    int t = n >> 4, co = n & 15, s = k8 >> 1, ci0 = (k8 & 1) * 8;
    int tau = t - s;
    float v[8];
    if (tau > 0) {
      const float* q = KT + ((((size_t)(layer * 2 + 0) * 32 + g) * 32 + tau) * 16 + co) * 16 + ci0;
#pragma unroll
      for (int j = 0; j < 8; ++j) v[j] = q[j];
    } else if (tau < 0) {
      const float* q = KT + ((((size_t)(layer * 2 + 1) * 32 + g) * 32 - tau) * 16 + co) * 16 + ci0;
#pragma unroll
      for (int j = 0; j < 8; ++j) v[j] = q[j];
    } else {
      const float* q0 = KT + ((((size_t)(layer * 2 + 0) * 32 + g) * 32) * 16 + co) * 16 + ci0;
      const float* q1 = KT + ((((size_t)(layer * 2 + 1) * 32 + g) * 32) * 16 + co) * 16 + ci0;
#pragma unroll
      for (int j = 0; j < 8; ++j) v[j] = q0[j] + q1[j];
    }
    u32x4 o;
    o[0] = pk2(v[0], v[1]); o[1] = pk2(v[2], v[3]); o[2] = pk2(v[4], v[5]); o[3] = pk2(v[6], v[7]);
    *(u32x4*)(WY + ((size_t)((layer * 32 + g) * 512 + n)) * ASTR + k8 * 8) = o;
  }
}

DI const float* xrow(const P& p, int layer, int tok) {
  if (layer == 0) return tok < NTP ? p.in[0] + (size_t)tok * 1024 : p.in[1] + (size_t)(tok - NTP) * 1024;
  return p.out + (size_t)tok * 1024;
}
DI void phase_convert(const P& p, const float* __restrict__ src0, const float* __restrict__ src1) {
  const int TID = opaque_tid();
  const int lane = TID & 63, wave = TID >> 6;
  u16* XN = (u16*)(p.ws + WS_XN);
  float* SSQ = (float*)(p.ws + WS_SSQ);
  for (int tok = blockIdx.x * 8 + wave; tok < NT; tok += gridDim.x * 8) {
    const float* x = tok < NTP ? src0 + (size_t)tok * 1024 : src1 + (size_t)(tok - NTP) * 1024;
    float4 v[4];
    float ss = 0.f;
#pragma unroll
    for (int i = 0; i < 4; ++i) {
      v[i] = *(const float4*)(x + i * 256 + lane * 4);
      ss += v[i].x * v[i].x + v[i].y * v[i].y + v[i].z * v[i].z + v[i].w * v[i].w;
    }
#pragma unroll
    for (int o = 32; o >= 1; o >>= 1) ss += __shfl_xor(ss, o);
    if (lane < 4) SSQ[(size_t)lane * NT + tok] = lane == 0 ? ss : 0.f;
#pragma unroll
    for (int i = 0; i < 4; ++i) {
      u32x2 o;
      o[0] = pk2(v[i].x, v[i].y);
      o[1] = pk2(v[i].z, v[i].w);
      *(u32x2*)(XN + (size_t)tok * 1024 + i * 256 + lane * 4) = o;
    }
  }
}

DI void phase_scan(const P& p, int layer) {
  const int TID = opaque_tid();
  const int gtid = blockIdx.x * 512 + TID, nth = gridDim.x * 512;
  const float2* LP = (const float2*)(p.ws + WS_LPOW);
  for (int i = gtid; i < 18 * 4096; i += nth) {
    int pp = i & 63, dir = (i >> 6) & 1, g = (i >> 7) & 31, seq = i >> 12;
    int c0 = seq < 16 ? seq * 128 : 2048 + (seq - 16) * 256;
    int nc = seq < 16 ? 128 : 256;
    float2 a = LP[(size_t)(((layer * 2 + dir) * 32 + g) * 64 + pp) * 33 + 32];
    const float2* S = (const float2*)(p.ws + WS_S) + ((size_t)(g * NCH + c0) * 256 + dir * 128 + pp * 2) / 2;
    unsigned* H = (unsigned*)((u16*)(p.ws + WS_ASSM) + (size_t)(g * NCH + c0) * ASTR + 512 + dir * 128 + pp * 2);
    float hr = 0.f, hi = 0.f;
    for (int cb = 0; cb < nc; cb += 16) {
      float2 sv[16];
#pragma unroll
      for (int k = 0; k < 16; ++k) {
        const int c = dir == 0 ? cb + k : nc - 1 - cb - k;
        sv[k] = S[(size_t)c * 128];
      }
#pragma unroll
      for (int k = 0; k < 16; ++k) {
        const int c = dir == 0 ? cb + k : nc - 1 - cb - k;
        H[(size_t)c * (ASTR / 2)] = pk2(hr, hi);
        const float nr = a.x * hr - a.y * hi + sv[k].x;
        hi = a.x * hi + a.y * hr + sv[k].y;
        hr = nr;
      }
    }
  }
}

#define MFMA32(a, b, c) __builtin_amdgcn_mfma_f32_32x32x16_bf16((a), (b), (c), 0, 0, 0)
DI void attn_item(const P& pin, int layer, int seq_start, int L, int head, int qb) {
  const int TID = opaque_tid();
  struct { unsigned char* ws; } p;
  p.ws = pin.ws;
  asm volatile("" : "+s"(p.ws));
  extern __shared__ __attribute__((aligned(16))) unsigned char smem[];
  const u16* Q = (const u16*)(p.ws + WS_Q);
  const u16* KB = (const u16*)(p.ws + WS_K);
  const u16* VT = (const u16*)(p.ws + WS_VT);
  const int tid = TID, wave = tid >> 6, lane = tid & 63, r = lane & 31, h = lane >> 5;
  const int kvh = head >> 2;
  const int q0 = seq_start + qb * 512 + wave * 64;
  bf16x8 qf[2][4];
#pragma unroll
  for (int nt = 0; nt < 2; ++nt)
#pragma unroll
    for (int ds = 0; ds < 4; ++ds)
      qf[nt][ds] = gld<bf16x8>(Q + (size_t)(q0 + nt * 32 + r) * 1024 + head * 64 + ds * 16 + h * 8);
#pragma unroll
  for (int nt = 0; nt < 2; ++nt)
#pragma unroll
    for (int ds = 0; ds < 4; ++ds) asm volatile("" ::"v"(qf[nt][ds]));
  bool no_check;
  {
    float gq = fabsf(pin.in[4][layer * 64 + lane]), gk = fabsf(pin.in[5][layer * 64 + lane]);
#pragma unroll
    for (int o = 32; o >= 1; o >>= 1) { gq = fmaxf(gq, __shfl_xor(gq, o)); gk = fmaxf(gk, __shfl_xor(gk, o)); }
    no_check = __builtin_amdgcn_readfirstlane(11.5416f * 1.01f * gq * gk <= 15.5f ? 1 : 0) != 0;
  }
  const int srow = tid >> 3, spos = tid & 7, scc = spos ^ ((srow >> 1) & 7);
  const u16* kg = KB + ((size_t)kvh * NT + seq_start + srow) * 64 + scc * 8;
  const u16* vg = VT + (size_t)(kvh * 64 + srow) * NT + seq_start + scc * 8;
  unsigned char* ldst = smem + tid * 16;
  const int nkt = L >> 6;
  const int pr = ((r >> 4) * 16) + (((r >> 2) & 1) * 8) + (((r >> 3) & 1) * 4) + (r & 3);
  int koff[4];
#pragma unroll
  for (int ds = 0; ds < 4; ++ds) koff[ds] = pr * 128 + (((ds * 2 + h) ^ ((pr >> 1) & 7)) << 4);
  const int vxh = ((r >> 1) & 7) >> 1;
  const int vbase = 8192 + r * 128 + ((h ^ ((r >> 1) & 1)) << 4);

  f32x16 o[2][2];
#pragma unroll
  for (int a = 0; a < 2; ++a)
#pragma unroll
    for (int b = 0; b < 2; ++b)
#pragma unroll
      for (int j = 0; j < 16; ++j) o[a][b][j] = 0.f;
  float mrun[2] = {0.f, 0.f}, lrun[2] = {0.f, 0.f};


#define ATT_STAGE(T, B) do { GLDS(kg + (size_t)(T) * 128 * 64, ldst + (B) * 32768); GLDS(vg + (T) * 128, ldst + (B) * 32768 + 8192); \
    GLDS(kg + (size_t)(T) * 128 * 64 + 64 * 64, ldst + (B) * 32768 + 16384); GLDS(vg + (T) * 128 + 64, ldst + (B) * 32768 + 16384 + 8192); } while (0)
  const int nst = nkt >> 1;
  ATT_STAGE(0, 0);
  ATT_STAGE(1, 1);
  int bcur = 0;
  for (int st = 0; st < nst; ++st) {
    if (st + 1 < nst) { WAIT_V(4); } else { WAIT_V(0); }
    BAR;
    if (st + 2 < nst) {
      int bn = bcur + 2; if (bn >= 3) bn -= 3;
      ATT_STAGE(st + 2, bn);
    }
    const unsigned char* sbase = smem + bcur * 32768;
    auto qk = [&](const int hx, f32x16 (&sc)[2]) {
      const unsigned char* kb = sbase + (hx >> 1) * 16384 + (hx & 1) * 4096;
      bf16x8 kf[4];
#pragma unroll
      for (int ds = 0; ds < 4; ++ds) kf[ds] = *(const bf16x8*)(kb + koff[ds]);
      if (no_check) {
        f32x16 z16;
#pragma unroll
        for (int j = 0; j < 16; ++j) z16[j] = 0.f;
#pragma unroll
        for (int nt = 0; nt < 2; ++nt) sc[nt] = MFMA32(kf[0], qf[nt][0], z16);
      } else {
#pragma unroll
        for (int nt = 0; nt < 2; ++nt) {
#pragma unroll
          for (int j = 0; j < 16; ++j) sc[nt][j] = -mrun[nt];
          sc[nt] = MFMA32(kf[0], qf[nt][0], sc[nt]);
        }
      }
#pragma unroll
      for (int ds = 1; ds < 4; ++ds)
#pragma unroll
        for (int nt = 0; nt < 2; ++nt) sc[nt] = MFMA32(kf[ds], qf[nt][ds], sc[nt]);
    };
    auto sm_pv = [&](const int hx, f32x16 (&sc)[2], f32x16 (&pend)[2], const bool has_pend) {
      const bool chk = !no_check;
      const unsigned char* kb = sbase + (hx >> 1) * 16384;
      const int kt = hx & 1;
      bf16x8 vf[2][2];
#pragma unroll
      for (int s2 = 0; s2 < 2; ++s2)
#pragma unroll
        for (int mt = 0; mt < 2; ++mt) vf[s2][mt] = *(const bf16x8*)(kb + vbase + (((kt * 2 + s2) ^ vxh) << 5) + mt * 4096);
      float mx[2] = {0.f, 0.f};
      if (chk) {
#pragma unroll
        for (int nt = 0; nt < 2; ++nt) {
          float m0 = sc[nt][0];
#pragma unroll
          for (int j = 1; j < 16; ++j) m0 = fmaxf(m0, sc[nt][j]);
          mx[nt] = m0;
        }
      }
      if (chk && __any((fabsf(mx[0]) > 16.0f) | (fabsf(mx[1]) > 16.0f))) {
#pragma unroll
        for (int nt = 0; nt < 2; ++nt) {
          const float mp = fmaxf(mx[nt], __shfl_xor(mx[nt], 32));
          const float dm = (fabsf(mp) > 12.0f) ? mp : 0.0f;
          const float alpha = __builtin_amdgcn_exp2f(-dm);
          mrun[nt] += dm;
          lrun[nt] *= alpha;
#pragma unroll
          for (int j = 0; j < 16; ++j) sc[nt][j] -= dm;
          if (has_pend) {
#pragma unroll
            for (int j = 0; j < 16; ++j) pend[nt][j] -= dm;
          }
#pragma unroll
          for (int mt = 0; mt < 2; ++mt)
#pragma unroll
            for (int j = 0; j < 16; ++j) o[mt][nt][j] *= alpha;
        }
      }
#pragma unroll
      for (int nt = 0; nt < 2; ++nt) {
        float sum = 0.f;
#pragma unroll
        for (int j = 0; j < 16; ++j) { float pv = __builtin_amdgcn_exp2f(sc[nt][j]); sc[nt][j] = pv; sum += pv; }
        lrun[nt] += sum;
      }
#pragma unroll
      for (int s2 = 0; s2 < 2; ++s2) {
        bf16x8 pf[2];
#pragma unroll
        for (int nt = 0; nt < 2; ++nt) {
          u32x4 pk;
#pragma unroll
          for (int i = 0; i < 4; ++i) pk[i] = pk2(sc[nt][s2 * 8 + 2 * i], sc[nt][s2 * 8 + 2 * i + 1]);
          pf[nt] = __builtin_bit_cast(bf16x8, pk);
        }
#pragma unroll
        for (int mt = 0; mt < 2; ++mt)
#pragma unroll
          for (int nt = 0; nt < 2; ++nt) o[mt][nt] = MFMA32(vf[s2][mt], pf[nt], o[mt][nt]);
      }
    };
    f32x16 sa[2], sb[2];
    qk(0, sa);
    qk(1, sb); sm_pv(0, sa, sb, true);
    qk(2, sa); sm_pv(1, sb, sa, true);
    qk(3, sb); sm_pv(2, sa, sb, true);
    sm_pv(3, sb, sa, false);
    bcur = bcur + 1; if (bcur >= 3) bcur = 0;
  }
  unsigned char* ws2 = pin.ws;
  asm volatile("" : "+s"(ws2));
  u16* O = (u16*)(ws2 + WS_ATTO);
  const int tid2 = opaque_tid();
  const int r2 = tid2 & 31, h2 = (tid2 >> 5) & 1;
  const int q0b = seq_start + qb * 512 + (tid2 >> 6) * 64;
#pragma unroll
  for (int nt = 0; nt < 2; ++nt) {
    float l = lrun[nt] + __shfl_xor(lrun[nt], 32);
    float inv = 1.0f / l;
    const int tok = q0b + nt * 32 + r2;
#pragma unroll
    for (int mt = 0; mt < 2; ++mt)
#pragma unroll
      for (int jg = 0; jg < 4; ++jg) {
        u32x2 ov;
        ov[0] = pk2(o[mt][nt][jg * 4 + 0] * inv, o[mt][nt][jg * 4 + 1] * inv);
        ov[1] = pk2(o[mt][nt][jg * 4 + 2] * inv, o[mt][nt][jg * 4 + 3] * inv);
        gst<u32x2>(O + (size_t)tok * 1024 + head * 64 + mt * 32 + jg * 8 + h2 * 4, ov);
      }
  }
  WAIT_L(0);
  BAR;
}


enum { EK_Q = 0, EK_K, EK_V, EK_U, EK_S, EK_Y, EK_M0, EK_M1, EK_M2, EK_M3, EK_M4, EK_OUT, EK_FF1, EK_FF2 };
struct Job {
  const u16* A; const u16* Bt;
  int lda, ldb, gsB, tmB, K, kind, tm, tn, layer;
};

DI void stage_acc(AccT& acc, unsigned char* smem, const int tid, const int linear = 0) {
  const int wid = tid >> 6, lane = tid & 63, wr = wid >> 2, wc = wid & 3, fr = lane & 15, fq = lane >> 4;
#if PROBE_MASK
  if (linear) {
    int k = 0;
#pragma unroll
    for (int ai = 0; ai < 2; ++ai)
#pragma unroll
      for (int bj = 0; bj < 2; ++bj)
#pragma unroll
        for (int m = 0; m < 4; ++m)
#pragma unroll
          for (int n = 0; n < 2; ++n) {
            u32x2 w;
            w[0] = pk2(acc[ai][bj][m][n][0], acc[ai][bj][m][n][1]);
            w[1] = pk2(acc[ai][bj][m][n][2], acc[ai][bj][m][n][3]);
            *(u32x2*)(smem + tid * 8 + k * 4096) = w;
            ++k;
          }
    return;
  }
#endif
#pragma unroll
  for (int ai = 0; ai < 2; ++ai)
#pragma unroll
    for (int bj = 0; bj < 2; ++bj)
#pragma unroll
      for (int m = 0; m < 4; ++m)
#pragma unroll
        for (int n = 0; n < 2; ++n) {
          const int col = bj * 128 + wc * 32 + n * 16 + fr;
          const int row0 = ai * 128 + wr * 64 + m * 16 + fq * 4;
          u32x2 w;
          w[0] = pk2(acc[ai][bj][m][n][0], acc[ai][bj][m][n][1]);
          w[1] = pk2(acc[ai][bj][m][n][2], acc[ai][bj][m][n][3]);
          *(u32x2*)(smem + col * 512 + (((row0 >> 3) ^ (col & 31)) << 4) + ((row0 & 4) << 1)) = w;
        }
}
DI void unpack8(const u32x4 u, float* f) {
#pragma unroll
  for (int i = 0; i < 4; ++i) { f[2 * i] = __uint_as_float(u[i] << 16); f[2 * i + 1] = __uint_as_float(u[i] & 0xffff0000u); }
}
DI u32x4 pack8(const float* f) {
  u32x4 o;
#pragma unroll
  for (int i = 0; i < 4; ++i) o[i] = pk2(f[2 * i], f[2 * i + 1]);
  return o;
}

DI float bflo(unsigned u) { return __uint_as_float(u << 16); }
DI float bfhi(unsigned u) { return __uint_as_float(u & 0xffff0000u); }
DI float tok_rstd(const unsigned char* ws, int tok) {
  const float* q = (const float*)(ws + WS_SSQ) + tok;
  return rsqrtf((q[0] + q[NT] + q[2 * NT] + q[3 * (size_t)NT]) * (1.0f / 1024.0f) + 1e-6f);
}
DI void run_epilogue(const P& pin, const Job& jb, AccT& acc) {
  extern __shared__ __attribute__((aligned(16))) unsigned char smem[];
  const int TID = opaque_tid();
  P p = pin;
  asm volatile("" : "+s"(p.ws), "+s"(p.out));
  const int tm = jb.tm, tn = jb.tn, layer = jb.layer & 255, kind = jb.kind;
  const int nit = (jb.layer & 256) ? 8 : (jb.layer & 512) ? 1 : (jb.layer & 1024) ? 0 : 16;
#if PROBE_MASK
  if (kind == -1) return;
  if (kind == -3) {
    u32x4 z; z[0] = acc[0][0][0][0][0] > 1e30f ? 1u : 0u; z[1] = 2; z[2] = 3; z[3] = 4;
    for (int it = 0; it < 16; ++it) {
      const int q = it * 512 + TID;
      *(u32x4*)((u16*)(p.ws + WS_FF) + (size_t)(tn * 256 + (q >> 5)) * 4096 + tm * 256 + (q & 31) * 8) = z;
    }
    return;
  }
#endif
  if (kind == EK_S) {
    stage_acc(acc, smem, TID);
    __syncthreads();
    const int g = tn / 10, ct = tn % 10;
    const int pp = TID & 63, dir = (TID >> 6) & 1, sq = TID >> 7;
    const int nseq = ct < 8 ? 2 : 1, nc = ct < 8 ? 128 : 256;
    if (sq < nseq) {
      const float2 a = ((const float2*)(p.ws + WS_LPOW))[(size_t)(((layer * 2 + dir) * 32 + g) * 64 + pp) * 33 + 32];
      const int n = dir * 128 + pp * 2;
      unsigned* H = (unsigned*)((u16*)(p.ws + WS_ASSM) + ((size_t)g * NCH + ct * 256 + sq * nc) * ASTR + 512 + n);
      float hr = 0.f, hi = 0.f;
#pragma unroll 8
      for (int k = 0; k < nc; ++k) {
        const int c = dir == 0 ? k : nc - 1 - k;
        const int col = sq * nc + c;
        gst<unsigned>(H + (size_t)c * (ASTR / 2), pk2(hr, hi));
        const unsigned sv = *(const unsigned*)(smem + col * 512 + (((n >> 3) ^ (col & 31)) << 4) + (n & 7) * 2);
        const float nr = a.x * hr - a.y * hi + bflo(sv);
        hi = a.x * hi + a.y * hr + bfhi(sv);
        hr = nr;
      }
    }
    __syncthreads();
    return;
  }
#if PROBE_MASK
  if (jb.layer & 16384) { if (acc[1][1][3][1][3] == 12345.678f) smem[TID] = 1; }
  if (!(jb.layer & 2048))
  for (int rep = (jb.layer & 8192) ? 4 : 1; rep > 0; --rep)
#endif
  stage_acc(acc, smem, TID, (jb.layer & 4096) ? 1 : 0);
  float* lrs = (float*)(smem + 131072);
  if ((kind <= EK_U || kind == EK_M2 || kind == EK_M3 || kind == EK_FF1) && TID < 256) lrs[TID] = tok_rstd(p.ws, tn * 256 + TID);
  __syncthreads();
  const bool two_pass = kind == EK_Q || kind == EK_K || kind == EK_Y || kind == EK_M1 || kind == EK_M2 || kind == EK_M4;
  if (two_pass) {
    auto slot_of = [&](const int it, int& col, int& c) -> unsigned char* {
      const int q = it * 512 + TID;
      col = q >> 5; c = q & 31;
      return smem + col * 512 + ((c ^ (col & 31)) << 4);
    };
    if (kind == EK_M1 || kind == EK_M2 || kind == EK_M4) {
      const u16* T1 = (const u16*)(p.ws + WS_Q) + (size_t)(tn * 256) * 1024 + tm * 256;
      const u16* T2 = (const u16*)(p.ws + WS_ASSM) + (size_t)(tn * 256) * 1024 + tm * 256;
      if (kind == EK_M1) {
#pragma unroll 8
        for (int it = 0; it < 16; ++it) {
          int col, c; unsigned char* sl = slot_of(it, col, c);
          float f[8], a[8], r[8];
          unpack8(gld<u32x4>(T1 + (size_t)col * 1024 + c * 8), a);
          unpack8(*(const u32x4*)sl, f);
#pragma unroll
          for (int i = 0; i < 8; ++i) r[i] = f[i] * a[i];
          *(u32x4*)sl = pack8(r);
        }
      } else if (kind == EK_M2) {
#pragma unroll 8
        for (int it = 0; it < 16; ++it) {
          int col, c; unsigned char* sl = slot_of(it, col, c);
          float f[8], a[8], r[8];
          unpack8(gld<u32x4>(T1 + (size_t)col * 1024 + c * 8), a);
          unpack8(*(const u32x4*)sl, f);
          const float tr = lrs[col];
#pragma unroll
          for (int i = 0; i < 8; ++i) r[i] = sigmoidf_(f[i] * tr) * a[i];
          *(u32x4*)sl = pack8(r);
        }
      } else {
#pragma unroll 8
        for (int it = 0; it < 16; ++it) {
          int col, c; unsigned char* sl = slot_of(it, col, c);
          float f[8], a[8], b[8], r[8];
          unpack8(gld<u32x4>(T1 + (size_t)col * 1024 + c * 8), a);
          unpack8(gld<u32x4>(T2 + (size_t)col * 1024 + c * 8), b);
          unpack8(*(const u32x4*)sl, f);
#pragma unroll
          for (int i = 0; i < 8; ++i) r[i] = b[i] * f[i] + a[i];
          *(u32x4*)sl = pack8(r);
        }
      }
    } else if (kind == EK_Y) {
      const int g = tn / 10, ch0 = (tn % 10) * 256;
      const float* dsk = p.in[14] + layer * 512 + g * 16 + (TID & 1) * 8;
      const f32x4 d0 = *(const f32x4*)dsk, d1 = *(const f32x4*)(dsk + 4);
      const u16* UU = (const u16*)(p.ws + WS_ASSM) + ((size_t)g * NCH + ch0) * ASTR + tm * 256;
#pragma unroll 8
      for (int it = 0; it < 16; ++it) {
        int col, c; unsigned char* sl = slot_of(it, col, c);
        float f[8], u[8], r[8];
        unpack8(gld<u32x4>(UU + (size_t)col * ASTR + c * 8), u);
        unpack8(*(const u32x4*)sl, f);
#pragma unroll
        for (int i = 0; i < 4; ++i) { r[i] = gelu_tanh(f[i] + d0[i] * u[i]); r[4 + i] = gelu_tanh(f[4 + i] + d1[i] * u[4 + i]); }
        *(u32x4*)sl = pack8(r);
      }
    } else {
      const float* gn = (kind == EK_Q ? p.in[4] : p.in[5]) + layer * 64 + (TID & 7) * 8;
      const f32x4 g0 = *(const f32x4*)gn, g1 = *(const f32x4*)(gn + 4);
      const float qs = (kind == EK_Q) ? 0.125f * 1.4426950408889634f : 1.0f;
      const int i0 = (TID & 7) * 4;
#pragma unroll 4
      for (int it = 0; it < 16; ++it) {
        int col, c; unsigned char* sl = slot_of(it, col, c);
        const int tok = tn * 256 + col;
        const int pos = tok < NTP ? (tok & 4095) : ((tok - NTP) & 8191);
        const float* rp = (const float*)(p.ws + WS_ROPE) + 2 * ((i0 < 16) ? (pos >> 6) * 16 + i0 : (pos & 63) * 16 + i0 - 16);
        const f32x4 cs0 = gld<f32x4>(rp), cs1 = gld<f32x4>(rp + 4);
        float f[8], r[8];
        unpack8(*(const u32x4*)sl, f);
        const float tr = lrs[col];
        float ss = 0.f;
#pragma unroll
        for (int i = 0; i < 8; ++i) { f[i] *= tr; ss += f[i] * f[i]; }
        ss += __shfl_xor(ss, 1); ss += __shfl_xor(ss, 2); ss += __shfl_xor(ss, 4);
        const float rstd = rsqrtf(ss * (1.0f / 64.0f) + 1e-6f) * qs;
        const float x0 = f[0] * rstd * g0[0], x1 = f[1] * rstd * g0[1], x2 = f[2] * rstd * g0[2], x3 = f[3] * rstd * g0[3];
        const float x4 = f[4] * rstd * g1[0], x5 = f[5] * rstd * g1[1], x6 = f[6] * rstd * g1[2], x7 = f[7] * rstd * g1[3];
        r[0] = x0 * cs0[0] - x1 * cs0[1]; r[1] = x0 * cs0[1] + x1 * cs0[0];
        r[2] = x2 * cs0[2] - x3 * cs0[3]; r[3] = x2 * cs0[3] + x3 * cs0[2];
        r[4] = x4 * cs1[0] - x5 * cs1[1]; r[5] = x4 * cs1[1] + x5 * cs1[0];
        r[6] = x6 * cs1[2] - x7 * cs1[3]; r[7] = x6 * cs1[3] + x7 * cs1[2];
        *(u32x4*)sl = pack8(r);
      }
    }
#pragma unroll 4
    for (int it = 0; it < 16; ++it) {
      int col, c; unsigned char* sl = slot_of(it, col, c);
      const u32x4 v = *(const u32x4*)sl;
      u16* dst;
      if (kind == EK_Q) dst = (u16*)(p.ws + WS_Q) + (size_t)(tn * 256 + col) * 1024 + (tm * 4 + (c >> 3)) * 64 + (c & 7) * 8;
      else if (kind == EK_K) dst = (u16*)(p.ws + WS_K) + ((size_t)(c >> 3) * NT + tn * 256 + col) * 64 + (c & 7) * 8;
      else if (kind == EK_Y) dst = (u16*)(p.ws + WS_Y) + (size_t)(tn / 10) * NT * 16 + (size_t)((tn % 10) * 256 + col) * 512 + tm * 256 + c * 8;
      else dst = (u16*)(p.ws + WS_Q) + (size_t)(tn * 256 + col) * 1024 + tm * 256 + c * 8;
      gst<u32x4>(dst, v);
    }
    __syncthreads();
    return;
  }
  if (kind == EK_OUT || kind == EK_FF2) {
    const int cc = tm * 256 + (TID & 31) * 8;
#pragma unroll 1
    for (int it0 = 0; it0 < 16; it0 += 4) {
      f32x4 X0[4], X1[4];
#pragma unroll
      for (int k = 0; k < 4; ++k) {
        const int tok = tn * 256 + (((it0 + k) * 512 + TID) >> 5);
        const float* x = (kind == EK_OUT) ? xrow(p, layer, tok) + cc : p.out + (size_t)tok * 1024 + cc;
        X0[k] = gld<f32x4>(x); X1[k] = gld<f32x4>(x + 4);
      }
#pragma unroll
      for (int k = 0; k < 4; ++k) {
        const int q = (it0 + k) * 512 + TID;
        const int col = q >> 5, c = q & 31;
        const int tok = tn * 256 + col;
        float f[8], r[8];
        unpack8(*(const u32x4*)(smem + col * 512 + ((c ^ (col & 31)) << 4)), f);
        float* o = p.out + (size_t)tok * 1024 + cc;
        f32x4 o0, o1;
        float ss = 0.f;
#pragma unroll
        for (int i = 0; i < 4; ++i) { o0[i] = X0[k][i] + f[i]; o1[i] = X1[k][i] + f[4 + i]; r[i] = o0[i]; r[4 + i] = o1[i]; ss += o0[i] * o0[i] + o1[i] * o1[i]; }
        gst<f32x4>(o, o0); gst<f32x4>(o + 4, o1);
        gst<u32x4>((u16*)(p.ws + WS_XN) + (size_t)tok * 1024 + cc, pack8(r));
        ss += __shfl_xor(ss, 1); ss += __shfl_xor(ss, 2); ss += __shfl_xor(ss, 4); ss += __shfl_xor(ss, 8); ss += __shfl_xor(ss, 16);
        if (c == 0) ((float*)(p.ws + WS_SSQ))[(size_t)tm * NT + tok] = ss;
      }
    }
    __syncthreads();
    return;
  }
#pragma unroll 2
  for (int it = 0; it < nit; ++it) {
    const int q = it * 512 + TID;
    int col = q >> 5, c = q & 31;
    if (kind == EK_U) { col = (q >> 1) & 255; c = ((q >> 9) << 1) | (q & 1); }
    const u32x4 sv = *(const u32x4*)(smem + col * 512 + ((c ^ (col & 31)) << 4));
    float f[8], r[8];
    unpack8(sv, f);
#if PROBE_MASK
    if (kind == -2) { if (f[0] > 1e30f) *(u32x4*)(p.ws + WS_FF) = sv; continue; }
#endif
    switch (kind) {
      case EK_V: {
        {
          const int tok0 = tn * 256 + c * 8;
#pragma unroll
          for (int i = 0; i < 8; ++i) r[i] = f[i] * lrs[c * 8 + i];
          gst<u32x4>((u16*)(p.ws + WS_VT) + (size_t)col * NT + tok0, pack8(r));
        }
      } break;
      case EK_U: {
        const int tok = tn * 256 + col, g = (tm - 6) * 16 + (c >> 1);
        const float tr = lrs[col];
#pragma unroll
        for (int i = 0; i < 8; ++i) r[i] = f[i] * tr;
        gst<u32x4>((u16*)(p.ws + WS_ASSM) + ((size_t)g * NCH + (tok >> 5)) * ASTR + (tok & 31) * 16 + (c & 1) * 8, pack8(r));
      } break;
      case EK_M0: case EK_M3: {
        const size_t o = (size_t)(tn * 256 + col) * 1024 + tm * 256 + c * 8;
        const float tr = (kind == EK_M3) ? lrs[col] : 1.0f;
#pragma unroll
        for (int i = 0; i < 8; ++i) r[i] = sigmoidf_(f[i] * tr);
        gst<u32x4>((kind == EK_M3 ? (u16*)(p.ws + WS_ASSM) : (u16*)(p.ws + WS_Q)) + o, pack8(r));
      } break;
      case EK_FF1: {
        const float tr = lrs[col];
#pragma unroll
        for (int i = 0; i < 8; ++i) { const float a = fmaxf(f[i] * tr, 0.f); r[i] = a * a; }
        gst<u32x4>((u16*)(p.ws + WS_FF) + ((size_t)(tn * 16 + tm) << 16) + col * 256 + c * 8, pack8(r));
      } break;
    }
  }
  __syncthreads();
}

DI void make_job(const P& pin, int layer, int s, int w, int step, Job& jb) {
  struct { unsigned char* ws; } p;
  p.ws = pin.ws;
  asm volatile("" : "+s"(p.ws));
  const u16* XN = (const u16*)(p.ws + WS_XN);
  jb.layer = layer; jb.gsB = 16; jb.tmB = 0;
  if (s == 1) {
    int g = w / 10;
    jb.A = (const u16*)(p.ws + WS_W1T) + ((size_t)layer * 32 + g) * 256 * 512;
    jb.Bt = (const u16*)(p.ws + WS_ASSM) + (size_t)w * 256 * ASTR;
    jb.lda = 512; jb.ldb = ASTR; jb.K = 512; jb.kind = EK_S; jb.tm = 0; jb.tn = w;
    return;
  }
  if (s == 3) {
    int gc = w >> 1, rt = w & 1, g = gc / 10;
    jb.A = (const u16*)(p.ws + WS_WYT) + (((size_t)layer * 32 + g) * 512 + rt * 256) * ASTR;
    jb.Bt = (const u16*)(p.ws + WS_ASSM) + (size_t)gc * 256 * ASTR;
    jb.lda = ASTR; jb.ldb = ASTR; jb.K = ASTR; jb.kind = EK_Y; jb.tm = rt; jb.tn = gc;
    return;
  }
  const int nft = (s == 0) ? 8 : (s == 6) ? 16 : 4;
  int tt, ft; tile_map(w, nft, tt, ft);
  if (s == 6) {
    const int xcd = w & 7, r = w >> 3, blk = r >> 5, i = r & 31;
    ft = (blk & 1) * 8 + (i & 7);
    tt = ((blk >> 1) * 4 + (i >> 3)) * 8 + xcd;
  }
  jb.tm = ft; jb.tn = tt;
  jb.lda = 1024; jb.ldb = 1024; jb.K = 1024;
  if (s == 0) {
    const u16* W = (const u16*)(p.ws + WS_WT_IN) + (size_t)layer * 4096 * 1024 + (size_t)ft * 256 * 1024;
    const u16* X = XN + (size_t)tt * 256 * 1024;
    if (ft == 5) { jb.A = X; jb.Bt = W; jb.kind = EK_V; }
    else { jb.A = W; jb.Bt = X; jb.kind = ft < 4 ? EK_Q : ft == 4 ? EK_K : EK_U; }
  } else if (s == 4) {
    jb.kind = EK_M0 + step;
    if (step < 2) {
      jb.A = (const u16*)(p.ws + (step == 0 ? WS_WT_GB : WS_WT_GA)) + (size_t)layer * 1024 * 512 + (size_t)ft * 256 * 512;
      jb.Bt = (const u16*)(p.ws + WS_Y) + (size_t)tt * 256 * 16;
      jb.lda = 512; jb.ldb = 16; jb.gsB = NT * 16; jb.K = 512;
    } else if (step < 4) {
      jb.A = (const u16*)(p.ws + WS_WT_IN) + (size_t)layer * 4096 * 1024 + (size_t)((step == 2 ? 3072 : 2048) + ft * 256) * 1024;
      jb.Bt = XN + (size_t)tt * 256 * 1024;
    } else {
      jb.A = (const u16*)(p.ws + WS_WT_AP) + (size_t)layer * 1024 * 1024 + (size_t)ft * 256 * 1024;
      jb.Bt = (const u16*)(p.ws + WS_ATTO) + (size_t)tt * 256 * 1024;
    }
  } else if (s == 5) {
    jb.A = (const u16*)(p.ws + WS_WT_OUT) + (size_t)layer * 1024 * 1024 + (size_t)ft * 256 * 1024;
    jb.Bt = (const u16*)(p.ws + WS_Q) + (size_t)tt * 256 * 1024; jb.kind = EK_OUT;
  } else if (s == 6) {
    jb.A = (const u16*)(p.ws + WS_WT_FF1) + (size_t)layer * 4096 * 1024 + (size_t)ft * 256 * 1024;
    jb.Bt = XN + (size_t)tt * 256 * 1024; jb.kind = EK_FF1;
  } else {
    jb.A = (const u16*)(p.ws + WS_WT_FF2) + (size_t)layer * 1024 * 4096 + (size_t)ft * 256 * 4096;
    jb.Bt = (const u16*)(p.ws + WS_FF) + ((size_t)tt * 16 << 16);
    jb.lda = 4096; jb.ldb = 256; jb.tmB = 1; jb.K = 4096; jb.kind = EK_FF2;
  }
}

DI void phase_jobs(const P& p, int layer, int s, int probe = 0) {
  int nitems, nsteps = 1, nattn = 0;
  switch (s) {
    case 0: nitems = 2560; break;
    case 1: nitems = 320; break;
    case 3: nitems = 3200; nattn = 2560; break;
    case 4: nitems = 1280; nsteps = 5; break;
    case 5: nitems = 1280; break;
    case 6: nitems = 5120; break;
    default: nitems = 1280; break;
  }
#if STAGGER_SLEEP
  if (s != 3) {
    const int slot = (blockIdx.x >> 3) & 31;
    for (int i = 0; i < slot; ++i) __builtin_amdgcn_s_sleep(STAGGER_SLEEP);
  }
#endif
  for (int w = blockIdx.x; w < nitems; w += gridDim.x) {
    if (w < nattn) {
      int seq_start, L, head, qb;
      if (w < 512) {
        int xcd = w & 7, r = w >> 3;
        int seq = xcd >> 2, kvh = xcd & 3;
        seq_start = NTP + seq * 8192; L = 8192; head = kvh * 4 + (r >> 4); qb = r & 15;
      } else {
        int w2 = w - 512, xcd = w2 & 7, r = w2 >> 3;
        int grp = (r >> 5) * 8 + xcd, within = r & 31;
        int seq = grp >> 2, kvh = grp & 3;
        seq_start = seq * 4096; L = 4096; head = kvh * 4 + (within >> 3); qb = within & 7;
      }
      attn_item(p, layer, seq_start, L, head, qb);
    } else {
      for (int step = 0; step < nsteps; ++step) {
        Job jb;
        make_job(p, layer, s, w - nattn, step, jb);
#if PROBE_MASK
        if (probe == 2 || probe == 3) jb.kind = -1;
        if (probe == 3) jb.K = jb.K / 2;
#endif
        gemm_tile(jb.A, jb.Bt, jb.lda, jb.ldb, jb.gsB, jb.tmB, jb.K, [&](AccT& acc) {
          int w2 = w - nattn, st2 = step;
          asm volatile("" : "+s"(w2), "+s"(st2));
          Job j2;
          make_job(p, layer, s, w2, st2, j2);
#if PROBE_MASK
          if (probe == 2 || probe == 3) j2.kind = -1;
          if (probe == 4) j2.kind = -2;
          if (probe == 6) j2.layer |= 256;
          if (probe == 7) j2.layer |= 512;
          if (probe == 8) j2.layer |= 1024 | 2048;
          if (probe == 9) j2.layer |= 1024;
          if (probe == 10) j2.layer |= 1024 | 4096;
          if (probe == 11) j2.layer |= 1024 | 8192;
          if (probe == 12) j2.layer |= 1024 | 2048 | 16384;
          if (probe == 5) j2.kind = -3;
#endif
          run_epilogue(p, j2, acc);
        });
      }
    }
  }
}

DI void run_phase(const P& pin, int ph, int probe = 0) {
  P p = pin;
  asm volatile("" : "+s"(p.ws), "+s"(p.out));
  int layer = (ph - 3) / 8, s = (ph - 3) % 8;
  if (s == 2) phase_scan(p, layer);
  else phase_jobs(p, layer, s, probe);
}

__global__ void __launch_bounds__(512, 2) mega_coop(P p) {
  cg::grid_group grid = cg::this_grid();
  phase_prep_a(p);
  grid.sync();
  phase_prep_b(p);
  grid.sync();
  phase_prep_c(p);
  phase_convert(p, p.in[0], p.in[1]);
  grid.sync();
  for (int ph = 3; ph < NPHASE; ++ph) {
    if ((ph - 3) % 8 == 2) continue;
    run_phase(p, ph);
#if PROBE_MASK
    {
      const int s_ = (ph - 3) % 8;
      bool rep = false;
      if ((PROBE_MASK & 1) && s_ == 3) rep = true;
      if ((PROBE_MASK & 2) && (s_ == 0 || s_ == 4 || s_ == 6)) rep = true;
      if ((PROBE_MASK & 4) && (s_ == 1 || s_ == 2)) rep = true;
      if ((PROBE_MASK & 8) && s_ == 6) run_phase(p, ph, (PROBE_MASK >> 4));
      if (rep) run_phase(p, ph);
    }
#endif
    if (ph + 1 < NPHASE) grid.sync();
  }
}
#if N_LAUNCH_MODE == 0
__global__ void __launch_bounds__(512, 2) mega_one(P p) {
  run_phase(p, p.ph_lo);
}
#endif

extern "C" void kernel_launch(void* const* d_in, const int* in_sizes, int n_in, void* d_out, int out_size, void* d_ws, size_t ws_size,
                              hipStream_t stream) {
  static int grid = 0;
  if (grid == 0) {
    if (n_in != 21 || ws_size < WS_END) { fprintf(stderr, "kernel_launch: unexpected n_in %d / ws_size %zu (need %zu)\n", n_in, ws_size, (size_t)WS_END); grid = -1; return; }
    int dev = 0, cus = 0, per_cu = 0;
    hipGetDevice(&dev);
    hipDeviceGetAttribute(&cus, hipDeviceAttributeMultiprocessorCount, dev);
    hipFuncSetAttribute((const void*)mega_coop, hipFuncAttributeMaxDynamicSharedMemorySize, LDS_BYTES);
#if N_LAUNCH_MODE == 0
    hipFuncSetAttribute((const void*)mega_one, hipFuncAttributeMaxDynamicSharedMemorySize, LDS_BYTES);
#endif
    hipOccupancyMaxActiveBlocksPerMultiprocessor(&per_cu, (const void*)mega_coop, 512, LDS_BYTES);
    if (per_cu < 1) { fprintf(stderr, "kernel_launch: occupancy query says %d blocks/CU\n", per_cu); per_cu = 1; }
    (void)hipGetLastError();
    grid = cus * 1;
  }
  if (grid < 0) return;
  P p{};
  for (int i = 0; i < 21; ++i) p.in[i] = (const float*)d_in[i];
  p.out = (float*)d_out;
  p.ws = (unsigned char*)d_ws;
#if N_LAUNCH_MODE == 1
  p.ph_lo = 0; p.ph_hi = NPHASE;
  void* args[] = {&p};
  hipError_t e = hipLaunchCooperativeKernel((const void*)mega_coop, dim3(grid), dim3(512), args, LDS_BYTES, stream);
  if (e != hipSuccess) fprintf(stderr, "cooperative launch failed: %s (grid %d)\n", hipGetErrorString(e), grid);
#else
  for (int ph = 0; ph < NPHASE; ++ph) {
    p.ph_lo = ph; p.ph_hi = ph + 1;
    hipLaunchKernelGGL(mega_one, dim3(grid), dim3(512), LDS_BYTES, stream, p);
  }
#endif
}
```

```cpp
#include <hip/hip_runtime.h>
#include <hip/hip_cooperative_groups.h>
#include <cstdio>
namespace cg = cooperative_groups;

typedef unsigned short u16;
typedef __attribute__((ext_vector_type(8))) short bf16x8;
typedef __attribute__((ext_vector_type(4))) float f32x4;
typedef __attribute__((ext_vector_type(16))) float f32x16;
typedef __attribute__((ext_vector_type(4))) unsigned u32x4;
typedef __attribute__((ext_vector_type(2))) unsigned u32x2;
typedef __attribute__((ext_vector_type(2))) float f32x2;
typedef __attribute__((ext_vector_type(2))) __bf16 bf16v2;

#define DI __device__ __forceinline__
#ifndef PROBE_MASK
#define PROBE_MASK 0
#endif
#ifndef STAGGER_SLEEP
#define STAGGER_SLEEP 0
#endif
#ifndef N_LAUNCH_MODE
#define N_LAUNCH_MODE 1
#endif

constexpr int NT = 81920;
constexpr int NTP = 65536;
constexpr int NCH = 2560;
constexpr int ASTR = 768;
constexpr int NPHASE = 19;
constexpr int LDS_BYTES = 131072 + 1024 + 16;

constexpr size_t MiB = 1ull << 20;
constexpr size_t WS_WT_IN = 0;
constexpr size_t WS_WT_AP = 16 * MiB;
constexpr size_t WS_WT_GA = 20 * MiB;
constexpr size_t WS_WT_GB = 22 * MiB;
constexpr size_t WS_WT_OUT = 24 * MiB;
constexpr size_t WS_WT_FF1 = 28 * MiB;
constexpr size_t WS_WT_FF2 = 44 * MiB;
constexpr size_t WS_W1T = 60 * MiB;
constexpr size_t WS_WYT = 76 * MiB;
constexpr size_t WS_LPOW = 124 * MiB;
constexpr size_t WS_BBAR = 127 * MiB;
constexpr size_t WS_KTAB = 128 * MiB;
constexpr size_t WS_ROPE = 132 * MiB;
constexpr size_t WS_SSQ = 133 * MiB;
constexpr size_t WS_XN = 135 * MiB;
constexpr size_t WS_BIG = 295 * MiB;
constexpr size_t WS_Q = WS_BIG;
constexpr size_t WS_K = WS_BIG + 160 * MiB;
constexpr size_t WS_VT = WS_BIG + 200 * MiB;
constexpr size_t WS_ASSM = WS_BIG + 240 * MiB;
constexpr size_t WS_S = WS_BIG + 360 * MiB;
constexpr size_t WS_Y = WS_BIG + 440 * MiB;
constexpr size_t WS_ATTO = WS_BIG + 520 * MiB;
constexpr size_t WS_FF = WS_BIG;
constexpr size_t WS_END = WS_BIG + 680 * MiB;

struct P {
  const float* in[21];
  float* out;
  unsigned char* ws;
  int ph_lo, ph_hi;
};

DI u16 f2bf(float f) { unsigned u = __float_as_uint(f); u += 0x7fffu + ((u >> 16) & 1u); return (u16)(u >> 16); }
DI float bf2f(u16 h) { return __uint_as_float(((unsigned)h) << 16); }
DI unsigned pk2(float a, float b) {
  f32x2 v; v[0] = a; v[1] = b;
  bf16v2 r = __builtin_convertvector(v, bf16v2);
  return __builtin_bit_cast(unsigned, r);
}
DI float sigmoidf_(float x) { return 1.0f / (1.0f + __expf(-x)); }
DI float gelu_tanh(float x) {
  float z = 0.7978845608028654f * (x + 0.044715f * x * x * x);
  float e = __expf(2.0f * z);
  return 0.5f * x * (2.0f - 2.0f / (e + 1.0f));
}


DI void sincos_d(double x, double* sn, double* cs) {
  const double TWO_PI_HI = 6.283185307179586232e+00, TWO_PI_LO = 2.449293598294706414e-16;
  double k = rint(x * 0.15915494309189534561);
  double r = (x - k * TWO_PI_HI) - k * TWO_PI_LO;
  r *= 0.25;
  double r2 = r * r;
  double s = 1.0, c = 1.0;
  s = 1.0 - r2 / (18.0 * 19.0);
  s = 1.0 - r2 / (16.0 * 17.0) * s;
  s = 1.0 - r2 / (14.0 * 15.0) * s;
  s = 1.0 - r2 / (12.0 * 13.0) * s;
  s = 1.0 - r2 / (10.0 * 11.0) * s;
  s = 1.0 - r2 / (8.0 * 9.0) * s;
  s = 1.0 - r2 / (6.0 * 7.0) * s;
  s = 1.0 - r2 / (4.0 * 5.0) * s;
  s = 1.0 - r2 / (2.0 * 3.0) * s;
  s *= r;
  c = 1.0 - r2 / (17.0 * 18.0);
  c = 1.0 - r2 / (15.0 * 16.0) * c;
  c = 1.0 - r2 / (13.0 * 14.0) * c;
  c = 1.0 - r2 / (11.0 * 12.0) * c;
  c = 1.0 - r2 / (9.0 * 10.0) * c;
  c = 1.0 - r2 / (7.0 * 8.0) * c;
  c = 1.0 - r2 / (5.0 * 6.0) * c;
  c = 1.0 - r2 / (3.0 * 4.0) * c;
  c = 1.0 - r2 / (1.0 * 2.0) * c;
  double s2 = 2.0 * s * c, c2 = c * c - s * s;
  *sn = 2.0 * s2 * c2; *cs = c2 * c2 - s2 * s2;
}

template <class T> DI T gld(const void* q) { return *(const __attribute__((address_space(1))) T*)q; }
template <class T> DI void gst(void* q, const T v) { *(__attribute__((address_space(1))) T*)q = v; }
DI int opaque_tid() { int t = threadIdx.x; asm volatile("" : "+v"(t)); return t; }
DI const char* sgpr_ptr(const char* p) { asm("" : "+s"(p)); return p; }
#define WAIT_V(n) asm volatile("s_waitcnt vmcnt(" #n ")" ::: "memory")
#define WAIT_L(n) asm volatile("s_waitcnt lgkmcnt(" #n ")" ::: "memory")
#define BAR __builtin_amdgcn_s_barrier()
#define SCHED __builtin_amdgcn_sched_barrier(0)
#define GLDS(gp, lp) __builtin_amdgcn_global_load_lds((const unsigned*)(gp), (unsigned*)(lp), 16, 0, 0)

constexpr int GBK = 64, GHALF = 128, GHT = GHALF * GBK;
DI int lds_byte(int r, int c) {
  int st = (r >> 4) * 2 + (c >> 5), rr = r & 15, cc = c & 31, ob = rr * 64 + cc * 2;
  return st * 1024 + (ob ^ (((ob >> 9) & 1) << 5));
}
DI void stage_rc(int b, int& R, int& C) {
  int st = b / 1024, sb = b % 1024, swz = sb ^ (((sb >> 9) & 1) << 5);
  R = (st >> 1) * 16 + swz / 64; C = (st & 1) * 32 + (swz % 64) / 2;
}

typedef f32x4 AccT[2][2][4][2];

template <class Epi>
DI void gemm_tile(const u16* __restrict__ A, const u16* __restrict__ Bt, const int lda, const int ldb, const int gsB, const int tmB, const int K, Epi&& epi) {
  const int TID = opaque_tid();
  extern __shared__ __attribute__((aligned(16))) unsigned char smem[];
  u16* shm = (u16*)smem;
#define SA(b, h) (shm + ((b) * 2 + (h)) * GHT)
#define SB(b, h) (shm + (4 + (b) * 2 + (h)) * GHT)
  int R0, C0, R1, C1;
  stage_rc(TID * 16, R0, C0);
  stage_rc(TID * 16 + 8192, R1, C1);
  const unsigned voA0 = (unsigned)(R0 * lda + C0) * 2u, voA1 = (unsigned)(R1 * lda + C1) * 2u;
  const unsigned voB0 = (unsigned)(R0 * ldb + (C0 & 15) + (C0 >> 4) * gsB) * 2u, voB1 = (unsigned)(R1 * ldb + (C1 & 15) + (C1 >> 4) * gsB) * 2u;
  const int hA = GHALF * lda, hB = GHALF * ldb;
  const unsigned wid_u = __builtin_amdgcn_readfirstlane(TID >> 6);
#define STAGE_A(PTR, half, kt) do { const char* _g = sgpr_ptr((const char*)(A + (size_t)(half) * hA + (size_t)(kt) * GBK)); \
    char* _l = (char*)(PTR) + wid_u * 1024u; \
    GLDS(_g + voA0, _l); GLDS(_g + voA1, _l + 8192); } while (0)
#define STAGE_B(PTR, half, kt) do { const char* _g = sgpr_ptr((const char*)(Bt + (size_t)(half) * hB + (tmB ? (size_t)((((kt) >> 2) << 16) + (((kt) & 3) << 6)) : (size_t)(kt) * (size_t)(4 * gsB)))); \
    char* _l = (char*)(PTR) + wid_u * 1024u; \
    GLDS(_g + voB0, _l); GLDS(_g + voB1, _l + 8192); } while (0)
#define LDA(dst, b, h) for (int m = 0; m < 4; ++m) for (int k = 0; k < 2; ++k) \
    dst[m][k] = *reinterpret_cast<const bf16x8*>((char*)SA(b, h) + lds_byte(wr * 64 + m * 16 + fr, k * 32 + fq * 8))
#define LDB(dst, b, h) for (int n = 0; n < 2; ++n) for (int k = 0; k < 2; ++k) \
    dst[n][k] = *reinterpret_cast<const bf16x8*>((char*)SB(b, h) + lds_byte(wc * 32 + n * 16 + fr, k * 32 + fq * 8))
#define MMA(ai, bj, At, Bq) do { __builtin_amdgcn_s_setprio(1); \
    for (int m = 0; m < 4; ++m) for (int n = 0; n < 2; ++n) for (int k = 0; k < 2; ++k) \
      acc[ai][bj][m][n] = __builtin_amdgcn_mfma_f32_16x16x32_bf16(At[m][k], Bq[n][k], acc[ai][bj][m][n], 0, 0, 0); \
    __builtin_amdgcn_s_setprio(0); } while (0)

  const int wid = TID >> 6, lane = TID & 63, wr = wid >> 2, wc = wid & 3, fr = lane & 15, fq = lane >> 4;
  AccT acc;
#pragma unroll
  for (int a = 0; a < 2; ++a)
#pragma unroll
    for (int b = 0; b < 2; ++b)
#pragma unroll
      for (int m = 0; m < 4; ++m)
#pragma unroll
        for (int n = 0; n < 2; ++n) acc[a][b][m][n] = f32x4{0.f, 0.f, 0.f, 0.f};
  bf16x8 At[4][2], B0[2][2], B1[2][2];
  const int nt = K / GBK;
  STAGE_B(SB(0, 0), 0, 0); STAGE_A(SA(0, 0), 0, 0);
  STAGE_B(SB(0, 1), 1, 0); STAGE_A(SA(0, 1), 1, 0);
  if (wr == 1) BAR;
  WAIT_V(4); BAR;
  STAGE_B(SB(1, 0), 0, 1); STAGE_A(SA(1, 0), 0, 1); STAGE_B(SB(1, 1), 1, 1);
  WAIT_V(6); BAR;
  for (int t = 0; t < nt - 2; t += 2) {
    LDB(B0, 0, 0); SCHED; LDA(At, 0, 0); STAGE_A(SA(1, 1), 1, t + 1);
    WAIT_L(8); BAR; WAIT_L(0); MMA(0, 0, At, B0); BAR; SCHED;
    LDB(B1, 0, 1); STAGE_B(SB(0, 0), 0, t + 2);
    BAR; WAIT_L(0); MMA(0, 1, At, B1); BAR;
    LDA(At, 0, 1); STAGE_A(SA(0, 0), 0, t + 2);
    BAR; WAIT_L(0); MMA(1, 0, At, B0); BAR; SCHED;
    STAGE_B(SB(0, 1), 1, t + 2);
    WAIT_V(6); BAR; MMA(1, 1, At, B1); BAR;
    LDB(B0, 1, 0); SCHED; LDA(At, 1, 0); STAGE_A(SA(0, 1), 1, t + 2);
    WAIT_L(8); BAR; WAIT_L(0); MMA(0, 0, At, B0); BAR; SCHED;
    LDB(B1, 1, 1); STAGE_B(SB(1, 0), 0, t + 3);
    BAR; WAIT_L(0); MMA(0, 1, At, B1); BAR;
    LDA(At, 1, 1); STAGE_A(SA(1, 0), 0, t + 3);
    BAR; WAIT_L(0); MMA(1, 0, At, B0); BAR; SCHED;
    STAGE_B(SB(1, 1), 1, t + 3);
    WAIT_V(6); BAR; MMA(1, 1, At, B1); BAR;
  }
  { LDB(B0, 0, 0); LDA(At, 0, 0); STAGE_A(SA(1, 1), 1, nt - 1);
    BAR; WAIT_L(0); MMA(0, 0, At, B0); BAR;
    LDB(B1, 0, 1); BAR; WAIT_L(0); MMA(0, 1, At, B1); BAR;
    LDA(At, 0, 1); WAIT_V(4); BAR; WAIT_L(0); MMA(1, 0, At, B0); MMA(1, 1, At, B1); BAR; }
  { LDB(B0, 1, 0); LDA(At, 1, 0); WAIT_V(2); BAR; WAIT_L(0); MMA(0, 0, At, B0); BAR;
    LDB(B1, 1, 1); WAIT_V(0); BAR; WAIT_L(0); MMA(0, 1, At, B1); BAR;
    LDA(At, 1, 1); BAR; WAIT_L(0); MMA(1, 0, At, B0); MMA(1, 1, At, B1); BAR; }
  if (wr == 0) BAR;
  epi(acc);
#undef SA
#undef SB
}

template <class F>
DI void epi_for(AccT& acc, F&& f) {
  const int TID = opaque_tid();
  const int _wid = TID >> 6, _lane = TID & 63, _wr = _wid >> 2, _wc = _wid & 3, _fr = _lane & 15, _fq = _lane >> 4;
#pragma unroll
  for (int _ai = 0; _ai < 2; ++_ai)
#pragma unroll
    for (int _bj = 0; _bj < 2; ++_bj)
#pragma unroll
      for (int _m = 0; _m < 4; ++_m)
#pragma unroll
        for (int _n = 0; _n < 2; ++_n)
          f(_ai * 128 + _wr * 64 + _m * 16 + _fq * 4, _bj * 128 + _wc * 32 + _n * 16 + _fr, acc[_ai][_bj][_m][_n]);
}

DI void tile_map(int w, int ntn, int& tm, int& tn) {
  int xcd = w & 7, r = w >> 3;
  tn = r % ntn; tm = (r / ntn) * 8 + xcd;
}

DI void transpose_tile(const float* __restrict__ src, int N, u16* __restrict__ dst, int K, int tk, int tn, const float* __restrict__ gain) {
  const int TID = opaque_tid();
  extern __shared__ __attribute__((aligned(16))) unsigned char smem[];
  float* tile = (float*)smem;
  const int t = TID;
  {
    const int cs = (t & 15) * 4;
    float4 v[8];
#pragma unroll
    for (int i = 0; i < 8; ++i) v[i] = *(const float4*)(src + (size_t)(tk * 256 + (t >> 4) + 32 * i) * N + tn * 64 + cs);
#pragma unroll
    for (int i = 0; i < 8; ++i) {
      const int rk = (t >> 4) + 32 * i;
      const float gk = gain ? gain[tk * 256 + rk] : 1.0f;
      float* d = tile + rk * 65 + cs;
      d[0] = v[i].x * gk; d[1] = v[i].y * gk; d[2] = v[i].z * gk; d[3] = v[i].w * gk;
    }
  }
  __syncthreads();
  {
    const int n = t >> 3, ks = (t & 7) * 32;
#pragma unroll
    for (int j = 0; j < 4; ++j) {
      const float* q = tile + (ks + 8 * j) * 65 + n;
      u32x4 o;
      o[0] = pk2(q[0], q[65]); o[1] = pk2(q[130], q[195]); o[2] = pk2(q[260], q[325]); o[3] = pk2(q[390], q[455]);
      *(u32x4*)(dst + (size_t)(tn * 64 + n) * K + tk * 256 + ks + 8 * j) = o;
    }
  }
  __syncthreads();
}

DI void phase_prep_a(const P& p) {
  const int TID = opaque_tid();
  const int bid = blockIdx.x, nb = gridDim.x;
  for (int w = bid; w < 1920; w += nb) {
    int layer = w / 960, r = w % 960;
    const float* src; u16* dst; int K, N, tl; const float* gain = nullptr;
    if (r < 256) { src = p.in[3] + (size_t)layer * 1024 * 4096; dst = (u16*)(p.ws + WS_WT_IN) + (size_t)layer * 4096 * 1024; K = 1024; N = 4096; tl = r; gain = p.in[2] + layer * 1024; }
    else if (r < 320) { src = p.in[6] + (size_t)layer * 1024 * 1024; dst = (u16*)(p.ws + WS_WT_AP) + (size_t)layer * 1024 * 1024; K = 1024; N = 1024; tl = r - 256; }
    else if (r < 352) { src = p.in[15] + (size_t)layer * 512 * 1024; dst = (u16*)(p.ws + WS_WT_GA) + (size_t)layer * 1024 * 512; K = 512; N = 1024; tl = r - 320; }
    else if (r < 384) { src = p.in[16] + (size_t)layer * 512 * 1024; dst = (u16*)(p.ws + WS_WT_GB) + (size_t)layer * 1024 * 512; K = 512; N = 1024; tl = r - 352; }
    else if (r < 448) { src = p.in[17] + (size_t)layer * 1024 * 1024; dst = (u16*)(p.ws + WS_WT_OUT) + (size_t)layer * 1024 * 1024; K = 1024; N = 1024; tl = r - 384; }
    else if (r < 704) { src = p.in[19] + (size_t)layer * 1024 * 4096; dst = (u16*)(p.ws + WS_WT_FF1) + (size_t)layer * 4096 * 1024; K = 1024; N = 4096; tl = r - 448; gain = p.in[18] + layer * 1024; }
    else { src = p.in[20] + (size_t)layer * 4096 * 1024; dst = (u16*)(p.ws + WS_WT_FF2) + (size_t)layer * 1024 * 4096; K = 4096; N = 1024; tl = r - 704; }
    int ntn = N / 64;
    transpose_tile(src, N, dst, K, tl / ntn, tl % ntn, gain);
  }
  const int gtid = bid * 512 + TID, nth = nb * 512;
  float2* LP = (float2*)(p.ws + WS_LPOW);
  float2* BB = (float2*)(p.ws + WS_BBAR);
  for (int idx = gtid; idx < 8192 * 33; idx += nth) {
    const int i = idx / 33, tau = idx - i * 33, lg = i >> 6;
    const double step = exp((double)p.in[9][lg]);
    const double zr = (double)p.in[7][i] * step, zi = (double)p.in[8][i] * step;
    double e = exp(zr * tau), sn, cs;
    sincos_d(zi * tau, &sn, &cs);
    LP[idx] = make_float2((float)(e * cs), (float)(e * sn));
  }
  for (int idx = gtid; idx < 8192 * 16; idx += nth) {
    const int i = idx >> 4, ci = idx & 15, lg = i >> 6;
    const double step = exp((double)p.in[9][lg]);
    const double lr = p.in[7][i], li = p.in[8][i];
    const double zr = lr * step, zi = li * step;
    double e = exp(zr), sn, cs;
    sincos_d(zi, &sn, &cs);
    const double nr = e * cs - 1.0, ni = e * sn, den = lr * lr + li * li;
    const double fr = (nr * lr + ni * li) / den, fi = (ni * lr - nr * li) / den;
    const double br = p.in[10][idx], bi = p.in[11][idx];
    BB[idx] = make_float2((float)(fr * br - fi * bi), (float)(fr * bi + fi * br));
  }
  float2* RP = (float2*)(p.ws + WS_ROPE);
  for (int i = gtid; i < 128 * 16; i += nth) {
    int pos = i >> 4, f = i & 15;
    double inv = exp(-(double)(2 * f) / 32.0 * 9.210340371976184);
    double sn, cs;
    sincos_d((double)pos * inv, &sn, &cs);
    RP[i] = make_float2((float)cs, (float)sn);
  }
}

DI void phase_prep_b(const P& p) {
  const int TID = opaque_tid();
  const int gtid = blockIdx.x * 512 + TID, nth = gridDim.x * 512;
  const float2* LP = (const float2*)(p.ws + WS_LPOW);
  const float2* BB = (const float2*)(p.ws + WS_BBAR);
  float* KT = (float*)(p.ws + WS_KTAB);
  const float* cre = p.in[12];
  const float* cim = p.in[13];
  {
    extern __shared__ __attribute__((aligned(16))) unsigned char smem[];
    float2* Cs = (float2*)smem;
    float2* Bs = Cs + 1024;
    float2* Ls = Bs + 1024;
    for (int item = blockIdx.x; item < 256; item += gridDim.x) {
      const int lg = item >> 1, th = item & 1;
      for (int e = TID; e < 1024; e += 512) {
        Cs[e] = make_float2(cre[(size_t)lg * 1024 + e], cim[(size_t)lg * 1024 + e]);
        Bs[e] = BB[(size_t)lg * 1024 + e];
        Ls[e] = LP[(size_t)(lg * 64 + (e >> 4)) * 33 + th * 16 + (e & 15)];
      }
      __syncthreads();
      const int co = (TID >> 4) & 15, ci = TID & 15, tsel = TID >> 8;
      float a8[8];
#pragma unroll
      for (int k = 0; k < 8; ++k) a8[k] = 0.f;
      for (int pp = 0; pp < 64; ++pp) {
        const float2 c = Cs[co * 64 + pp], b = Bs[pp * 16 + ci];
        const float zr = c.x * b.x - c.y * b.y, zi = c.x * b.y + c.y * b.x;
#pragma unroll
        for (int k = 0; k < 8; ++k) { const float2 l = Ls[pp * 16 + tsel + 2 * k]; a8[k] += zr * l.x - zi * l.y; }
      }
#pragma unroll
      for (int k = 0; k < 8; ++k) KT[(((size_t)lg * 32 + th * 16 + tsel + 2 * k) * 16 + co) * 16 + ci] = a8[k];
      __syncthreads();
    }
  }
  u16* W1 = (u16*)(p.ws + WS_W1T);
  for (int i8 = gtid; i8 < (1 << 20); i8 += nth) {
    const int i = i8 << 3;
    const int k = i & 511, n = (i >> 9) & 255, g = (i >> 17) & 31, layer = i >> 22;
    const int dir = n >> 7, pp = (n >> 1) & 63, ri = n & 1, sidx = k >> 4, ci0 = k & 15;
    const int e = dir ? sidx : 31 - sidx;
    const int lg = (layer * 2 + dir) * 32 + g;
    const float2 l = LP[(size_t)(lg * 64 + pp) * 33 + e];
    const float2* b = BB + (size_t)(lg * 64 + pp) * 16 + ci0;
    float v[8];
#pragma unroll
    for (int q = 0; q < 8; ++q) { const float2 bq = b[q]; v[q] = ri ? (l.x * bq.y + l.y * bq.x) : (l.x * bq.x - l.y * bq.y); }
    u32x4 o;
    o[0] = pk2(v[0], v[1]); o[1] = pk2(v[2], v[3]); o[2] = pk2(v[4], v[5]); o[3] = pk2(v[6], v[7]);
    *(u32x4*)(W1 + i) = o;
  }
  u16* WY = (u16*)(p.ws + WS_WYT);
  for (int i8 = gtid; i8 < (1 << 20); i8 += nth) {
    const int i = i8 << 3;
    const int kk = i & 255, n = (i >> 8) & 511, g = (i >> 17) & 31, layer = i >> 22;
    const int t = n >> 4, co = n & 15, dir = kk >> 7, pp0 = (kk >> 1) & 63;
    const int e = dir ? 32 - t : t + 1;
    const int lg = (layer * 2 + dir) * 32 + g;
    float v[8];
#pragma unroll
    for (int q = 0; q < 4; ++q) {
      const float cr = cre[(size_t)(lg * 16 + co) * 64 + pp0 + q], cI = cim[(size_t)(lg * 16 + co) * 64 + pp0 + q];
      const float2 l = LP[(size_t)(lg * 64 + pp0 + q) * 33 + e];
      v[2 * q] = cr * l.x - cI * l.y;
      v[2 * q + 1] = -(cr * l.y + cI * l.x);
    }
    u32x4 o;
    o[0] = pk2(v[0], v[1]); o[1] = pk2(v[2], v[3]); o[2] = pk2(v[4], v[5]); o[3] = pk2(v[6], v[7]);
    *(u32x4*)(WY + ((size_t)((layer * 32 + g) * 512 + n)) * ASTR + 512 + kk) = o;
  }
}

DI void phase_prep_c(const P& p) {
  const int TID = opaque_tid();
#if PROBE_MASK & 64
  {
    u32x4* dst = (u32x4*)(p.ws + WS_FF);
    u32x4 z; z[0] = 1; z[1] = 2; z[2] = 3; z[3] = 4;
    for (unsigned i = blockIdx.x * 512 + TID; i < 640u * 65536u; i += gridDim.x * 512) { z[0] = i * 2654435761u; z[1] = z[0] ^ (i << 7); z[2] = z[1] * 40503u + i; z[3] = z[2] ^ z[0]; dst[i] = z; }
  }
#endif
  const int gtid = blockIdx.x * 512 + TID, nth = gridDim.x * 512;
  const float* KT = (const float*)(p.ws + WS_KTAB);
  u16* WY = (u16*)(p.ws + WS_WYT);
  for (int i = gtid; i < (1 << 21); i += nth) {
    int k8 = i & 63, n = (i >> 6) & 511, g = (i >> 15) & 31, layer = i >> 20;
    int t = n >> 4, co = n & 15, s = k8 >> 1, ci0 = (k8 & 1) * 8;
    int tau = t - s;
    float v[8];
    if (tau > 0) {
      const float* q = KT + ((((size_t)(layer * 2 + 0) * 32 + g) * 32 + tau) * 16 + co) * 16 + ci0;
#pragma unroll
      for (int j = 0; j < 8; ++j) v[j] = q[j];
    } else if (tau < 0) {
      const float* q = KT + ((((size_t)(layer * 2 + 1) * 32 + g) * 32 - tau) * 16 + co) * 16 + ci0;
#pragma unroll
      for (int j = 0; j < 8; ++j) v[j] = q[j];
    } else {
      const float* q0 = KT + ((((size_t)(layer * 2 + 0) * 32 + g) * 32) * 16 + co) * 16 + ci0;
      const float* q1 = KT + ((((size_t)(layer * 2 + 1) * 32 + g) * 32) * 16 + co) * 16 + ci0;
#pragma unroll
      for (int j = 0; j < 8; ++j) v[j] = q0[j] + q1[j];
    }
    u32x4 o;
    o[0] = pk2(v[0], v[1]); o[1] = pk2(v[2], v[3]); o[2] = pk2(v[4], v[5]); o[3] = pk2(v[6], v[7]);
    *(u32x4*)(WY + ((size_t)((layer * 32 + g) * 512 + n)) * ASTR + k8 * 8) = o;
  }
}

DI const float* xrow(const P& p, int layer, int tok) {
  if (layer == 0) return tok < NTP ? p.in[0] + (size_t)tok * 1024 : p.in[1] + (size_t)(tok - NTP) * 1024;
  return p.out + (size_t)tok * 1024;
}
DI void phase_convert(const P& p, const float* __restrict__ src0, const float* __restrict__ src1) {
  const int TID = opaque_tid();
  const int lane = TID & 63, wave = TID >> 6;
  u16* XN = (u16*)(p.ws + WS_XN);
  float* SSQ = (float*)(p.ws + WS_SSQ);
  for (int tok = blockIdx.x * 8 + wave; tok < NT; tok += gridDim.x * 8) {
    const float* x = tok < NTP ? src0 + (size_t)tok * 1024 : src1 + (size_t)(tok - NTP) * 1024;
    float4 v[4];
    float ss = 0.f;
#pragma unroll
    for (int i = 0; i < 4; ++i) {
      v[i] = *(const float4*)(x + i * 256 + lane * 4);
      ss += v[i].x * v[i].x + v[i].y * v[i].y + v[i].z * v[i].z + v[i].w * v[i].w;
    }
#pragma unroll
    for (int o = 32; o >= 1; o >>= 1) ss += __shfl_xor(ss, o);
    if (lane < 4) SSQ[(size_t)lane * NT + tok] = lane == 0 ? ss : 0.f;
#pragma unroll
    for (int i = 0; i < 4; ++i) {
      u32x2 o;
      o[0] = pk2(v[i].x, v[i].y);
      o[1] = pk2(v[i].z, v[i].w);
      *(u32x2*)(XN + (size_t)tok * 1024 + i * 256 + lane * 4) = o;
    }
  }
}

DI void phase_scan(const P& p, int layer) {
  const int TID = opaque_tid();
  const int gtid = blockIdx.x * 512 + TID, nth = gridDim.x * 512;
  const float2* LP = (const float2*)(p.ws + WS_LPOW);
  for (int i = gtid; i < 18 * 4096; i += nth) {
    int pp = i & 63, dir = (i >> 6) & 1, g = (i >> 7) & 31, seq = i >> 12;
    int c0 = seq < 16 ? seq * 128 : 2048 + (seq - 16) * 256;
    int nc = seq < 16 ? 128 : 256;
    float2 a = LP[(size_t)(((layer * 2 + dir) * 32 + g) * 64 + pp) * 33 + 32];
    const float2* S = (const float2*)(p.ws + WS_S) + ((size_t)(g * NCH + c0) * 256 + dir * 128 + pp * 2) / 2;
    unsigned* H = (unsigned*)((u16*)(p.ws + WS_ASSM) + (size_t)(g * NCH + c0) * ASTR + 512 + dir * 128 + pp * 2);
    float hr = 0.f, hi = 0.f;
    for (int cb = 0; cb < nc; cb += 16) {
      float2 sv[16];
#pragma unroll
      for (int k = 0; k < 16; ++k) {
        const int c = dir == 0 ? cb + k : nc - 1 - cb - k;
        sv[k] = S[(size_t)c * 128];
      }
#pragma unroll
      for (int k = 0; k < 16; ++k) {
        const int c = dir == 0 ? cb + k : nc - 1 - cb - k;
        H[(size_t)c * (ASTR / 2)] = pk2(hr, hi);
        const float nr = a.x * hr - a.y * hi + sv[k].x;
        hi = a.x * hi + a.y * hr + sv[k].y;
        hr = nr;
      }
    }
  }
}

#define MFMA32(a, b, c) __builtin_amdgcn_mfma_f32_32x32x16_bf16((a), (b), (c), 0, 0, 0)
DI void attn_item(const P& pin, int layer, int seq_start, int L, int head, int qb) {
  const int TID = opaque_tid();
  struct { unsigned char* ws; } p;
  p.ws = pin.ws;
  asm volatile("" : "+s"(p.ws));
  extern __shared__ __attribute__((aligned(16))) unsigned char smem[];
  const u16* Q = (const u16*)(p.ws + WS_Q);
  const u16* KB = (const u16*)(p.ws + WS_K);
  const u16* VT = (const u16*)(p.ws + WS_VT);
  const int tid = TID, wave = tid >> 6, lane = tid & 63, r = lane & 31, h = lane >> 5;
  const int kvh = head >> 2;
  const int q0 = seq_start + qb * 512 + wave * 64;
  bf16x8 qf[2][4];
#pragma unroll
  for (int nt = 0; nt < 2; ++nt)
#pragma unroll
    for (int ds = 0; ds < 4; ++ds)
      qf[nt][ds] = gld<bf16x8>(Q + (size_t)(q0 + nt * 32 + r) * 1024 + head * 64 + ds * 16 + h * 8);
#pragma unroll
  for (int nt = 0; nt < 2; ++nt)
#pragma unroll
    for (int ds = 0; ds < 4; ++ds) asm volatile("" ::"v"(qf[nt][ds]));
  bool no_check;
  {
    float gq = fabsf(pin.in[4][layer * 64 + lane]), gk = fabsf(pin.in[5][layer * 64 + lane]);
#pragma unroll
    for (int o = 32; o >= 1; o >>= 1) { gq = fmaxf(gq, __shfl_xor(gq, o)); gk = fmaxf(gk, __shfl_xor(gk, o)); }
    no_check = __builtin_amdgcn_readfirstlane(11.5416f * 1.01f * gq * gk <= 15.5f ? 1 : 0) != 0;
  }
  const int srow = tid >> 3, spos = tid & 7, scc = spos ^ ((srow >> 1) & 7);
  const u16* kg = KB + ((size_t)kvh * NT + seq_start + srow) * 64 + scc * 8;
  const u16* vg = VT + (size_t)(kvh * 64 + srow) * NT + seq_start + scc * 8;
  unsigned char* ldst = smem + tid * 16;
  const int nkt = L >> 6;
  const int pr = ((r >> 4) * 16) + (((r >> 2) & 1) * 8) + (((r >> 3) & 1) * 4) + (r & 3);
  int koff[4];
#pragma unroll
  for (int ds = 0; ds < 4; ++ds) koff[ds] = pr * 128 + (((ds * 2 + h) ^ ((pr >> 1) & 7)) << 4);
  const int vxh = ((r >> 1) & 7) >> 1;
  const int vbase = 8192 + r * 128 + ((h ^ ((r >> 1) & 1)) << 4);

  f32x16 o[2][2];
#pragma unroll
  for (int a = 0; a < 2; ++a)
#pragma unroll
    for (int b = 0; b < 2; ++b)
#pragma unroll
      for (int j = 0; j < 16; ++j) o[a][b][j] = 0.f;
  float mrun[2] = {0.f, 0.f}, lrun[2] = {0.f, 0.f};


#define ATT_STAGE(T, B) do { GLDS(kg + (size_t)(T) * 128 * 64, ldst + (B) * 32768); GLDS(vg + (T) * 128, ldst + (B) * 32768 + 8192); \
    GLDS(kg + (size_t)(T) * 128 * 64 + 64 * 64, ldst + (B) * 32768 + 16384); GLDS(vg + (T) * 128 + 64, ldst + (B) * 32768 + 16384 + 8192); } while (0)
  const int nst = nkt >> 1;
  ATT_STAGE(0, 0);
  ATT_STAGE(1, 1);
  int bcur = 0;
  for (int st = 0; st < nst; ++st) {
    if (st + 1 < nst) { WAIT_V(4); } else { WAIT_V(0); }
    BAR;
    if (st + 2 < nst) {
      int bn = bcur + 2; if (bn >= 3) bn -= 3;
      ATT_STAGE(st + 2, bn);
    }
    const unsigned char* sbase = smem + bcur * 32768;
    auto qk = [&](const int hx, f32x16 (&sc)[2]) {
      const unsigned char* kb = sbase + (hx >> 1) * 16384 + (hx & 1) * 4096;
      bf16x8 kf[4];
#pragma unroll
      for (int ds = 0; ds < 4; ++ds) kf[ds] = *(const bf16x8*)(kb + koff[ds]);
      if (no_check) {
        f32x16 z16;
#pragma unroll
        for (int j = 0; j < 16; ++j) z16[j] = 0.f;
#pragma unroll
        for (int nt = 0; nt < 2; ++nt) sc[nt] = MFMA32(kf[0], qf[nt][0], z16);
      } else {
#pragma unroll
        for (int nt = 0; nt < 2; ++nt) {
#pragma unroll
          for (int j = 0; j < 16; ++j) sc[nt][j] = -mrun[nt];
          sc[nt] = MFMA32(kf[0], qf[nt][0], sc[nt]);
        }
      }
#pragma unroll
      for (int ds = 1; ds < 4; ++ds)
#pragma unroll
        for (int nt = 0; nt < 2; ++nt) sc[nt] = MFMA32(kf[ds], qf[nt][ds], sc[nt]);
    };
    auto sm_pv = [&](const int hx, f32x16 (&sc)[2], f32x16 (&pend)[2], const bool has_pend) {
      const bool chk = !no_check;
      const unsigned char* kb = sbase + (hx >> 1) * 16384;
      const int kt = hx & 1;
      bf16x8 vf[2][2];
#pragma unroll
      for (int s2 = 0; s2 < 2; ++s2)
#pragma unroll
        for (int mt = 0; mt < 2; ++mt) vf[s2][mt] = *(const bf16x8*)(kb + vbase + (((kt * 2 + s2) ^ vxh) << 5) + mt * 4096);
      float mx[2] = {0.f, 0.f};
      if (chk) {
#pragma unroll
        for (int nt = 0; nt < 2; ++nt) {
          float m0 = sc[nt][0];
#pragma unroll
          for (int j = 1; j < 16; ++j) m0 = fmaxf(m0, sc[nt][j]);
          mx[nt] = m0;
        }
      }
      if (chk && __any((fabsf(mx[0]) > 16.0f) | (fabsf(mx[1]) > 16.0f))) {
#pragma unroll
        for (int nt = 0; nt < 2; ++nt) {
          const float mp = fmaxf(mx[nt], __shfl_xor(mx[nt], 32));
          const float dm = (fabsf(mp) > 12.0f) ? mp : 0.0f;
          const float alpha = __builtin_amdgcn_exp2f(-dm);
          mrun[nt] += dm;
          lrun[nt] *= alpha;
#pragma unroll
          for (int j = 0; j < 16; ++j) sc[nt][j] -= dm;
          if (has_pend) {
#pragma unroll
            for (int j = 0; j < 16; ++j) pend[nt][j] -= dm;
          }
#pragma unroll
          for (int mt = 0; mt < 2; ++mt)
#pragma unroll
            for (int j = 0; j < 16; ++j) o[mt][nt][j] *= alpha;
        }
      }
#pragma unroll
      for (int nt = 0; nt < 2; ++nt) {
        float sum = 0.f;
#pragma unroll
        for (int j = 0; j < 16; ++j) { float pv = __builtin_amdgcn_exp2f(sc[nt][j]); sc[nt][j] = pv; sum += pv; }
        lrun[nt] += sum;
      }
#pragma unroll
      for (int s2 = 0; s2 < 2; ++s2) {
        bf16x8 pf[2];
#pragma unroll
        for (int nt = 0; nt < 2; ++nt) {
          u32x4 pk;
#pragma unroll
          for (int i = 0; i < 4; ++i) pk[i] = pk2(sc[nt][s2 * 8 + 2 * i], sc[nt][s2 * 8 + 2 * i + 1]);
          pf[nt] = __builtin_bit_cast(bf16x8, pk);
        }
#pragma unroll
        for (int mt = 0; mt < 2; ++mt)
#pragma unroll
          for (int nt = 0; nt < 2; ++nt) o[mt][nt] = MFMA32(vf[s2][mt], pf[nt], o[mt][nt]);
      }
    };
    f32x16 sa[2], sb[2];
    qk(0, sa);
    qk(1, sb); sm_pv(0, sa, sb, true);
    qk(2, sa); sm_pv(1, sb, sa, true);
    qk(3, sb); sm_pv(2, sa, sb, true);
    sm_pv(3, sb, sa, false);
    bcur = bcur + 1; if (bcur >= 3) bcur = 0;
  }
  unsigned char* ws2 = pin.ws;
  asm volatile("" : "+s"(ws2));
  u16* O = (u16*)(ws2 + WS_ATTO);
  const int tid2 = opaque_tid();
  const int r2 = tid2 & 31, h2 = (tid2 >> 5) & 1;
  const int q0b = seq_start + qb * 512 + (tid2 >> 6) * 64;
#pragma unroll
  for (int nt = 0; nt < 2; ++nt) {
    float l = lrun[nt] + __shfl_xor(lrun[nt], 32);
    float inv = 1.0f / l;
    const int tok = q0b + nt * 32 + r2;
#pragma unroll
    for (int mt = 0; mt < 2; ++mt)
#pragma unroll
      for (int jg = 0; jg < 4; ++jg) {
        u32x2 ov;
        ov[0] = pk2(o[mt][nt][jg * 4 + 0] * inv, o[mt][nt][jg * 4 + 1] * inv);
        ov[1] = pk2(o[mt][nt][jg * 4 + 2] * inv, o[mt][nt][jg * 4 + 3] * inv);
        gst<u32x2>(O + (size_t)tok * 1024 + head * 64 + mt * 32 + jg * 8 + h2 * 4, ov);
      }
  }
  WAIT_L(0);
  BAR;
}


enum { EK_Q = 0, EK_K, EK_V, EK_U, EK_S, EK_Y, EK_M0, EK_M1, EK_M2, EK_M3, EK_M4, EK_OUT, EK_FF1, EK_FF2 };
struct Job {
  const u16* A; const u16* Bt;
  int lda, ldb, gsB, tmB, K, kind, tm, tn, layer;
};

DI void stage_acc(AccT& acc, unsigned char* smem, const int tid, const int linear = 0) {
  const int wid = tid >> 6, lane = tid & 63, wr = wid >> 2, wc = wid & 3, fr = lane & 15, fq = lane >> 4;
#if PROBE_MASK
  if (linear) {
    int k = 0;
#pragma unroll
    for (int ai = 0; ai < 2; ++ai)
#pragma unroll
      for (int bj = 0; bj < 2; ++bj)
#pragma unroll
        for (int m = 0; m < 4; ++m)
#pragma unroll
          for (int n = 0; n < 2; ++n) {
            u32x2 w;
            w[0] = pk2(acc[ai][bj][m][n][0], acc[ai][bj][m][n][1]);
            w[1] = pk2(acc[ai][bj][m][n][2], acc[ai][bj][m][n][3]);
            *(u32x2*)(smem + tid * 8 + k * 4096) = w;
            ++k;
          }
    return;
  }
#endif
#pragma unroll
  for (int ai = 0; ai < 2; ++ai)
#pragma unroll
    for (int bj = 0; bj < 2; ++bj)
#pragma unroll
      for (int m = 0; m < 4; ++m)
#pragma unroll
        for (int n = 0; n < 2; ++n) {
          const int col = bj * 128 + wc * 32 + n * 16 + fr;
          const int row0 = ai * 128 + wr * 64 + m * 16 + fq * 4;
          u32x2 w;
          w[0] = pk2(acc[ai][bj][m][n][0], acc[ai][bj][m][n][1]);
          w[1] = pk2(acc[ai][bj][m][n][2], acc[ai][bj][m][n][3]);
          *(u32x2*)(smem + col * 512 + (((row0 >> 3) ^ (col & 31)) << 4) + ((row0 & 4) << 1)) = w;
        }
}
DI void unpack8(const u32x4 u, float* f) {
#pragma unroll
  for (int i = 0; i < 4; ++i) { f[2 * i] = __uint_as_float(u[i] << 16); f[2 * i + 1] = __uint_as_float(u[i] & 0xffff0000u); }
}
DI u32x4 pack8(const float* f) {
  u32x4 o;
#pragma unroll
  for (int i = 0; i < 4; ++i) o[i] = pk2(f[2 * i], f[2 * i + 1]);
  return o;
}

DI float bflo(unsigned u) { return __uint_as_float(u << 16); }
DI float bfhi(unsigned u) { return __uint_as_float(u & 0xffff0000u); }
DI float tok_rstd(const unsigned char* ws, int tok) {
  const float* q = (const float*)(ws + WS_SSQ) + tok;
  return rsqrtf((q[0] + q[NT] + q[2 * NT] + q[3 * (size_t)NT]) * (1.0f / 1024.0f) + 1e-6f);
}
DI void run_epilogue(const P& pin, const Job& jb, AccT& acc) {
  extern __shared__ __attribute__((aligned(16))) unsigned char smem[];
  const int TID = opaque_tid();
  P p = pin;
  asm volatile("" : "+s"(p.ws), "+s"(p.out));
  const int tm = jb.tm, tn = jb.tn, layer = jb.layer & 255, kind = jb.kind;
  const int nit = (jb.layer & 256) ? 8 : (jb.layer & 512) ? 1 : (jb.layer & 1024) ? 0 : 16;
#if PROBE_MASK
  if (kind == -1) return;
  if (kind == -3) {
    u32x4 z; z[0] = acc[0][0][0][0][0] > 1e30f ? 1u : 0u; z[1] = 2; z[2] = 3; z[3] = 4;
    for (int it = 0; it < 16; ++it) {
      const int q = it * 512 + TID;
      *(u32x4*)((u16*)(p.ws + WS_FF) + (size_t)(tn * 256 + (q >> 5)) * 4096 + tm * 256 + (q & 31) * 8) = z;
    }
    return;
  }
#endif
  if (kind == EK_S) {
    stage_acc(acc, smem, TID);
    __syncthreads();
    const int g = tn / 10, ct = tn % 10;
    const int pp = TID & 63, dir = (TID >> 6) & 1, sq = TID >> 7;
    const int nseq = ct < 8 ? 2 : 1, nc = ct < 8 ? 128 : 256;
    if (sq < nseq) {
      const float2 a = ((const float2*)(p.ws + WS_LPOW))[(size_t)(((layer * 2 + dir) * 32 + g) * 64 + pp) * 33 + 32];
      const int n = dir * 128 + pp * 2;
      unsigned* H = (unsigned*)((u16*)(p.ws + WS_ASSM) + ((size_t)g * NCH + ct * 256 + sq * nc) * ASTR + 512 + n);
      float hr = 0.f, hi = 0.f;
#pragma unroll 8
      for (int k = 0; k < nc; ++k) {
        const int c = dir == 0 ? k : nc - 1 - k;
        const int col = sq * nc + c;
        gst<unsigned>(H + (size_t)c * (ASTR / 2), pk2(hr, hi));
        const unsigned sv = *(const unsigned*)(smem + col * 512 + (((n >> 3) ^ (col & 31)) << 4) + (n & 7) * 2);
        const float nr = a.x * hr - a.y * hi + bflo(sv);
        hi = a.x * hi + a.y * hr + bfhi(sv);
        hr = nr;
      }
    }
    __syncthreads();
    return;
  }
#if PROBE_MASK
  if (jb.layer & 16384) { if (acc[1][1][3][1][3] == 12345.678f) smem[TID] = 1; }
  if (!(jb.layer & 2048))
  for (int rep = (jb.layer & 8192) ? 4 : 1; rep > 0; --rep)
#endif
  stage_acc(acc, smem, TID, (jb.layer & 4096) ? 1 : 0);
  float* lrs = (float*)(smem + 131072);
  if ((kind <= EK_U || kind == EK_M2 || kind == EK_M3 || kind == EK_FF1) && TID < 256) lrs[TID] = tok_rstd(p.ws, tn * 256 + TID);
  __syncthreads();
  const bool two_pass = kind == EK_Q || kind == EK_K || kind == EK_Y || kind == EK_M1 || kind == EK_M2 || kind == EK_M4;
  if (two_pass) {
    auto slot_of = [&](const int it, int& col, int& c) -> unsigned char* {
      const int q = it * 512 + TID;
      col = q >> 5; c = q & 31;
      return smem + col * 512 + ((c ^ (col & 31)) << 4);
    };
    if (kind == EK_M1 || kind == EK_M2 || kind == EK_M4) {
      const u16* T1 = (const u16*)(p.ws + WS_Q) + (size_t)(tn * 256) * 1024 + tm * 256;
      const u16* T2 = (const u16*)(p.ws + WS_ASSM) + (size_t)(tn * 256) * 1024 + tm * 256;
      if (kind == EK_M1) {
#pragma unroll 8
        for (int it = 0; it < 16; ++it) {
          int col, c; unsigned char* sl = slot_of(it, col, c);
          float f[8], a[8], r[8];
          unpack8(gld<u32x4>(T1 + (size_t)col * 1024 + c * 8), a);
          unpack8(*(const u32x4*)sl, f);
#pragma unroll
          for (int i = 0; i < 8; ++i) r[i] = f[i] * a[i];
          *(u32x4*)sl = pack8(r);
        }
      } else if (kind == EK_M2) {
#pragma unroll 8
        for (int it = 0; it < 16; ++it) {
          int col, c; unsigned char* sl = slot_of(it, col, c);
          float f[8], a[8], r[8];
          unpack8(gld<u32x4>(T1 + (size_t)col * 1024 + c * 8), a);
          unpack8(*(const u32x4*)sl, f);
          const float tr = lrs[col];
#pragma unroll
          for (int i = 0; i < 8; ++i) r[i] = sigmoidf_(f[i] * tr) * a[i];
          *(u32x4*)sl = pack8(r);
        }
      } else {
#pragma unroll 8
        for (int it = 0; it < 16; ++it) {
          int col, c; unsigned char* sl = slot_of(it, col, c);
          float f[8], a[8], b[8], r[8];
          unpack8(gld<u32x4>(T1 + (size_t)col * 1024 + c * 8), a);
          unpack8(gld<u32x4>(T2 + (size_t)col * 1024 + c * 8), b);
          unpack8(*(const u32x4*)sl, f);
#pragma unroll
          for (int i = 0; i < 8; ++i) r[i] = b[i] * f[i] + a[i];
          *(u32x4*)sl = pack8(r);
        }
      }
    } else if (kind == EK_Y) {
      const int g = tn / 10, ch0 = (tn % 10) * 256;
      const float* dsk = p.in[14] + layer * 512 + g * 16 + (TID & 1) * 8;
      const f32x4 d0 = *(const f32x4*)dsk, d1 = *(const f32x4*)(dsk + 4);
      const u16* UU = (const u16*)(p.ws + WS_ASSM) + ((size_t)g * NCH + ch0) * ASTR + tm * 256;
#pragma unroll 8
      for (int it = 0; it < 16; ++it) {
        int col, c; unsigned char* sl = slot_of(it, col, c);
        float f[8], u[8], r[8];
        unpack8(gld<u32x4>(UU + (size_t)col * ASTR + c * 8), u);
        unpack8(*(const u32x4*)sl, f);
#pragma unroll
        for (int i = 0; i < 4; ++i) { r[i] = gelu_tanh(f[i] + d0[i] * u[i]); r[4 + i] = gelu_tanh(f[4 + i] + d1[i] * u[4 + i]); }
        *(u32x4*)sl = pack8(r);
      }
    } else {
      const float* gn = (kind == EK_Q ? p.in[4] : p.in[5]) + layer * 64 + (TID & 7) * 8;
      const f32x4 g0 = *(const f32x4*)gn, g1 = *(const f32x4*)(gn + 4);
      const float qs = (kind == EK_Q) ? 0.125f * 1.4426950408889634f : 1.0f;
      const int i0 = (TID & 7) * 4;
#pragma unroll 4
      for (int it = 0; it < 16; ++it) {
        int col, c; unsigned char* sl = slot_of(it, col, c);
        const int tok = tn * 256 + col;
        const int pos = tok < NTP ? (tok & 4095) : ((tok - NTP) & 8191);
        const float* rp = (const float*)(p.ws + WS_ROPE) + 2 * ((i0 < 16) ? (pos >> 6) * 16 + i0 : (pos & 63) * 16 + i0 - 16);
        const f32x4 cs0 = gld<f32x4>(rp), cs1 = gld<f32x4>(rp + 4);
        float f[8], r[8];
        unpack8(*(const u32x4*)sl, f);
        const float tr = lrs[col];
        float ss = 0.f;
#pragma unroll
        for (int i = 0; i < 8; ++i) { f[i] *= tr; ss += f[i] * f[i]; }
        ss += __shfl_xor(ss, 1); ss += __shfl_xor(ss, 2); ss += __shfl_xor(ss, 4);
        const float rstd = rsqrtf(ss * (1.0f / 64.0f) + 1e-6f) * qs;
        const float x0 = f[0] * rstd * g0[0], x1 = f[1] * rstd * g0[1], x2 = f[2] * rstd * g0[2], x3 = f[3] * rstd * g0[3];
        const float x4 = f[4] * rstd * g1[0], x5 = f[5] * rstd * g1[1], x6 = f[6] * rstd * g1[2], x7 = f[7] * rstd * g1[3];
        r[0] = x0 * cs0[0] - x1 * cs0[1]; r[1] = x0 * cs0[1] + x1 * cs0[0];
        r[2] = x2 * cs0[2] - x3 * cs0[3]; r[3] = x2 * cs0[3] + x3 * cs0[2];
        r[4] = x4 * cs1[0] - x5 * cs1[1]; r[5] = x4 * cs1[1] + x5 * cs1[0];
        r[6] = x6 * cs1[2] - x7 * cs1[3]; r[7] = x6 * cs1[3] + x7 * cs1[2];
        *(u32x4*)sl = pack8(r);
      }
    }
#pragma unroll 4
    for (int it = 0; it < 16; ++it) {
      int col, c; unsigned char* sl = slot_of(it, col, c);
      const u32x4 v = *(const u32x4*)sl;
      u16* dst;
      if (kind == EK_Q) dst = (u16*)(p.ws + WS_Q) + (size_t)(tn * 256 + col) * 1024 + (tm * 4 + (c >> 3)) * 64 + (c & 7) * 8;
      else if (kind == EK_K) dst = (u16*)(p.ws + WS_K) + ((size_t)(c >> 3) * NT + tn * 256 + col) * 64 + (c & 7) * 8;
      else if (kind == EK_Y) dst = (u16*)(p.ws + WS_Y) + (size_t)(tn / 10) * NT * 16 + (size_t)((tn % 10) * 256 + col) * 512 + tm * 256 + c * 8;
      else dst = (u16*)(p.ws + WS_Q) + (size_t)(tn * 256 + col) * 1024 + tm * 256 + c * 8;
      gst<u32x4>(dst, v);
    }
    __syncthreads();
    return;
  }
  if (kind == EK_OUT || kind == EK_FF2) {
    const int cc = tm * 256 + (TID & 31) * 8;
#pragma unroll 1
    for (int it0 = 0; it0 < 16; it0 += 4) {
      f32x4 X0[4], X1[4];
#pragma unroll
      for (int k = 0; k < 4; ++k) {
        const int tok = tn * 256 + (((it0 + k) * 512 + TID) >> 5);
        const float* x = (kind == EK_OUT) ? xrow(p, layer, tok) + cc : p.out + (size_t)tok * 1024 + cc;
        X0[k] = gld<f32x4>(x); X1[k] = gld<f32x4>(x + 4);
      }
#pragma unroll
      for (int k = 0; k < 4; ++k) {
        const int q = (it0 + k) * 512 + TID;
        const int col = q >> 5, c = q & 31;
        const int tok = tn * 256 + col;
        float f[8], r[8];
        unpack8(*(const u32x4*)(smem + col * 512 + ((c ^ (col & 31)) << 4)), f);
        float* o = p.out + (size_t)tok * 1024 + cc;
        f32x4 o0, o1;
        float ss = 0.f;
#pragma unroll
        for (int i = 0; i < 4; ++i) { o0[i] = X0[k][i] + f[i]; o1[i] = X1[k][i] + f[4 + i]; r[i] = o0[i]; r[4 + i] = o1[i]; ss += o0[i] * o0[i] + o1[i] * o1[i]; }
        gst<f32x4>(o, o0); gst<f32x4>(o + 4, o1);
        gst<u32x4>((u16*)(p.ws + WS_XN) + (size_t)tok * 1024 + cc, pack8(r));
        ss += __shfl_xor(ss, 1); ss += __shfl_xor(ss, 2); ss += __shfl_xor(ss, 4); ss += __shfl_xor(ss, 8); ss += __shfl_xor(ss, 16);
        if (c == 0) ((float*)(p.ws + WS_SSQ))[(size_t)tm * NT + tok] = ss;
      }
    }
    __syncthreads();
    return;
  }
#pragma unroll 2
  for (int it = 0; it < nit; ++it) {
    const int q = it * 512 + TID;
    int col = q >> 5, c = q & 31;
    if (kind == EK_U) { col = (q >> 1) & 255; c = ((q >> 9) << 1) | (q & 1); }
    const u32x4 sv = *(const u32x4*)(smem + col * 512 + ((c ^ (col & 31)) << 4));
    float f[8], r[8];
    unpack8(sv, f);
#if PROBE_MASK
    if (kind == -2) { if (f[0] > 1e30f) *(u32x4*)(p.ws + WS_FF) = sv; continue; }
#endif
    switch (kind) {
      case EK_V: {
        {
          const int tok0 = tn * 256 + c * 8;
#pragma unroll
          for (int i = 0; i < 8; ++i) r[i] = f[i] * lrs[c * 8 + i];
          gst<u32x4>((u16*)(p.ws + WS_VT) + (size_t)col * NT + tok0, pack8(r));
        }
      } break;
      case EK_U: {
        const int tok = tn * 256 + col, g = (tm - 6) * 16 + (c >> 1);
        const float tr = lrs[col];
#pragma unroll
        for (int i = 0; i < 8; ++i) r[i] = f[i] * tr;
        gst<u32x4>((u16*)(p.ws + WS_ASSM) + ((size_t)g * NCH + (tok >> 5)) * ASTR + (tok & 31) * 16 + (c & 1) * 8, pack8(r));
      } break;
      case EK_M0: case EK_M3: {
        const size_t o = (size_t)(tn * 256 + col) * 1024 + tm * 256 + c * 8;
        const float tr = (kind == EK_M3) ? lrs[col] : 1.0f;
#pragma unroll
        for (int i = 0; i < 8; ++i) r[i] = sigmoidf_(f[i] * tr);
        gst<u32x4>((kind == EK_M3 ? (u16*)(p.ws + WS_ASSM) : (u16*)(p.ws + WS_Q)) + o, pack8(r));
      } break;
      case EK_FF1: {
        const float tr = lrs[col];
#pragma unroll
        for (int i = 0; i < 8; ++i) { const float a = fmaxf(f[i] * tr, 0.f); r[i] = a * a; }
        gst<u32x4>((u16*)(p.ws + WS_FF) + ((size_t)(tn * 16 + tm) << 16) + col * 256 + c * 8, pack8(r));
      } break;
    }
  }
  __syncthreads();
}

DI void make_job(const P& pin, int layer, int s, int w, int step, Job& jb) {
  struct { unsigned char* ws; } p;
  p.ws = pin.ws;
  asm volatile("" : "+s"(p.ws));
  const u16* XN = (const u16*)(p.ws + WS_XN);
  jb.layer = layer; jb.gsB = 16; jb.tmB = 0;
  if (s == 1) {
    int g = w / 10;
    jb.A = (const u16*)(p.ws + WS_W1T) + ((size_t)layer * 32 + g) * 256 * 512;
    jb.Bt = (const u16*)(p.ws + WS_ASSM) + (size_t)w * 256 * ASTR;
    jb.lda = 512; jb.ldb = ASTR; jb.K = 512; jb.kind = EK_S; jb.tm = 0; jb.tn = w;
    return;
  }
  if (s == 3) {
    int gc = w >> 1, rt = w & 1, g = gc / 10;
    jb.A = (const u16*)(p.ws + WS_WYT) + (((size_t)layer * 32 + g) * 512 + rt * 256) * ASTR;
    jb.Bt = (const u16*)(p.ws + WS_ASSM) + (size_t)gc * 256 * ASTR;
    jb.lda = ASTR; jb.ldb = ASTR; jb.K = ASTR; jb.kind = EK_Y; jb.tm = rt; jb.tn = gc;
    return;
  }
  const int nft = (s == 0) ? 8 : (s == 6) ? 16 : 4;
  int tt, ft; tile_map(w, nft, tt, ft);
  if (s == 6) {
    const int xcd = w & 7, r = w >> 3, blk = r >> 5, i = r & 31;
    ft = (blk & 1) * 8 + (i & 7);
    tt = ((blk >> 1) * 4 + (i >> 3)) * 8 + xcd;
  }
  jb.tm = ft; jb.tn = tt;
  jb.lda = 1024; jb.ldb = 1024; jb.K = 1024;
  if (s == 0) {
    const u16* W = (const u16*)(p.ws + WS_WT_IN) + (size_t)layer * 4096 * 1024 + (size_t)ft * 256 * 1024;
    const u16* X = XN + (size_t)tt * 256 * 1024;
    if (ft == 5) { jb.A = X; jb.Bt = W; jb.kind = EK_V; }
    else { jb.A = W; jb.Bt = X; jb.kind = ft < 4 ? EK_Q : ft == 4 ? EK_K : EK_U; }
  } else if (s == 4) {
    jb.kind = EK_M0 + step;
    if (step < 2) {
      jb.A = (const u16*)(p.ws + (step == 0 ? WS_WT_GB : WS_WT_GA)) + (size_t)layer * 1024 * 512 + (size_t)ft * 256 * 512;
      jb.Bt = (const u16*)(p.ws + WS_Y) + (size_t)tt * 256 * 16;
      jb.lda = 512; jb.ldb = 16; jb.gsB = NT * 16; jb.K = 512;
    } else if (step < 4) {
      jb.A = (const u16*)(p.ws + WS_WT_IN) + (size_t)layer * 4096 * 1024 + (size_t)((step == 2 ? 3072 : 2048) + ft * 256) * 1024;
      jb.Bt = XN + (size_t)tt * 256 * 1024;
    } else {
      jb.A = (const u16*)(p.ws + WS_WT_AP) + (size_t)layer * 1024 * 1024 + (size_t)ft * 256 * 1024;
      jb.Bt = (const u16*)(p.ws + WS_ATTO) + (size_t)tt * 256 * 1024;
    }
  } else if (s == 5) {
    jb.A = (const u16*)(p.ws + WS_WT_OUT) + (size_t)layer * 1024 * 1024 + (size_t)ft * 256 * 1024;
    jb.Bt = (const u16*)(p.ws + WS_Q) + (size_t)tt * 256 * 1024; jb.kind = EK_OUT;
  } else if (s == 6) {
    jb.A = (const u16*)(p.ws + WS_WT_FF1) + (size_t)layer * 4096 * 1024 + (size_t)ft * 256 * 1024;
    jb.Bt = XN + (size_t)tt * 256 * 1024; jb.kind = EK_FF1;
  } else {
    jb.A = (const u16*)(p.ws + WS_WT_FF2) + (size_t)layer * 1024 * 4096 + (size_t)ft * 256 * 4096;
    jb.Bt = (const u16*)(p.ws + WS_FF) + ((size_t)tt * 16 << 16);
    jb.lda = 4096; jb.ldb = 256; jb.tmB = 1; jb.K = 4096; jb.kind = EK_FF2;
  }
}

DI void phase_jobs(const P& p, int layer, int s, int probe = 0) {
  int nitems, nsteps = 1, nattn = 0;
  switch (s) {
    case 0: nitems = 2560; break;
    case 1: nitems = 320; break;
    case 3: nitems = 3200; nattn = 2560; break;
    case 4: nitems = 1280; nsteps = 5; break;
    case 5: nitems = 1280; break;
    case 6: nitems = 5120; break;
    default: nitems = 1280; break;
  }
#if STAGGER_SLEEP
  if (s != 3) {
    const int slot = (blockIdx.x >> 3) & 31;
    for (int i = 0; i < slot; ++i) __builtin_amdgcn_s_sleep(STAGGER_SLEEP);
  }
#endif
  for (int w = blockIdx.x; w < nitems; w += gridDim.x) {
    if (w < nattn) {
      int seq_start, L, head, qb;
      if (w < 512) {
        int xcd = w & 7, r = w >> 3;
        int seq = xcd >> 2, kvh = xcd & 3;
        seq_start = NTP + seq * 8192; L = 8192; head = kvh * 4 + (r >> 4); qb = r & 15;
      } else {
        int w2 = w - 512, xcd = w2 & 7, r = w2 >> 3;
        int grp = (r >> 5) * 8 + xcd, within = r & 31;
        int seq = grp >> 2, kvh = grp & 3;
        seq_start = seq * 4096; L = 4096; head = kvh * 4 + (within >> 3); qb = within & 7;
      }
      attn_item(p, layer, seq_start, L, head, qb);
    } else {
      for (int step = 0; step < nsteps; ++step) {
        Job jb;
        make_job(p, layer, s, w - nattn, step, jb);
#if PROBE_MASK
        if (probe == 2 || probe == 3) jb.kind = -1;
        if (probe == 3) jb.K = jb.K / 2;
#endif
        gemm_tile(jb.A, jb.Bt, jb.lda, jb.ldb, jb.gsB, jb.tmB, jb.K, [&](AccT& acc) {
          int w2 = w - nattn, st2 = step;
          asm volatile("" : "+s"(w2), "+s"(st2));
          Job j2;
          make_job(p, layer, s, w2, st2, j2);
#if PROBE_MASK
          if (probe == 2 || probe == 3) j2.kind = -1;
          if (probe == 4) j2.kind = -2;
          if (probe == 6) j2.layer |= 256;
          if (probe == 7) j2.layer |= 512;
          if (probe == 8) j2.layer |= 1024 | 2048;
          if (probe == 9) j2.layer |= 1024;
          if (probe == 10) j2.layer |= 1024 | 4096;
          if (probe == 11) j2.layer |= 1024 | 8192;
          if (probe == 12) j2.layer |= 1024 | 2048 | 16384;
          if (probe == 5) j2.kind = -3;
#endif
          run_epilogue(p, j2, acc);
        });
      }
    }
  }
}

DI void run_phase(const P& pin, int ph, int probe = 0) {
  P p = pin;
  asm volatile("" : "+s"(p.ws), "+s"(p.out));
  int layer = (ph - 3) / 8, s = (ph - 3) % 8;
  if (s == 2) phase_scan(p, layer);
  else phase_jobs(p, layer, s, probe);
}

constexpr size_t WS_BAR = WS_ROPE + 512 * 1024;
#define XB_XCNT(j) (256 + 64 * (j))
#define XB_XSUB(j) (1280 + 64 * (j))
#define XB_XGEN(j) (2304 + 64 * (j))
#define XB_TOP 3328
#define XB_TOPGEN 3392
#define XB_WORDS 3456
DI unsigned xb_ld(unsigned* q) { return __hip_atomic_load(q, __ATOMIC_RELAXED, __HIP_MEMORY_SCOPE_AGENT); }
DI unsigned xb_add(unsigned* q, unsigned v) { return __hip_atomic_fetch_add(q, v, __ATOMIC_RELAXED, __HIP_MEMORY_SCOPE_AGENT); }
DI unsigned xb_xcc_id() { return (unsigned)__builtin_amdgcn_s_getreg((3 << 11) | 20) & 0xFu; }
#define XB_SPIN(cond) do { unsigned _sp = 0; while ((cond) && ++_sp < (1u << 22)) __builtin_amdgcn_s_sleep(1); } while (0)
DI void xcd_bar(unsigned char* ws) {
  unsigned* bar = (unsigned*)(ws + WS_BAR);
  const unsigned x = xb_xcc_id();
  extern __shared__ __attribute__((aligned(16))) unsigned char smem[];
  asm volatile("s_waitcnt vmcnt(0)" ::: "memory");
  __syncthreads();
  if (threadIdx.x == 0) {
    __builtin_amdgcn_s_waitcnt(0);
    volatile unsigned* st = (volatile unsigned*)(smem + 132096);
    const unsigned nloc = st[0], nx = st[1];
    const unsigned old = xb_add(&bar[XB_XSUB(x)], 1u);
    const unsigned gen = old / nloc;
    if (old + 1u == (gen + 1u) * nloc) {
      __builtin_amdgcn_fence(__ATOMIC_RELEASE, "agent");
      asm volatile("s_waitcnt vmcnt(0)" ::: "memory");
      const unsigned og = xb_add(&bar[XB_TOP], 1u);
      const unsigned tg = og / nx;
      if (og + 1u == (tg + 1u) * nx) xb_add(&bar[XB_TOPGEN], 1u);
      else XB_SPIN(xb_ld(&bar[XB_TOPGEN]) == tg);
      __builtin_amdgcn_fence(__ATOMIC_ACQUIRE, "agent");
      xb_add(&bar[XB_XGEN(x)], 1u);
      asm volatile("s_waitcnt vmcnt(0)" ::: "memory");
    } else {
      XB_SPIN(xb_ld(&bar[XB_XGEN(x)]) == gen);
      __builtin_amdgcn_fence(__ATOMIC_ACQUIRE, "agent");
      asm volatile("s_waitcnt vmcnt(0)" ::: "memory");
    }
  }
  __syncthreads();
}

__global__ void __launch_bounds__(512, 2) mega_coop(P p) {
  cg::grid_group grid = cg::this_grid();
  if (threadIdx.x == 0) (void)xb_add(&((unsigned*)(p.ws + WS_BAR))[XB_XCNT(xb_xcc_id())], 1u);
  phase_prep_a(p);
  grid.sync();
  if (threadIdx.x == 0) {
    extern __shared__ __attribute__((aligned(16))) unsigned char smem_[];
    unsigned* bar = (unsigned*)(p.ws + WS_BAR);
    const unsigned xcc = xb_xcc_id();
    unsigned mine = 0, cnt = 0;
    for (unsigned j = 0; j < 16; ++j) { const unsigned c = xb_ld(&bar[XB_XCNT(j)]); cnt += c > 0u ? 1u : 0u; mine = j == xcc ? c : mine; }
    volatile unsigned* st = (volatile unsigned*)(smem_ + 132096);
    st[0] = mine > 0u ? mine : 1u; st[1] = cnt > 0u ? cnt : 1u;
  }
  __syncthreads();
  phase_prep_b(p);
  xcd_bar(p.ws);
  phase_prep_c(p);
  phase_convert(p, p.in[0], p.in[1]);
  xcd_bar(p.ws);
  for (int ph = 3; ph < NPHASE; ++ph) {
    if ((ph - 3) % 8 == 2) continue;
    run_phase(p, ph);
#if PROBE_MASK
    {
      const int s_ = (ph - 3) % 8;
      bool rep = false;
      if ((PROBE_MASK & 1) && s_ == 3) rep = true;
      if ((PROBE_MASK & 2) && (s_ == 0 || s_ == 4 || s_ == 6)) rep = true;
      if ((PROBE_MASK & 4) && (s_ == 1 || s_ == 2)) rep = true;
      if ((PROBE_MASK & 8) && s_ == 6) run_phase(p, ph, (PROBE_MASK >> 4));
      if (rep) run_phase(p, ph);
    }
#endif
    if (ph + 1 < NPHASE) xcd_bar(p.ws);
  }
}
#if N_LAUNCH_MODE == 0
__global__ void __launch_bounds__(512, 2) mega_one(P p) {
  run_phase(p, p.ph_lo);
}
#endif

extern "C" void kernel_launch(void* const* d_in, const int* in_sizes, int n_in, void* d_out, int out_size, void* d_ws, size_t ws_size,
                              hipStream_t stream) {
  static int grid = 0;
  if (grid == 0) {
    if (n_in != 21 || ws_size < WS_END) { fprintf(stderr, "kernel_launch: unexpected n_in %d / ws_size %zu (need %zu)\n", n_in, ws_size, (size_t)WS_END); grid = -1; return; }
    int dev = 0, cus = 0, per_cu = 0;
    hipGetDevice(&dev);
    hipDeviceGetAttribute(&cus, hipDeviceAttributeMultiprocessorCount, dev);
    hipFuncSetAttribute((const void*)mega_coop, hipFuncAttributeMaxDynamicSharedMemorySize, LDS_BYTES);
#if N_LAUNCH_MODE == 0
    hipFuncSetAttribute((const void*)mega_one, hipFuncAttributeMaxDynamicSharedMemorySize, LDS_BYTES);
#endif
    hipOccupancyMaxActiveBlocksPerMultiprocessor(&per_cu, (const void*)mega_coop, 512, LDS_BYTES);
    if (per_cu < 1) { fprintf(stderr, "kernel_launch: occupancy query says %d blocks/CU\n", per_cu); per_cu = 1; }
    (void)hipGetLastError();
    grid = cus * 1;
  }
  if (grid < 0) return;
  P p{};
  for (int i = 0; i < 21; ++i) p.in[i] = (const float*)d_in[i];
  p.out = (float*)d_out;
  p.ws = (unsigned char*)d_ws;
#if N_LAUNCH_MODE == 1
  p.ph_lo = 0; p.ph_hi = NPHASE;
  void* args[] = {&p};
  if (hipMemsetAsync((unsigned char*)d_ws + WS_BAR, 0, 16384, stream) != hipSuccess) { fprintf(stderr, "kernel_launch: barrier memset failed\n"); return; }
  hipError_t e = hipLaunchCooperativeKernel((const void*)mega_coop, dim3(grid), dim3(512), args, LDS_BYTES, stream);
  if (e != hipSuccess) fprintf(stderr, "cooperative launch failed: %s (grid %d)\n", hipGetErrorString(e), grid);
#else
  for (int ph = 0; ph < NPHASE; ++ph) {
    p.ph_lo = ph; p.ph_hi = ph + 1;
    hipLaunchKernelGGL(mega_one, dim3(grid), dim3(512), LDS_BYTES, stream, p);
  }
#endif
}
```

```cpp
#include <hip/hip_runtime.h>
#include <hip/hip_cooperative_groups.h>
#include <cstdio>
namespace cg = cooperative_groups;

typedef unsigned short u16;
typedef __attribute__((ext_vector_type(8))) short bf16x8;
typedef __attribute__((ext_vector_type(4))) float f32x4;
typedef __attribute__((ext_vector_type(16))) float f32x16;
typedef __attribute__((ext_vector_type(4))) unsigned u32x4;
typedef __attribute__((ext_vector_type(2))) unsigned u32x2;
typedef __attribute__((ext_vector_type(2))) float f32x2;
typedef __attribute__((ext_vector_type(2))) __bf16 bf16v2;

#define DI __device__ __forceinline__
#ifndef PROBE_MASK
#define PROBE_MASK 0
#endif
#ifndef STAGGER_SLEEP
#define STAGGER_SLEEP 0
#endif
#ifndef USE_XCD_BAR
#define USE_XCD_BAR 1
#endif
#ifndef N_LAUNCH_MODE
#define N_LAUNCH_MODE 1
#endif

constexpr int NT = 81920;
constexpr int NTP = 65536;
constexpr int NCH = 2560;
constexpr int ASTR = 768;
constexpr int NPHASE = 19;
constexpr int LDS_BYTES = 131072 + 1024 + 16;

constexpr size_t MiB = 1ull << 20;
constexpr size_t WS_WT_IN = 0;
constexpr size_t WS_WT_AP = 16 * MiB;
constexpr size_t WS_WT_GA = 20 * MiB;
constexpr size_t WS_WT_GB = 22 * MiB;
constexpr size_t WS_WT_OUT = 24 * MiB;
constexpr size_t WS_WT_FF1 = 28 * MiB;
constexpr size_t WS_WT_FF2 = 44 * MiB;
constexpr size_t WS_W1T = 60 * MiB;
constexpr size_t WS_WYT = 76 * MiB;
constexpr size_t WS_LPOW = 124 * MiB;
constexpr size_t WS_BBAR = 127 * MiB;
constexpr size_t WS_KTAB = 128 * MiB;
constexpr size_t WS_ROPE = 132 * MiB;
constexpr size_t WS_SSQ = 133 * MiB;
constexpr size_t WS_XN = 135 * MiB;
constexpr size_t WS_BIG = 295 * MiB;
constexpr size_t WS_Q = WS_BIG;
constexpr size_t WS_K = WS_BIG + 160 * MiB;
constexpr size_t WS_VT = WS_BIG + 200 * MiB;
constexpr size_t WS_ASSM = WS_BIG + 240 * MiB;
constexpr size_t WS_S = WS_BIG + 360 * MiB;
constexpr size_t WS_Y = WS_BIG + 440 * MiB;
constexpr size_t WS_ATTO = WS_BIG + 520 * MiB;
constexpr size_t WS_FF = WS_BIG;
constexpr size_t WS_END = WS_BIG + 680 * MiB;

struct P {
  const float* in[21];
  float* out;
  unsigned char* ws;
  int ph_lo, ph_hi;
};

DI u16 f2bf(float f) { unsigned u = __float_as_uint(f); u += 0x7fffu + ((u >> 16) & 1u); return (u16)(u >> 16); }
DI float bf2f(u16 h) { return __uint_as_float(((unsigned)h) << 16); }
DI unsigned pk2(float a, float b) {
  f32x2 v; v[0] = a; v[1] = b;
  bf16v2 r = __builtin_convertvector(v, bf16v2);
  return __builtin_bit_cast(unsigned, r);
}
DI float sigmoidf_(float x) { return 1.0f / (1.0f + __expf(-x)); }
DI float gelu_tanh(float x) {
  float z = 0.7978845608028654f * (x + 0.044715f * x * x * x);
  float e = __expf(2.0f * z);
  return 0.5f * x * (2.0f - 2.0f / (e + 1.0f));
}


DI void sincos_d(double x, double* sn, double* cs) {
  const double TWO_PI_HI = 6.283185307179586232e+00, TWO_PI_LO = 2.449293598294706414e-16;
  double k = rint(x * 0.15915494309189534561);
  double r = (x - k * TWO_PI_HI) - k * TWO_PI_LO;
  r *= 0.25;
  double r2 = r * r;
  double s = 1.0, c = 1.0;
  s = 1.0 - r2 / (18.0 * 19.0);
  s = 1.0 - r2 / (16.0 * 17.0) * s;
  s = 1.0 - r2 / (14.0 * 15.0) * s;
  s = 1.0 - r2 / (12.0 * 13.0) * s;
  s = 1.0 - r2 / (10.0 * 11.0) * s;
  s = 1.0 - r2 / (8.0 * 9.0) * s;
  s = 1.0 - r2 / (6.0 * 7.0) * s;
  s = 1.0 - r2 / (4.0 * 5.0) * s;
  s = 1.0 - r2 / (2.0 * 3.0) * s;
  s *= r;
  c = 1.0 - r2 / (17.0 * 18.0);
  c = 1.0 - r2 / (15.0 * 16.0) * c;
  c = 1.0 - r2 / (13.0 * 14.0) * c;
  c = 1.0 - r2 / (11.0 * 12.0) * c;
  c = 1.0 - r2 / (9.0 * 10.0) * c;
  c = 1.0 - r2 / (7.0 * 8.0) * c;
  c = 1.0 - r2 / (5.0 * 6.0) * c;
  c = 1.0 - r2 / (3.0 * 4.0) * c;
  c = 1.0 - r2 / (1.0 * 2.0) * c;
  double s2 = 2.0 * s * c, c2 = c * c - s * s;
  *sn = 2.0 * s2 * c2; *cs = c2 * c2 - s2 * s2;
}

template <class T> DI T gld(const void* q) { return *(const __attribute__((address_space(1))) T*)q; }
template <class T> DI void gst(void* q, const T v) { *(__attribute__((address_space(1))) T*)q = v; }
DI int opaque_tid() { int t = threadIdx.x; asm volatile("" : "+v"(t)); return t; }
DI const char* sgpr_ptr(const char* p) { asm("" : "+s"(p)); return p; }
#define WAIT_V(n) asm volatile("s_waitcnt vmcnt(" #n ")" ::: "memory")
#define WAIT_L(n) asm volatile("s_waitcnt lgkmcnt(" #n ")" ::: "memory")
#define BAR __builtin_amdgcn_s_barrier()
#define SCHED __builtin_amdgcn_sched_barrier(0)
#define GLDS(gp, lp) __builtin_amdgcn_global_load_lds((const unsigned*)(gp), (unsigned*)(lp), 16, 0, 0)

constexpr int GBK = 64, GHALF = 128, GHT = GHALF * GBK;
DI int lds_byte(int r, int c) {
  int st = (r >> 4) * 2 + (c >> 5), rr = r & 15, cc = c & 31, ob = rr * 64 + cc * 2;
  return st * 1024 + (ob ^ (((ob >> 9) & 1) << 5));
}
DI void stage_rc(int b, int& R, int& C) {
  int st = b / 1024, sb = b % 1024, swz = sb ^ (((sb >> 9) & 1) << 5);
  R = (st >> 1) * 16 + swz / 64; C = (st & 1) * 32 + (swz % 64) / 2;
}

typedef f32x4 AccT[2][2][4][2];

template <class Epi>
DI void gemm_tile(const u16* __restrict__ A, const u16* __restrict__ Bt, const int lda, const int ldb, const int gsB, const int tmB, const int K, Epi&& epi) {
  const int TID = opaque_tid();
  extern __shared__ __attribute__((aligned(16))) unsigned char smem[];
  u16* shm = (u16*)smem;
#define SA(b, h) (shm + ((b) * 2 + (h)) * GHT)
#define SB(b, h) (shm + (4 + (b) * 2 + (h)) * GHT)
  int R0, C0, R1, C1;
  stage_rc(TID * 16, R0, C0);
  stage_rc(TID * 16 + 8192, R1, C1);
  const unsigned voA0 = (unsigned)(R0 * lda + C0) * 2u, voA1 = (unsigned)(R1 * lda + C1) * 2u;
  const unsigned voB0 = (unsigned)(R0 * ldb + (C0 & 15) + (C0 >> 4) * gsB) * 2u, voB1 = (unsigned)(R1 * ldb + (C1 & 15) + (C1 >> 4) * gsB) * 2u;
  const int hA = GHALF * lda, hB = GHALF * ldb;
  const unsigned wid_u = __builtin_amdgcn_readfirstlane(TID >> 6);
#define STAGE_A(PTR, half, kt) do { const char* _g = sgpr_ptr((const char*)(A + (size_t)(half) * hA + (size_t)(kt) * GBK)); \
    char* _l = (char*)(PTR) + wid_u * 1024u; \
    GLDS(_g + voA0, _l); GLDS(_g + voA1, _l + 8192); } while (0)
#define STAGE_B(PTR, half, kt) do { const char* _g = sgpr_ptr((const char*)(Bt + (size_t)(half) * hB + (tmB ? (size_t)((((kt) >> 2) << 16) + (((kt) & 3) << 6)) : (size_t)(kt) * (size_t)(4 * gsB)))); \
    char* _l = (char*)(PTR) + wid_u * 1024u; \
    GLDS(_g + voB0, _l); GLDS(_g + voB1, _l + 8192); } while (0)
#define LDA(dst, b, h) for (int m = 0; m < 4; ++m) for (int k = 0; k < 2; ++k) \
    dst[m][k] = *reinterpret_cast<const bf16x8*>((char*)SA(b, h) + lds_byte(wr * 64 + m * 16 + fr, k * 32 + fq * 8))
#define LDB(dst, b, h) for (int n = 0; n < 2; ++n) for (int k = 0; k < 2; ++k) \
    dst[n][k] = *reinterpret_cast<const bf16x8*>((char*)SB(b, h) + lds_byte(wc * 32 + n * 16 + fr, k * 32 + fq * 8))
#define MMA(ai, bj, At, Bq) do { __builtin_amdgcn_s_setprio(1); \
    for (int m = 0; m < 4; ++m) for (int n = 0; n < 2; ++n) for (int k = 0; k < 2; ++k) \
      acc[ai][bj][m][n] = __builtin_amdgcn_mfma_f32_16x16x32_bf16(At[m][k], Bq[n][k], acc[ai][bj][m][n], 0, 0, 0); \
    __builtin_amdgcn_s_setprio(0); } while (0)

  const int wid = TID >> 6, lane = TID & 63, wr = wid >> 2, wc = wid & 3, fr = lane & 15, fq = lane >> 4;
  AccT acc;
#pragma unroll
  for (int a = 0; a < 2; ++a)
#pragma unroll
    for (int b = 0; b < 2; ++b)
#pragma unroll
      for (int m = 0; m < 4; ++m)
#pragma unroll
        for (int n = 0; n < 2; ++n) acc[a][b][m][n] = f32x4{0.f, 0.f, 0.f, 0.f};
  bf16x8 At[4][2], B0[2][2], B1[2][2];
  const int nt = K / GBK;
  STAGE_B(SB(0, 0), 0, 0); STAGE_A(SA(0, 0), 0, 0);
  STAGE_B(SB(0, 1), 1, 0); STAGE_A(SA(0, 1), 1, 0);
  if (wr == 1) BAR;
  WAIT_V(4); BAR;
  STAGE_B(SB(1, 0), 0, 1); STAGE_A(SA(1, 0), 0, 1); STAGE_B(SB(1, 1), 1, 1);
  WAIT_V(6); BAR;
  for (int t = 0; t < nt - 2; t += 2) {
    LDB(B0, 0, 0); SCHED; LDA(At, 0, 0); STAGE_A(SA(1, 1), 1, t + 1);
    WAIT_L(8); BAR; WAIT_L(0); MMA(0, 0, At, B0); BAR; SCHED;
    LDB(B1, 0, 1); STAGE_B(SB(0, 0), 0, t + 2);
    BAR; WAIT_L(0); MMA(0, 1, At, B1); BAR;
    LDA(At, 0, 1); STAGE_A(SA(0, 0), 0, t + 2);
    BAR; WAIT_L(0); MMA(1, 0, At, B0); BAR; SCHED;
    STAGE_B(SB(0, 1), 1, t + 2);
    WAIT_V(6); BAR; MMA(1, 1, At, B1); BAR;
    LDB(B0, 1, 0); SCHED; LDA(At, 1, 0); STAGE_A(SA(0, 1), 1, t + 2);
    WAIT_L(8); BAR; WAIT_L(0); MMA(0, 0, At, B0); BAR; SCHED;
    LDB(B1, 1, 1); STAGE_B(SB(1, 0), 0, t + 3);
    BAR; WAIT_L(0); MMA(0, 1, At, B1); BAR;
    LDA(At, 1, 1); STAGE_A(SA(1, 0), 0, t + 3);
    BAR; WAIT_L(0); MMA(1, 0, At, B0); BAR; SCHED;
    STAGE_B(SB(1, 1), 1, t + 3);
    WAIT_V(6); BAR; MMA(1, 1, At, B1); BAR;
  }
  { LDB(B0, 0, 0); LDA(At, 0, 0); STAGE_A(SA(1, 1), 1, nt - 1);
    BAR; WAIT_L(0); MMA(0, 0, At, B0); BAR;
    LDB(B1, 0, 1); BAR; WAIT_L(0); MMA(0, 1, At, B1); BAR;
    LDA(At, 0, 1); WAIT_V(4); BAR; WAIT_L(0); MMA(1, 0, At, B0); MMA(1, 1, At, B1); BAR; }
  { LDB(B0, 1, 0); LDA(At, 1, 0); WAIT_V(2); BAR; WAIT_L(0); MMA(0, 0, At, B0); BAR;
    LDB(B1, 1, 1); WAIT_V(0); BAR; WAIT_L(0); MMA(0, 1, At, B1); BAR;
    LDA(At, 1, 1); BAR; WAIT_L(0); MMA(1, 0, At, B0); MMA(1, 1, At, B1); BAR; }
  if (wr == 0) BAR;
  epi(acc);
#undef SA
#undef SB
}

template <class F>
DI void epi_for(AccT& acc, F&& f) {
  const int TID = opaque_tid();
  const int _wid = TID >> 6, _lane = TID & 63, _wr = _wid >> 2, _wc = _wid & 3, _fr = _lane & 15, _fq = _lane >> 4;
#pragma unroll
  for (int _ai = 0; _ai < 2; ++_ai)
#pragma unroll
    for (int _bj = 0; _bj < 2; ++_bj)
#pragma unroll
      for (int _m = 0; _m < 4; ++_m)
#pragma unroll
        for (int _n = 0; _n < 2; ++_n)
          f(_ai * 128 + _wr * 64 + _m * 16 + _fq * 4, _bj * 128 + _wc * 32 + _n * 16 + _fr, acc[_ai][_bj][_m][_n]);
}

DI void tile_map(int w, int ntn, int& tm, int& tn) {
  int xcd = w & 7, r = w >> 3;
  tn = r % ntn; tm = (r / ntn) * 8 + xcd;
}

DI void transpose_tile(const float* __restrict__ src, int N, u16* __restrict__ dst, int K, int tk, int tn, const float* __restrict__ gain) {
  const int TID = opaque_tid();
  extern __shared__ __attribute__((aligned(16))) unsigned char smem[];
  float* tile = (float*)smem;
  const int t = TID;
  {
    const int cs = (t & 15) * 4;
    float4 v[8];
#pragma unroll
    for (int i = 0; i < 8; ++i) v[i] = *(const float4*)(src + (size_t)(tk * 256 + (t >> 4) + 32 * i) * N + tn * 64 + cs);
#pragma unroll
    for (int i = 0; i < 8; ++i) {
      const int rk = (t >> 4) + 32 * i;
      const float gk = gain ? gain[tk * 256 + rk] : 1.0f;
      float* d = tile + rk * 65 + cs;
      d[0] = v[i].x * gk; d[1] = v[i].y * gk; d[2] = v[i].z * gk; d[3] = v[i].w * gk;
    }
  }
  __syncthreads();
  {
    const int n = t >> 3, ks = (t & 7) * 32;
#pragma unroll
    for (int j = 0; j < 4; ++j) {
      const float* q = tile + (ks + 8 * j) * 65 + n;
      u32x4 o;
      o[0] = pk2(q[0], q[65]); o[1] = pk2(q[130], q[195]); o[2] = pk2(q[260], q[325]); o[3] = pk2(q[390], q[455]);
      *(u32x4*)(dst + (size_t)(tn * 64 + n) * K + tk * 256 + ks + 8 * j) = o;
    }
  }
  __syncthreads();
}

DI void phase_prep_a(const P& p) {
  const int TID = opaque_tid();
  const int bid = blockIdx.x, nb = gridDim.x;
  for (int w = bid; w < 1920; w += nb) {
    int layer = w / 960, r = w % 960;
    const float* src; u16* dst; int K, N, tl; const float* gain = nullptr;
    if (r < 256) { src = p.in[3] + (size_t)layer * 1024 * 4096; dst = (u16*)(p.ws + WS_WT_IN) + (size_t)layer * 4096 * 1024; K = 1024; N = 4096; tl = r; gain = p.in[2] + layer * 1024; }
    else if (r < 320) { src = p.in[6] + (size_t)layer * 1024 * 1024; dst = (u16*)(p.ws + WS_WT_AP) + (size_t)layer * 1024 * 1024; K = 1024; N = 1024; tl = r - 256; }
    else if (r < 352) { src = p.in[15] + (size_t)layer * 512 * 1024; dst = (u16*)(p.ws + WS_WT_GA) + (size_t)layer * 1024 * 512; K = 512; N = 1024; tl = r - 320; }
    else if (r < 384) { src = p.in[16] + (size_t)layer * 512 * 1024; dst = (u16*)(p.ws + WS_WT_GB) + (size_t)layer * 1024 * 512; K = 512; N = 1024; tl = r - 352; }
    else if (r < 448) { src = p.in[17] + (size_t)layer * 1024 * 1024; dst = (u16*)(p.ws + WS_WT_OUT) + (size_t)layer * 1024 * 1024; K = 1024; N = 1024; tl = r - 384; }
    else if (r < 704) { src = p.in[19] + (size_t)layer * 1024 * 4096; dst = (u16*)(p.ws + WS_WT_FF1) + (size_t)layer * 4096 * 1024; K = 1024; N = 4096; tl = r - 448; gain = p.in[18] + layer * 1024; }
    else { src = p.in[20] + (size_t)layer * 4096 * 1024; dst = (u16*)(p.ws + WS_WT_FF2) + (size_t)layer * 1024 * 4096; K = 4096; N = 1024; tl = r - 704; }
    int ntn = N / 64;
    transpose_tile(src, N, dst, K, tl / ntn, tl % ntn, gain);
  }
  const int gtid = bid * 512 + TID, nth = nb * 512;
  float2* LP = (float2*)(p.ws + WS_LPOW);
  float2* BB = (float2*)(p.ws + WS_BBAR);
  for (int idx = gtid; idx < 8192 * 33; idx += nth) {
    const int i = idx / 33, tau = idx - i * 33, lg = i >> 6;
    const double step = exp((double)p.in[9][lg]);
    const double zr = (double)p.in[7][i] * step, zi = (double)p.in[8][i] * step;
    double e = exp(zr * tau), sn, cs;
    sincos_d(zi * tau, &sn, &cs);
    LP[idx] = make_float2((float)(e * cs), (float)(e * sn));
  }
  for (int idx = gtid; idx < 8192 * 16; idx += nth) {
    const int i = idx >> 4, ci = idx & 15, lg = i >> 6;
    const double step = exp((double)p.in[9][lg]);
    const double lr = p.in[7][i], li = p.in[8][i];
    const double zr = lr * step, zi = li * step;
    double e = exp(zr), sn, cs;
    sincos_d(zi, &sn, &cs);
    const double nr = e * cs - 1.0, ni = e * sn, den = lr * lr + li * li;
    const double fr = (nr * lr + ni * li) / den, fi = (ni * lr - nr * li) / den;
    const double br = p.in[10][idx], bi = p.in[11][idx];
    BB[idx] = make_float2((float)(fr * br - fi * bi), (float)(fr * bi + fi * br));
  }
  float2* RP = (float2*)(p.ws + WS_ROPE);
  for (int i = gtid; i < 128 * 16; i += nth) {
    int pos = i >> 4, f = i & 15;
    double inv = exp(-(double)(2 * f) / 32.0 * 9.210340371976184);
    double sn, cs;
    sincos_d((double)pos * inv, &sn, &cs);
    RP[i] = make_float2((float)cs, (float)sn);
  }
}

DI void phase_prep_b(const P& p) {
  const int TID = opaque_tid();
  const int gtid = blockIdx.x * 512 + TID, nth = gridDim.x * 512;
  const float2* LP = (const float2*)(p.ws + WS_LPOW);
  const float2* BB = (const float2*)(p.ws + WS_BBAR);
  float* KT = (float*)(p.ws + WS_KTAB);
  const float* cre = p.in[12];
  const float* cim = p.in[13];
  {
    extern __shared__ __attribute__((aligned(16))) unsigned char smem[];
    float2* Cs = (float2*)smem;
    float2* Bs = Cs + 1024;
    float2* Ls = Bs + 1024;
    for (int item = blockIdx.x; item < 256; item += gridDim.x) {
      const int lg = item >> 1, th = item & 1;
      for (int e = TID; e < 1024; e += 512) {
        Cs[e] = make_float2(cre[(size_t)lg * 1024 + e], cim[(size_t)lg * 1024 + e]);
        Bs[e] = BB[(size_t)lg * 1024 + e];
        Ls[e] = LP[(size_t)(lg * 64 + (e >> 4)) * 33 + th * 16 + (e & 15)];
      }
      __syncthreads();
      const int co = (TID >> 4) & 15, ci = TID & 15, tsel = TID >> 8;
      float a8[8];
#pragma unroll
      for (int k = 0; k < 8; ++k) a8[k] = 0.f;
      for (int pp = 0; pp < 64; ++pp) {
        const float2 c = Cs[co * 64 + pp], b = Bs[pp * 16 + ci];
        const float zr = c.x * b.x - c.y * b.y, zi = c.x * b.y + c.y * b.x;
#pragma unroll
        for (int k = 0; k < 8; ++k) { const float2 l = Ls[pp * 16 + tsel + 2 * k]; a8[k] += zr * l.x - zi * l.y; }
      }
#pragma unroll
      for (int k = 0; k < 8; ++k) KT[(((size_t)lg * 32 + th * 16 + tsel + 2 * k) * 16 + co) * 16 + ci] = a8[k];
      __syncthreads();
    }
  }
  u16* W1 = (u16*)(p.ws + WS_W1T);
  for (int i8 = gtid; i8 < (1 << 20); i8 += nth) {
    const int i = i8 << 3;
    const int k = i & 511, n = (i >> 9) & 255, g = (i >> 17) & 31, layer = i >> 22;
    const int dir = n >> 7, pp = (n >> 1) & 63, ri = n & 1, sidx = k >> 4, ci0 = k & 15;
    const int e = dir ? sidx : 31 - sidx;
    const int lg = (layer * 2 + dir) * 32 + g;
    const float2 l = LP[(size_t)(lg * 64 + pp) * 33 + e];
    const float2* b = BB + (size_t)(lg * 64 + pp) * 16 + ci0;
    float v[8];
#pragma unroll
    for (int q = 0; q < 8; ++q) { const float2 bq = b[q]; v[q] = ri ? (l.x * bq.y + l.y * bq.x) : (l.x * bq.x - l.y * bq.y); }
    u32x4 o;
    o[0] = pk2(v[0], v[1]); o[1] = pk2(v[2], v[3]); o[2] = pk2(v[4], v[5]); o[3] = pk2(v[6], v[7]);
    *(u32x4*)(W1 + i) = o;
  }
  u16* WY = (u16*)(p.ws + WS_WYT);
  for (int i8 = gtid; i8 < (1 << 20); i8 += nth) {
    const int i = i8 << 3;
    const int kk = i & 255, n = (i >> 8) & 511, g = (i >> 17) & 31, layer = i >> 22;
    const int t = n >> 4, co = n & 15, dir = kk >> 7, pp0 = (kk >> 1) & 63;
    const int e = dir ? 32 - t : t + 1;
    const int lg = (layer * 2 + dir) * 32 + g;
    float v[8];
#pragma unroll
    for (int q = 0; q < 4; ++q) {
      const float cr = cre[(size_t)(lg * 16 + co) * 64 + pp0 + q], cI = cim[(size_t)(lg * 16 + co) * 64 + pp0 + q];
      const float2 l = LP[(size_t)(lg * 64 + pp0 + q) * 33 + e];
      v[2 * q] = cr * l.x - cI * l.y;
      v[2 * q + 1] = -(cr * l.y + cI * l.x);
    }
    u32x4 o;
    o[0] = pk2(v[0], v[1]); o[1] = pk2(v[2], v[3]); o[2] = pk2(v[4], v[5]); o[3] = pk2(v[6], v[7]);
    *(u32x4*)(WY + ((size_t)((layer * 32 + g) * 512 + n)) * ASTR + 512 + kk) = o;
  }
}

DI void phase_prep_c(const P& p) {
  const int TID = opaque_tid();
#if PROBE_MASK & 64
  {
    u32x4* dst = (u32x4*)(p.ws + WS_FF);
    u32x4 z; z[0] = 1; z[1] = 2; z[2] = 3; z[3] = 4;
    for (unsigned i = blockIdx.x * 512 + TID; i < 640u * 65536u; i += gridDim.x * 512) { z[0] = i * 2654435761u; z[1] = z[0] ^ (i << 7); z[2] = z[1] * 40503u + i; z[3] = z[2] ^ z[0]; dst[i] = z; }
  }
#endif
  const int gtid = blockIdx.x * 512 + TID, nth = gridDim.x * 512;
  const float* KT = (const float*)(p.ws + WS_KTAB);
  u16* WY = (u16*)(p.ws + WS_WYT);
  for (int i = gtid; i < (1 << 21); i += nth) {
    int k8 = i & 63, n = (i >> 6) & 511, g = (i >> 15) & 31, layer = i >> 20;
    int t = n >> 4, co = n & 15, s = k8 >> 1, ci0 = (k8 & 1) * 8;
    int tau = t - s;
    float v[8];
    if (tau > 0) {
      const float* q = KT + ((((size_t)(layer * 2 + 0) * 32 + g) * 32 + tau) * 16 + co) * 16 + ci0;
#pragma unroll
      for (int j = 0; j < 8; ++j) v[j] = q[j];
    } else if (tau < 0) {
      const float* q = KT + ((((size_t)(layer * 2 + 1) * 32 + g) * 32 - tau) * 16 + co) * 16 + ci0;
#pragma unroll
      for (int j = 0; j < 8; ++j) v[j] = q[j];
    } else {
      const float* q0 = KT + ((((size_t)(layer * 2 + 0) * 32 + g) * 32) * 16 + co) * 16 + ci0;
      const float* q1 = KT + ((((size_t)(layer * 2 + 1) * 32 + g) * 32) * 16 + co) * 16 + ci0;
#pragma unroll
      for (int j = 0; j < 8; ++j) v[j] = q0[j] + q1[j];
    }
    u32x4 o;
    o[0] = pk2(v[0], v[1]); o[1] = pk2(v[2], v[3]); o[2] = pk2(v[4], v[5]); o[3] = pk2(v[6], v[7]);
    *(u32x4*)(WY + ((size_t)((layer * 32 + g) * 512 + n)) * ASTR + k8 * 8) = o;
  }
}

DI const float* xrow(const P& p, int layer, int tok) {
  if (layer == 0) return tok < NTP ? p.in[0] + (size_t)tok * 1024 : p.in[1] + (size_t)(tok - NTP) * 1024;
  return p.out + (size_t)tok * 1024;
}
DI void phase_convert(const P& p, const float* __restrict__ src0, const float* __restrict__ src1) {
  const int TID = opaque_tid();
  const int lane = TID & 63, wave = TID >> 6;
  u16* XN = (u16*)(p.ws + WS_XN);
  float* SSQ = (float*)(p.ws + WS_SSQ);
  for (int tok = blockIdx.x * 8 + wave; tok < NT; tok += gridDim.x * 8) {
    const float* x = tok < NTP ? src0 + (size_t)tok * 1024 : src1 + (size_t)(tok - NTP) * 1024;
    float4 v[4];
    float ss = 0.f;
#pragma unroll
    for (int i = 0; i < 4; ++i) {
      v[i] = *(const float4*)(x + i * 256 + lane * 4);
      ss += v[i].x * v[i].x + v[i].y * v[i].y + v[i].z * v[i].z + v[i].w * v[i].w;
    }
#pragma unroll
    for (int o = 32; o >= 1; o >>= 1) ss += __shfl_xor(ss, o);
    if (lane < 4) SSQ[(size_t)lane * NT + tok] = lane == 0 ? ss : 0.f;
#pragma unroll
    for (int i = 0; i < 4; ++i) {
      u32x2 o;
      o[0] = pk2(v[i].x, v[i].y);
      o[1] = pk2(v[i].z, v[i].w);
      *(u32x2*)(XN + (size_t)tok * 1024 + i * 256 + lane * 4) = o;
    }
  }
}

DI void phase_scan(const P& p, int layer) {
  const int TID = opaque_tid();
  const int gtid = blockIdx.x * 512 + TID, nth = gridDim.x * 512;
  const float2* LP = (const float2*)(p.ws + WS_LPOW);
  for (int i = gtid; i < 18 * 4096; i += nth) {
    int pp = i & 63, dir = (i >> 6) & 1, g = (i >> 7) & 31, seq = i >> 12;
    int c0 = seq < 16 ? seq * 128 : 2048 + (seq - 16) * 256;
    int nc = seq < 16 ? 128 : 256;
    float2 a = LP[(size_t)(((layer * 2 + dir) * 32 + g) * 64 + pp) * 33 + 32];
    const float2* S = (const float2*)(p.ws + WS_S) + ((size_t)(g * NCH + c0) * 256 + dir * 128 + pp * 2) / 2;
    unsigned* H = (unsigned*)((u16*)(p.ws + WS_ASSM) + (size_t)(g * NCH + c0) * ASTR + 512 + dir * 128 + pp * 2);
    float hr = 0.f, hi = 0.f;
    for (int cb = 0; cb < nc; cb += 16) {
      float2 sv[16];
#pragma unroll
      for (int k = 0; k < 16; ++k) {
        const int c = dir == 0 ? cb + k : nc - 1 - cb - k;
        sv[k] = S[(size_t)c * 128];
      }
#pragma unroll
      for (int k = 0; k < 16; ++k) {
        const int c = dir == 0 ? cb + k : nc - 1 - cb - k;
        H[(size_t)c * (ASTR / 2)] = pk2(hr, hi);
        const float nr = a.x * hr - a.y * hi + sv[k].x;
        hi = a.x * hi + a.y * hr + sv[k].y;
        hr = nr;
      }
    }
  }
}

#define MFMA32(a, b, c) __builtin_amdgcn_mfma_f32_32x32x16_bf16((a), (b), (c), 0, 0, 0)
DI void attn_item(const P& pin, int layer, int seq_start, int L, int head, int qb) {
  const int TID = opaque_tid();
  struct { unsigned char* ws; } p;
  p.ws = pin.ws;
  asm volatile("" : "+s"(p.ws));
  extern __shared__ __attribute__((aligned(16))) unsigned char smem[];
  const u16* Q = (const u16*)(p.ws + WS_Q);
  const u16* KB = (const u16*)(p.ws + WS_K);
  const u16* VT = (const u16*)(p.ws + WS_VT);
  const int tid = TID, wave = tid >> 6, lane = tid & 63, r = lane & 31, h = lane >> 5;
  const int kvh = head >> 2;
  const int q0 = seq_start + qb * 512 + wave * 64;
  bf16x8 qf[2][4];
#pragma unroll
  for (int nt = 0; nt < 2; ++nt)
#pragma unroll
    for (int ds = 0; ds < 4; ++ds)
      qf[nt][ds] = gld<bf16x8>(Q + (size_t)(q0 + nt * 32 + r) * 1024 + head * 64 + ds * 16 + h * 8);
#pragma unroll
  for (int nt = 0; nt < 2; ++nt)
#pragma unroll
    for (int ds = 0; ds < 4; ++ds) asm volatile("" ::"v"(qf[nt][ds]));
  bool no_check;
  {
    float gq = fabsf(pin.in[4][layer * 64 + lane]), gk = fabsf(pin.in[5][layer * 64 + lane]);
#pragma unroll
    for (int o = 32; o >= 1; o >>= 1) { gq = fmaxf(gq, __shfl_xor(gq, o)); gk = fmaxf(gk, __shfl_xor(gk, o)); }
    no_check = __builtin_amdgcn_readfirstlane(11.5416f * 1.01f * gq * gk <= 15.5f ? 1 : 0) != 0;
  }
  const int srow = tid >> 3, spos = tid & 7, scc = spos ^ ((srow >> 1) & 7);
  const u16* kg = KB + ((size_t)kvh * NT + seq_start + srow) * 64 + scc * 8;
  const u16* vg = VT + (size_t)(kvh * 64 + srow) * NT + seq_start + scc * 8;
  unsigned char* ldst = smem + tid * 16;
  const int nkt = L >> 6;
  const int pr = ((r >> 4) * 16) + (((r >> 2) & 1) * 8) + (((r >> 3) & 1) * 4) + (r & 3);
  int koff[4];
#pragma unroll
  for (int ds = 0; ds < 4; ++ds) koff[ds] = pr * 128 + (((ds * 2 + h) ^ ((pr >> 1) & 7)) << 4);
  const int vxh = ((r >> 1) & 7) >> 1;
  const int vbase = 8192 + r * 128 + ((h ^ ((r >> 1) & 1)) << 4);

  f32x16 o[2][2];
#pragma unroll
  for (int a = 0; a < 2; ++a)
#pragma unroll
    for (int b = 0; b < 2; ++b)
#pragma unroll
      for (int j = 0; j < 16; ++j) o[a][b][j] = 0.f;
  float mrun[2] = {0.f, 0.f}, lrun[2] = {0.f, 0.f};


#define ATT_STAGE(T, B) do { GLDS(kg + (size_t)(T) * 128 * 64, ldst + (B) * 32768); GLDS(vg + (T) * 128, ldst + (B) * 32768 + 8192); \
    GLDS(kg + (size_t)(T) * 128 * 64 + 64 * 64, ldst + (B) * 32768 + 16384); GLDS(vg + (T) * 128 + 64, ldst + (B) * 32768 + 16384 + 8192); } while (0)
  const int nst = nkt >> 1;
  ATT_STAGE(0, 0);
  ATT_STAGE(1, 1);
  int bcur = 0;
  for (int st = 0; st < nst; ++st) {
    if (st + 1 < nst) { WAIT_V(4); } else { WAIT_V(0); }
    BAR;
    if (st + 2 < nst) {
      int bn = bcur + 2; if (bn >= 3) bn -= 3;
      ATT_STAGE(st + 2, bn);
    }
    const unsigned char* sbase = smem + bcur * 32768;
    auto qk = [&](const int hx, f32x16 (&sc)[2]) {
      const unsigned char* kb = sbase + (hx >> 1) * 16384 + (hx & 1) * 4096;
      bf16x8 kf[4];
#pragma unroll
      for (int ds = 0; ds < 4; ++ds) kf[ds] = *(const bf16x8*)(kb + koff[ds]);
      if (no_check) {
        f32x16 z16;
#pragma unroll
        for (int j = 0; j < 16; ++j) z16[j] = 0.f;
#pragma unroll
        for (int nt = 0; nt < 2; ++nt) sc[nt] = MFMA32(kf[0], qf[nt][0], z16);
      } else {
#pragma unroll
        for (int nt = 0; nt < 2; ++nt) {
#pragma unroll
          for (int j = 0; j < 16; ++j) sc[nt][j] = -mrun[nt];
          sc[nt] = MFMA32(kf[0], qf[nt][0], sc[nt]);
        }
      }
#pragma unroll
      for (int ds = 1; ds < 4; ++ds)
#pragma unroll
        for (int nt = 0; nt < 2; ++nt) sc[nt] = MFMA32(kf[ds], qf[nt][ds], sc[nt]);
    };
    auto sm_pv = [&](const int hx, f32x16 (&sc)[2], f32x16 (&pend)[2], const bool has_pend) {
      const bool chk = !no_check;
      const unsigned char* kb = sbase + (hx >> 1) * 16384;
      const int kt = hx & 1;
      bf16x8 vf[2][2];
#pragma unroll
      for (int s2 = 0; s2 < 2; ++s2)
#pragma unroll
        for (int mt = 0; mt < 2; ++mt) vf[s2][mt] = *(const bf16x8*)(kb + vbase + (((kt * 2 + s2) ^ vxh) << 5) + mt * 4096);
      float mx[2] = {0.f, 0.f};
      if (chk) {
#pragma unroll
        for (int nt = 0; nt < 2; ++nt) {
          float m0 = sc[nt][0];
#pragma unroll
          for (int j = 1; j < 16; ++j) m0 = fmaxf(m0, sc[nt][j]);
          mx[nt] = m0;
        }
      }
      if (chk && __any((fabsf(mx[0]) > 16.0f) | (fabsf(mx[1]) > 16.0f))) {
#pragma unroll
        for (int nt = 0; nt < 2; ++nt) {
          const float mp = fmaxf(mx[nt], __shfl_xor(mx[nt], 32));
          const float dm = (fabsf(mp) > 12.0f) ? mp : 0.0f;
          const float alpha = __builtin_amdgcn_exp2f(-dm);
          mrun[nt] += dm;
          lrun[nt] *= alpha;
#pragma unroll
          for (int j = 0; j < 16; ++j) sc[nt][j] -= dm;
          if (has_pend) {
#pragma unroll
            for (int j = 0; j < 16; ++j) pend[nt][j] -= dm;
          }
#pragma unroll
          for (int mt = 0; mt < 2; ++mt)
#pragma unroll
            for (int j = 0; j < 16; ++j) o[mt][nt][j] *= alpha;
        }
      }
#pragma unroll
      for (int nt = 0; nt < 2; ++nt) {
        float sum = 0.f;
#pragma unroll
        for (int j = 0; j < 16; ++j) { float pv = __builtin_amdgcn_exp2f(sc[nt][j]); sc[nt][j] = pv; sum += pv; }
        lrun[nt] += sum;
      }
#pragma unroll
      for (int s2 = 0; s2 < 2; ++s2) {
        bf16x8 pf[2];
#pragma unroll
        for (int nt = 0; nt < 2; ++nt) {
          u32x4 pk;
#pragma unroll
          for (int i = 0; i < 4; ++i) pk[i] = pk2(sc[nt][s2 * 8 + 2 * i], sc[nt][s2 * 8 + 2 * i + 1]);
          pf[nt] = __builtin_bit_cast(bf16x8, pk);
        }
#pragma unroll
        for (int mt = 0; mt < 2; ++mt)
#pragma unroll
          for (int nt = 0; nt < 2; ++nt) o[mt][nt] = MFMA32(vf[s2][mt], pf[nt], o[mt][nt]);
      }
    };
    f32x16 sa[2], sb[2];
    qk(0, sa);
    qk(1, sb); sm_pv(0, sa, sb, true);
    qk(2, sa); sm_pv(1, sb, sa, true);
    qk(3, sb); sm_pv(2, sa, sb, true);
    sm_pv(3, sb, sa, false);
    bcur = bcur + 1; if (bcur >= 3) bcur = 0;
  }
  unsigned char* ws2 = pin.ws;
  asm volatile("" : "+s"(ws2));
  u16* O = (u16*)(ws2 + WS_ATTO);
  const int tid2 = opaque_tid();
  const int r2 = tid2 & 31, h2 = (tid2 >> 5) & 1;
  const int q0b = seq_start + qb * 512 + (tid2 >> 6) * 64;
#pragma unroll
  for (int nt = 0; nt < 2; ++nt) {
    float l = lrun[nt] + __shfl_xor(lrun[nt], 32);
    float inv = 1.0f / l;
    const int tok = q0b + nt * 32 + r2;
#pragma unroll
    for (int mt = 0; mt < 2; ++mt)
#pragma unroll
      for (int jg = 0; jg < 4; ++jg) {
        u32x2 ov;
        ov[0] = pk2(o[mt][nt][jg * 4 + 0] * inv, o[mt][nt][jg * 4 + 1] * inv);
        ov[1] = pk2(o[mt][nt][jg * 4 + 2] * inv, o[mt][nt][jg * 4 + 3] * inv);
        gst<u32x2>(O + (size_t)tok * 1024 + head * 64 + mt * 32 + jg * 8 + h2 * 4, ov);
      }
  }
  WAIT_L(0);
  BAR;
}


enum { EK_Q = 0, EK_K, EK_V, EK_U, EK_S, EK_Y, EK_M0, EK_M1, EK_M2, EK_M3, EK_M4, EK_OUT, EK_FF1, EK_FF2 };
struct Job {
  const u16* A; const u16* Bt;
  int lda, ldb, gsB, tmB, K, kind, tm, tn, layer;
};

DI void stage_acc(AccT& acc, unsigned char* smem, const int tid, const int linear = 0) {
  const int wid = tid >> 6, lane = tid & 63, wr = wid >> 2, wc = wid & 3, fr = lane & 15, fq = lane >> 4;
#if PROBE_MASK
  if (linear) {
    int k = 0;
#pragma unroll
    for (int ai = 0; ai < 2; ++ai)
#pragma unroll
      for (int bj = 0; bj < 2; ++bj)
#pragma unroll
        for (int m = 0; m < 4; ++m)
#pragma unroll
          for (int n = 0; n < 2; ++n) {
            u32x2 w;
            w[0] = pk2(acc[ai][bj][m][n][0], acc[ai][bj][m][n][1]);
            w[1] = pk2(acc[ai][bj][m][n][2], acc[ai][bj][m][n][3]);
            *(u32x2*)(smem + tid * 8 + k * 4096) = w;
            ++k;
          }
    return;
  }
#endif
#pragma unroll
  for (int ai = 0; ai < 2; ++ai)
#pragma unroll
    for (int bj = 0; bj < 2; ++bj)
#pragma unroll
      for (int m = 0; m < 4; ++m)
#pragma unroll
        for (int n = 0; n < 2; ++n) {
          const int col = bj * 128 + wc * 32 + n * 16 + fr;
          const int row0 = ai * 128 + wr * 64 + m * 16 + fq * 4;
          u32x2 w;
          w[0] = pk2(acc[ai][bj][m][n][0], acc[ai][bj][m][n][1]);
          w[1] = pk2(acc[ai][bj][m][n][2], acc[ai][bj][m][n][3]);
          *(u32x2*)(smem + col * 512 + (((row0 >> 3) ^ (col & 31)) << 4) + ((row0 & 4) << 1)) = w;
        }
}
DI void unpack8(const u32x4 u, float* f) {
#pragma unroll
  for (int i = 0; i < 4; ++i) { f[2 * i] = __uint_as_float(u[i] << 16); f[2 * i + 1] = __uint_as_float(u[i] & 0xffff0000u); }
}
DI u32x4 pack8(const float* f) {
  u32x4 o;
#pragma unroll
  for (int i = 0; i < 4; ++i) o[i] = pk2(f[2 * i], f[2 * i + 1]);
  return o;
}

DI float bflo(unsigned u) { return __uint_as_float(u << 16); }
DI float bfhi(unsigned u) { return __uint_as_float(u & 0xffff0000u); }
DI float tok_rstd(const unsigned char* ws, int tok) {
  const float* q = (const float*)(ws + WS_SSQ) + tok;
  return rsqrtf((q[0] + q[NT] + q[2 * NT] + q[3 * (size_t)NT]) * (1.0f / 1024.0f) + 1e-6f);
}
DI void run_epilogue(const P& pin, const Job& jb, AccT& acc) {
  extern __shared__ __attribute__((aligned(16))) unsigned char smem[];
  const int TID = opaque_tid();
  P p = pin;
  asm volatile("" : "+s"(p.ws), "+s"(p.out));
  const int tm = jb.tm, tn = jb.tn, layer = jb.layer & 255, kind = jb.kind;
  const int nit = (jb.layer & 256) ? 8 : (jb.layer & 512) ? 1 : (jb.layer & 1024) ? 0 : 16;
#if PROBE_MASK
  if (kind == -1) return;
  if (kind == -3) {
    u32x4 z; z[0] = acc[0][0][0][0][0] > 1e30f ? 1u : 0u; z[1] = 2; z[2] = 3; z[3] = 4;
    for (int it = 0; it < 16; ++it) {
      const int q = it * 512 + TID;
      *(u32x4*)((u16*)(p.ws + WS_FF) + (size_t)(tn * 256 + (q >> 5)) * 4096 + tm * 256 + (q & 31) * 8) = z;
    }
    return;
  }
#endif
  if (kind == EK_S) {
    stage_acc(acc, smem, TID);
    __syncthreads();
    const int g = tn / 10, ct = tn % 10;
    const int pp = TID & 63, dir = (TID >> 6) & 1, sq = TID >> 7;
    const int nseq = ct < 8 ? 2 : 1, nc = ct < 8 ? 128 : 256;
    if (sq < nseq) {
      const float2 a = ((const float2*)(p.ws + WS_LPOW))[(size_t)(((layer * 2 + dir) * 32 + g) * 64 + pp) * 33 + 32];
      const int n = dir * 128 + pp * 2;
      unsigned* H = (unsigned*)((u16*)(p.ws + WS_ASSM) + ((size_t)g * NCH + ct * 256 + sq * nc) * ASTR + 512 + n);
      float hr = 0.f, hi = 0.f;
#pragma unroll 8
      for (int k = 0; k < nc; ++k) {
        const int c = dir == 0 ? k : nc - 1 - k;
        const int col = sq * nc + c;
        gst<unsigned>(H + (size_t)c * (ASTR / 2), pk2(hr, hi));
        const unsigned sv = *(const unsigned*)(smem + col * 512 + (((n >> 3) ^ (col & 31)) << 4) + (n & 7) * 2);
        const float nr = a.x * hr - a.y * hi + bflo(sv);
        hi = a.x * hi + a.y * hr + bfhi(sv);
        hr = nr;
      }
    }
    __syncthreads();
    return;
  }
#if PROBE_MASK
  if (jb.layer & 16384) { if (acc[1][1][3][1][3] == 12345.678f) smem[TID] = 1; }
  if (!(jb.layer & 2048))
  for (int rep = (jb.layer & 8192) ? 4 : 1; rep > 0; --rep)
#endif
  stage_acc(acc, smem, TID, (jb.layer & 4096) ? 1 : 0);
  float* lrs = (float*)(smem + 131072);
  if ((kind <= EK_U || kind == EK_M2 || kind == EK_M3 || kind == EK_FF1) && TID < 256) lrs[TID] = tok_rstd(p.ws, tn * 256 + TID);
  __syncthreads();
  const bool two_pass = kind == EK_Q || kind == EK_K || kind == EK_Y || kind == EK_M1 || kind == EK_M2 || kind == EK_M4;
  if (two_pass) {
    auto slot_of = [&](const int it, int& col, int& c) -> unsigned char* {
      const int q = it * 512 + TID;
      col = q >> 5; c = q & 31;
      return smem + col * 512 + ((c ^ (col & 31)) << 4);
    };
    if (kind == EK_M1 || kind == EK_M2 || kind == EK_M4) {
      const u16* T1 = (const u16*)(p.ws + WS_Q) + (size_t)(tn * 256) * 1024 + tm * 256;
      const u16* T2 = (const u16*)(p.ws + WS_ASSM) + (size_t)(tn * 256) * 1024 + tm * 256;
      if (kind == EK_M1) {
#pragma unroll 8
        for (int it = 0; it < 16; ++it) {
          int col, c; unsigned char* sl = slot_of(it, col, c);
          float f[8], a[8], r[8];
          unpack8(gld<u32x4>(T1 + (size_t)col * 1024 + c * 8), a);
          unpack8(*(const u32x4*)sl, f);
#pragma unroll
          for (int i = 0; i < 8; ++i) r[i] = f[i] * a[i];
          *(u32x4*)sl = pack8(r);
        }
      } else if (kind == EK_M2) {
#pragma unroll 8
        for (int it = 0; it < 16; ++it) {
          int col, c; unsigned char* sl = slot_of(it, col, c);
          float f[8], a[8], r[8];
          unpack8(gld<u32x4>(T1 + (size_t)col * 1024 + c * 8), a);
          unpack8(*(const u32x4*)sl, f);
          const float tr = lrs[col];
#pragma unroll
          for (int i = 0; i < 8; ++i) r[i] = sigmoidf_(f[i] * tr) * a[i];
          *(u32x4*)sl = pack8(r);
        }
      } else {
#pragma unroll 8
        for (int it = 0; it < 16; ++it) {
          int col, c; unsigned char* sl = slot_of(it, col, c);
          float f[8], a[8], b[8], r[8];
          unpack8(gld<u32x4>(T1 + (size_t)col * 1024 + c * 8), a);
          unpack8(gld<u32x4>(T2 + (size_t)col * 1024 + c * 8), b);
          unpack8(*(const u32x4*)sl, f);
#pragma unroll
          for (int i = 0; i < 8; ++i) r[i] = b[i] * f[i] + a[i];
          *(u32x4*)sl = pack8(r);
        }
      }
    } else if (kind == EK_Y) {
      const int g = tn / 10, ch0 = (tn % 10) * 256;
      const float* dsk = p.in[14] + layer * 512 + g * 16 + (TID & 1) * 8;
      const f32x4 d0 = *(const f32x4*)dsk, d1 = *(const f32x4*)(dsk + 4);
      const u16* UU = (const u16*)(p.ws + WS_ASSM) + ((size_t)g * NCH + ch0) * ASTR + tm * 256;
#pragma unroll 8
      for (int it = 0; it < 16; ++it) {
        int col, c; unsigned char* sl = slot_of(it, col, c);
        float f[8], u[8], r[8];
        unpack8(gld<u32x4>(UU + (size_t)col * ASTR + c * 8), u);
        unpack8(*(const u32x4*)sl, f);
#pragma unroll
        for (int i = 0; i < 4; ++i) { r[i] = gelu_tanh(f[i] + d0[i] * u[i]); r[4 + i] = gelu_tanh(f[4 + i] + d1[i] * u[4 + i]); }
        *(u32x4*)sl = pack8(r);
      }
    } else {
      const float* gn = (kind == EK_Q ? p.in[4] : p.in[5]) + layer * 64 + (TID & 7) * 8;
      const f32x4 g0 = *(const f32x4*)gn, g1 = *(const f32x4*)(gn + 4);
      const float qs = (kind == EK_Q) ? 0.125f * 1.4426950408889634f : 1.0f;
      const int i0 = (TID & 7) * 4;
#pragma unroll 4
      for (int it = 0; it < 16; ++it) {
        int col, c; unsigned char* sl = slot_of(it, col, c);
        const int tok = tn * 256 + col;
        const int pos = tok < NTP ? (tok & 4095) : ((tok - NTP) & 8191);
        const float* rp = (const float*)(p.ws + WS_ROPE) + 2 * ((i0 < 16) ? (pos >> 6) * 16 + i0 : (pos & 63) * 16 + i0 - 16);
        const f32x4 cs0 = gld<f32x4>(rp), cs1 = gld<f32x4>(rp + 4);
        float f[8], r[8];
        unpack8(*(const u32x4*)sl, f);
        const float tr = lrs[col];
        float ss = 0.f;
#pragma unroll
        for (int i = 0; i < 8; ++i) { f[i] *= tr; ss += f[i] * f[i]; }
        ss += __shfl_xor(ss, 1); ss += __shfl_xor(ss, 2); ss += __shfl_xor(ss, 4);
        const float rstd = rsqrtf(ss * (1.0f / 64.0f) + 1e-6f) * qs;
        const float x0 = f[0] * rstd * g0[0], x1 = f[1] * rstd * g0[1], x2 = f[2] * rstd * g0[2], x3 = f[3] * rstd * g0[3];
        const float x4 = f[4] * rstd * g1[0], x5 = f[5] * rstd * g1[1], x6 = f[6] * rstd * g1[2], x7 = f[7] * rstd * g1[3];
        r[0] = x0 * cs0[0] - x1 * cs0[1]; r[1] = x0 * cs0[1] + x1 * cs0[0];
        r[2] = x2 * cs0[2] - x3 * cs0[3]; r[3] = x2 * cs0[3] + x3 * cs0[2];
        r[4] = x4 * cs1[0] - x5 * cs1[1]; r[5] = x4 * cs1[1] + x5 * cs1[0];
        r[6] = x6 * cs1[2] - x7 * cs1[3]; r[7] = x6 * cs1[3] + x7 * cs1[2];
        *(u32x4*)sl = pack8(r);
      }
    }
#pragma unroll 4
    for (int it = 0; it < 16; ++it) {
      int col, c; unsigned char* sl = slot_of(it, col, c);
      const u32x4 v = *(const u32x4*)sl;
      u16* dst;
      if (kind == EK_Q) dst = (u16*)(p.ws + WS_Q) + (size_t)(tn * 256 + col) * 1024 + (tm * 4 + (c >> 3)) * 64 + (c & 7) * 8;
      else if (kind == EK_K) dst = (u16*)(p.ws + WS_K) + ((size_t)(c >> 3) * NT + tn * 256 + col) * 64 + (c & 7) * 8;
      else if (kind == EK_Y) dst = (u16*)(p.ws + WS_Y) + (size_t)(tn / 10) * NT * 16 + (size_t)((tn % 10) * 256 + col) * 512 + tm * 256 + c * 8;
      else dst = (u16*)(p.ws + WS_Q) + (size_t)(tn * 256 + col) * 1024 + tm * 256 + c * 8;
      gst<u32x4>(dst, v);
    }
    __syncthreads();
    return;
  }
  if (kind == EK_OUT || kind == EK_FF2) {
    const int cc = tm * 256 + (TID & 31) * 8;
#pragma unroll 1
    for (int it0 = 0; it0 < 16; it0 += 4) {
      f32x4 X0[4], X1[4];
#pragma unroll
      for (int k = 0; k < 4; ++k) {
        const int tok = tn * 256 + (((it0 + k) * 512 + TID) >> 5);
        const float* x = (kind == EK_OUT) ? xrow(p, layer, tok) + cc : p.out + (size_t)tok * 1024 + cc;
        X0[k] = gld<f32x4>(x); X1[k] = gld<f32x4>(x + 4);
      }
#pragma unroll
      for (int k = 0; k < 4; ++k) {
        const int q = (it0 + k) * 512 + TID;
        const int col = q >> 5, c = q & 31;
        const int tok = tn * 256 + col;
        float f[8], r[8];
        unpack8(*(const u32x4*)(smem + col * 512 + ((c ^ (col & 31)) << 4)), f);
        float* o = p.out + (size_t)tok * 1024 + cc;
        f32x4 o0, o1;
        float ss = 0.f;
#pragma unroll
        for (int i = 0; i < 4; ++i) { o0[i] = X0[k][i] + f[i]; o1[i] = X1[k][i] + f[4 + i]; r[i] = o0[i]; r[4 + i] = o1[i]; ss += o0[i] * o0[i] + o1[i] * o1[i]; }
        gst<f32x4>(o, o0); gst<f32x4>(o + 4, o1);
        gst<u32x4>((u16*)(p.ws + WS_XN) + (size_t)tok * 1024 + cc, pack8(r));
        ss += __shfl_xor(ss, 1); ss += __shfl_xor(ss, 2); ss += __shfl_xor(ss, 4); ss += __shfl_xor(ss, 8); ss += __shfl_xor(ss, 16);
        if (c == 0) ((float*)(p.ws + WS_SSQ))[(size_t)tm * NT + tok] = ss;
      }
    }
    __syncthreads();
    return;
  }
#pragma unroll 2
  for (int it = 0; it < nit; ++it) {
    const int q = it * 512 + TID;
    int col = q >> 5, c = q & 31;
    if (kind == EK_U) { col = (q >> 1) & 255; c = ((q >> 9) << 1) | (q & 1); }
    const u32x4 sv = *(const u32x4*)(smem + col * 512 + ((c ^ (col & 31)) << 4));
    float f[8], r[8];
    unpack8(sv, f);
#if PROBE_MASK
    if (kind == -2) { if (f[0] > 1e30f) *(u32x4*)(p.ws + WS_FF) = sv; continue; }
#endif
    switch (kind) {
      case EK_V: {
        {
          const int tok0 = tn * 256 + c * 8;
#pragma unroll
          for (int i = 0; i < 8; ++i) r[i] = f[i] * lrs[c * 8 + i];
          gst<u32x4>((u16*)(p.ws + WS_VT) + (size_t)col * NT + tok0, pack8(r));
        }
      } break;
      case EK_U: {
        const int tok = tn * 256 + col, g = (tm - 6) * 16 + (c >> 1);
        const float tr = lrs[col];
#pragma unroll
        for (int i = 0; i < 8; ++i) r[i] = f[i] * tr;
        gst<u32x4>((u16*)(p.ws + WS_ASSM) + ((size_t)g * NCH + (tok >> 5)) * ASTR + (tok & 31) * 16 + (c & 1) * 8, pack8(r));
      } break;
      case EK_M0: case EK_M3: {
        const size_t o = (size_t)(tn * 256 + col) * 1024 + tm * 256 + c * 8;
        const float tr = (kind == EK_M3) ? lrs[col] : 1.0f;
#pragma unroll
        for (int i = 0; i < 8; ++i) r[i] = sigmoidf_(f[i] * tr);
        gst<u32x4>((kind == EK_M3 ? (u16*)(p.ws + WS_ASSM) : (u16*)(p.ws + WS_Q)) + o, pack8(r));
      } break;
      case EK_FF1: {
        const float tr = lrs[col];
#pragma unroll
        for (int i = 0; i < 8; ++i) { const float a = fmaxf(f[i] * tr, 0.f); r[i] = a * a; }
        gst<u32x4>((u16*)(p.ws + WS_FF) + ((size_t)(tn * 16 + tm) << 16) + col * 256 + c * 8, pack8(r));
      } break;
    }
  }
  __syncthreads();
}

DI void make_job(const P& pin, int layer, int s, int w, int step, Job& jb) {
  struct { unsigned char* ws; } p;
  p.ws = pin.ws;
  asm volatile("" : "+s"(p.ws));
  const u16* XN = (const u16*)(p.ws + WS_XN);
  jb.layer = layer; jb.gsB = 16; jb.tmB = 0;
  if (s == 1) {
    int g = w / 10;
    jb.A = (const u16*)(p.ws + WS_W1T) + ((size_t)layer * 32 + g) * 256 * 512;
    jb.Bt = (const u16*)(p.ws + WS_ASSM) + (size_t)w * 256 * ASTR;
    jb.lda = 512; jb.ldb = ASTR; jb.K = 512; jb.kind = EK_S; jb.tm = 0; jb.tn = w;
    return;
  }
  if (s == 3) {
    int gc = w >> 1, rt = w & 1, g = gc / 10;
    jb.A = (const u16*)(p.ws + WS_WYT) + (((size_t)layer * 32 + g) * 512 + rt * 256) * ASTR;
    jb.Bt = (const u16*)(p.ws + WS_ASSM) + (size_t)gc * 256 * ASTR;
    jb.lda = ASTR; jb.ldb = ASTR; jb.K = ASTR; jb.kind = EK_Y; jb.tm = rt; jb.tn = gc;
    return;
  }
  const int nft = (s == 0) ? 8 : (s == 6) ? 16 : 4;
  int tt, ft; tile_map(w, nft, tt, ft);
  if (s == 6) {
    const int xcd = w & 7, r = w >> 3, blk = r >> 5, i = r & 31;
    ft = (blk & 1) * 8 + (i & 7);
    tt = ((blk >> 1) * 4 + (i >> 3)) * 8 + xcd;
  }
  jb.tm = ft; jb.tn = tt;
  jb.lda = 1024; jb.ldb = 1024; jb.K = 1024;
  if (s == 0) {
    const u16* W = (const u16*)(p.ws + WS_WT_IN) + (size_t)layer * 4096 * 1024 + (size_t)ft * 256 * 1024;
    const u16* X = XN + (size_t)tt * 256 * 1024;
    if (ft == 5) { jb.A = X; jb.Bt = W; jb.kind = EK_V; }
    else { jb.A = W; jb.Bt = X; jb.kind = ft < 4 ? EK_Q : ft == 4 ? EK_K : EK_U; }
  } else if (s == 4) {
    jb.kind = EK_M0 + step;
    if (step < 2) {
      jb.A = (const u16*)(p.ws + (step == 0 ? WS_WT_GB : WS_WT_GA)) + (size_t)layer * 1024 * 512 + (size_t)ft * 256 * 512;
      jb.Bt = (const u16*)(p.ws + WS_Y) + (size_t)tt * 256 * 16;
      jb.lda = 512; jb.ldb = 16; jb.gsB = NT * 16; jb.K = 512;
    } else if (step < 4) {
      jb.A = (const u16*)(p.ws + WS_WT_IN) + (size_t)layer * 4096 * 1024 + (size_t)((step == 2 ? 3072 : 2048) + ft * 256) * 1024;
      jb.Bt = XN + (size_t)tt * 256 * 1024;
    } else {
      jb.A = (const u16*)(p.ws + WS_WT_AP) + (size_t)layer * 1024 * 1024 + (size_t)ft * 256 * 1024;
      jb.Bt = (const u16*)(p.ws + WS_ATTO) + (size_t)tt * 256 * 1024;
    }
  } else if (s == 5) {
    jb.A = (const u16*)(p.ws + WS_WT_OUT) + (size_t)layer * 1024 * 1024 + (size_t)ft * 256 * 1024;
    jb.Bt = (const u16*)(p.ws + WS_Q) + (size_t)tt * 256 * 1024; jb.kind = EK_OUT;
  } else if (s == 6) {
    jb.A = (const u16*)(p.ws + WS_WT_FF1) + (size_t)layer * 4096 * 1024 + (size_t)ft * 256 * 1024;
    jb.Bt = XN + (size_t)tt * 256 * 1024; jb.kind = EK_FF1;
  } else {
    jb.A = (const u16*)(p.ws + WS_WT_FF2) + (size_t)layer * 1024 * 4096 + (size_t)ft * 256 * 4096;
    jb.Bt = (const u16*)(p.ws + WS_FF) + ((size_t)tt * 16 << 16);
    jb.lda = 4096; jb.ldb = 256; jb.tmB = 1; jb.K = 4096; jb.kind = EK_FF2;
  }
}

DI void phase_jobs(const P& p, int layer, int s, int probe = 0) {
  int nitems, nsteps = 1, nattn = 0;
  switch (s) {
    case 0: nitems = 2560; break;
    case 1: nitems = 320; break;
    case 3: nitems = 3200; nattn = 2560; break;
    case 4: nitems = 1280; nsteps = 5; break;
    case 5: nitems = 1280; break;
    case 6: nitems = 5120; break;
    default: nitems = 1280; break;
  }
#if STAGGER_SLEEP
  if (s != 3) {
    const int slot = (blockIdx.x >> 3) & 31;
    for (int i = 0; i < slot; ++i) __builtin_amdgcn_s_sleep(STAGGER_SLEEP);
  }
#endif
  for (int w = blockIdx.x; w < nitems; w += gridDim.x) {
    if (w < nattn) {
      int seq_start, L, head, qb;
      if (w < 512) {
        int xcd = w & 7, r = w >> 3;
        int seq = xcd >> 2, kvh = xcd & 3;
        seq_start = NTP + seq * 8192; L = 8192; head = kvh * 4 + (r >> 4); qb = r & 15;
      } else {
        int w2 = w - 512, xcd = w2 & 7, r = w2 >> 3;
        int grp = (r >> 5) * 8 + xcd, within = r & 31;
        int seq = grp >> 2, kvh = grp & 3;
        seq_start = seq * 4096; L = 4096; head = kvh * 4 + (within >> 3); qb = within & 7;
      }
      attn_item(p, layer, seq_start, L, head, qb);
    } else {
      for (int step = 0; step < nsteps; ++step) {
        Job jb;
        make_job(p, layer, s, w - nattn, step, jb);
#if PROBE_MASK
        if (probe == 2 || probe == 3) jb.kind = -1;
        if (probe == 3) jb.K = jb.K / 2;
#endif
        gemm_tile(jb.A, jb.Bt, jb.lda, jb.ldb, jb.gsB, jb.tmB, jb.K, [&](AccT& acc) {
          int w2 = w - nattn, st2 = step;
          asm volatile("" : "+s"(w2), "+s"(st2));
          Job j2;
          make_job(p, layer, s, w2, st2, j2);
#if PROBE_MASK
          if (probe == 2 || probe == 3) j2.kind = -1;
          if (probe == 4) j2.kind = -2;
          if (probe == 6) j2.layer |= 256;
          if (probe == 7) j2.layer |= 512;
          if (probe == 8) j2.layer |= 1024 | 2048;
          if (probe == 9) j2.layer |= 1024;
          if (probe == 10) j2.layer |= 1024 | 4096;
          if (probe == 11) j2.layer |= 1024 | 8192;
          if (probe == 12) j2.layer |= 1024 | 2048 | 16384;
          if (probe == 5) j2.kind = -3;
#endif
          run_epilogue(p, j2, acc);
        });
      }
    }
  }
}

DI void run_phase(const P& pin, int ph, int probe = 0) {
  P p = pin;
  asm volatile("" : "+s"(p.ws), "+s"(p.out));
  int layer = (ph - 3) / 8, s = (ph - 3) % 8;
  if (s == 2) phase_scan(p, layer);
  else phase_jobs(p, layer, s, probe);
}

constexpr size_t WS_BAR = WS_ROPE + 512 * 1024;
#define XB_XCNT(j) (256 + 64 * (j))
#define XB_XSUB(j) (1280 + 64 * (j))
#define XB_XGEN(j) (2304 + 64 * (j))
#define XB_TOP 3328
#define XB_TOPGEN 3392
#define XB_WORDS 3456
DI unsigned xb_ld(unsigned* q) { return __hip_atomic_load(q, __ATOMIC_RELAXED, __HIP_MEMORY_SCOPE_AGENT); }
DI unsigned xb_add(unsigned* q, unsigned v) { return __hip_atomic_fetch_add(q, v, __ATOMIC_RELAXED, __HIP_MEMORY_SCOPE_AGENT); }
DI unsigned xb_xcc_id() { return (unsigned)__builtin_amdgcn_s_getreg((3 << 11) | 20) & 0xFu; }
#define XB_SPIN(cond) do { unsigned _sp = 0; while ((cond) && ++_sp < (1u << 22)) __builtin_amdgcn_s_sleep(1); } while (0)
DI void xcd_bar(unsigned char* ws) {
  unsigned* bar = (unsigned*)(ws + WS_BAR);
  const unsigned x = xb_xcc_id();
  extern __shared__ __attribute__((aligned(16))) unsigned char smem[];
  asm volatile("s_waitcnt vmcnt(0)" ::: "memory");
  __syncthreads();
  if (threadIdx.x == 0) {
    __builtin_amdgcn_s_waitcnt(0);
    volatile unsigned* st = (volatile unsigned*)(smem + 132096);
    const unsigned nloc = st[0], nx = st[1];
    const unsigned old = xb_add(&bar[XB_XSUB(x)], 1u);
    const unsigned gen = old / nloc;
    if (old + 1u == (gen + 1u) * nloc) {
      __builtin_amdgcn_fence(__ATOMIC_RELEASE, "agent");
      asm volatile("s_waitcnt vmcnt(0)" ::: "memory");
      const unsigned og = xb_add(&bar[XB_TOP], 1u);
      const unsigned tg = og / nx;
      if (og + 1u == (tg + 1u) * nx) xb_add(&bar[XB_TOPGEN], 1u);
      else XB_SPIN(xb_ld(&bar[XB_TOPGEN]) == tg);
      __builtin_amdgcn_fence(__ATOMIC_ACQUIRE, "agent");
      xb_add(&bar[XB_XGEN(x)], 1u);
      asm volatile("s_waitcnt vmcnt(0)" ::: "memory");
    } else {
      XB_SPIN(xb_ld(&bar[XB_XGEN(x)]) == gen);
      __builtin_amdgcn_fence(__ATOMIC_ACQUIRE, "agent");
      asm volatile("s_waitcnt vmcnt(0)" ::: "memory");
    }
  }
  __syncthreads();
}

__global__ void __launch_bounds__(512, 2) mega_coop(P p) {
  cg::grid_group grid = cg::this_grid();
  if (threadIdx.x == 0) (void)xb_add(&((unsigned*)(p.ws + WS_BAR))[XB_XCNT(xb_xcc_id())], 1u);
  phase_prep_a(p);
  phase_convert(p, p.in[0], p.in[1]);
  grid.sync();
  if (threadIdx.x == 0) {
    extern __shared__ __attribute__((aligned(16))) unsigned char smem_[];
    unsigned* bar = (unsigned*)(p.ws + WS_BAR);
    const unsigned xcc = xb_xcc_id();
    unsigned mine = 0, cnt = 0;
    for (unsigned j = 0; j < 16; ++j) { const unsigned c = xb_ld(&bar[XB_XCNT(j)]); cnt += c > 0u ? 1u : 0u; mine = j == xcc ? c : mine; }
    volatile unsigned* st = (volatile unsigned*)(smem_ + 132096);
    st[0] = mine > 0u ? mine : 1u; st[1] = cnt > 0u ? cnt : 1u;
  }
  __syncthreads();
#if USE_XCD_BAR
#define SEAM() xcd_bar(p.ws)
#else
#define SEAM() grid.sync()
#endif
  for (int ph = 3; ph < NPHASE; ++ph) {
    if ((ph - 3) % 8 == 2) continue;
    run_phase(p, ph);
    if (ph == 3) phase_prep_b(p);
    if (ph == 4) phase_prep_c(p);
#if PROBE_MASK
    {
      const int s_ = (ph - 3) % 8;
      bool rep = false;
      if ((PROBE_MASK & 1) && s_ == 3) rep = true;
      if ((PROBE_MASK & 2) && (s_ == 0 || s_ == 4 || s_ == 6)) rep = true;
      if ((PROBE_MASK & 4) && (s_ == 1 || s_ == 2)) rep = true;
      if ((PROBE_MASK & 8) && s_ == 6) run_phase(p, ph, (PROBE_MASK >> 4));
      if (rep) run_phase(p, ph);
    }
#endif
    if (ph + 1 < NPHASE) SEAM();
  }
}
#if N_LAUNCH_MODE == 0
__global__ void __launch_bounds__(512, 2) mega_one(P p) {
  run_phase(p, p.ph_lo);
}
#endif

extern "C" void kernel_launch(void* const* d_in, const int* in_sizes, int n_in, void* d_out, int out_size, void* d_ws, size_t ws_size,
                              hipStream_t stream) {
  static int grid = 0;
  if (grid == 0) {
    if (n_in != 21 || ws_size < WS_END) { fprintf(stderr, "kernel_launch: unexpected n_in %d / ws_size %zu (need %zu)\n", n_in, ws_size, (size_t)WS_END); grid = -1; return; }
    int dev = 0, cus = 0, per_cu = 0;
    hipGetDevice(&dev);
    hipDeviceGetAttribute(&cus, hipDeviceAttributeMultiprocessorCount, dev);
    hipFuncSetAttribute((const void*)mega_coop, hipFuncAttributeMaxDynamicSharedMemorySize, LDS_BYTES);
#if N_LAUNCH_MODE == 0
    hipFuncSetAttribute((const void*)mega_one, hipFuncAttributeMaxDynamicSharedMemorySize, LDS_BYTES);
#endif
    hipOccupancyMaxActiveBlocksPerMultiprocessor(&per_cu, (const void*)mega_coop, 512, LDS_BYTES);
    if (per_cu < 1) { fprintf(stderr, "kernel_launch: occupancy query says %d blocks/CU\n", per_cu); per_cu = 1; }
    (void)hipGetLastError();
    grid = cus * 1;
  }
  if (grid < 0) return;
  P p{};
  for (int i = 0; i < 21; ++i) p.in[i] = (const float*)d_in[i];
  p.out = (float*)d_out;
  p.ws = (unsigned char*)d_ws;
#if N_LAUNCH_MODE == 1
  p.ph_lo = 0; p.ph_hi = NPHASE;
  void* args[] = {&p};
  if (hipMemsetAsync((unsigned char*)d_ws + WS_BAR, 0, 16384, stream) != hipSuccess) { fprintf(stderr, "kernel_launch: barrier memset failed\n"); return; }
  hipError_t e = hipLaunchCooperativeKernel((const void*)mega_coop, dim3(grid), dim3(512), args, LDS_BYTES, stream);
  if (e != hipSuccess) fprintf(stderr, "cooperative launch failed: %s (grid %d)\n", hipGetErrorString(e), grid);
#else
  for (int ph = 0; ph < NPHASE; ++ph) {
    p.ph_lo = ph; p.ph_hi = ph + 1;
    hipLaunchKernelGGL(mega_one, dim3(grid), dim3(512), LDS_BYTES, stream, p);
  }
#endif
}
```

```cpp
#include <hip/hip_runtime.h>
#include <hip/hip_cooperative_groups.h>
#include <cstdio>
namespace cg = cooperative_groups;

typedef unsigned short u16;
typedef __attribute__((ext_vector_type(8))) short bf16x8;
typedef __attribute__((ext_vector_type(4))) float f32x4;
typedef __attribute__((ext_vector_type(16))) float f32x16;
typedef __attribute__((ext_vector_type(4))) unsigned u32x4;
typedef __attribute__((ext_vector_type(2))) unsigned u32x2;
typedef __attribute__((ext_vector_type(2))) float f32x2;
typedef __attribute__((ext_vector_type(2))) __bf16 bf16v2;

#define DI __device__ __forceinline__
#ifndef PROBE_MASK
#define PROBE_MASK 0
#endif
#ifndef STAGGER_SLEEP
#define STAGGER_SLEEP 0
#endif
#ifndef USE_XCD_BAR
#define USE_XCD_BAR 1
#endif
#ifndef N_LAUNCH_MODE
#define N_LAUNCH_MODE 1
#endif

constexpr int NT = 81920;
constexpr int NTP = 65536;
constexpr int NCH = 2560;
constexpr int ASTR = 768;
constexpr int NPHASE = 19;
constexpr int LDS_BYTES = 131072 + 1024 + 16;

constexpr size_t MiB = 1ull << 20;
constexpr size_t WS_WT_IN = 0;
constexpr size_t WS_WT_AP = 16 * MiB;
constexpr size_t WS_WT_GA = 20 * MiB;
constexpr size_t WS_WT_GB = 22 * MiB;
constexpr size_t WS_WT_OUT = 24 * MiB;
constexpr size_t WS_WT_FF1 = 28 * MiB;
constexpr size_t WS_WT_FF2 = 44 * MiB;
constexpr size_t WS_W1T = 60 * MiB;
constexpr size_t WS_WYT = 76 * MiB;
constexpr size_t WS_LPOW = 124 * MiB;
constexpr size_t WS_BBAR = 127 * MiB;
constexpr size_t WS_KTAB = 128 * MiB;
constexpr size_t WS_ROPE = 132 * MiB;
constexpr size_t WS_SSQ = 133 * MiB;
constexpr size_t WS_XN = 135 * MiB;
constexpr size_t WS_BIG = 295 * MiB;
constexpr size_t WS_Q = WS_BIG;
constexpr size_t WS_K = WS_BIG + 160 * MiB;
constexpr size_t WS_VT = WS_BIG + 200 * MiB;
constexpr size_t WS_ASSM = WS_BIG + 240 * MiB;
constexpr size_t WS_S = WS_BIG + 360 * MiB;
constexpr size_t WS_Y = WS_BIG + 440 * MiB;
constexpr size_t WS_ATTO = WS_BIG + 520 * MiB;
constexpr size_t WS_FF = WS_BIG;
constexpr size_t WS_END = WS_BIG + 680 * MiB;

struct P {
  const float* in[21];
  float* out;
  unsigned char* ws;
  int ph_lo, ph_hi;
};

DI u16 f2bf(float f) { unsigned u = __float_as_uint(f); u += 0x7fffu + ((u >> 16) & 1u); return (u16)(u >> 16); }
DI float bf2f(u16 h) { return __uint_as_float(((unsigned)h) << 16); }
DI unsigned pk2(float a, float b) {
  f32x2 v; v[0] = a; v[1] = b;
  bf16v2 r = __builtin_convertvector(v, bf16v2);
  return __builtin_bit_cast(unsigned, r);
}
DI float sigmoidf_(float x) { return 1.0f / (1.0f + __expf(-x)); }
DI float gelu_tanh(float x) {
  float z = 0.7978845608028654f * (x + 0.044715f * x * x * x);
  float e = __expf(2.0f * z);
  return 0.5f * x * (2.0f - 2.0f / (e + 1.0f));
}


DI void sincos_d(double x, double* sn, double* cs) {
  const double TWO_PI_HI = 6.283185307179586232e+00, TWO_PI_LO = 2.449293598294706414e-16;
  double k = rint(x * 0.15915494309189534561);
  double r = (x - k * TWO_PI_HI) - k * TWO_PI_LO;
  r *= 0.25;
  double r2 = r * r;
  double s = 1.0, c = 1.0;
  s = 1.0 - r2 / (18.0 * 19.0);
  s = 1.0 - r2 / (16.0 * 17.0) * s;
  s = 1.0 - r2 / (14.0 * 15.0) * s;
  s = 1.0 - r2 / (12.0 * 13.0) * s;
  s = 1.0 - r2 / (10.0 * 11.0) * s;
  s = 1.0 - r2 / (8.0 * 9.0) * s;
  s = 1.0 - r2 / (6.0 * 7.0) * s;
  s = 1.0 - r2 / (4.0 * 5.0) * s;
  s = 1.0 - r2 / (2.0 * 3.0) * s;
  s *= r;
  c = 1.0 - r2 / (17.0 * 18.0);
  c = 1.0 - r2 / (15.0 * 16.0) * c;
  c = 1.0 - r2 / (13.0 * 14.0) * c;
  c = 1.0 - r2 / (11.0 * 12.0) * c;
  c = 1.0 - r2 / (9.0 * 10.0) * c;
  c = 1.0 - r2 / (7.0 * 8.0) * c;
  c = 1.0 - r2 / (5.0 * 6.0) * c;
  c = 1.0 - r2 / (3.0 * 4.0) * c;
  c = 1.0 - r2 / (1.0 * 2.0) * c;
  double s2 = 2.0 * s * c, c2 = c * c - s * s;
  *sn = 2.0 * s2 * c2; *cs = c2 * c2 - s2 * s2;
}

template <class T> DI T gld(const void* q) { return *(const __attribute__((address_space(1))) T*)q; }
template <class T> DI void gst(void* q, const T v) { *(__attribute__((address_space(1))) T*)q = v; }
DI int opaque_tid() { int t = threadIdx.x; asm volatile("" : "+v"(t)); return t; }
DI const char* sgpr_ptr(const char* p) { asm("" : "+s"(p)); return p; }
#define WAIT_V(n) asm volatile("s_waitcnt vmcnt(" #n ")" ::: "memory")
#define WAIT_L(n) asm volatile("s_waitcnt lgkmcnt(" #n ")" ::: "memory")
#define BAR __builtin_amdgcn_s_barrier()
#define SCHED __builtin_amdgcn_sched_barrier(0)
#define GLDS(gp, lp) __builtin_amdgcn_global_load_lds((const unsigned*)(gp), (unsigned*)(lp), 16, 0, 0)

constexpr int GBK = 64, GHALF = 128, GHT = GHALF * GBK;
DI int lds_byte(int r, int c) {
  int st = (r >> 4) * 2 + (c >> 5), rr = r & 15, cc = c & 31, ob = rr * 64 + cc * 2;
  return st * 1024 + (ob ^ (((ob >> 9) & 1) << 5));
}
DI void stage_rc(int b, int& R, int& C) {
  int st = b / 1024, sb = b % 1024, swz = sb ^ (((sb >> 9) & 1) << 5);
  R = (st >> 1) * 16 + swz / 64; C = (st & 1) * 32 + (swz % 64) / 2;
}

typedef f32x4 AccT[2][2][4][2];

template <class Epi>
DI void gemm_tile(const u16* __restrict__ A, const u16* __restrict__ Bt, const int lda, const int ldb, const int gsB, const int tmB, const int K, Epi&& epi) {
  const int TID = opaque_tid();
  extern __shared__ __attribute__((aligned(16))) unsigned char smem[];
  u16* shm = (u16*)smem;
#define SA(b, h) (shm + ((b) * 2 + (h)) * GHT)
#define SB(b, h) (shm + (4 + (b) * 2 + (h)) * GHT)
  int R0, C0, R1, C1;
  stage_rc(TID * 16, R0, C0);
  stage_rc(TID * 16 + 8192, R1, C1);
  const unsigned voA0 = (unsigned)(R0 * lda + C0) * 2u, voA1 = (unsigned)(R1 * lda + C1) * 2u;
  const unsigned voB0 = (unsigned)(R0 * ldb + (C0 & 15) + (C0 >> 4) * gsB) * 2u, voB1 = (unsigned)(R1 * ldb + (C1 & 15) + (C1 >> 4) * gsB) * 2u;
  const int hA = GHALF * lda, hB = GHALF * ldb;
  const unsigned wid_u = __builtin_amdgcn_readfirstlane(TID >> 6);
#define STAGE_A(PTR, half, kt) do { const char* _g = sgpr_ptr((const char*)(A + (size_t)(half) * hA + (size_t)(kt) * GBK)); \
    char* _l = (char*)(PTR) + wid_u * 1024u; \
    GLDS(_g + voA0, _l); GLDS(_g + voA1, _l + 8192); } while (0)
#define STAGE_B(PTR, half, kt) do { const char* _g = sgpr_ptr((const char*)(Bt + (size_t)(half) * hB + (tmB ? (size_t)((((kt) >> 2) << 16) + (((kt) & 3) << 6)) : (size_t)(kt) * (size_t)(4 * gsB)))); \
    char* _l = (char*)(PTR) + wid_u * 1024u; \
    GLDS(_g + voB0, _l); GLDS(_g + voB1, _l + 8192); } while (0)
#define LDA(dst, b, h) for (int m = 0; m < 4; ++m) for (int k = 0; k < 2; ++k) \
    dst[m][k] = *reinterpret_cast<const bf16x8*>((char*)SA(b, h) + lds_byte(wr * 64 + m * 16 + fr, k * 32 + fq * 8))
#define LDB(dst, b, h) for (int n = 0; n < 2; ++n) for (int k = 0; k < 2; ++k) \
    dst[n][k] = *reinterpret_cast<const bf16x8*>((char*)SB(b, h) + lds_byte(wc * 32 + n * 16 + fr, k * 32 + fq * 8))
#define MMA(ai, bj, At, Bq) do { __builtin_amdgcn_s_setprio(1); \
    for (int m = 0; m < 4; ++m) for (int n = 0; n < 2; ++n) for (int k = 0; k < 2; ++k) \
      acc[ai][bj][m][n] = __builtin_amdgcn_mfma_f32_16x16x32_bf16(At[m][k], Bq[n][k], acc[ai][bj][m][n], 0, 0, 0); \
    __builtin_amdgcn_s_setprio(0); } while (0)

  const int wid = TID >> 6, lane = TID & 63, wr = wid >> 2, wc = wid & 3, fr = lane & 15, fq = lane >> 4;
  AccT acc;
#pragma unroll
  for (int a = 0; a < 2; ++a)
#pragma unroll
    for (int b = 0; b < 2; ++b)
#pragma unroll
      for (int m = 0; m < 4; ++m)
#pragma unroll
        for (int n = 0; n < 2; ++n) acc[a][b][m][n] = f32x4{0.f, 0.f, 0.f, 0.f};
  bf16x8 At[4][2], B0[2][2], B1[2][2];
  const int nt = K / GBK;
  STAGE_B(SB(0, 0), 0, 0); STAGE_A(SA(0, 0), 0, 0);
  STAGE_B(SB(0, 1), 1, 0); STAGE_A(SA(0, 1), 1, 0);
  if (wr == 1) BAR;
  WAIT_V(4); BAR;
  STAGE_B(SB(1, 0), 0, 1); STAGE_A(SA(1, 0), 0, 1); STAGE_B(SB(1, 1), 1, 1);
  WAIT_V(6); BAR;
  for (int t = 0; t < nt - 2; t += 2) {
    LDB(B0, 0, 0); SCHED; LDA(At, 0, 0); STAGE_A(SA(1, 1), 1, t + 1);
    WAIT_L(8); BAR; WAIT_L(0); MMA(0, 0, At, B0); BAR; SCHED;
    LDB(B1, 0, 1); STAGE_B(SB(0, 0), 0, t + 2);
    BAR; WAIT_L(0); MMA(0, 1, At, B1); BAR;
    LDA(At, 0, 1); STAGE_A(SA(0, 0), 0, t + 2);
    BAR; WAIT_L(0); MMA(1, 0, At, B0); BAR; SCHED;
    STAGE_B(SB(0, 1), 1, t + 2);
    WAIT_V(6); BAR; MMA(1, 1, At, B1); BAR;
    LDB(B0, 1, 0); SCHED; LDA(At, 1, 0); STAGE_A(SA(0, 1), 1, t + 2);
    WAIT_L(8); BAR; WAIT_L(0); MMA(0, 0, At, B0); BAR; SCHED;
    LDB(B1, 1, 1); STAGE_B(SB(1, 0), 0, t + 3);
    BAR; WAIT_L(0); MMA(0, 1, At, B1); BAR;
    LDA(At, 1, 1); STAGE_A(SA(1, 0), 0, t + 3);
    BAR; WAIT_L(0); MMA(1, 0, At, B0); BAR; SCHED;
    STAGE_B(SB(1, 1), 1, t + 3);
    WAIT_V(6); BAR; MMA(1, 1, At, B1); BAR;
  }
  { LDB(B0, 0, 0); LDA(At, 0, 0); STAGE_A(SA(1, 1), 1, nt - 1);
    BAR; WAIT_L(0); MMA(0, 0, At, B0); BAR;
    LDB(B1, 0, 1); BAR; WAIT_L(0); MMA(0, 1, At, B1); BAR;
    LDA(At, 0, 1); WAIT_V(4); BAR; WAIT_L(0); MMA(1, 0, At, B0); MMA(1, 1, At, B1); BAR; }
  { LDB(B0, 1, 0); LDA(At, 1, 0); WAIT_V(2); BAR; WAIT_L(0); MMA(0, 0, At, B0); BAR;
    LDB(B1, 1, 1); WAIT_V(0); BAR; WAIT_L(0); MMA(0, 1, At, B1); BAR;
    LDA(At, 1, 1); BAR; WAIT_L(0); MMA(1, 0, At, B0); MMA(1, 1, At, B1); BAR; }
  if (wr == 0) BAR;
  epi(acc);
#undef SA
#undef SB
}

template <class F>
DI void epi_for(AccT& acc, F&& f) {
  const int TID = opaque_tid();
  const int _wid = TID >> 6, _lane = TID & 63, _wr = _wid >> 2, _wc = _wid & 3, _fr = _lane & 15, _fq = _lane >> 4;
#pragma unroll
  for (int _ai = 0; _ai < 2; ++_ai)
#pragma unroll
    for (int _bj = 0; _bj < 2; ++_bj)
#pragma unroll
      for (int _m = 0; _m < 4; ++_m)
#pragma unroll
        for (int _n = 0; _n < 2; ++_n)
          f(_ai * 128 + _wr * 64 + _m * 16 + _fq * 4, _bj * 128 + _wc * 32 + _n * 16 + _fr, acc[_ai][_bj][_m][_n]);
}

DI void tile_map(int w, int ntn, int& tm, int& tn) {
  int xcd = w & 7, r = w >> 3;
  tn = r % ntn; tm = (r / ntn) * 8 + xcd;
}

DI void transpose_tile(const float* __restrict__ src, int N, u16* __restrict__ dst, int K, int tk, int tn, const float* __restrict__ gain) {
  const int TID = opaque_tid();
  extern __shared__ __attribute__((aligned(16))) unsigned char smem[];
  float* tile = (float*)smem;
  const int t = TID;
  {
    const int cs = (t & 15) * 4;
    float4 v[8];
#pragma unroll
    for (int i = 0; i < 8; ++i) v[i] = *(const float4*)(src + (size_t)(tk * 256 + (t >> 4) + 32 * i) * N + tn * 64 + cs);
#pragma unroll
    for (int i = 0; i < 8; ++i) {
      const int rk = (t >> 4) + 32 * i;
      const float gk = gain ? gain[tk * 256 + rk] : 1.0f;
      float* d = tile + rk * 65 + cs;
      d[0] = v[i].x * gk; d[1] = v[i].y * gk; d[2] = v[i].z * gk; d[3] = v[i].w * gk;
    }
  }
  __syncthreads();
  {
    const int n = t >> 3, ks = (t & 7) * 32;
#pragma unroll
    for (int j = 0; j < 4; ++j) {
      const float* q = tile + (ks + 8 * j) * 65 + n;
      u32x4 o;
      o[0] = pk2(q[0], q[65]); o[1] = pk2(q[130], q[195]); o[2] = pk2(q[260], q[325]); o[3] = pk2(q[390], q[455]);
      *(u32x4*)(dst + (size_t)(tn * 64 + n) * K + tk * 256 + ks + 8 * j) = o;
    }
  }
  __syncthreads();
}

DI void phase_prep_a(const P& p) {
  const int TID = opaque_tid();
  const int bid = blockIdx.x, nb = gridDim.x;
  for (int w = bid; w < 1920; w += nb) {
    int layer = w / 960, r = w % 960;
    const float* src; u16* dst; int K, N, tl; const float* gain = nullptr;
    if (r < 256) { src = p.in[3] + (size_t)layer * 1024 * 4096; dst = (u16*)(p.ws + WS_WT_IN) + (size_t)layer * 4096 * 1024; K = 1024; N = 4096; tl = r; gain = p.in[2] + layer * 1024; }
    else if (r < 320) { src = p.in[6] + (size_t)layer * 1024 * 1024; dst = (u16*)(p.ws + WS_WT_AP) + (size_t)layer * 1024 * 1024; K = 1024; N = 1024; tl = r - 256; }
    else if (r < 352) { src = p.in[15] + (size_t)layer * 512 * 1024; dst = (u16*)(p.ws + WS_WT_GA) + (size_t)layer * 1024 * 512; K = 512; N = 1024; tl = r - 320; }
    else if (r < 384) { src = p.in[16] + (size_t)layer * 512 * 1024; dst = (u16*)(p.ws + WS_WT_GB) + (size_t)layer * 1024 * 512; K = 512; N = 1024; tl = r - 352; }
    else if (r < 448) { src = p.in[17] + (size_t)layer * 1024 * 1024; dst = (u16*)(p.ws + WS_WT_OUT) + (size_t)layer * 1024 * 1024; K = 1024; N = 1024; tl = r - 384; }
    else if (r < 704) { src = p.in[19] + (size_t)layer * 1024 * 4096; dst = (u16*)(p.ws + WS_WT_FF1) + (size_t)layer * 4096 * 1024; K = 1024; N = 4096; tl = r - 448; gain = p.in[18] + layer * 1024; }
    else { src = p.in[20] + (size_t)layer * 4096 * 1024; dst = (u16*)(p.ws + WS_WT_FF2) + (size_t)layer * 1024 * 4096; K = 4096; N = 1024; tl = r - 704; }
    int ntn = N / 64;
    transpose_tile(src, N, dst, K, tl / ntn, tl % ntn, gain);
  }
  const int gtid = bid * 512 + TID, nth = nb * 512;
  float2* LP = (float2*)(p.ws + WS_LPOW);
  float2* BB = (float2*)(p.ws + WS_BBAR);
  for (int idx = gtid; idx < 8192 * 33; idx += nth) {
    const int i = idx / 33, tau = idx - i * 33, lg = i >> 6;
    const double step = exp((double)p.in[9][lg]);
    const double zr = (double)p.in[7][i] * step, zi = (double)p.in[8][i] * step;
    double e = exp(zr * tau), sn, cs;
    sincos_d(zi * tau, &sn, &cs);
    LP[idx] = make_float2((float)(e * cs), (float)(e * sn));
  }
  for (int idx = gtid; idx < 8192 * 16; idx += nth) {
    const int i = idx >> 4, ci = idx & 15, lg = i >> 6;
    const double step = exp((double)p.in[9][lg]);
    const double lr = p.in[7][i], li = p.in[8][i];
    const double zr = lr * step, zi = li * step;
    double e = exp(zr), sn, cs;
    sincos_d(zi, &sn, &cs);
    const double nr = e * cs - 1.0, ni = e * sn, den = lr * lr + li * li;
    const double fr = (nr * lr + ni * li) / den, fi = (ni * lr - nr * li) / den;
    const double br = p.in[10][idx], bi = p.in[11][idx];
    BB[idx] = make_float2((float)(fr * br - fi * bi), (float)(fr * bi + fi * br));
  }
  float2* RP = (float2*)(p.ws + WS_ROPE);
  for (int i = gtid; i < 128 * 16; i += nth) {
    int pos = i >> 4, f = i & 15;
    double inv = exp(-(double)(2 * f) / 32.0 * 9.210340371976184);
    double sn, cs;
    sincos_d((double)pos * inv, &sn, &cs);
    RP[i] = make_float2((float)cs, (float)sn);
  }
}

DI void phase_prep_b(const P& p) {
  const int TID = opaque_tid();
  const int gtid = blockIdx.x * 512 + TID, nth = gridDim.x * 512;
  const float2* LP = (const float2*)(p.ws + WS_LPOW);
  const float2* BB = (const float2*)(p.ws + WS_BBAR);
  float* KT = (float*)(p.ws + WS_KTAB);
  const float* cre = p.in[12];
  const float* cim = p.in[13];
  {
    extern __shared__ __attribute__((aligned(16))) unsigned char smem[];
    float2* Cs = (float2*)smem;
    float2* Bs = Cs + 1024;
    float2* Ls = Bs + 1024;
    for (int item = blockIdx.x; item < 256; item += gridDim.x) {
      const int lg = item >> 1, th = item & 1;
      for (int e = TID; e < 1024; e += 512) {
        Cs[e] = make_float2(cre[(size_t)lg * 1024 + e], cim[(size_t)lg * 1024 + e]);
        Bs[e] = BB[(size_t)lg * 1024 + e];
        Ls[e] = LP[(size_t)(lg * 64 + (e >> 4)) * 33 + th * 16 + (e & 15)];
      }
      __syncthreads();
      const int co = (TID >> 4) & 15, ci = TID & 15, tsel = TID >> 8;
      float a8[8];
#pragma unroll
      for (int k = 0; k < 8; ++k) a8[k] = 0.f;
      for (int pp = 0; pp < 64; ++pp) {
        const float2 c = Cs[co * 64 + pp], b = Bs[pp * 16 + ci];
        const float zr = c.x * b.x - c.y * b.y, zi = c.x * b.y + c.y * b.x;
#pragma unroll
        for (int k = 0; k < 8; ++k) { const float2 l = Ls[pp * 16 + tsel + 2 * k]; a8[k] += zr * l.x - zi * l.y; }
      }
#pragma unroll
      for (int k = 0; k < 8; ++k) KT[(((size_t)lg * 32 + th * 16 + tsel + 2 * k) * 16 + co) * 16 + ci] = a8[k];
      __syncthreads();
    }
  }
  u16* W1 = (u16*)(p.ws + WS_W1T);
  for (int i8 = gtid; i8 < (1 << 20); i8 += nth) {
    const int i = i8 << 3;
    const int k = i & 511, n = (i >> 9) & 255, g = (i >> 17) & 31, layer = i >> 22;
    const int dir = n >> 7, pp = (n >> 1) & 63, ri = n & 1, sidx = k >> 4, ci0 = k & 15;
    const int e = dir ? sidx : 31 - sidx;
    const int lg = (layer * 2 + dir) * 32 + g;
    const float2 l = LP[(size_t)(lg * 64 + pp) * 33 + e];
    const float2* b = BB + (size_t)(lg * 64 + pp) * 16 + ci0;
    float v[8];
#pragma unroll
    for (int q = 0; q < 8; ++q) { const float2 bq = b[q]; v[q] = ri ? (l.x * bq.y + l.y * bq.x) : (l.x * bq.x - l.y * bq.y); }
    u32x4 o;
    o[0] = pk2(v[0], v[1]); o[1] = pk2(v[2], v[3]); o[2] = pk2(v[4], v[5]); o[3] = pk2(v[6], v[7]);
    *(u32x4*)(W1 + i) = o;
  }
  u16* WY = (u16*)(p.ws + WS_WYT);
  for (int i8 = gtid; i8 < (1 << 20); i8 += nth) {
    const int i = i8 << 3;
    const int kk = i & 255, n = (i >> 8) & 511, g = (i >> 17) & 31, layer = i >> 22;
    const int t = n >> 4, co = n & 15, dir = kk >> 7, pp0 = (kk >> 1) & 63;
    const int e = dir ? 32 - t : t + 1;
    const int lg = (layer * 2 + dir) * 32 + g;
    float v[8];
#pragma unroll
    for (int q = 0; q < 4; ++q) {
      const float cr = cre[(size_t)(lg * 16 + co) * 64 + pp0 + q], cI = cim[(size_t)(lg * 16 + co) * 64 + pp0 + q];
      const float2 l = LP[(size_t)(lg * 64 + pp0 + q) * 33 + e];
      v[2 * q] = cr * l.x - cI * l.y;
      v[2 * q + 1] = -(cr * l.y + cI * l.x);
    }
    u32x4 o;
    o[0] = pk2(v[0], v[1]); o[1] = pk2(v[2], v[3]); o[2] = pk2(v[4], v[5]); o[3] = pk2(v[6], v[7]);
    *(u32x4*)(WY + ((size_t)((layer * 32 + g) * 512 + n)) * ASTR + 512 + kk) = o;
  }
}

DI void phase_prep_c(const P& p) {
  const int TID = opaque_tid();
#if PROBE_MASK & 64
  {
    u32x4* dst = (u32x4*)(p.ws + WS_FF);
    u32x4 z; z[0] = 1; z[1] = 2; z[2] = 3; z[3] = 4;
    for (unsigned i = blockIdx.x * 512 + TID; i < 640u * 65536u; i += gridDim.x * 512) { z[0] = i * 2654435761u; z[1] = z[0] ^ (i << 7); z[2] = z[1] * 40503u + i; z[3] = z[2] ^ z[0]; dst[i] = z; }
  }
#endif
  const int gtid = blockIdx.x * 512 + TID, nth = gridDim.x * 512;
  const float* KT = (const float*)(p.ws + WS_KTAB);
  u16* WY = (u16*)(p.ws + WS_WYT);
  for (int i = gtid; i < (1 << 21); i += nth) {
    int k8 = i & 63, n = (i >> 6) & 511, g = (i >> 15) & 31, layer = i >> 20;
    int t = n >> 4, co = n & 15, s = k8 >> 1, ci0 = (k8 & 1) * 8;
    int tau = t - s;
    float v[8];
    if (tau > 0) {
      const float* q = KT + ((((size_t)(layer * 2 + 0) * 32 + g) * 32 + tau) * 16 + co) * 16 + ci0;
#pragma unroll
      for (int j = 0; j < 8; ++j) v[j] = q[j];
    } else if (tau < 0) {
      const float* q = KT + ((((size_t)(layer * 2 + 1) * 32 + g) * 32 - tau) * 16 + co) * 16 + ci0;
#pragma unroll
      for (int j = 0; j < 8; ++j) v[j] = q[j];
    } else {
      const float* q0 = KT + ((((size_t)(layer * 2 + 0) * 32 + g) * 32) * 16 + co) * 16 + ci0;
      const float* q1 = KT + ((((size_t)(layer * 2 + 1) * 32 + g) * 32) * 16 + co) * 16 + ci0;
#pragma unroll
      for (int j = 0; j < 8; ++j) v[j] = q0[j] + q1[j];
    }
    u32x4 o;
    o[0] = pk2(v[0], v[1]); o[1] = pk2(v[2], v[3]); o[2] = pk2(v[4], v[5]); o[3] = pk2(v[6], v[7]);
    *(u32x4*)(WY + ((size_t)((layer * 32 + g) * 512 + n)) * ASTR + k8 * 8) = o;
  }
}

DI const float* xrow(const P& p, int layer, int tok) {
  if (layer == 0) return tok < NTP ? p.in[0] + (size_t)tok * 1024 : p.in[1] + (size_t)(tok - NTP) * 1024;
  return p.out + (size_t)tok * 1024;
}
DI void phase_convert(const P& p, const float* __restrict__ src0, const float* __restrict__ src1) {
  const int TID = opaque_tid();
  const int lane = TID & 63, wave = TID >> 6;
  u16* XN = (u16*)(p.ws + WS_XN);
  float* SSQ = (float*)(p.ws + WS_SSQ);
  for (int tok = blockIdx.x * 8 + wave; tok < NT; tok += gridDim.x * 8) {
    const float* x = tok < NTP ? src0 + (size_t)tok * 1024 : src1 + (size_t)(tok - NTP) * 1024;
    float4 v[4];
    float ss = 0.f;
#pragma unroll
    for (int i = 0; i < 4; ++i) {
      v[i] = *(const float4*)(x + i * 256 + lane * 4);
      ss += v[i].x * v[i].x + v[i].y * v[i].y + v[i].z * v[i].z + v[i].w * v[i].w;
    }
#pragma unroll
    for (int o = 32; o >= 1; o >>= 1) ss += __shfl_xor(ss, o);
    if (lane < 4) SSQ[(size_t)lane * NT + tok] = lane == 0 ? ss : 0.f;
#pragma unroll
    for (int i = 0; i < 4; ++i) {
      u32x2 o;
      o[0] = pk2(v[i].x, v[i].y);
      o[1] = pk2(v[i].z, v[i].w);
      *(u32x2*)(XN + (size_t)tok * 1024 + i * 256 + lane * 4) = o;
    }
  }
}

DI void phase_scan(const P& p, int layer) {
  const int TID = opaque_tid();
  const int gtid = blockIdx.x * 512 + TID, nth = gridDim.x * 512;
  const float2* LP = (const float2*)(p.ws + WS_LPOW);
  for (int i = gtid; i < 18 * 4096; i += nth) {
    int pp = i & 63, dir = (i >> 6) & 1, g = (i >> 7) & 31, seq = i >> 12;
    int c0 = seq < 16 ? seq * 128 : 2048 + (seq - 16) * 256;
    int nc = seq < 16 ? 128 : 256;
    float2 a = LP[(size_t)(((layer * 2 + dir) * 32 + g) * 64 + pp) * 33 + 32];
    const float2* S = (const float2*)(p.ws + WS_S) + ((size_t)(g * NCH + c0) * 256 + dir * 128 + pp * 2) / 2;
    unsigned* H = (unsigned*)((u16*)(p.ws + WS_ASSM) + (size_t)(g * NCH + c0) * ASTR + 512 + dir * 128 + pp * 2);
    float hr = 0.f, hi = 0.f;
    for (int cb = 0; cb < nc; cb += 16) {
      float2 sv[16];
#pragma unroll
      for (int k = 0; k < 16; ++k) {
        const int c = dir == 0 ? cb + k : nc - 1 - cb - k;
        sv[k] = S[(size_t)c * 128];
      }
#pragma unroll
      for (int k = 0; k < 16; ++k) {
        const int c = dir == 0 ? cb + k : nc - 1 - cb - k;
        H[(size_t)c * (ASTR / 2)] = pk2(hr, hi);
        const float nr = a.x * hr - a.y * hi + sv[k].x;
        hi = a.x * hi + a.y * hr + sv[k].y;
        hr = nr;
      }
    }
  }
}

#define MFMA32(a, b, c) __builtin_amdgcn_mfma_f32_32x32x16_bf16((a), (b), (c), 0, 0, 0)
DI void attn_item(const P& pin, int layer, int seq_start, int L, int head, int qb) {
  const int TID = opaque_tid();
  struct { unsigned char* ws; } p;
  p.ws = pin.ws;
  asm volatile("" : "+s"(p.ws));
  extern __shared__ __attribute__((aligned(16))) unsigned char smem[];
  const u16* Q = (const u16*)(p.ws + WS_Q);
  const u16* KB = (const u16*)(p.ws + WS_K);
  const u16* VT = (const u16*)(p.ws + WS_VT);
  const int tid = TID, wave = tid >> 6, lane = tid & 63, r = lane & 31, h = lane >> 5;
  const int kvh = head >> 2;
  const int q0 = seq_start + qb * 512 + wave * 64;
  bf16x8 qf[2][4];
#pragma unroll
  for (int nt = 0; nt < 2; ++nt)
#pragma unroll
    for (int ds = 0; ds < 4; ++ds)
      qf[nt][ds] = gld<bf16x8>(Q + (size_t)(q0 + nt * 32 + r) * 1024 + head * 64 + ds * 16 + h * 8);
#pragma unroll
  for (int nt = 0; nt < 2; ++nt)
#pragma unroll
    for (int ds = 0; ds < 4; ++ds) asm volatile("" ::"v"(qf[nt][ds]));
  bool no_check;
  {
    float gq = fabsf(pin.in[4][layer * 64 + lane]), gk = fabsf(pin.in[5][layer * 64 + lane]);
#pragma unroll
    for (int o = 32; o >= 1; o >>= 1) { gq = fmaxf(gq, __shfl_xor(gq, o)); gk = fmaxf(gk, __shfl_xor(gk, o)); }
    no_check = __builtin_amdgcn_readfirstlane(11.5416f * 1.01f * gq * gk <= 15.5f ? 1 : 0) != 0;
  }
  const int srow = tid >> 3, spos = tid & 7, scc = spos ^ ((srow >> 1) & 7);
  const u16* kg = KB + ((size_t)kvh * NT + seq_start + srow) * 64 + scc * 8;
  const u16* vg = VT + (size_t)(kvh * 64 + srow) * NT + seq_start + scc * 8;
  unsigned char* ldst = smem + tid * 16;
  const int nkt = L >> 6;
  const int pr = ((r >> 4) * 16) + (((r >> 2) & 1) * 8) + (((r >> 3) & 1) * 4) + (r & 3);
  int koff[4];
#pragma unroll
  for (int ds = 0; ds < 4; ++ds) koff[ds] = pr * 128 + (((ds * 2 + h) ^ ((pr >> 1) & 7)) << 4);
  const int vxh = ((r >> 1) & 7) >> 1;
  const int vbase = 8192 + r * 128 + ((h ^ ((r >> 1) & 1)) << 4);

  f32x16 o[2][2];
#pragma unroll
  for (int a = 0; a < 2; ++a)
#pragma unroll
    for (int b = 0; b < 2; ++b)
#pragma unroll
      for (int j = 0; j < 16; ++j) o[a][b][j] = 0.f;
  float mrun[2] = {0.f, 0.f}, lrun[2] = {0.f, 0.f};


#define ATT_STAGE(T, B) do { GLDS(kg + (size_t)(T) * 128 * 64, ldst + (B) * 32768); GLDS(vg + (T) * 128, ldst + (B) * 32768 + 8192); \
    GLDS(kg + (size_t)(T) * 128 * 64 + 64 * 64, ldst + (B) * 32768 + 16384); GLDS(vg + (T) * 128 + 64, ldst + (B) * 32768 + 16384 + 8192); } while (0)
  const int nst = nkt >> 1;
  ATT_STAGE(0, 0);
  ATT_STAGE(1, 1);
  int bcur = 0;
  for (int st = 0; st < nst; ++st) {
    if (st + 1 < nst) { WAIT_V(4); } else { WAIT_V(0); }
    BAR;
    if (st + 2 < nst) {
      int bn = bcur + 2; if (bn >= 3) bn -= 3;
      ATT_STAGE(st + 2, bn);
    }
    const unsigned char* sbase = smem + bcur * 32768;
    auto qk = [&](const int hx, f32x16 (&sc)[2]) {
      const unsigned char* kb = sbase + (hx >> 1) * 16384 + (hx & 1) * 4096;
      bf16x8 kf[4];
#pragma unroll
      for (int ds = 0; ds < 4; ++ds) kf[ds] = *(const bf16x8*)(kb + koff[ds]);
      if (no_check) {
        f32x16 z16;
#pragma unroll
        for (int j = 0; j < 16; ++j) z16[j] = 0.f;
#pragma unroll
        for (int nt = 0; nt < 2; ++nt) sc[nt] = MFMA32(kf[0], qf[nt][0], z16);
      } else {
#pragma unroll
        for (int nt = 0; nt < 2; ++nt) {
#pragma unroll
          for (int j = 0; j < 16; ++j) sc[nt][j] = -mrun[nt];
          sc[nt] = MFMA32(kf[0], qf[nt][0], sc[nt]);
        }
      }
#pragma unroll
      for (int ds = 1; ds < 4; ++ds)
#pragma unroll
        for (int nt = 0; nt < 2; ++nt) sc[nt] = MFMA32(kf[ds], qf[nt][ds], sc[nt]);
    };
    auto sm_pv = [&](const int hx, f32x16 (&sc)[2], f32x16 (&pend)[2], const bool has_pend) {
      const bool chk = !no_check;
      const unsigned char* kb = sbase + (hx >> 1) * 16384;
      const int kt = hx & 1;
      bf16x8 vf[2][2];
#pragma unroll
      for (int s2 = 0; s2 < 2; ++s2)
#pragma unroll
        for (int mt = 0; mt < 2; ++mt) vf[s2][mt] = *(const bf16x8*)(kb + vbase + (((kt * 2 + s2) ^ vxh) << 5) + mt * 4096);
      float mx[2] = {0.f, 0.f};
      if (chk) {
#pragma unroll
        for (int nt = 0; nt < 2; ++nt) {
          float m0 = sc[nt][0];
#pragma unroll
          for (int j = 1; j < 16; ++j) m0 = fmaxf(m0, sc[nt][j]);
          mx[nt] = m0;
        }
      }
      if (chk && __any((fabsf(mx[0]) > 16.0f) | (fabsf(mx[1]) > 16.0f))) {
#pragma unroll
        for (int nt = 0; nt < 2; ++nt) {
          const float mp = fmaxf(mx[nt], __shfl_xor(mx[nt], 32));
          const float dm = (fabsf(mp) > 12.0f) ? mp : 0.0f;
          const float alpha = __builtin_amdgcn_exp2f(-dm);
          mrun[nt] += dm;
          lrun[nt] *= alpha;
#pragma unroll
          for (int j = 0; j < 16; ++j) sc[nt][j] -= dm;
          if (has_pend) {
#pragma unroll
            for (int j = 0; j < 16; ++j) pend[nt][j] -= dm;
          }
#pragma unroll
          for (int mt = 0; mt < 2; ++mt)
#pragma unroll
            for (int j = 0; j < 16; ++j) o[mt][nt][j] *= alpha;
        }
      }
#pragma unroll
      for (int nt = 0; nt < 2; ++nt) {
        float sum = 0.f;
#pragma unroll
        for (int j = 0; j < 16; ++j) { float pv = __builtin_amdgcn_exp2f(sc[nt][j]); sc[nt][j] = pv; sum += pv; }
        lrun[nt] += sum;
      }
#pragma unroll
      for (int s2 = 0; s2 < 2; ++s2) {
        bf16x8 pf[2];
#pragma unroll
        for (int nt = 0; nt < 2; ++nt) {
          u32x4 pk;
#pragma unroll
          for (int i = 0; i < 4; ++i) pk[i] = pk2(sc[nt][s2 * 8 + 2 * i], sc[nt][s2 * 8 + 2 * i + 1]);
          pf[nt] = __builtin_bit_cast(bf16x8, pk);
        }
#pragma unroll
        for (int mt = 0; mt < 2; ++mt)
#pragma unroll
          for (int nt = 0; nt < 2; ++nt) o[mt][nt] = MFMA32(vf[s2][mt], pf[nt], o[mt][nt]);
      }
    };
    f32x16 sa[2], sb[2];
    qk(0, sa);
    qk(1, sb); sm_pv(0, sa, sb, true);
    qk(2, sa); sm_pv(1, sb, sa, true);
    qk(3, sb); sm_pv(2, sa, sb, true);
    sm_pv(3, sb, sa, false);
    bcur = bcur + 1; if (bcur >= 3) bcur = 0;
  }
  unsigned char* ws2 = pin.ws;
  asm volatile("" : "+s"(ws2));
  u16* O = (u16*)(ws2 + WS_ATTO);
  const int tid2 = opaque_tid();
  const int r2 = tid2 & 31, h2 = (tid2 >> 5) & 1;
  const int q0b = seq_start + qb * 512 + (tid2 >> 6) * 64;
#pragma unroll
  for (int nt = 0; nt < 2; ++nt) {
    float l = lrun[nt] + __shfl_xor(lrun[nt], 32);
    float inv = 1.0f / l;
    const int tok = q0b + nt * 32 + r2;
#pragma unroll
    for (int mt = 0; mt < 2; ++mt)
#pragma unroll
      for (int jg = 0; jg < 4; ++jg) {
        u32x2 ov;
        ov[0] = pk2(o[mt][nt][jg * 4 + 0] * inv, o[mt][nt][jg * 4 + 1] * inv);
        ov[1] = pk2(o[mt][nt][jg * 4 + 2] * inv, o[mt][nt][jg * 4 + 3] * inv);
        gst<u32x2>(O + (size_t)tok * 1024 + head * 64 + mt * 32 + jg * 8 + h2 * 4, ov);
      }
  }
  WAIT_L(0);
  BAR;
}


enum { EK_Q = 0, EK_K, EK_V, EK_U, EK_S, EK_Y, EK_M0, EK_M1, EK_M2, EK_M3, EK_M4, EK_OUT, EK_FF1, EK_FF2 };
struct Job {
  const u16* A; const u16* Bt;
  int lda, ldb, gsB, tmB, K, kind, tm, tn, layer;
};

DI void stage_acc(AccT& acc, unsigned char* smem, const int tid, const int linear = 0) {
  const int wid = tid >> 6, lane = tid & 63, wr = wid >> 2, wc = wid & 3, fr = lane & 15, fq = lane >> 4;
#if PROBE_MASK
  if (linear) {
    int k = 0;
#pragma unroll
    for (int ai = 0; ai < 2; ++ai)
#pragma unroll
      for (int bj = 0; bj < 2; ++bj)
#pragma unroll
        for (int m = 0; m < 4; ++m)
#pragma unroll
          for (int n = 0; n < 2; ++n) {
            u32x2 w;
            w[0] = pk2(acc[ai][bj][m][n][0], acc[ai][bj][m][n][1]);
            w[1] = pk2(acc[ai][bj][m][n][2], acc[ai][bj][m][n][3]);
            *(u32x2*)(smem + tid * 8 + k * 4096) = w;
            ++k;
          }
    return;
  }
#endif
#pragma unroll
  for (int ai = 0; ai < 2; ++ai)
#pragma unroll
    for (int bj = 0; bj < 2; ++bj)
#pragma unroll
      for (int m = 0; m < 4; ++m)
#pragma unroll
        for (int n = 0; n < 2; ++n) {
          const int col = bj * 128 + wc * 32 + n * 16 + fr;
          const int row0 = ai * 128 + wr * 64 + m * 16 + fq * 4;
          u32x2 w;
          w[0] = pk2(acc[ai][bj][m][n][0], acc[ai][bj][m][n][1]);
          w[1] = pk2(acc[ai][bj][m][n][2], acc[ai][bj][m][n][3]);
          *(u32x2*)(smem + col * 512 + (((row0 >> 3) ^ (col & 31)) << 4) + ((row0 & 4) << 1)) = w;
        }
}
DI void unpack8(const u32x4 u, float* f) {
#pragma unroll
  for (int i = 0; i < 4; ++i) { f[2 * i] = __uint_as_float(u[i] << 16); f[2 * i + 1] = __uint_as_float(u[i] & 0xffff0000u); }
}
DI u32x4 pack8(const float* f) {
  u32x4 o;
#pragma unroll
  for (int i = 0; i < 4; ++i) o[i] = pk2(f[2 * i], f[2 * i + 1]);
  return o;
}

DI float bflo(unsigned u) { return __uint_as_float(u << 16); }
DI float bfhi(unsigned u) { return __uint_as_float(u & 0xffff0000u); }
DI float tok_rstd(const unsigned char* ws, int tok) {
  const float* q = (const float*)(ws + WS_SSQ) + tok;
  return rsqrtf((q[0] + q[NT] + q[2 * NT] + q[3 * (size_t)NT]) * (1.0f / 1024.0f) + 1e-6f);
}
DI void run_epilogue(const P& pin, const Job& jb, AccT& acc) {
  extern __shared__ __attribute__((aligned(16))) unsigned char smem[];
  const int TID = opaque_tid();
  P p = pin;
  asm volatile("" : "+s"(p.ws), "+s"(p.out));
  const int tm = jb.tm, tn = jb.tn, layer = jb.layer & 255, kind = jb.kind;
  const int nit = (jb.layer & 256) ? 8 : (jb.layer & 512) ? 1 : (jb.layer & 1024) ? 0 : 16;
#if PROBE_MASK
  if (kind == -1) return;
  if (kind == -3) {
    u32x4 z; z[0] = acc[0][0][0][0][0] > 1e30f ? 1u : 0u; z[1] = 2; z[2] = 3; z[3] = 4;
    for (int it = 0; it < 16; ++it) {
      const int q = it * 512 + TID;
      *(u32x4*)((u16*)(p.ws + WS_FF) + (size_t)(tn * 256 + (q >> 5)) * 4096 + tm * 256 + (q & 31) * 8) = z;
    }
    return;
  }
#endif
  if (kind == EK_S) {
    stage_acc(acc, smem, TID);
    __syncthreads();
    const int g = tn / 10, ct = tn % 10;
    const int pp = TID & 63, dir = (TID >> 6) & 1, sq = TID >> 7;
    const int nseq = ct < 8 ? 2 : 1, nc = ct < 8 ? 128 : 256;
    if (sq < nseq) {
      const float2 a = ((const float2*)(p.ws + WS_LPOW))[(size_t)(((layer * 2 + dir) * 32 + g) * 64 + pp) * 33 + 32];
      const int n = dir * 128 + pp * 2;
      unsigned* H = (unsigned*)((u16*)(p.ws + WS_ASSM) + ((size_t)g * NCH + ct * 256 + sq * nc) * ASTR + 512 + n);
      float hr = 0.f, hi = 0.f;
#pragma unroll 8
      for (int k = 0; k < nc; ++k) {
        const int c = dir == 0 ? k : nc - 1 - k;
        const int col = sq * nc + c;
        gst<unsigned>(H + (size_t)c * (ASTR / 2), pk2(hr, hi));
        const unsigned sv = *(const unsigned*)(smem + col * 512 + (((n >> 3) ^ (col & 31)) << 4) + (n & 7) * 2);
        const float nr = a.x * hr - a.y * hi + bflo(sv);
        hi = a.x * hi + a.y * hr + bfhi(sv);
        hr = nr;
      }
    }
    __syncthreads();
    return;
  }
#if PROBE_MASK
  if (jb.layer & 16384) { if (acc[1][1][3][1][3] == 12345.678f) smem[TID] = 1; }
  if (!(jb.layer & 2048))
  for (int rep = (jb.layer & 8192) ? 4 : 1; rep > 0; --rep)
#endif
  float* lrs = (float*)(smem + 131072);
  const bool need_rs = (kind <= EK_U || kind == EK_M2 || kind == EK_M3 || kind == EK_FF1) && TID < 256;
  float my_rs = 0.f;
  if (need_rs) my_rs = tok_rstd(p.ws, tn * 256 + TID);
  asm volatile("" : "+v"(my_rs));
  stage_acc(acc, smem, TID, (jb.layer & 4096) ? 1 : 0);
  if (need_rs) lrs[TID] = my_rs;
  __syncthreads();
  const bool two_pass = kind == EK_Q || kind == EK_K || kind == EK_Y || kind == EK_M1 || kind == EK_M2 || kind == EK_M4;
  if (two_pass) {
    auto slot_of = [&](const int it, int& col, int& c) -> unsigned char* {
      const int q = it * 512 + TID;
      col = q >> 5; c = q & 31;
      return smem + col * 512 + ((c ^ (col & 31)) << 4);
    };
    if (kind == EK_M1 || kind == EK_M2 || kind == EK_M4) {
      const u16* T1 = (const u16*)(p.ws + WS_Q) + (size_t)(tn * 256) * 1024 + tm * 256;
      const u16* T2 = (const u16*)(p.ws + WS_ASSM) + (size_t)(tn * 256) * 1024 + tm * 256;
      if (kind == EK_M1) {
#pragma unroll 8
        for (int it = 0; it < 16; ++it) {
          int col, c; unsigned char* sl = slot_of(it, col, c);
          float f[8], a[8], r[8];
          unpack8(gld<u32x4>(T1 + (size_t)col * 1024 + c * 8), a);
          unpack8(*(const u32x4*)sl, f);
#pragma unroll
          for (int i = 0; i < 8; ++i) r[i] = f[i] * a[i];
          *(u32x4*)sl = pack8(r);
        }
      } else if (kind == EK_M2) {
#pragma unroll 8
        for (int it = 0; it < 16; ++it) {
          int col, c; unsigned char* sl = slot_of(it, col, c);
          float f[8], a[8], r[8];
          unpack8(gld<u32x4>(T1 + (size_t)col * 1024 + c * 8), a);
          unpack8(*(const u32x4*)sl, f);
          const float tr = lrs[col];
#pragma unroll
          for (int i = 0; i < 8; ++i) r[i] = sigmoidf_(f[i] * tr) * a[i];
          *(u32x4*)sl = pack8(r);
        }
      } else {
#pragma unroll 8
        for (int it = 0; it < 16; ++it) {
          int col, c; unsigned char* sl = slot_of(it, col, c);
          float f[8], a[8], b[8], r[8];
          unpack8(gld<u32x4>(T1 + (size_t)col * 1024 + c * 8), a);
          unpack8(gld<u32x4>(T2 + (size_t)col * 1024 + c * 8), b);
          unpack8(*(const u32x4*)sl, f);
#pragma unroll
          for (int i = 0; i < 8; ++i) r[i] = b[i] * f[i] + a[i];
          *(u32x4*)sl = pack8(r);
        }
      }
    } else if (kind == EK_Y) {
      const int g = tn / 10, ch0 = (tn % 10) * 256;
      const float* dsk = p.in[14] + layer * 512 + g * 16 + (TID & 1) * 8;
      const f32x4 d0 = *(const f32x4*)dsk, d1 = *(const f32x4*)(dsk + 4);
      const u16* UU = (const u16*)(p.ws + WS_ASSM) + ((size_t)g * NCH + ch0) * ASTR + tm * 256;
#pragma unroll 8
      for (int it = 0; it < 16; ++it) {
        int col, c; unsigned char* sl = slot_of(it, col, c);
        float f[8], u[8], r[8];
        unpack8(gld<u32x4>(UU + (size_t)col * ASTR + c * 8), u);
        unpack8(*(const u32x4*)sl, f);
#pragma unroll
        for (int i = 0; i < 4; ++i) { r[i] = gelu_tanh(f[i] + d0[i] * u[i]); r[4 + i] = gelu_tanh(f[4 + i] + d1[i] * u[4 + i]); }
        *(u32x4*)sl = pack8(r);
      }
    } else {
      const float* gn = (kind == EK_Q ? p.in[4] : p.in[5]) + layer * 64 + (TID & 7) * 8;
      const f32x4 g0 = *(const f32x4*)gn, g1 = *(const f32x4*)(gn + 4);
      const float qs = (kind == EK_Q) ? 0.125f * 1.4426950408889634f : 1.0f;
      const int i0 = (TID & 7) * 4;
#pragma unroll 4
      for (int it = 0; it < 16; ++it) {
        int col, c; unsigned char* sl = slot_of(it, col, c);
        const int tok = tn * 256 + col;
        const int pos = tok < NTP ? (tok & 4095) : ((tok - NTP) & 8191);
        const float* rp = (const float*)(p.ws + WS_ROPE) + 2 * ((i0 < 16) ? (pos >> 6) * 16 + i0 : (pos & 63) * 16 + i0 - 16);
        const f32x4 cs0 = gld<f32x4>(rp), cs1 = gld<f32x4>(rp + 4);
        float f[8], r[8];
        unpack8(*(const u32x4*)sl, f);
        const float tr = lrs[col];
        float ss = 0.f;
#pragma unroll
        for (int i = 0; i < 8; ++i) { f[i] *= tr; ss += f[i] * f[i]; }
        ss += __shfl_xor(ss, 1); ss += __shfl_xor(ss, 2); ss += __shfl_xor(ss, 4);
        const float rstd = rsqrtf(ss * (1.0f / 64.0f) + 1e-6f) * qs;
        const float x0 = f[0] * rstd * g0[0], x1 = f[1] * rstd * g0[1], x2 = f[2] * rstd * g0[2], x3 = f[3] * rstd * g0[3];
        const float x4 = f[4] * rstd * g1[0], x5 = f[5] * rstd * g1[1], x6 = f[6] * rstd * g1[2], x7 = f[7] * rstd * g1[3];
        r[0] = x0 * cs0[0] - x1 * cs0[1]; r[1] = x0 * cs0[1] + x1 * cs0[0];
        r[2] = x2 * cs0[2] - x3 * cs0[3]; r[3] = x2 * cs0[3] + x3 * cs0[2];
        r[4] = x4 * cs1[0] - x5 * cs1[1]; r[5] = x4 * cs1[1] + x5 * cs1[0];
        r[6] = x6 * cs1[2] - x7 * cs1[3]; r[7] = x6 * cs1[3] + x7 * cs1[2];
        *(u32x4*)sl = pack8(r);
      }
    }
#pragma unroll 4
    for (int it = 0; it < 16; ++it) {
      int col, c; unsigned char* sl = slot_of(it, col, c);
      const u32x4 v = *(const u32x4*)sl;
      u16* dst;
      if (kind == EK_Q) dst = (u16*)(p.ws + WS_Q) + (size_t)(tn * 256 + col) * 1024 + (tm * 4 + (c >> 3)) * 64 + (c & 7) * 8;
      else if (kind == EK_K) dst = (u16*)(p.ws + WS_K) + ((size_t)(c >> 3) * NT + tn * 256 + col) * 64 + (c & 7) * 8;
      else if (kind == EK_Y) dst = (u16*)(p.ws + WS_Y) + (size_t)(tn / 10) * NT * 16 + (size_t)((tn % 10) * 256 + col) * 512 + tm * 256 + c * 8;
      else dst = (u16*)(p.ws + WS_Q) + (size_t)(tn * 256 + col) * 1024 + tm * 256 + c * 8;
      gst<u32x4>(dst, v);
    }
    __syncthreads();
    return;
  }
  if (kind == EK_OUT || kind == EK_FF2) {
    const int cc = tm * 256 + (TID & 31) * 8;
#pragma unroll 1
    for (int it0 = 0; it0 < 16; it0 += 4) {
      f32x4 X0[4], X1[4];
#pragma unroll
      for (int k = 0; k < 4; ++k) {
        const int tok = tn * 256 + (((it0 + k) * 512 + TID) >> 5);
        const float* x = (kind == EK_OUT) ? xrow(p, layer, tok) + cc : p.out + (size_t)tok * 1024 + cc;
        X0[k] = gld<f32x4>(x); X1[k] = gld<f32x4>(x + 4);
      }
#pragma unroll
      for (int k = 0; k < 4; ++k) {
        const int q = (it0 + k) * 512 + TID;
        const int col = q >> 5, c = q & 31;
        const int tok = tn * 256 + col;
        float f[8], r[8];
        unpack8(*(const u32x4*)(smem + col * 512 + ((c ^ (col & 31)) << 4)), f);
        float* o = p.out + (size_t)tok * 1024 + cc;
        f32x4 o0, o1;
        float ss = 0.f;
#pragma unroll
        for (int i = 0; i < 4; ++i) { o0[i] = X0[k][i] + f[i]; o1[i] = X1[k][i] + f[4 + i]; r[i] = o0[i]; r[4 + i] = o1[i]; ss += o0[i] * o0[i] + o1[i] * o1[i]; }
        gst<f32x4>(o, o0); gst<f32x4>(o + 4, o1);
        gst<u32x4>((u16*)(p.ws + WS_XN) + (size_t)tok * 1024 + cc, pack8(r));
        ss += __shfl_xor(ss, 1); ss += __shfl_xor(ss, 2); ss += __shfl_xor(ss, 4); ss += __shfl_xor(ss, 8); ss += __shfl_xor(ss, 16);
        if (c == 0) ((float*)(p.ws + WS_SSQ))[(size_t)tm * NT + tok] = ss;
      }
    }
    __syncthreads();
    return;
  }
#pragma unroll 2
  for (int it = 0; it < nit; ++it) {
    const int q = it * 512 + TID;
    int col = q >> 5, c = q & 31;
    if (kind == EK_U) { col = (q >> 1) & 255; c = ((q >> 9) << 1) | (q & 1); }
    const u32x4 sv = *(const u32x4*)(smem + col * 512 + ((c ^ (col & 31)) << 4));
    float f[8], r[8];
    unpack8(sv, f);
#if PROBE_MASK
    if (kind == -2) { if (f[0] > 1e30f) *(u32x4*)(p.ws + WS_FF) = sv; continue; }
#endif
    switch (kind) {
      case EK_V: {
        {
          const int tok0 = tn * 256 + c * 8;
#pragma unroll
          for (int i = 0; i < 8; ++i) r[i] = f[i] * lrs[c * 8 + i];
          gst<u32x4>((u16*)(p.ws + WS_VT) + (size_t)col * NT + tok0, pack8(r));
        }
      } break;
      case EK_U: {
        const int tok = tn * 256 + col, g = (tm - 6) * 16 + (c >> 1);
        const float tr = lrs[col];
#pragma unroll
        for (int i = 0; i < 8; ++i) r[i] = f[i] * tr;
        gst<u32x4>((u16*)(p.ws + WS_ASSM) + ((size_t)g * NCH + (tok >> 5)) * ASTR + (tok & 31) * 16 + (c & 1) * 8, pack8(r));
      } break;
      case EK_M0: case EK_M3: {
        const size_t o = (size_t)(tn * 256 + col) * 1024 + tm * 256 + c * 8;
        const float tr = (kind == EK_M3) ? lrs[col] : 1.0f;
#pragma unroll
        for (int i = 0; i < 8; ++i) r[i] = sigmoidf_(f[i] * tr);
        gst<u32x4>((kind == EK_M3 ? (u16*)(p.ws + WS_ASSM) : (u16*)(p.ws + WS_Q)) + o, pack8(r));
      } break;
      case EK_FF1: {
        const float tr = lrs[col];
#pragma unroll
        for (int i = 0; i < 8; ++i) { const float a = fmaxf(f[i] * tr, 0.f); r[i] = a * a; }
        gst<u32x4>((u16*)(p.ws + WS_FF) + ((size_t)(tn * 16 + tm) << 16) + col * 256 + c * 8, pack8(r));
      } break;
    }
  }
  __syncthreads();
}

DI void make_job(const P& pin, int layer, int s, int w, int step, Job& jb) {
  struct { unsigned char* ws; } p;
  p.ws = pin.ws;
  asm volatile("" : "+s"(p.ws));
  const u16* XN = (const u16*)(p.ws + WS_XN);
  jb.layer = layer; jb.gsB = 16; jb.tmB = 0;
  if (s == 1) {
    int g = w / 10;
    jb.A = (const u16*)(p.ws + WS_W1T) + ((size_t)layer * 32 + g) * 256 * 512;
    jb.Bt = (const u16*)(p.ws + WS_ASSM) + (size_t)w * 256 * ASTR;
    jb.lda = 512; jb.ldb = ASTR; jb.K = 512; jb.kind = EK_S; jb.tm = 0; jb.tn = w;
    return;
  }
  if (s == 3) {
    int gc = w >> 1, rt = w & 1, g = gc / 10;
    jb.A = (const u16*)(p.ws + WS_WYT) + (((size_t)layer * 32 + g) * 512 + rt * 256) * ASTR;
    jb.Bt = (const u16*)(p.ws + WS_ASSM) + (size_t)gc * 256 * ASTR;
    jb.lda = ASTR; jb.ldb = ASTR; jb.K = ASTR; jb.kind = EK_Y; jb.tm = rt; jb.tn = gc;
    return;
  }
  const int nft = (s == 0) ? 8 : (s == 6) ? 16 : 4;
  int tt, ft; tile_map(w, nft, tt, ft);
  if (s == 6) {
    const int xcd = w & 7, r = w >> 3, blk = r >> 5, i = r & 31;
    ft = (blk & 1) * 8 + (i & 7);
    tt = ((blk >> 1) * 4 + (i >> 3)) * 8 + xcd;
  }
  jb.tm = ft; jb.tn = tt;
  jb.lda = 1024; jb.ldb = 1024; jb.K = 1024;
  if (s == 0) {
    const u16* W = (const u16*)(p.ws + WS_WT_IN) + (size_t)layer * 4096 * 1024 + (size_t)ft * 256 * 1024;
    const u16* X = XN + (size_t)tt * 256 * 1024;
    if (ft == 5) { jb.A = X; jb.Bt = W; jb.kind = EK_V; }
    else { jb.A = W; jb.Bt = X; jb.kind = ft < 4 ? EK_Q : ft == 4 ? EK_K : EK_U; }
  } else if (s == 4) {
    jb.kind = EK_M0 + step;
    if (step < 2) {
      jb.A = (const u16*)(p.ws + (step == 0 ? WS_WT_GB : WS_WT_GA)) + (size_t)layer * 1024 * 512 + (size_t)ft * 256 * 512;
      jb.Bt = (const u16*)(p.ws + WS_Y) + (size_t)tt * 256 * 16;
      jb.lda = 512; jb.ldb = 16; jb.gsB = NT * 16; jb.K = 512;
    } else if (step < 4) {
      jb.A = (const u16*)(p.ws + WS_WT_IN) + (size_t)layer * 4096 * 1024 + (size_t)((step == 2 ? 3072 : 2048) + ft * 256) * 1024;
      jb.Bt = XN + (size_t)tt * 256 * 1024;
    } else {
      jb.A = (const u16*)(p.ws + WS_WT_AP) + (size_t)layer * 1024 * 1024 + (size_t)ft * 256 * 1024;
      jb.Bt = (const u16*)(p.ws + WS_ATTO) + (size_t)tt * 256 * 1024;
    }
  } else if (s == 5) {
    jb.A = (const u16*)(p.ws + WS_WT_OUT) + (size_t)layer * 1024 * 1024 + (size_t)ft * 256 * 1024;
    jb.Bt = (const u16*)(p.ws + WS_Q) + (size_t)tt * 256 * 1024; jb.kind = EK_OUT;
  } else if (s == 6) {
    jb.A = (const u16*)(p.ws + WS_WT_FF1) + (size_t)layer * 4096 * 1024 + (size_t)ft * 256 * 1024;
    jb.Bt = XN + (size_t)tt * 256 * 1024; jb.kind = EK_FF1;
  } else {
    jb.A = (const u16*)(p.ws + WS_WT_FF2) + (size_t)layer * 1024 * 4096 + (size_t)ft * 256 * 4096;
    jb.Bt = (const u16*)(p.ws + WS_FF) + ((size_t)tt * 16 << 16);
    jb.lda = 4096; jb.ldb = 256; jb.tmB = 1; jb.K = 4096; jb.kind = EK_FF2;
  }
}

DI void phase_jobs(const P& p, int layer, int s, int probe = 0) {
  int nitems, nsteps = 1, nattn = 0;
  switch (s) {
    case 0: nitems = 2560; break;
    case 1: nitems = 320; break;
    case 3: nitems = 3200; nattn = 2560; break;
    case 4: nitems = 1280; nsteps = 5; break;
    case 5: nitems = 1280; break;
    case 6: nitems = 5120; break;
    default: nitems = 1280; break;
  }
#if STAGGER_SLEEP
  if (s != 3) {
    const int slot = (blockIdx.x >> 3) & 31;
    for (int i = 0; i < slot; ++i) __builtin_amdgcn_s_sleep(STAGGER_SLEEP);
  }
#endif
  for (int w = blockIdx.x; w < nitems; w += gridDim.x) {
    if (w < nattn) {
      int seq_start, L, head, qb;
      if (w < 512) {
        int xcd = w & 7, r = w >> 3;
        int seq = xcd >> 2, kvh = xcd & 3;
        seq_start = NTP + seq * 8192; L = 8192; head = kvh * 4 + (r >> 4); qb = r & 15;
      } else {
        int w2 = w - 512, xcd = w2 & 7, r = w2 >> 3;
        int grp = (r >> 5) * 8 + xcd, within = r & 31;
        int seq = grp >> 2, kvh = grp & 3;
        seq_start = seq * 4096; L = 4096; head = kvh * 4 + (within >> 3); qb = within & 7;
      }
      attn_item(p, layer, seq_start, L, head, qb);
    } else {
      for (int step = 0; step < nsteps; ++step) {
        Job jb;
        make_job(p, layer, s, w - nattn, step, jb);
#if PROBE_MASK
        if (probe == 2 || probe == 3) jb.kind = -1;
        if (probe == 3) jb.K = jb.K / 2;
#endif
        gemm_tile(jb.A, jb.Bt, jb.lda, jb.ldb, jb.gsB, jb.tmB, jb.K, [&](AccT& acc) {
          int w2 = w - nattn, st2 = step;
          asm volatile("" : "+s"(w2), "+s"(st2));
          Job j2;
          make_job(p, layer, s, w2, st2, j2);
#if PROBE_MASK
          if (probe == 2 || probe == 3) j2.kind = -1;
          if (probe == 4) j2.kind = -2;
          if (probe == 6) j2.layer |= 256;
          if (probe == 7) j2.layer |= 512;
          if (probe == 8) j2.layer |= 1024 | 2048;
          if (probe == 9) j2.layer |= 1024;
          if (probe == 10) j2.layer |= 1024 | 4096;
          if (probe == 11) j2.layer |= 1024 | 8192;
          if (probe == 12) j2.layer |= 1024 | 2048 | 16384;
          if (probe == 5) j2.kind = -3;
#endif
          run_epilogue(p, j2, acc);
        });
      }
    }
  }
}

DI void run_phase(const P& pin, int ph, int probe = 0) {
  P p = pin;
  asm volatile("" : "+s"(p.ws), "+s"(p.out));
  int layer = (ph - 3) / 8, s = (ph - 3) % 8;
  if (s == 2) phase_scan(p, layer);
  else phase_jobs(p, layer, s, probe);
}

constexpr size_t WS_BAR = WS_ROPE + 512 * 1024;
#define XB_XCNT(j) (256 + 64 * (j))
#define XB_XSUB(j) (1280 + 64 * (j))
#define XB_XGEN(j) (2304 + 64 * (j))
#define XB_TOP 3328
#define XB_TOPGEN 3392
#define XB_WORDS 3456
DI unsigned xb_ld(unsigned* q) { return __hip_atomic_load(q, __ATOMIC_RELAXED, __HIP_MEMORY_SCOPE_AGENT); }
DI unsigned xb_add(unsigned* q, unsigned v) { return __hip_atomic_fetch_add(q, v, __ATOMIC_RELAXED, __HIP_MEMORY_SCOPE_AGENT); }
DI unsigned xb_xcc_id() { return (unsigned)__builtin_amdgcn_s_getreg((3 << 11) | 20) & 0xFu; }
#define XB_SPIN(cond) do { unsigned _sp = 0; while ((cond) && ++_sp < (1u << 22)) __builtin_amdgcn_s_sleep(1); } while (0)
DI void xcd_bar(unsigned char* ws) {
  unsigned* bar = (unsigned*)(ws + WS_BAR);
  const unsigned x = xb_xcc_id();
  extern __shared__ __attribute__((aligned(16))) unsigned char smem[];
  asm volatile("s_waitcnt vmcnt(0)" ::: "memory");
  __syncthreads();
  if (threadIdx.x == 0) {
    __builtin_amdgcn_s_waitcnt(0);
    volatile unsigned* st = (volatile unsigned*)(smem + 132096);
    const unsigned nloc = st[0], nx = st[1];
    const unsigned old = xb_add(&bar[XB_XSUB(x)], 1u);
    const unsigned gen = old / nloc;
    if (old + 1u == (gen + 1u) * nloc) {
      __builtin_amdgcn_fence(__ATOMIC_RELEASE, "agent");
      asm volatile("s_waitcnt vmcnt(0)" ::: "memory");
      const unsigned og = xb_add(&bar[XB_TOP], 1u);
      const unsigned tg = og / nx;
      if (og + 1u == (tg + 1u) * nx) xb_add(&bar[XB_TOPGEN], 1u);
      else XB_SPIN(xb_ld(&bar[XB_TOPGEN]) == tg);
      __builtin_amdgcn_fence(__ATOMIC_ACQUIRE, "agent");
      xb_add(&bar[XB_XGEN(x)], 1u);
      asm volatile("s_waitcnt vmcnt(0)" ::: "memory");
    } else {
      XB_SPIN(xb_ld(&bar[XB_XGEN(x)]) == gen);
      __builtin_amdgcn_fence(__ATOMIC_ACQUIRE, "agent");
      asm volatile("s_waitcnt vmcnt(0)" ::: "memory");
    }
  }
  __syncthreads();
}

__global__ void __launch_bounds__(512, 2) mega_coop(P p) {
  cg::grid_group grid = cg::this_grid();
  if (threadIdx.x == 0) (void)xb_add(&((unsigned*)(p.ws + WS_BAR))[XB_XCNT(xb_xcc_id())], 1u);
  phase_prep_a(p);
  phase_convert(p, p.in[0], p.in[1]);
  grid.sync();
  if (threadIdx.x == 0) {
    extern __shared__ __attribute__((aligned(16))) unsigned char smem_[];
    unsigned* bar = (unsigned*)(p.ws + WS_BAR);
    const unsigned xcc = xb_xcc_id();
    unsigned mine = 0, cnt = 0;
    for (unsigned j = 0; j < 16; ++j) { const unsigned c = xb_ld(&bar[XB_XCNT(j)]); cnt += c > 0u ? 1u : 0u; mine = j == xcc ? c : mine; }
    volatile unsigned* st = (volatile unsigned*)(smem_ + 132096);
    st[0] = mine > 0u ? mine : 1u; st[1] = cnt > 0u ? cnt : 1u;
  }
  __syncthreads();
#if USE_XCD_BAR
#define SEAM() xcd_bar(p.ws)
#else
#define SEAM() grid.sync()
#endif
  for (int ph = 3; ph < NPHASE; ++ph) {
    if ((ph - 3) % 8 == 2) continue;
    run_phase(p, ph);
    if (ph == 3) phase_prep_b(p);
    if (ph == 4) phase_prep_c(p);
#if PROBE_MASK
    {
      const int s_ = (ph - 3) % 8;
      bool rep = false;
      if ((PROBE_MASK & 1) && s_ == 3) rep = true;
      if ((PROBE_MASK & 2) && (s_ == 0 || s_ == 4 || s_ == 6)) rep = true;
      if ((PROBE_MASK & 4) && (s_ == 1 || s_ == 2)) rep = true;
      if ((PROBE_MASK & 8) && s_ == 6) run_phase(p, ph, (PROBE_MASK >> 4));
      if (rep) run_phase(p, ph);
    }
#endif
    if (ph + 1 < NPHASE) SEAM();
  }
}
#if N_LAUNCH_MODE == 0
__global__ void __launch_bounds__(512, 2) mega_one(P p) {
  run_phase(p, p.ph_lo);
}
#endif

extern "C" void kernel_launch(void* const* d_in, const int* in_sizes, int n_in, void* d_out, int out_size, void* d_ws, size_t ws_size,
                              hipStream_t stream) {
  static int grid = 0;
  if (grid == 0) {
    if (n_in != 21 || ws_size < WS_END) { fprintf(stderr, "kernel_launch: unexpected n_in %d / ws_size %zu (need %zu)\n", n_in, ws_size, (size_t)WS_END); grid = -1; return; }
    int dev = 0, cus = 0, per_cu = 0;
    hipGetDevice(&dev);
    hipDeviceGetAttribute(&cus, hipDeviceAttributeMultiprocessorCount, dev);
    hipFuncSetAttribute((const void*)mega_coop, hipFuncAttributeMaxDynamicSharedMemorySize, LDS_BYTES);
#if N_LAUNCH_MODE == 0
    hipFuncSetAttribute((const void*)mega_one, hipFuncAttributeMaxDynamicSharedMemorySize, LDS_BYTES);
#endif
    hipOccupancyMaxActiveBlocksPerMultiprocessor(&per_cu, (const void*)mega_coop, 512, LDS_BYTES);
    if (per_cu < 1) { fprintf(stderr, "kernel_launch: occupancy query says %d blocks/CU\n", per_cu); per_cu = 1; }
    (void)hipGetLastError();
    grid = cus * 1;
  }
  if (grid < 0) return;
  P p{};
  for (int i = 0; i < 21; ++i) p.in[i] = (const float*)d_in[i];
  p.out = (float*)d_out;
  p.ws = (unsigned char*)d_ws;
#if N_LAUNCH_MODE == 1
  p.ph_lo = 0; p.ph_hi = NPHASE;
  void* args[] = {&p};
  if (hipMemsetAsync((unsigned char*)d_ws + WS_BAR, 0, 16384, stream) != hipSuccess) { fprintf(stderr, "kernel_launch: barrier memset failed\n"); return; }
  hipError_t e = hipLaunchCooperativeKernel((const void*)mega_coop, dim3(grid), dim3(512), args, LDS_BYTES, stream);
  if (e != hipSuccess) fprintf(stderr, "cooperative launch failed: %s (grid %d)\n", hipGetErrorString(e), grid);
#else
  for (int ph = 0; ph < NPHASE; ++ph) {
    p.ph_lo = ph; p.ph_hi = ph + 1;
    hipLaunchKernelGGL(mega_one, dim3(grid), dim3(512), LDS_BYTES, stream, p);
  }
#endif
}
```
